# Optimizing an MI355X kernel written in HIP

```python
import math
import jax, jax.numpy as jnp
from jax import lax
import numpy as np

D_MODEL = 1024
BATCH = 16
SEQ = 4096
DEPTH = 4

MLA_HEADS = 8
MLA_Q_LORA = 256
MLA_KV_LORA = 128
MLA_NOPE = 64
MLA_ROPE = 32
MLA_V = 64
MLA_QK = MLA_NOPE + MLA_ROPE
ROPE_THETA = 10000.0
Q_BLOCK = 128
DIL_HEADS = 8
DIL_HEAD_DIM = 64
DIL_PATTERNS = ((128, 1), (512, 4), (2048, 16))
REL_BUCKETS = 32
REL_MAX_DIST = 1024
FFN_HIDDEN = -(-8 * D_MODEL // (3 * 256)) * 256
EPS = 1e-6
NEG_INF = -1e30
IN_SIZES = (MLA_Q_LORA, MLA_KV_LORA, MLA_ROPE, 3 * DIL_HEADS * DIL_HEAD_DIM, D_MODEL, D_MODEL)
IN_COLS = sum(IN_SIZES)
IN_SPLIT = tuple(int(s) for s in np.cumsum(IN_SIZES)[:-1])

kernel_name = 'hybrid_mla_dilated_encoder'


def rmsnorm(x, g):
    x32 = x.astype(jnp.float32)
    r = lax.rsqrt(jnp.mean(x32 * x32, axis=-1, keepdims=True) + EPS)
    return (x32 * r).astype(x.dtype) * g


def modulate(h, shift, scale):
    return h * (1.0 + scale[:, None, :]) + shift[:, None, :]


def rope_tables(positions, dtype):
    half = MLA_ROPE // 2
    inv = ROPE_THETA ** (-jnp.arange(half, dtype=jnp.float32) / half)
    ang = positions.astype(jnp.float32)[..., None] * inv
    return jnp.cos(ang)[:, :, None, :].astype(dtype), jnp.sin(ang)[:, :, None, :].astype(dtype)


def apply_rope(x, cos, sin):
    half = x.shape[-1] // 2
    x1, x2 = x[..., :half], x[..., half:]
    return jnp.concatenate([x1 * cos - x2 * sin, x2 * cos + x1 * sin], axis=-1)


def t5_bucket(rel):
    nb = REL_BUCKETS // 2
    max_exact = nb // 2
    ret = jnp.where(rel > 0, nb, 0)
    n = jnp.abs(rel)
    nf = jnp.maximum(n, 1).astype(jnp.float32)
    large = max_exact + (jnp.log(nf / max_exact) / math.log(REL_MAX_DIST / max_exact) * (nb - max_exact)).astype(jnp.int32)
    large = jnp.minimum(large, nb - 1)
    return ret + jnp.where(n < max_exact, n, large)


def mla_attention(q_c, kv_c, k_rope, cos, sin, q_a_norm, w_q_b, kv_a_norm, w_kv_b, q_norm, k_norm):
    B, S, _ = q_c.shape
    q = (rmsnorm(q_c, q_a_norm) @ w_q_b).reshape(B, S, MLA_HEADS, MLA_QK)
    kv = (rmsnorm(kv_c, kv_a_norm) @ w_kv_b).reshape(B, S, MLA_HEADS, MLA_NOPE + MLA_V)
    k_nope, v = kv[..., :MLA_NOPE], kv[..., MLA_NOPE:]
    k = jnp.concatenate([k_nope, jnp.broadcast_to(k_rope[:, :, None, :], (B, S, MLA_HEADS, MLA_ROPE))], axis=-1)
    q = rmsnorm(q, q_norm)
    k = rmsnorm(k, k_norm)
    q = jnp.concatenate([q[..., :MLA_NOPE], apply_rope(q[..., MLA_NOPE:], cos, sin)], axis=-1)
    k = jnp.concatenate([k[..., :MLA_NOPE], apply_rope(k[..., MLA_NOPE:], cos, sin)], axis=-1)
    scale = MLA_QK ** -0.5
    n_blk = S // Q_BLOCK
    qb = q.reshape(B, n_blk, Q_BLOCK, MLA_HEADS, MLA_QK).transpose(1, 0, 2, 3, 4)

    def attend(qi):
        s = jnp.einsum('bqhd,bkhd->bhqk', qi, k).astype(jnp.float32) * scale
        p = jax.nn.softmax(s, axis=-1).astype(v.dtype)
        return jnp.einsum('bhqk,bkhd->bqhd', p, v)

    o = lax.map(attend, qb)
    return o.transpose(1, 0, 2, 3, 4).reshape(B, S, MLA_HEADS * MLA_V)


def strided_band_attention(q, k, v, dil, half, rel_bias):
    B, S, H, dh = q.shape
    L = S // dil
    W = half
    n = -(-L // W)
    Lp = n * W

    def to_sub(t):
        return t.reshape(B, L, dil, H, dh).transpose(0, 2, 3, 1, 4)

    qb = jnp.pad(to_sub(q), ((0, 0), (0, 0), (0, 0), (0, Lp - L), (0, 0))).reshape(B, dil, H, n, W, dh)
    kv_pad = ((0, 0), (0, 0), (0, 0), (W, Lp - L + W), (0, 0))

    def bands(t):
        tb = jnp.pad(to_sub(t), kv_pad).reshape(B, dil, H, n + 2, W, dh)
        return jnp.concatenate([tb[:, :, :, :-2], tb[:, :, :, 1:-1], tb[:, :, :, 2:]], axis=-2)

    kb, vb = bands(k), bands(v)
    s = jnp.einsum('brhnqd,brhnkd->brhnqk', qb, kb).astype(jnp.float32) * (dh ** -0.5)
    qi = jnp.arange(W)[:, None]
    ki = jnp.arange(3 * W)[None, :]
    rel = ki - W - qi
    key_idx = jnp.arange(n)[:, None, None] * W + ki[None] - W
    valid = (jnp.abs(rel) <= W)[None] & (key_idx >= 0) & (key_idx < L)
    bias = rel_bias[t5_bucket(rel * dil)].astype(jnp.float32).transpose(2, 0, 1)
    s = jnp.where(valid, s + bias[:, None], NEG_INF)
    m = jnp.max(s, axis=-1, keepdims=True)
    p = jnp.exp(s - m)
    den = jnp.sum(p, axis=-1)
    o = jnp.einsum('brhnqk,brhnkd->brhnqd', p, vb.astype(jnp.float32)) / den[..., None]
    lse = m[..., 0] + jnp.log(den)
    o = o.reshape(B, dil, H, Lp, dh)[:, :, :, :L].transpose(0, 3, 1, 2, 4).reshape(B, S, H, dh)
    lse = lse.reshape(B, dil, H, Lp)[..., :L].transpose(0, 3, 1, 2).reshape(B, S, H)
    return o, lse


def dilated_attention(qkv, rel_bias, q_norm, k_norm):
    B, S, _ = qkv.shape
    qkv = qkv.reshape(B, S, 3, DIL_HEADS, DIL_HEAD_DIM)
    q = rmsnorm(qkv[:, :, 0], q_norm)
    k = rmsnorm(qkv[:, :, 1], k_norm)
    v = qkv[:, :, 2]
    outs, lses = [], []
    for window, dil in DIL_PATTERNS:
        o, lse = strided_band_attention(q, k, v, dil, window // (2 * dil), rel_bias)
        outs.append(o)
        lses.append(lse)
    w = jax.nn.softmax(jnp.stack(lses, axis=0), axis=0)
    y = jnp.einsum('pbsh,pbshd->bshd', w, jnp.stack(outs, axis=0))
    return y.reshape(B, S, DIL_HEADS * DIL_HEAD_DIM).astype(qkv.dtype)


def swiglu(h, w_gate, w_up, w_down):
    return (jax.nn.silu(h @ w_gate) * (h @ w_up)) @ w_down


def setup_inputs(seed: int = 0) -> dict:
    key = jax.random.key(seed)
    ks = jax.random.split(key, 24)
    f32 = jnp.float32

    def w(k, shape, fan_in):
        return jax.random.normal(k, shape, f32) * (fan_in ** -0.5)

    def gain(k, shape):
        return 1.0 + 0.02 * jax.random.normal(k, shape, f32)

    return {
        'x': jax.random.normal(ks[0], (BATCH, SEQ, D_MODEL), f32),
        'c': jax.random.normal(ks[1], (BATCH, D_MODEL), f32),
        'positions': jax.random.randint(ks[2], (BATCH, 1), 0, 1024, dtype=jnp.int32) + jnp.arange(SEQ, dtype=jnp.int32)[None, :],
        'rel_bias': 0.5 * jax.random.normal(ks[3], (REL_BUCKETS, DIL_HEADS), f32),
        'norm1_g': gain(ks[4], (DEPTH, D_MODEL)),
        'norm2_g': gain(ks[5], (DEPTH, D_MODEL)),
        'ada_w': 0.5 * w(ks[6], (DEPTH, D_MODEL, 6 * D_MODEL), D_MODEL),
        'ada_b': 0.02 * jax.random.normal(ks[7], (DEPTH, 6 * D_MODEL), f32),
        'w_in': w(ks[8], (DEPTH, D_MODEL, IN_COLS), D_MODEL),
        'q_a_norm': gain(ks[9], (DEPTH, MLA_Q_LORA)),
        'w_q_b': w(ks[10], (DEPTH, MLA_Q_LORA, MLA_HEADS * MLA_QK), MLA_Q_LORA),
        'kv_a_norm': gain(ks[11], (DEPTH, MLA_KV_LORA)),
        'w_kv_b': w(ks[12], (DEPTH, MLA_KV_LORA, MLA_HEADS * (MLA_NOPE + MLA_V)), MLA_KV_LORA),
        'q_norm_a': gain(ks[13], (DEPTH, MLA_QK)),
        'k_norm_a': gain(ks[14], (DEPTH, MLA_QK)),
        'q_norm_b': gain(ks[15], (DEPTH, DIL_HEAD_DIM)),
        'k_norm_b': gain(ks[16], (DEPTH, DIL_HEAD_DIM)),
        'w_branch_a': w(ks[17], (DEPTH, MLA_HEADS * MLA_V, D_MODEL), MLA_HEADS * MLA_V),
        'w_branch_b': w(ks[18], (DEPTH, DIL_HEADS * DIL_HEAD_DIM, D_MODEL), DIL_HEADS * DIL_HEAD_DIM),
        'w_out': w(ks[19], (DEPTH, D_MODEL, D_MODEL), D_MODEL),
        'w_ffn_gate': w(ks[20], (DEPTH, D_MODEL, FFN_HIDDEN), D_MODEL),
        'w_ffn_up': w(ks[21], (DEPTH, D_MODEL, FFN_HIDDEN), D_MODEL),
        'w_ffn_down': w(ks[22], (DEPTH, FFN_HIDDEN, D_MODEL), FFN_HIDDEN),
    }


def reference(x, c, positions, rel_bias, norm1_g, norm2_g, ada_w, ada_b, w_in, q_a_norm, w_q_b,
              kv_a_norm, w_kv_b, q_norm_a, k_norm_a, q_norm_b, k_norm_b, w_branch_a, w_branch_b,
              w_out, w_ffn_gate, w_ffn_up, w_ffn_down):
    cos, sin = rope_tables(positions, x.dtype)
    c_act = jax.nn.silu(c)
    for l in range(DEPTH):
        mod = c_act @ ada_w[l] + ada_b[l]
        sh1, sc1, g1, sh2, sc2, g2 = jnp.split(mod, 6, axis=-1)
        h = modulate(rmsnorm(x, norm1_g[l]), sh1, sc1)
        proj = h @ w_in[l]
        q_c, kv_c, k_r, qkv_b, gate_a, gate_b = jnp.split(proj, IN_SPLIT, axis=-1)
        y_a = mla_attention(q_c, kv_c, k_r, cos, sin, q_a_norm[l], w_q_b[l], kv_a_norm[l], w_kv_b[l],
                            q_norm_a[l], k_norm_a[l])
        y_b = dilated_attention(qkv_b, rel_bias, q_norm_b[l], k_norm_b[l])
        merged = jax.nn.sigmoid(gate_a) * (y_a @ w_branch_a[l]) + jax.nn.sigmoid(gate_b) * (y_b @ w_branch_b[l])
        x = x + g1[:, None, :] * (merged @ w_out[l])
        h = modulate(rmsnorm(x, norm2_g[l]), sh2, sc2)
        x = x + g2[:, None, :] * swiglu(h, w_ffn_gate[l], w_ffn_up[l], w_ffn_down[l])
    return x
```

```cpp
#include <hip/hip_runtime.h>
#include <hip/hip_cooperative_groups.h>
#include <cstdio>
#include <cstdint>
namespace cg = cooperative_groups;
__device__ __forceinline__ int otid() { int t = (int)threadIdx.x; asm volatile("" : "+v"(t)); return t; }
__device__ __forceinline__ int obid() { int b = (int)blockIdx.x; asm volatile("" : "+s"(b)); return b; }

#include <cmath>
namespace pg8 {
#define PG8_LAS __attribute__((address_space(3)))
typedef unsigned short bf16_t;
typedef short bf16x8 __attribute__((ext_vector_type(8)));
typedef float f32x4 __attribute__((ext_vector_type(4)));
typedef unsigned u32x4 __attribute__((ext_vector_type(4)));
constexpr int BM = 256, BK = 64, HALF = 128, HTB = HALF * BK * 2  , STAGE_BYTES = 8 * HTB, NXCD = 8, WGM = 8;

__host__ __device__ __forceinline__ int lds_byte(int r, int c) { const int st = (r >> 4) * 2 + (c >> 5), rr = r & 15, cc = c & 31, ob = rr * 64 + cc * 2; return st * 1024 + (ob ^ (((ob >> 9) & 1) << 5)); }
__host__ __device__ __forceinline__ void stage_rc(int b, int& R, int& C) { const int st = b / 1024, sb = b % 1024, swz = sb ^ (((sb >> 9) & 1) << 5); R = (st >> 1) * 16 + swz / 64; C = (st & 1) * 32 + (swz % 64) / 2; }
__host__ __device__ __forceinline__ int perm32(int rho) { const int n = rho >> 4, i = rho & 15; return 8 * (i >> 2) + 4 * n + (i & 3); }

struct Unit { int pm, pn; };
struct Gemm { const bf16_t* A; const bf16_t* Bt; int M, N, K, lda; };

struct StaticOrder {
    int nM, nN, nwg, G, c;
    __host__ __device__ void init(int M, int N, int G_, int c_) { nM = M / BM; nN = N / BM; nwg = nM * nN; G = G_; c = c_; }
    __host__ __device__ bool next(int i, Unit& u) const {
        const long L = (long)i * G + c; if (L >= nwg) return false;
        int wgid = (int)L; { const int q = nwg / NXCD, r = nwg % NXCD, xcd = wgid % NXCD, off = wgid / NXCD; wgid = (xcd < r ? xcd * (q + 1) : r * (q + 1) + (xcd - r) * q) + off; }
        const int nig = WGM * nN, gid = wgid / nig, fm = gid * WGM, gsz = (nM - fm) < WGM ? (nM - fm) : WGM;
        u.pm = fm + ((wgid % nig) % gsz); u.pn = (wgid % nig) / gsz; return true;
    }
    __device__ __forceinline__ void a_ready(const Unit&) const {}
    __device__ __forceinline__ void done(const Unit&) const {}
};


__device__ __forceinline__ unsigned cvt_pk_bf16(float lo, float hi) { unsigned r; asm volatile("v_cvt_pk_bf16_f32 %0, %1, %2" : "=v"(r) : "v"(lo), "v"(hi)); return r; }
typedef unsigned u32x2 __attribute__((ext_vector_type(2)));
__device__ __forceinline__ float bf_lo(unsigned w) { return __builtin_bit_cast(float, w << 16); }
__device__ __forceinline__ float bf_hi(unsigned w) { return __builtin_bit_cast(float, w & 0xffff0000u); }
__device__ __forceinline__ float sigmoidf_(float x) { return 1.0f / (1.0f + __builtin_amdgcn_exp2f(-1.4426950408889634f * x)); }

constexpr float RMS_EPS = 1e-6f;
constexpr size_t DPLANE = (size_t)65536 * 512;
constexpr float LOG2E = 1.4426950408889634f;
constexpr float QSCALE_B = 0.125f * 1.4426950408889634f;
constexpr float QSCALE_A = 0.10206207261596575f * 1.4426950408889634f;

struct EpiIn {
    static constexpr bool PERM = false, AFTER_DRAIN = false, MIDHOOK = false;
    bf16_t* PA; bf16_t* DIL; bf16_t* GATES; float* ssq_q; float* ssq_kv; const float* qn; const float* kn; const float* ssq1; const float* bw;
    __device__ __forceinline__ void operator()(const f32x4 (&acc_)[2][2][4][2], const Unit& u, int wr, int wc, int fr, int fq) const {
        { const int ln_ = otid() & 63; fr = ln_ & 15; fq = ln_ >> 4; }
        const int pn = u.pn; const size_t rowb = (size_t)u.pm * BM + wr * 64 + fr;
        f32x4 bv[2][2]; float r8[2][4];
        { const float* bwp = bw + (size_t)(u.pm >> 4) * 4096 + pn * BM + wc * 32 + fq * 4;
#pragma unroll
          for (int bj = 0; bj < 2; ++bj)
#pragma unroll
              for (int n = 0; n < 2; ++n) bv[bj][n] = *(const f32x4*)(bwp + bj * HALF + n * 16);
#pragma unroll
          for (int ai = 0; ai < 2; ++ai)
#pragma unroll
              for (int m = 0; m < 4; ++m) r8[ai][m] = __builtin_amdgcn_rsqf(ssq1[rowb + ai * HALF + m * 16] * (1.0f / 1024.0f) + RMS_EPS); }
#define EPIIN_VAL(ai, bj, m, n) (acc_[ai][bj][m][n] * r8[ai][m] + bv[bj][n])
        if (pn < 2) {
            float* sq = pn == 0 ? ssq_q : ssq_kv;
#pragma unroll
            for (int ai = 0; ai < 2; ++ai)
#pragma unroll
                for (int m = 0; m < 4; ++m) { const size_t row = rowb + ai * HALF + m * 16; float s = 0.f;
#pragma unroll
                    for (int bj = 0; bj < 2; ++bj)
#pragma unroll
                        for (int n = 0; n < 2; ++n) { const f32x4 v = EPIIN_VAL(ai, bj, m, n);
                            u32x2 w; w.x = cvt_pk_bf16(v[0], v[1]); w.y = cvt_pk_bf16(v[2], v[3]);
                            *(u32x2*)(PA + row * 512 + pn * 256 + bj * HALF + wc * 32 + n * 16 + fq * 4) = w;
                            if (pn == 0 || bj == 0) s += (v[0] * v[0] + v[1] * v[1]) + (v[2] * v[2] + v[3] * v[3]); }
                    s += __shfl_xor(s, 16); s += __shfl_xor(s, 32);
                    if (fq == 0) atomicAdd(sq + row, s); }
        } else if (pn < 6) {
            const int sec = (pn - 2) >> 1, head = 4 * ((pn - 2) & 1) + wc; const float* gp = sec == 0 ? qn : kn; const float gs = sec == 0 ? QSCALE_B : 1.0f;
            f32x4 gv[2][2];
#pragma unroll
            for (int bj = 0; bj < 2; ++bj)
#pragma unroll
                for (int n = 0; n < 2; ++n) gv[bj][n] = *(const f32x4*)(gp + 32 * bj + 16 * n + 4 * fq) * gs;
#pragma unroll
            for (int ai = 0; ai < 2; ++ai)
#pragma unroll
                for (int m = 0; m < 4; ++m) { const size_t row = rowb + ai * HALF + m * 16; float s = 0.f;
#pragma unroll
                    for (int bj = 0; bj < 2; ++bj)
#pragma unroll
                        for (int n = 0; n < 2; ++n) { const f32x4 v = EPIIN_VAL(ai, bj, m, n); s += (v[0] * v[0] + v[1] * v[1]) + (v[2] * v[2] + v[3] * v[3]); }
                    s += __shfl_xor(s, 16); s += __shfl_xor(s, 32);
                    const float r = __builtin_amdgcn_rsqf(s * (1.0f / 64.0f) + RMS_EPS);
#pragma unroll
                    for (int bj = 0; bj < 2; ++bj)
#pragma unroll
                        for (int n = 0; n < 2; ++n) { const f32x4 v = EPIIN_VAL(ai, bj, m, n) * r * gv[bj][n];
                            u32x2 w; w.x = cvt_pk_bf16(v[0], v[1]); w.y = cvt_pk_bf16(v[2], v[3]);
                            *(u32x2*)(DIL + (size_t)sec * DPLANE + ((((row >> 12) * 8 + head) << 12) + (row & 4095)) * 64 + 32 * bj + 16 * n + 4 * fq) = w; } }
        } else if (pn < 8) {
#pragma unroll
            for (int ai = 0; ai < 2; ++ai)
#pragma unroll
                for (int m = 0; m < 4; ++m) { const size_t row = rowb + ai * HALF + m * 16;
#pragma unroll
                    for (int bj = 0; bj < 2; ++bj)
#pragma unroll
                        for (int n = 0; n < 2; ++n) { const f32x4 v = EPIIN_VAL(ai, bj, m, n);
                            u32x2 w; w.x = cvt_pk_bf16(v[0], v[1]); w.y = cvt_pk_bf16(v[2], v[3]);
                            *(u32x2*)(DIL + 2 * DPLANE + ((((row >> 12) * 8 + (pn - 6) * 4 + 2 * bj + (wc >> 1)) << 12) + (row & 4095)) * 64 + 32 * (wc & 1) + n * 16 + fq * 4) = w; } }
        } else {
#pragma unroll
            for (int ai = 0; ai < 2; ++ai)
#pragma unroll
                for (int m = 0; m < 4; ++m) { const size_t row = rowb + ai * HALF + m * 16;
#pragma unroll
                    for (int bj = 0; bj < 2; ++bj)
#pragma unroll
                        for (int n = 0; n < 2; ++n) { const f32x4 v = EPIIN_VAL(ai, bj, m, n);
                            u32x2 w; w.x = cvt_pk_bf16(sigmoidf_(v[0]), sigmoidf_(v[1])); w.y = cvt_pk_bf16(sigmoidf_(v[2]), sigmoidf_(v[3]));
                            *(u32x2*)(GATES + row * 2048 + (pn - 8) * 256 + bj * HALF + wc * 32 + n * 16 + fq * 4) = w; } }
        }
    }
};
#undef EPIIN_VAL
struct EpiRowScale {
    static constexpr bool PERM = true, AFTER_DRAIN = false, MIDHOOK = false;
    bf16_t* O; int ldc; const float* ssq; float invk;
    __device__ __forceinline__ void operator()(const f32x4 (&acc)[2][2][4][2], const Unit& u, int wr, int wc, int fr, int fq) const {
        { const int ln_ = otid() & 63; fr = ln_ & 15; fq = ln_ >> 4; }
        const size_t rowb = (size_t)u.pm * BM + wr * 64 + fr; const int col0 = u.pn * BM + wc * 32 + 8 * fq;
#pragma unroll
        for (int ai = 0; ai < 2; ++ai)
#pragma unroll
            for (int m = 0; m < 4; ++m) { const size_t row = rowb + ai * HALF + m * 16; const float r = __builtin_amdgcn_rsqf(ssq[row] * invk + RMS_EPS);
#pragma unroll
                for (int bj = 0; bj < 2; ++bj) { const f32x4 v0 = acc[ai][bj][m][0] * r, v1 = acc[ai][bj][m][1] * r;
                    u32x4 w; w.x = cvt_pk_bf16(v0[0], v0[1]); w.y = cvt_pk_bf16(v0[2], v0[3]); w.z = cvt_pk_bf16(v1[0], v1[1]); w.w = cvt_pk_bf16(v1[2], v1[3]);
                    *(u32x4*)(O + row * ldc + col0 + bj * HALF) = w; } }
    }
};
struct EpiGate2 {
    static constexpr bool PERM = true, AFTER_DRAIN = false, MIDHOOK = true;
    bf16_t* O; const bf16_t* SIG;
    __device__ __forceinline__ void mid(f32x4 (&acc)[2][2][4][2], const Unit& u, int wr, int wc) const {
        const int ln_ = otid() & 63, fr = ln_ & 15, fq = ln_ >> 4;
        const size_t rowb = (size_t)u.pm * BM + wr * 64 + fr; const int col0 = u.pn * BM + wc * 32 + 8 * fq;
#pragma unroll
        for (int ai = 0; ai < 2; ++ai)
#pragma unroll
            for (int m = 0; m < 4; ++m) { const bf16_t* sp = SIG + (rowb + ai * HALF + m * 16) * 2048 + col0;
#pragma unroll
                for (int bj = 0; bj < 2; ++bj) { const u32x4 sa = *(const u32x4*)(sp + bj * HALF), sb = *(const u32x4*)(sp + 1024 + bj * HALF);
                    f32x4& v0 = acc[ai][bj][m][0]; f32x4& v1 = acc[ai][bj][m][1];
                    v0[0] *= bf_lo(sa.x) * __builtin_amdgcn_rcpf(bf_lo(sb.x)); v0[1] *= bf_hi(sa.x) * __builtin_amdgcn_rcpf(bf_hi(sb.x));
                    v0[2] *= bf_lo(sa.y) * __builtin_amdgcn_rcpf(bf_lo(sb.y)); v0[3] *= bf_hi(sa.y) * __builtin_amdgcn_rcpf(bf_hi(sb.y));
                    v1[0] *= bf_lo(sa.z) * __builtin_amdgcn_rcpf(bf_lo(sb.z)); v1[1] *= bf_hi(sa.z) * __builtin_amdgcn_rcpf(bf_hi(sb.z));
                    v1[2] *= bf_lo(sa.w) * __builtin_amdgcn_rcpf(bf_lo(sb.w)); v1[3] *= bf_hi(sa.w) * __builtin_amdgcn_rcpf(bf_hi(sb.w)); }
                asm volatile("" ::: "memory"); }
    }
    __device__ __forceinline__ void operator()(const f32x4 (&acc)[2][2][4][2], const Unit& u, int wr, int wc, int fr, int fq) const {
        { const int ln_ = otid() & 63; fr = ln_ & 15; fq = ln_ >> 4; }
        const size_t rowb = (size_t)u.pm * BM + wr * 64 + fr; const int col0 = u.pn * BM + wc * 32 + 8 * fq;
#pragma unroll
        for (int ai = 0; ai < 2; ++ai)
#pragma unroll
            for (int m = 0; m < 4; ++m) { const size_t row = rowb + ai * HALF + m * 16;
#pragma unroll
                for (int bj = 0; bj < 2; ++bj) { const u32x4 sg = *(const u32x4*)(SIG + row * 2048 + 1024 + col0 + bj * HALF);
                    f32x4 v0 = acc[ai][bj][m][0], v1 = acc[ai][bj][m][1];
                    v0[0] *= bf_lo(sg.x); v0[1] *= bf_hi(sg.x); v0[2] *= bf_lo(sg.y); v0[3] *= bf_hi(sg.y);
                    v1[0] *= bf_lo(sg.z); v1[1] *= bf_hi(sg.z); v1[2] *= bf_lo(sg.w); v1[3] *= bf_hi(sg.w);
                    u32x4 w; w.x = cvt_pk_bf16(v0[0], v0[1]); w.y = cvt_pk_bf16(v0[2], v0[3]); w.z = cvt_pk_bf16(v1[0], v1[1]); w.w = cvt_pk_bf16(v1[2], v1[3]);
                    *(u32x4*)(O + row * 1024 + col0 + bj * HALF) = w; } }
    }
};
struct EpiResid {
    static constexpr bool PERM = false, AFTER_DRAIN = false, MIDHOOK = false;
    const float* xin; float* out; const float* gmod;
    bf16_t* XG; const float* gnorm; const float* scmod; float* ssq;
    __device__ __forceinline__ void operator()(const f32x4 (&acc)[2][2][4][2], const Unit& u, int wr, int wc, int fr, int fq) const {
        { const int ln_ = otid() & 63; fr = ln_ & 15; fq = ln_ >> 4; }
        const size_t rowb = (size_t)u.pm * BM + wr * 64 + fr; const int col0 = u.pn * BM + wc * 32 + 4 * fq; const float* gb = gmod + (size_t)(u.pm >> 4) * 6144;
        f32x4 gv[2][2], Gv[2][2];
#pragma unroll
        for (int bj = 0; bj < 2; ++bj)
#pragma unroll
            for (int n = 0; n < 2; ++n) { gv[bj][n] = *(const f32x4*)(gb + col0 + bj * HALF + n * 16);
                if (XG) Gv[bj][n] = *(const f32x4*)(gnorm + col0 + bj * HALF + n * 16) * (1.0f + *(const f32x4*)(scmod + (size_t)(u.pm >> 4) * 6144 + col0 + bj * HALF + n * 16)); }
#pragma unroll
        for (int ai = 0; ai < 2; ++ai)
#pragma unroll
            for (int m = 0; m < 4; ++m) { const size_t row = rowb + ai * HALF + m * 16; const size_t off = row * 1024 + col0; float s = 0.f;
#pragma unroll
                for (int bj = 0; bj < 2; ++bj)
#pragma unroll
                    for (int n = 0; n < 2; ++n) { const f32x4 xv = *(const f32x4*)(xin + off + bj * HALF + n * 16);
                        const f32x4 xn = xv + gv[bj][n] * acc[ai][bj][m][n];
                        *(f32x4*)(out + off + bj * HALF + n * 16) = xn;
                        if (XG) { s += (xn[0] * xn[0] + xn[1] * xn[1]) + (xn[2] * xn[2] + xn[3] * xn[3]); const f32x4 t = xn * Gv[bj][n];
                            u32x2 w; w.x = cvt_pk_bf16(t[0], t[1]); w.y = cvt_pk_bf16(t[2], t[3]); *(u32x2*)(XG + off + bj * HALF + n * 16) = w; } }
                if (XG) { s += __shfl_xor(s, 16); s += __shfl_xor(s, 32); if (fq == 0) atomicAdd(ssq + row, s); } }
    }
};
struct EpiSwiGLU {
    static constexpr bool PERM = true, AFTER_DRAIN = false, MIDHOOK = false;
    bf16_t* O; const float* ssq2; const float* bw;
    __device__ __forceinline__ void operator()(const f32x4 (&acc)[2][2][4][2], const Unit& u, int wr, int wc, int fr, int fq) const {
        { const int ln_ = otid() & 63; fr = ln_ & 15; fq = ln_ >> 4; }
        const size_t rowb = (size_t)u.pm * BM + wr * 64 + fr; const int col0 = u.pn * HALF + wc * 32 + 8 * fq;
        const float* bwp = bw + (size_t)(u.pm >> 4) * 5632 + u.pn * BM + wc * 32 + 8 * fq;
        const f32x4 bg0 = *(const f32x4*)bwp, bg1 = *(const f32x4*)(bwp + 4), bu0 = *(const f32x4*)(bwp + HALF), bu1 = *(const f32x4*)(bwp + HALF + 4);
#pragma unroll
        for (int ai = 0; ai < 2; ++ai)
#pragma unroll
            for (int m = 0; m < 4; ++m) { const size_t row = rowb + ai * HALF + m * 16; const float r = __builtin_amdgcn_rsqf(ssq2[row] * (1.0f / 1024.0f) + RMS_EPS);
                f32x4 g0 = acc[ai][0][m][0] * r + bg0, g1 = acc[ai][0][m][1] * r + bg1; const f32x4 u0 = acc[ai][1][m][0] * r + bu0, u1 = acc[ai][1][m][1] * r + bu1;
#pragma unroll
                for (int i = 0; i < 4; ++i) { g0[i] = g0[i] * sigmoidf_(g0[i]) * u0[i]; g1[i] = g1[i] * sigmoidf_(g1[i]) * u1[i]; }
                u32x4 w; w.x = cvt_pk_bf16(g0[0], g0[1]); w.y = cvt_pk_bf16(g0[2], g0[3]); w.z = cvt_pk_bf16(g1[0], g1[1]); w.w = cvt_pk_bf16(g1[2], g1[3]);
                *(u32x4*)(O + row * 2816 + col0) = w; }
    }
};

template <class Epi, class Sched, bool ALIGN_EPI = false, bool SP2 = false>
__device__ __forceinline__ void gemm_phase(PG8_LAS unsigned char* lds, const Gemm g, const Sched& S, const Epi& E) {
    const int tid = otid(), wid = __builtin_amdgcn_readfirstlane(tid >> 6), lane = tid & 63, wr = wid >> 2, wc = wid & 3, fr = lane & 15, fq = lane >> 4;
    const int K = g.K, lda = g.lda, nt = K / BK;
    unsigned voffA[2], voffB[2];
#pragma unroll
    for (int i = 0; i < 2; ++i) { int R, C; stage_rc(tid * 16 + i * 8192, R, C); const int Rb = Epi::PERM ? ((R & ~31) + perm32(R & 31)) : R;
        voffA[i] = (unsigned)(R * lda + C) * 2u; voffB[i] = (unsigned)(Rb * K + C) * 2u; }
    const size_t kstep = (size_t)(BK * 2);
    const size_t hstepB = (size_t)HALF * K * 2, hstepA = (size_t)HALF * lda * 2;
    const size_t tstepB = 2 * hstepB, tstepA = 2 * hstepA;
    const unsigned ldsw = (unsigned)wid * 1024u;
    const int aoff = lds_byte(wr * 64 + fr, fq * 8), boff = lds_byte(wc * 32 + fr, fq * 8);
#define PG8_SA(b, h) (((b) * 2 + (h)) * HTB)
#define PG8_SB(b, h) ((4 + (b) * 2 + (h)) * HTB)
#define PG8_STAGE(bufoff, gbase, voff) do { _Pragma("unroll") for (int _i = 0; _i < 2; ++_i) \
        __builtin_amdgcn_global_load_lds((const unsigned*)((const char*)(gbase) + (voff)[_i]), (PG8_LAS unsigned*)(lds + (bufoff) + ldsw + _i * 8192), 16, 0, 0); } while (0)
#define PG8_LDA(dst, b, h) do { _Pragma("unroll") for (int m = 0; m < 4; ++m) _Pragma("unroll") for (int k = 0; k < 2; ++k) dst[m][k] = *(const PG8_LAS bf16x8*)(lds + PG8_SA(b, h) + aoff + m * 2048 + k * 1024); } while (0)
#define PG8_LDB(dst, b, h) do { _Pragma("unroll") for (int n = 0; n < 2; ++n) _Pragma("unroll") for (int k = 0; k < 2; ++k) dst[n][k] = *(const PG8_LAS bf16x8*)(lds + PG8_SB(b, h) + boff + n * 2048 + k * 1024); } while (0)
#define PG8_MMA(ai, bj, At, Bt) do { __builtin_amdgcn_s_setprio(1); _Pragma("unroll") for (int m = 0; m < 4; ++m) _Pragma("unroll") for (int n = 0; n < 2; ++n) _Pragma("unroll") for (int k = 0; k < 2; ++k) \
        acc[ai][bj][m][n] = __builtin_amdgcn_mfma_f32_16x16x32_bf16(Bt[n][k], At[m][k], acc[ai][bj][m][n], 0, 0, 0); __builtin_amdgcn_s_setprio(0); } while (0)
#define PG8_WAIT_V(n) asm volatile("s_waitcnt vmcnt(" #n ")" ::: "memory")
#define PG8_WAIT_L(n) asm volatile("s_waitcnt lgkmcnt(" #n ")" ::: "memory")
#define PG8_BAR __builtin_amdgcn_s_barrier()
#define PG8_SCHED __builtin_amdgcn_sched_barrier(0)
    Unit cur, nxt; int ui = 0;
    if (!S.next(0, cur)) return;
    f32x4 acc[2][2][4][2];
#pragma unroll
    for (int a = 0; a < 2; ++a)
#pragma unroll
        for (int b = 0; b < 2; ++b)
#pragma unroll
            for (int m = 0; m < 4; ++m)
#pragma unroll
                for (int n = 0; n < 2; ++n) acc[a][b][m][n] = (f32x4){0.f, 0.f, 0.f, 0.f};
    bf16x8 At[4][2], B0[2][2], B1[2][2];
    const char* cA = (const char*)g.A + (size_t)cur.pm * tstepA; const char* cB = (const char*)g.Bt + (size_t)cur.pn * tstepB;
    S.a_ready(cur);
    if constexpr (SP2) {
        PG8_STAGE(PG8_SB(0, 0), cB, voffB); PG8_STAGE(PG8_SB(0, 1), cB + hstepB, voffB); PG8_STAGE(PG8_SA(0, 0), cA, voffA); PG8_STAGE(PG8_SA(0, 1), cA + hstepA, voffA);
        if (wr == 1) PG8_BAR;
        PG8_WAIT_V(2); PG8_BAR;
        PG8_STAGE(PG8_SB(1, 0), cB + kstep, voffB); PG8_STAGE(PG8_SA(1, 0), cA + kstep, voffA); PG8_STAGE(PG8_SB(1, 1), cB + hstepB + kstep, voffB);
        PG8_WAIT_V(6); PG8_BAR;
    } else {
        PG8_STAGE(PG8_SB(0, 0), cB, voffB); PG8_STAGE(PG8_SA(0, 0), cA, voffA); PG8_STAGE(PG8_SB(0, 1), cB + hstepB, voffB); PG8_STAGE(PG8_SA(0, 1), cA + hstepA, voffA);
        if (wr == 1) PG8_BAR;
        PG8_WAIT_V(4); PG8_BAR;
        PG8_STAGE(PG8_SB(1, 0), cB + kstep, voffB); PG8_STAGE(PG8_SA(1, 0), cA + kstep, voffA); PG8_STAGE(PG8_SB(1, 1), cB + hstepB + kstep, voffB);
        PG8_WAIT_V(6); PG8_BAR;
    }
    for (;;) {
        const bool has_next = S.next(ui + 1, nxt);
        const char* nA = has_next ? (const char*)g.A + (size_t)nxt.pm * tstepA : cA; const char* nB = has_next ? (const char*)g.Bt + (size_t)nxt.pn * tstepB : cB;
        for (int t = 0; t < nt; t += 2) {
            const bool last = (t == nt - 2);
            if constexpr (Epi::MIDHOOK) { if (t == (nt >> 1)) E.mid(acc, cur, wr, wc); }
            const char* a1 = cA + (size_t)(t + 1) * kstep;
            const char* a2 = last ? nA : cA + (size_t)(t + 2) * kstep; const char* b2 = last ? nB : cB + (size_t)(t + 2) * kstep;
            const char* a3 = a2 + kstep; const char* b3 = b2 + kstep;
            if (last && has_next) S.a_ready(nxt);
            if constexpr (SP2) {
            PG8_LDB(B0, 0, 0); PG8_LDB(B1, 0, 1); PG8_SCHED; PG8_LDA(At, 0, 0); PG8_STAGE(PG8_SA(1, 1), a1 + hstepA, voffA);
            PG8_WAIT_V(8); PG8_WAIT_L(0); PG8_BAR; PG8_MMA(0, 0, At, B0); PG8_MMA(0, 1, At, B1); PG8_BAR; PG8_SCHED;
            PG8_LDA(At, 0, 1); PG8_STAGE(PG8_SB(0, 0), b2, voffB); PG8_STAGE(PG8_SB(0, 1), b2 + hstepB, voffB); PG8_STAGE(PG8_SA(0, 0), a2, voffA);
            PG8_WAIT_V(8); PG8_WAIT_L(0); PG8_BAR; PG8_MMA(1, 0, At, B0); PG8_MMA(1, 1, At, B1); PG8_BAR; PG8_SCHED;
            PG8_LDB(B0, 1, 0); PG8_LDB(B1, 1, 1); PG8_SCHED; PG8_LDA(At, 1, 0); PG8_STAGE(PG8_SA(0, 1), a2 + hstepA, voffA);
            PG8_WAIT_V(8); PG8_WAIT_L(0); PG8_BAR; PG8_MMA(0, 0, At, B0); PG8_MMA(0, 1, At, B1); PG8_BAR; PG8_SCHED;
            PG8_LDA(At, 1, 1); PG8_STAGE(PG8_SB(1, 0), b3, voffB); PG8_STAGE(PG8_SB(1, 1), b3 + hstepB, voffB); PG8_STAGE(PG8_SA(1, 0), a3, voffA);
            PG8_WAIT_V(8); PG8_WAIT_L(0); PG8_BAR; PG8_MMA(1, 0, At, B0); PG8_MMA(1, 1, At, B1); PG8_BAR; PG8_SCHED;
            } else {
            PG8_LDB(B0, 0, 0); PG8_SCHED; PG8_LDA(At, 0, 0); PG8_STAGE(PG8_SA(1, 1), a1 + hstepA, voffA);
            PG8_WAIT_L(8); PG8_BAR; PG8_WAIT_L(0); PG8_MMA(0, 0, At, B0); PG8_BAR; PG8_SCHED;
            PG8_LDB(B1, 0, 1); PG8_STAGE(PG8_SB(0, 0), b2, voffB);
            PG8_BAR; PG8_WAIT_L(0); PG8_MMA(0, 1, At, B1); PG8_BAR;
            PG8_LDA(At, 0, 1); PG8_STAGE(PG8_SA(0, 0), a2, voffA);
            PG8_BAR; PG8_WAIT_L(0); PG8_MMA(1, 0, At, B0); PG8_BAR; PG8_SCHED;
            PG8_STAGE(PG8_SB(0, 1), b2 + hstepB, voffB);
            PG8_WAIT_V(6); PG8_BAR; PG8_MMA(1, 1, At, B1); PG8_BAR;
            PG8_LDB(B0, 1, 0); PG8_SCHED; PG8_LDA(At, 1, 0); PG8_STAGE(PG8_SA(0, 1), a2 + hstepA, voffA);
            PG8_WAIT_L(8); PG8_BAR; PG8_WAIT_L(0); PG8_MMA(0, 0, At, B0); PG8_BAR; PG8_SCHED;
            PG8_LDB(B1, 1, 1); PG8_STAGE(PG8_SB(1, 0), b3, voffB);
            PG8_BAR; PG8_WAIT_L(0); PG8_MMA(0, 1, At, B1); PG8_BAR;
            PG8_LDA(At, 1, 1); PG8_STAGE(PG8_SA(1, 0), a3, voffA);
            PG8_BAR; PG8_WAIT_L(0); PG8_MMA(1, 0, At, B0); PG8_BAR; PG8_SCHED;
            PG8_STAGE(PG8_SB(1, 1), b3 + hstepB, voffB);
            PG8_WAIT_V(6); PG8_BAR; PG8_MMA(1, 1, At, B1); PG8_BAR;
            }
        }
        if constexpr (ALIGN_EPI) { if (wr == 0) PG8_BAR; }
        if constexpr (!Epi::AFTER_DRAIN) { E(acc, cur, wr, wc, fr, fq); S.done(cur); }
        if (!has_next) break;
#pragma unroll
        for (int a = 0; a < 2; ++a)
#pragma unroll
            for (int b = 0; b < 2; ++b)
#pragma unroll
                for (int m = 0; m < 4; ++m)
#pragma unroll
                    for (int n = 0; n < 2; ++n) acc[a][b][m][n] = (f32x4){0.f, 0.f, 0.f, 0.f};
        cur = nxt; cA = nA; cB = nB; ++ui;
        if constexpr (ALIGN_EPI) { if (wr == 1) PG8_BAR; }
    }
    PG8_WAIT_V(0);
    if constexpr (!ALIGN_EPI) { if (wr == 0) PG8_BAR; }
    PG8_BAR;
    if constexpr (Epi::AFTER_DRAIN) { E.fused(acc, cur, wr, wc, fr, fq, lds, wid, lane); S.done(cur); }
#undef PG8_SA
#undef PG8_SB
#undef PG8_STAGE
#undef PG8_LDA
#undef PG8_LDB
#undef PG8_MMA
#undef PG8_WAIT_V
#undef PG8_WAIT_L
#undef PG8_BAR
#undef PG8_SCHED
}
}

constexpr int NB = 16, SEQ = 4096, DM = 1024, DEPTH = 4, NTOK = NB * SEQ, NH = 8, FFH = 2816, NIN = 4096, INC = 4000;
constexpr int NWAVES = 8, NTHR = 512;
constexpr int LDS_BYTES = 147456, RING_BYTES = 131072;
constexpr size_t MiB = 1u << 20;
constexpr size_t WS_H = 0;
constexpr size_t WS_PA = 128 * MiB;
constexpr size_t WS_DIL = 192 * MiB;
constexpr size_t WS_GATES = 384 * MiB;
constexpr size_t WS_HID = 128 * MiB;
constexpr size_t WS_KVRAW = 640 * MiB;
constexpr size_t WS_K = 768 * MiB;
constexpr size_t WS_V = 864 * MiB;
constexpr size_t WS_W = 928 * MiB, WS_WSTRIDE = 30 * MiB;
constexpr size_t W_IN = 0, W_Q = W_IN + (size_t)NIN * 1024 * 2, W_KV = W_Q + 768 * 256 * 2, W_A = W_KV + 1024 * 256 * 2, W_B = W_A + 1024 * 512 * 2,
                 W_O = W_B + 1024 * 512 * 2, W_1 = W_O + 1024 * 1024 * 2, W_2 = W_1 + (size_t)5632 * 1024 * 2, W_END = W_2 + (size_t)1024 * 2816 * 2;
constexpr size_t WS_MOD = 988 * MiB;
constexpr size_t WS_ROPE = 990 * MiB;
constexpr size_t WS_SSQ = 998 * MiB;
constexpr size_t WS_LSE = 999 * MiB;
constexpr size_t WS_BT = 1001 * MiB;
constexpr size_t WS_BW1 = 1002 * MiB;
constexpr size_t WS_BW2 = 1003 * MiB;
constexpr size_t WS_CTL = 1005 * MiB, CTL_BYTES = 65536;
constexpr size_t WS_END = 1006 * MiB;
static_assert(W_END <= WS_WSTRIDE && WS_W + 2 * WS_WSTRIDE <= WS_MOD, "weights fit");
static_assert(WS_HID + (size_t)NTOK * FFH * 2 <= WS_KVRAW, "hid overlay");

#define LAS __attribute__((address_space(3)))
typedef unsigned short bf16_t;
typedef short bf16x8 __attribute__((ext_vector_type(8)));
typedef short s16x4 __attribute__((ext_vector_type(4)));
typedef float f32x4 __attribute__((ext_vector_type(4)));
typedef float f32x16 __attribute__((ext_vector_type(16)));
typedef unsigned u32x4 __attribute__((ext_vector_type(4)));
typedef unsigned u32x2 __attribute__((ext_vector_type(2)));
using pg8::cvt_pk_bf16; using pg8::bf_lo; using pg8::bf_hi;

struct Params {
    const float *x, *c; const int* pos; const float *rel_bias, *norm1_g, *norm2_g, *ada_w, *ada_b, *w_in, *q_a_norm, *w_q_b, *kv_a_norm, *w_kv_b, *q_norm_a, *k_norm_a, *q_norm_b, *k_norm_b,
        *w_branch_a, *w_branch_b, *w_out, *w_ffn_gate, *w_ffn_up, *w_ffn_down;
    float* out; unsigned char* ws;
    float inv_freq[16];
    int ph_lo, ph_hi;
};

__device__ __forceinline__ float wave_sum(float v) {
#pragma unroll
    for (int o = 1; o < 64; o <<= 1) v += __shfl_xor(v, o);
    return v;
}
#define LDS_WAIT() asm volatile("s_waitcnt lgkmcnt(0)" ::: "memory")

__device__ __forceinline__ void phase0(const Params& P, LAS unsigned char* lds, int G) {
    const int tid = otid(), lane = tid & 63, wid = __builtin_amdgcn_readfirstlane(tid >> 6);
    float* MOD = (float*)(P.ws + WS_MOD); float* ROPE = (float*)(P.ws + WS_ROPE); float* BT = (float*)(P.ws + WS_BT);
    const int gtid = obid() * NTHR + tid, nthr = G * NTHR;
    for (int idx = gtid; idx < NTOK * 16; idx += nthr) { const int t = idx >> 4, i = idx & 15;
        const float ang = (float)P.pos[t] * P.inv_freq[i];
        double rev = (double)ang * 0.15915494309189535; rev -= __builtin_rint(rev); const float f = (float)rev;
        ROPE[t * 32 + i] = __builtin_amdgcn_cosf(f); ROPE[t * 32 + 16 + i] = __builtin_amdgcn_sinf(f); }
    for (int idx = gtid; idx < 3 * 8 * 129; idx += nthr) { const int j = idx % 129, h = (idx / 129) & 7, p = idx / (129 * 8);
        const int dil = p == 0 ? 1 : (p == 1 ? 4 : 16); const int rp = (j - 64) * dil; const int n = rp < 0 ? -rp : rp; int bk = rp > 0 ? 16 : 0;
        if (n < 8) bk += n; else { const float nf = (float)n; int lg = 8 + (int)(__logf(nf * 0.125f) / 4.852030263919617f * 8.0f); bk += lg < 15 ? lg : 15; }
        BT[idx] = P.rel_bias[bk * 8 + h] * pg8::LOG2E; }
    LAS float* sC = (LAS float*)lds;
    LAS float* red = (LAS float*)(lds + 65536);
    for (int i = tid; i < 16 * 1024; i += NTHR) { const float v = P.c[i]; sC[i] = v / (1.0f + __expf(-v)); }
    __syncthreads();
    for (int it = obid(); it < 4 * 96; it += G) { const int l = it / 96, cb = it % 96; const int col = cb * 64 + lane;
        float a[16];
#pragma unroll
        for (int b = 0; b < 16; ++b) a[b] = 0.f;
        const float* wp = P.ada_w + ((size_t)l * 1024 + wid * 128) * 6144 + col;
#pragma unroll 16
        for (int k = 0; k < 128; ++k) { const float w = wp[(size_t)k * 6144];
#pragma unroll
            for (int b = 0; b < 16; ++b) a[b] += sC[b * 1024 + wid * 128 + k] * w; }
#pragma unroll
        for (int b = 0; b < 16; ++b) red[(wid * 16 + b) * 64 + lane] = a[b];
        __syncthreads();
        for (int o = tid; o < 1024; o += NTHR) { const int b = o >> 6, ln = o & 63; float s = 0.f;
#pragma unroll
            for (int w = 0; w < 8; ++w) s += red[(w * 16 + b) * 64 + ln];
            MOD[((size_t)l * 16 + b) * 6144 + cb * 64 + ln] = s + P.ada_b[l * 6144 + cb * 64 + ln]; }
        __syncthreads();
    }
}

__device__ __forceinline__ void tr_item(const float* W, int Nsrc, int k0, int j0, const float* kscale, bf16_t* WT, int Kdst, int R0, LAS float* scr, int lane) {
    if (j0 >= 0) {
#pragma unroll 8
        for (int i = 0; i < 32; ++i) { const int kk = 2 * i + (lane >> 5); float v = W[(size_t)(k0 + kk) * Nsrc + j0 + (lane & 31)]; if (kscale) v *= kscale[k0 + kk]; scr[kk * 33 + (lane & 31)] = v; }
    } else {
#pragma unroll 8
        for (int i = 0; i < 32; ++i) { const int kk = 2 * i + (lane >> 5); scr[kk * 33 + (lane & 31)] = 0.f; }
    }
    LDS_WAIT();
    const int c = lane & 7;
#pragma unroll
    for (int j = 0; j < 4; ++j) { const int n = (lane >> 3) + 8 * j; const LAS float* s = scr + (8 * c) * 33 + n;
        u32x4 o; o.x = cvt_pk_bf16(s[0 * 33], s[1 * 33]); o.y = cvt_pk_bf16(s[2 * 33], s[3 * 33]); o.z = cvt_pk_bf16(s[4 * 33], s[5 * 33]); o.w = cvt_pk_bf16(s[6 * 33], s[7 * 33]);
        *(u32x4*)(WT + (size_t)(R0 + n) * Kdst + k0 + 8 * c) = o; }
    LDS_WAIT();
}
__device__ __forceinline__ int win_src_col(int R0) {
    const int pn = R0 >> 8, rho = R0 & 255;
    if (pn == 0) return rho;
    if (pn == 1) return rho < 160 ? 256 + rho : -1;
    if (pn < 6) { const int wc = (rho >> 5) & 3, dd = 32 * (rho >> 7); const int sec = (pn - 2) >> 1, head = 4 * ((pn - 2) & 1) + wc; return 416 + sec * 512 + head * 64 + dd; }
    if (pn < 8) return 416 + 1024 + (R0 - 1536);
    return 1952 + (R0 - 2048);
}
__device__ __forceinline__ void conv_weights(const Params& P, int l, unsigned char* wb, LAS unsigned char* lds, int G) {
    const int tid = otid(), lane = tid & 63, wid = __builtin_amdgcn_readfirstlane(tid >> 6);
    LAS float* scr = (LAS float*)(lds + wid * 16384);
    constexpr int I_IN = 16 * 128, I_Q = 4 * 24, I_KV = 4 * 32, I_A = 8 * 32, I_B = 8 * 32, I_O = 16 * 32, I_1 = 16 * 176, I_2 = 44 * 32;
    constexpr int NIT = I_IN + I_Q + I_KV + I_A + I_B + I_O + I_1 + I_2;
    for (int it = obid() * NWAVES + wid; it < NIT; it += G * NWAVES) {
        int r = it;
        if (r < I_IN) { const int kb = r / 128, rb = r % 128; tr_item(P.w_in + (size_t)l * 1024 * INC, INC, kb * 64, win_src_col(rb * 32), nullptr, (bf16_t*)(wb + W_IN), 1024, rb * 32, scr, lane); continue; } r -= I_IN;
        if (r < I_Q) { const int kb = r / 24, rb = r % 24; tr_item(P.w_q_b + (size_t)l * 256 * 768, 768, kb * 64, rb * 32, P.q_a_norm + l * 256, (bf16_t*)(wb + W_Q), 256, rb * 32, scr, lane); continue; } r -= I_Q;
        if (r < I_KV) { const int kb = r / 32, rb = r % 32; tr_item(P.w_kv_b + (size_t)l * 128 * 1024, 1024, kb * 64, kb < 2 ? rb * 32 : -1, P.kv_a_norm + l * 128, (bf16_t*)(wb + W_KV), 256, rb * 32, scr, lane); continue; } r -= I_KV;
        if (r < I_A) { const int kb = r / 32, rb = r % 32; tr_item(P.w_branch_a + (size_t)l * 512 * 1024, 1024, kb * 64, rb * 32, nullptr, (bf16_t*)(wb + W_A), 1024, rb * 32, scr, lane); continue; } r -= I_A;
        if (r < I_B) { const int kb = r / 32, rb = r % 32; tr_item(P.w_branch_b + (size_t)l * 512 * 1024, 1024, kb * 64, rb * 32, nullptr, (bf16_t*)(wb + W_A) + 512, 1024, rb * 32, scr, lane); continue; } r -= I_B;
        if (r < I_O) { const int kb = r / 32, rb = r % 32; tr_item(P.w_out + (size_t)l * 1024 * 1024, 1024, kb * 64, rb * 32, nullptr, (bf16_t*)(wb + W_O), 1024, rb * 32, scr, lane); continue; } r -= I_O;
        if (r < I_1) { const int kb = r / 176, rb = r % 176; const int R0 = rb * 32, pn = R0 >> 8, rho = R0 & 255;
            const float* src = (rho < 128 ? P.w_ffn_gate : P.w_ffn_up) + (size_t)l * 1024 * FFH;
            tr_item(src, FFH, kb * 64, pn * 128 + (rho & 127), nullptr, (bf16_t*)(wb + W_1), 1024, R0, scr, lane); continue; } r -= I_1;
        { const int kb = r / 32, rb = r % 32; tr_item(P.w_ffn_down + (size_t)l * FFH * 1024, 1024, kb * 64, rb * 32, nullptr, (bf16_t*)(wb + W_2), FFH, rb * 32, scr, lane); }
    }
}

__device__ __forceinline__ void norm_phase(const float* xin, const float* g, const float* mod  , int sh_off, int sc_off, bf16_t* H, int G) {
    const int tid = otid(), lane = tid & 63, wid = __builtin_amdgcn_readfirstlane(tid >> 6);
    for (int m = obid() * NWAVES + wid; m < NTOK; m += G * NWAVES) {
        const f32x4* xr = (const f32x4*)(xin + (size_t)m * DM) + lane; f32x4 v[4]; float s = 0.f;
#pragma unroll
        for (int j = 0; j < 4; ++j) { v[j] = xr[64 * j]; s += (v[j][0] * v[j][0] + v[j][1] * v[j][1]) + (v[j][2] * v[j][2] + v[j][3] * v[j][3]); }
        const float r = __builtin_amdgcn_rsqf(wave_sum(s) * (1.0f / DM) + pg8::RMS_EPS);
        const float* mb = mod + (size_t)(m >> 12) * 6144;
#pragma unroll
        for (int j = 0; j < 4; ++j) { const int col = 4 * lane + 256 * j;
            const f32x4 gv = *(const f32x4*)(g + col), sc = *(const f32x4*)(mb + sc_off + col), sh = *(const f32x4*)(mb + sh_off + col);
            const f32x4 o = (v[j] * r) * gv * (1.0f + sc) + sh;
            u32x2 w; w.x = cvt_pk_bf16(o[0], o[1]); w.y = cvt_pk_bf16(o[2], o[3]);
            *(u32x2*)(H + (size_t)m * DM + col) = w; }
    }
}

__device__ __forceinline__ void prepass_phase(const float* xin, const float* g, const float* mod  , int sc_off, bf16_t* XG, float* ssq, int G) {
    const int tid = otid(), lane = tid & 63, wid = __builtin_amdgcn_readfirstlane(tid >> 6);
    for (int m = obid() * NWAVES + wid; m < NTOK; m += G * NWAVES) {
        const f32x4* xr = (const f32x4*)(xin + (size_t)m * DM) + lane; float s = 0.f;
        const float* mb = mod + (size_t)(m >> 12) * 6144;
#pragma unroll
        for (int j = 0; j < 4; ++j) { const f32x4 v = xr[64 * j]; s += (v[0] * v[0] + v[1] * v[1]) + (v[2] * v[2] + v[3] * v[3]); const int col = 4 * lane + 256 * j;
            const f32x4 o = v * *(const f32x4*)(g + col) * (1.0f + *(const f32x4*)(mb + sc_off + col));
            u32x2 w; w.x = cvt_pk_bf16(o[0], o[1]); w.y = cvt_pk_bf16(o[2], o[3]);
            *(u32x2*)(XG + (size_t)m * DM + col) = w; }
        s = wave_sum(s);
        if (lane == 0) ssq[m] = s;
    }
}
__device__ __forceinline__ void bias_phase(const Params& P, LAS unsigned char* lds, int G) {
    const int tid = otid(), lane = tid & 63, wid = __builtin_amdgcn_readfirstlane(tid >> 6);
    const float* MOD = (const float*)(P.ws + WS_MOD); float* BW1 = (float*)(P.ws + WS_BW1); float* BW2 = (float*)(P.ws + WS_BW2);
    LAS float* sC = (LAS float*)lds;
    LAS float* red = (LAS float*)(lds + 65536);
    for (int it = obid(); it < 4 * 152; it += G) { const int l = it / 152, blk = it % 152; const bool ffn = blk >= 64; const int R0 = (ffn ? blk - 64 : blk) * 64;
        __syncthreads();
        for (int i = tid; i < 16 * 1024; i += NTHR) sC[i] = MOD[((size_t)l * 16 + (i >> 10)) * 6144 + (ffn ? 3072 : 0) + (i & 1023)];
        __syncthreads();
        const int R = R0 + lane; const float* wsrc; int j; size_t ncol;
        if (!ffn) { const int jb = win_src_col(R & ~31); j = jb < 0 ? -1 : jb + (R & 31); wsrc = P.w_in + (size_t)l * 1024 * INC; ncol = INC; }
        else { const int pn = R >> 8, rho = R & 255; j = pn * 128 + (rho & 127); wsrc = (rho < 128 ? P.w_ffn_gate : P.w_ffn_up) + (size_t)l * 1024 * FFH; ncol = FFH; }
        float a[16];
#pragma unroll
        for (int b = 0; b < 16; ++b) a[b] = 0.f;
        if (j >= 0) { const float* wp = wsrc + (size_t)(wid * 128) * ncol + j;
#pragma unroll 16
            for (int k = 0; k < 128; ++k) { const float w = wp[(size_t)k * ncol];
#pragma unroll
                for (int b = 0; b < 16; ++b) a[b] += sC[b * 1024 + wid * 128 + k] * w; } }
#pragma unroll
        for (int b = 0; b < 16; ++b) red[(wid * 16 + b) * 64 + lane] = a[b];
        __syncthreads();
        for (int o = tid; o < 1024; o += NTHR) { const int b = o >> 6, ln = o & 63; float s = 0.f;
#pragma unroll
            for (int w = 0; w < 8; ++w) s += red[(w * 16 + b) * 64 + ln];
            if (!ffn) BW1[((size_t)l * 16 + b) * 4096 + R0 + ln] = s; else BW2[((size_t)l * 16 + b) * 5632 + R0 + ln] = s; }
    }
    __syncthreads();
}

__device__ __forceinline__ void unpack8(const u32x4 w, float* f) { f[0] = bf_lo(w.x); f[1] = bf_hi(w.x); f[2] = bf_lo(w.y); f[3] = bf_hi(w.y); f[4] = bf_lo(w.z); f[5] = bf_hi(w.z); f[6] = bf_lo(w.w); f[7] = bf_hi(w.w); }
__device__ __forceinline__ u32x4 pack8(const float* f) { u32x4 w; w.x = cvt_pk_bf16(f[0], f[1]); w.y = cvt_pk_bf16(f[2], f[3]); w.z = cvt_pk_bf16(f[4], f[5]); w.w = cvt_pk_bf16(f[6], f[7]); return w; }
__device__ __forceinline__ float ssq8(const u32x4 w) { float f[8]; unpack8(w, f); return ((f[0] * f[0] + f[1] * f[1]) + (f[2] * f[2] + f[3] * f[3])) + ((f[4] * f[4] + f[5] * f[5]) + (f[6] * f[6] + f[7] * f[7])); }
__device__ __forceinline__ void head_norm_rope(const bf16_t* src_nope, const bf16_t* src_rope, bf16_t* dst, const float* gain, const float* rope, float oscale) {
    float s = 0.f;
#pragma unroll
    for (int c = 0; c < 8; ++c) s += ssq8(*(const u32x4*)(src_nope + 8 * c));
#pragma unroll
    for (int c = 0; c < 4; ++c) s += ssq8(*(const u32x4*)(src_rope + 8 * c));
    const float r = __builtin_amdgcn_rsqf(s * (1.0f / 96.0f) + pg8::RMS_EPS);
    asm volatile("" ::: "memory");
#pragma unroll
    for (int c = 0; c < 8; ++c) { float f[8]; unpack8(*(const u32x4*)(src_nope + 8 * c), f);
#pragma unroll
        for (int i = 0; i < 8; ++i) f[i] = f[i] * r * gain[8 * c + i] * oscale;
        *(u32x4*)(dst + 8 * c) = pack8(f); asm volatile("" ::: "memory"); }
    float x[32];
#pragma unroll
    for (int c = 0; c < 4; ++c) unpack8(*(const u32x4*)(src_rope + 8 * c), x + 8 * c);
#pragma unroll
    for (int i = 0; i < 32; ++i) x[i] = x[i] * r * gain[64 + i];
#pragma unroll
    for (int i = 0; i < 16; ++i) { const float cs = rope[i], sn = rope[16 + i]; const float x1 = x[i], x2 = x[16 + i]; x[i] = (x1 * cs - x2 * sn) * oscale; x[16 + i] = (x2 * cs + x1 * sn) * oscale; }
#pragma unroll
    for (int c = 0; c < 4; ++c) *(u32x4*)(dst + 64 + 8 * c) = pack8(x + 8 * c);
    asm volatile("" ::: "memory");
}
__device__ __forceinline__ void prep_phase(const Params& P, int l, int G) {
    const bf16_t* KVRAW = (const bf16_t*)(P.ws + WS_KVRAW); const bf16_t* PA = (const bf16_t*)(P.ws + WS_PA);
    bf16_t* K = (bf16_t*)(P.ws + WS_K); bf16_t* V = (bf16_t*)(P.ws + WS_V); const float* ROPE = (const float*)(P.ws + WS_ROPE);
    const float* kg = P.k_norm_a + l * 96;
    for (int idx = obid() * NTHR + otid(); idx < NTOK * NH; idx += G * NTHR) { const int t = idx >> 3, h = idx & 7;
        const float* rp = ROPE + (size_t)t * 32;
        const bf16_t* kp = KVRAW + (size_t)t * 1024 + h * 128;
        const size_t hrow = ((size_t)((t >> 12) * 8 + h) << 12) + (t & 4095);
        head_norm_rope(kp, PA + (size_t)t * 512 + 384, K + hrow * 96, kg, rp, 1.0f);
        bf16_t* vo = V + hrow * 64;
#pragma unroll
        for (int c = 0; c < 8; ++c) *(u32x4*)(vo + 8 * c) = *(const u32x4*)(kp + 64 + 8 * c);
    }
}
typedef short v4i16_t __attribute__((ext_vector_type(4)));
__device__ __forceinline__ s16x4 vtr(const LAS unsigned char* p) { return __builtin_bit_cast(s16x4, __builtin_amdgcn_ds_read_tr16_b64_v4i16((LAS v4i16_t*)p)); }
__device__ __forceinline__ bf16x8 cat8(s16x4 a, s16x4 b) { return (bf16x8){a[0], a[1], a[2], a[3], b[0], b[1], b[2], b[3]}; }
__device__ __forceinline__ bf16x8 packp(const f32x16& p, int o) {
    u32x4 w; w.x = cvt_pk_bf16(p[o + 0], p[o + 1]); w.y = cvt_pk_bf16(p[o + 2], p[o + 3]); w.z = cvt_pk_bf16(p[o + 4], p[o + 5]); w.w = cvt_pk_bf16(p[o + 6], p[o + 7]);
    return __builtin_bit_cast(bf16x8, w);
}
__device__ __forceinline__ float max16(const f32x16& p) {
    float a = fmaxf(fmaxf(p[0], p[1]), fmaxf(p[2], p[3])), b = fmaxf(fmaxf(p[4], p[5]), fmaxf(p[6], p[7]));
    float c = fmaxf(fmaxf(p[8], p[9]), fmaxf(p[10], p[11])), d = fmaxf(fmaxf(p[12], p[13]), fmaxf(p[14], p[15]));
    return fmaxf(fmaxf(a, b), fmaxf(c, d));
}
#define MFMA32(a, b, c) __builtin_amdgcn_mfma_f32_32x32x16_bf16((a), (b), (c), 0, 0, 0)
constexpr int KP = 208, VP = 192;
constexpr int KT_B = 64 * KP, VT_B = 64 * VP;
constexpr int MLA_K0 = 0, MLA_V0 = 2 * KT_B;

constexpr float MLA_THR = 8.0f;
__device__ __forceinline__ float max3f(float a, float b, float c) { float r; asm("v_max3_f32 %0, %1, %2, %3" : "=v"(r) : "v"(a), "v"(b), "v"(c)); return r; }
__device__ __forceinline__ float rowmax32(const f32x16& a, const f32x16& b) {
    float x = max3f(a[0], a[1], a[2]), y = max3f(b[0], b[1], b[2]);
    x = max3f(x, a[3], a[4]); y = max3f(y, b[3], b[4]); x = max3f(x, a[5], a[6]); y = max3f(y, b[5], b[6]); x = max3f(x, a[7], a[8]); y = max3f(y, b[7], b[8]);
    x = max3f(x, a[9], a[10]); y = max3f(y, b[9], b[10]); x = max3f(x, a[11], a[12]); y = max3f(y, b[11], b[12]); x = max3f(x, a[13], a[14]); y = max3f(y, b[13], b[14]);
    x = max3f(x, a[15], b[15]); x = max3f(x, y, y);
    return max3f(x, __shfl_xor(x, 32), x);
}
#define SBAR0() __builtin_amdgcn_sched_barrier(0)
__device__ __forceinline__ void mla_unit(LAS unsigned char* lds, const bf16_t* Q, const bf16_t* K, const bf16_t* V, bf16_t* Y, const float* qgain, const float* ROPE, int b, int h, int qb) {
    const int tid = otid(), lane = tid & 63, wid = __builtin_amdgcn_readfirstlane(tid >> 6), r32 = lane & 31, hi = lane >> 5;
    const size_t tok0 = (size_t)b * SEQ; const size_t qrow = tok0 + qb * 256 + wid * 32 + r32;
    bf16x8 qf[6];
    {
        const bf16_t* qp = Q + qrow * 768 + h * 96 + hi * 8; float f[6][8]; float s = 0.f;
#pragma unroll
        for (int d0 = 0; d0 < 6; ++d0) { unpack8(*(const u32x4*)(qp + d0 * 16), f[d0]);
#pragma unroll
            for (int i = 0; i < 8; ++i) s += f[d0][i] * f[d0][i]; }
        s += __shfl_xor(s, 32);
        const float r = __builtin_amdgcn_rsqf(s * (1.0f / 96.0f) + pg8::RMS_EPS);
#pragma unroll
        for (int d0 = 0; d0 < 6; ++d0)
#pragma unroll
            for (int i = 0; i < 8; ++i) f[d0][i] = f[d0][i] * r * qgain[d0 * 16 + hi * 8 + i];
        const float* rp = ROPE + qrow * 32 + hi * 8;
#pragma unroll
        for (int i = 0; i < 8; ++i) { const float cs = rp[i], sn = rp[16 + i]; const float x1 = f[4][i], x2 = f[5][i]; f[4][i] = x1 * cs - x2 * sn; f[5][i] = x2 * cs + x1 * sn; }
#pragma unroll
        for (int d0 = 0; d0 < 6; ++d0) {
#pragma unroll
            for (int i = 0; i < 8; ++i) f[d0][i] *= pg8::QSCALE_A;
            qf[d0] = __builtin_bit_cast(bf16x8, pack8(f[d0])); }
    }
    const int kr0 = tid / 12, kc0 = tid % 12, kr1 = (512 + tid) / 12, kc1 = (512 + tid) % 12, vr = tid >> 3, vc = tid & 7;
    const size_t hrow0 = (size_t)(b * 8 + h) * SEQ;
    const bf16_t* kg0 = K + (hrow0 + kr0) * 96 + kc0 * 8; const bf16_t* kg1 = K + (hrow0 + kr1) * 96 + kc1 * 8;
    const bf16_t* vg = V + (hrow0 + vr) * 64 + vc * 8;
    const int kl0 = kr0 * KP + kc0 * 16, kl1 = kr1 * KP + kc1 * 16, vl = vr * VP + vc * 16;
    const bool has1 = tid < 256;
    u32x4 ka0, kb0, ka1, kb1, vv0, vv1;
    ka0 = *(const u32x4*)kg0; if (has1) kb0 = *(const u32x4*)kg1; vv0 = *(const u32x4*)vg;
    ka1 = *(const u32x4*)(kg0 + (size_t)64 * 96); if (has1) kb1 = *(const u32x4*)(kg1 + (size_t)64 * 96);
    *(LAS u32x4*)(lds + MLA_K0 + kl0) = ka0; if (has1) *(LAS u32x4*)(lds + MLA_K0 + kl1) = kb0; *(LAS u32x4*)(lds + MLA_V0 + vl) = vv0;
    *(LAS u32x4*)(lds + MLA_K0 + KT_B + kl0) = ka1; if (has1) *(LAS u32x4*)(lds + MLA_K0 + KT_B + kl1) = kb1;
    ka0 = *(const u32x4*)(kg0 + (size_t)128 * 96); if (has1) kb0 = *(const u32x4*)(kg1 + (size_t)128 * 96); vv1 = *(const u32x4*)(vg + (size_t)64 * 64);
    __syncthreads();
    f32x16 o0, o1, negm;
#pragma unroll
    for (int i = 0; i < 16; ++i) { o0[i] = 0.f; o1[i] = 0.f; negm[i] = 0.f; }
    const int koff = r32 * KP + hi * 16;
    const int voff = (4 * hi + ((lane & 15) >> 2)) * VP + (16 * ((lane >> 4) & 1) + 4 * (lane & 3)) * 2;
    f32x16 p0, p1, n0, n1;
    { const LAS unsigned char* kb_ = lds + MLA_K0 + koff; p0 = negm; p1 = negm;
#pragma unroll
      for (int d0 = 0; d0 < 6; ++d0) { const bf16x8 a0 = *(const LAS bf16x8*)(kb_ + d0 * 32), a1 = *(const LAS bf16x8*)(kb_ + 32 * KP + d0 * 32); p0 = MFMA32(a0, qf[d0], p0); p1 = MFMA32(a1, qf[d0], p1); } }
    float m_ref, l_run = 0.f;
    { const float mx = rowmax32(p0, p1); m_ref = mx;
#pragma unroll
      for (int i = 0; i < 16; ++i) { p0[i] -= mx; p1[i] -= mx; negm[i] = -mx; } }
#define MLA_STEP(C0, C1, X0, X1, T, KAI, KBI, VVI, KAW, KBW, VVW) do { const int t_ = (T); const int cur = t_ & 1; \
        if (t_ + 3 < 64) { const size_t go = (size_t)(t_ + 3) * 64; KAI = *(const u32x4*)(kg0 + go * 96); if (has1) KBI = *(const u32x4*)(kg1 + go * 96); } \
        if (t_ + 2 < 64) { const size_t go = (size_t)(t_ + 2) * 64; VVI = *(const u32x4*)(vg + go * 64); } \
        bf16x8 kfr[12]; { const LAS unsigned char* kn = lds + MLA_K0 + (cur ^ 1) * KT_B + koff; \
            _Pragma("unroll") for (int d0 = 0; d0 < 6; ++d0) { kfr[2 * d0] = *(const LAS bf16x8*)(kn + d0 * 32); kfr[2 * d0 + 1] = *(const LAS bf16x8*)(kn + 32 * KP + d0 * 32); } } \
        SBAR0(); \
        const float mx = rowmax32(C0, C1); \
        if (__builtin_amdgcn_ballot_w64(mx > MLA_THR) != 0ull) { const float d = fmaxf(mx, 0.f); const float sc = __builtin_amdgcn_exp2f(-d); m_ref += d; l_run *= sc; \
            _Pragma("unroll") for (int i = 0; i < 16; ++i) { C0[i] -= d; C1[i] -= d; o0[i] *= sc; o1[i] *= sc; negm[i] = -m_ref; } } \
        SBAR0(); \
        X0 = negm; X1 = negm; \
        _Pragma("unroll") for (int d0 = 0; d0 < 6; ++d0) { X0 = MFMA32(kfr[2 * d0], qf[d0], X0); X1 = MFMA32(kfr[2 * d0 + 1], qf[d0], X1); } \
        SBAR0(); \
        float ls = 0.f; \
        _Pragma("unroll") for (int i = 0; i < 16; ++i) { C0[i] = __builtin_amdgcn_exp2f(C0[i]); C1[i] = __builtin_amdgcn_exp2f(C1[i]); ls += C0[i] + C1[i]; } \
        l_run += ls; \
        bf16x8 pb[4]; pb[0] = packp(C0, 0); pb[1] = packp(C0, 8); pb[2] = packp(C1, 0); pb[3] = packp(C1, 8); \
        const LAS unsigned char* vb_ = lds + MLA_V0 + cur * VT_B + voff; \
        _Pragma("unroll") for (int j = 0; j < 4; ++j) { const LAS unsigned char* vj = vb_ + 16 * j * VP; \
            const bf16x8 a0 = cat8(vtr(vj), vtr(vj + 8 * VP)); const bf16x8 a1 = cat8(vtr(vj + 64), vtr(vj + 8 * VP + 64)); \
            o0 = MFMA32(a0, pb[j], o0); o1 = MFMA32(a1, pb[j], o1); } \
        if (t_ + 2 < 64) { *(LAS u32x4*)(lds + MLA_K0 + cur * KT_B + kl0) = KAW; if (has1) *(LAS u32x4*)(lds + MLA_K0 + cur * KT_B + kl1) = KBW; } \
        if (t_ + 1 < 64) *(LAS u32x4*)(lds + MLA_V0 + (cur ^ 1) * VT_B + vl) = VVW; \
        __syncthreads(); } while (0)
    for (int t = 0; t < 64; t += 2) { MLA_STEP(p0, p1, n0, n1, t, ka1, kb1, vv0, ka0, kb0, vv1); MLA_STEP(n0, n1, p0, p1, t + 1, ka0, kb0, vv1, ka1, kb1, vv0); }
#undef MLA_STEP
    const float lt = l_run + __shfl_xor(l_run, 32); const float inv = 1.0f / lt;
    bf16_t* yp = Y + qrow * 1024 + h * 64 + 4 * hi;
#pragma unroll
    for (int g = 0; g < 4; ++g) {
        u32x2 w0; w0.x = cvt_pk_bf16(o0[4 * g] * inv, o0[4 * g + 1] * inv); w0.y = cvt_pk_bf16(o0[4 * g + 2] * inv, o0[4 * g + 3] * inv); *(u32x2*)(yp + 8 * g) = w0;
        u32x2 w1; w1.x = cvt_pk_bf16(o1[4 * g] * inv, o1[4 * g + 1] * inv); w1.y = cvt_pk_bf16(o1[4 * g + 2] * inv, o1[4 * g + 3] * inv); *(u32x2*)(yp + 32 + 8 * g) = w1; }
}

constexpr int DW_BYTES = 13440;
template <int DELTA>
__device__ __forceinline__ void dil_block(LAS unsigned char* wl, const bf16_t* kbase  , const bf16_t* vbase, size_t rstride  ,
                                          const bf16x8 (&qf)[2][4], f32x16 (&o)[2][2], float (&m_run)[2], float (&l_run)[2], int bvar, int voff, int lane, int r32, int hi, int btb) {
    u32x4 vv[8]; bf16x8 kf[2][4];
#pragma unroll
    for (int i = 0; i < 8; ++i) { const int idx = lane + 64 * i, row = idx >> 3, ch = idx & 7; vv[i] = *(const u32x4*)(vbase + (size_t)row * rstride + ch * 8); }
#pragma unroll
    for (int kvh = 0; kvh < 2; ++kvh)
#pragma unroll
        for (int d0 = 0; d0 < 4; ++d0) kf[kvh][d0] = *(const bf16x8*)(kbase + (size_t)(32 * kvh + r32) * rstride + d0 * 16);
    SBAR0();
#pragma unroll
    for (int i = 0; i < 8; ++i) { const int idx = lane + 64 * i, row = idx >> 3, ch = idx & 7; *(LAS u32x4*)(wl + row * VP + ch * 16) = vv[i]; }
    bf16x8 pb[2][4];
#pragma unroll
    for (int qh = 0; qh < 2; ++qh) {
        f32x16 s[2]; float mx = -1e30f;
#pragma unroll
        for (int kvh = 0; kvh < 2; ++kvh) {
            constexpr int dummy = 0; (void)dummy;
            const int toff = 64 * DELTA + 32 * (kvh - qh);
            if (toff > 64 || toff < -64) continue;
#pragma unroll
            for (int i = 0; i < 16; ++i) s[kvh][i] = 0.f;
#pragma unroll
            for (int d0 = 0; d0 < 4; ++d0) s[kvh] = MFMA32(kf[kvh][d0], qf[qh][d0], s[kvh]);
#pragma unroll
            for (int rr = 0; rr < 16; ++rr) { const int c4 = 4 * ((rr & 3) + 8 * (rr >> 2)); const float bias = *(const LAS float*)(wl + bvar + (VT_B + c4 + toff * 4));
                float v = s[kvh][rr] + bias;
                if (toff == 64) v = (bvar <= btb - c4) ? v : -1e30f;
                if (toff == -64) v = (bvar >= btb - c4) ? v : -1e30f;
                s[kvh][rr] = v; mx = fmaxf(mx, v); }
        }
        mx = fmaxf(mx, __shfl_xor(mx, 32));
        const float m_new = fmaxf(m_run[qh], mx); const float alpha = __builtin_amdgcn_exp2f(m_run[qh] - m_new); m_run[qh] = m_new;
        float ls = 0.f;
#pragma unroll
        for (int kvh = 0; kvh < 2; ++kvh) { const int toff = 64 * DELTA + 32 * (kvh - qh);
            if (toff > 64 || toff < -64) continue;
#pragma unroll
            for (int rr = 0; rr < 16; ++rr) { const float e = __builtin_amdgcn_exp2f(s[kvh][rr] - m_new); s[kvh][rr] = e; ls += e; }
            pb[qh][2 * kvh] = packp(s[kvh], 0); pb[qh][2 * kvh + 1] = packp(s[kvh], 8); }
        l_run[qh] = l_run[qh] * alpha + ls;
#pragma unroll
        for (int i = 0; i < 16; ++i) { o[qh][0][i] *= alpha; o[qh][1][i] *= alpha; }
    }
    LDS_WAIT();
#pragma unroll
    for (int j = 0; j < 4; ++j) { const LAS unsigned char* vj = wl + voff + 16 * j * VP;
        const bf16x8 a0 = cat8(vtr(vj), vtr(vj + 8 * VP)); const bf16x8 a1 = cat8(vtr(vj + 64), vtr(vj + 8 * VP + 64));
#pragma unroll
        for (int qh = 0; qh < 2; ++qh) { const int toff = 64 * DELTA + 32 * ((j >> 1) - qh);
            if (toff > 64 || toff < -64) continue;
            o[qh][0] = MFMA32(a0, pb[qh][j], o[qh][0]); o[qh][1] = MFMA32(a1, pb[qh][j], o[qh][1]); } }
    LDS_WAIT();
}
template <int P_>
__device__ __forceinline__ void dil_wave_unit(LAS unsigned char* wl, const bf16_t* DIL, bf16_t* Y, bf16_t* ST, float* LSE, const float* BT, int b, int h, int r, int nb) {
    constexpr int dil = P_ == 0 ? 1 : (P_ == 1 ? 4 : 16), nblk = 64 / dil; constexpr bool first = P_ == 0, last = P_ == 2;
    const int lane = otid() & 63, r32 = lane & 31, hi = lane >> 5;
    const size_t tok0 = (size_t)b * SEQ; const size_t rstride = (size_t)dil * 64;
    LAS float* bt = (LAS float*)(wl + VT_B);
    for (int i = lane; i < 257; i += 64) { int j = i - 64; j = j < 0 ? 0 : (j > 128 ? 128 : j); bt[i] = BT[(P_ * 8 + h) * 129 + j]; }
    const int btb = 128 * 4;
    const int bvar = btb + 4 * (4 * hi - r32);
    bf16x8 qf[2][4];
    const bf16_t* rowb = DIL + ((size_t)(b * 8 + h) * SEQ + (size_t)(64 * nb) * dil + r) * 64;
    constexpr size_t KOFF = pg8::DPLANE, VOFF = 2 * pg8::DPLANE;
#pragma unroll
    for (int qh = 0; qh < 2; ++qh)
#pragma unroll
        for (int d0 = 0; d0 < 4; ++d0) qf[qh][d0] = *(const bf16x8*)(rowb + (size_t)(32 * qh + r32) * rstride + hi * 8 + d0 * 16);
    f32x16 o[2][2];
#pragma unroll
    for (int a = 0; a < 2; ++a)
#pragma unroll
        for (int c = 0; c < 2; ++c)
#pragma unroll
            for (int i = 0; i < 16; ++i) o[a][c][i] = 0.f;
    float m_run[2] = {-1e30f, -1e30f}, l_run[2] = {0.f, 0.f};
    const int voff = (4 * hi + ((lane & 15) >> 2)) * VP + (16 * ((lane >> 4) & 1) + 4 * (lane & 3)) * 2;
    LDS_WAIT();
    dil_block<0>(wl, rowb + KOFF + hi * 8, rowb + VOFF, rstride, qf, o, m_run, l_run, bvar, voff, lane, r32, hi, btb);
    if (nb > 0) dil_block<-1>(wl, rowb - 64 * rstride + KOFF + hi * 8, rowb - 64 * rstride + VOFF, rstride, qf, o, m_run, l_run, bvar, voff, lane, r32, hi, btb);
    if (nb + 1 < nblk) dil_block<1>(wl, rowb + 64 * rstride + KOFF + hi * 8, rowb + 64 * rstride + VOFF, rstride, qf, o, m_run, l_run, bvar, voff, lane, r32, hi, btb);
    float lp[2]; u32x2 pv[2][8];
    if (!first) {
#pragma unroll
        for (int qh = 0; qh < 2; ++qh) { const size_t srow = (size_t)(b * 8 + h) * SEQ + (size_t)(64 * nb + 32 * qh + r32) * dil + r; lp[qh] = LSE[srow];
            const bf16_t* sp = ST + srow * 64 + 4 * hi;
#pragma unroll
            for (int e = 0; e < 8; ++e) pv[qh][e] = *(const u32x2*)(sp + 32 * (e >> 2) + 8 * (e & 3)); }
    }
#pragma unroll
    for (int qh = 0; qh < 2; ++qh) {
        const size_t spos = (size_t)(64 * nb + 32 * qh + r32) * dil + r; const size_t srow = (size_t)(b * 8 + h) * SEQ + spos;
        const float lt = l_run[qh] + __shfl_xor(l_run[qh], 32); const float inv = 1.0f / lt; const float lse2 = m_run[qh] + __builtin_amdgcn_logf(lt);
        float a_prev = 0.f, a_cur = inv, lse_new = lse2;
        if (!first) { const float M = fmaxf(lp[qh], lse2); const float wp = __builtin_amdgcn_exp2f(lp[qh] - M), wc = __builtin_amdgcn_exp2f(lse2 - M); const float den = wp + wc;
            a_prev = wp / den; a_cur = wc / den * inv; lse_new = M + __builtin_amdgcn_logf(den); }
        bf16_t* yp = last ? Y + (tok0 + spos) * 1024 + 512 + h * 64 + 4 * hi : ST + srow * 64 + 4 * hi;
#pragma unroll
        for (int e = 0; e < 8; ++e) { const int blk = e >> 2, g = e & 3;
            float v0 = o[qh][blk][4 * g] * a_cur, v1 = o[qh][blk][4 * g + 1] * a_cur, v2 = o[qh][blk][4 * g + 2] * a_cur, v3 = o[qh][blk][4 * g + 3] * a_cur;
            if (!first) { v0 += a_prev * bf_lo(pv[qh][e].x); v1 += a_prev * bf_hi(pv[qh][e].x); v2 += a_prev * bf_lo(pv[qh][e].y); v3 += a_prev * bf_hi(pv[qh][e].y); }
            u32x2 w; w.x = cvt_pk_bf16(v0, v1); w.y = cvt_pk_bf16(v2, v3); *(u32x2*)(yp + 32 * blk + 8 * g) = w; }
        if (!last && hi == 0) LSE[srow] = lse_new;
    }
}
__device__ __forceinline__ void dil_unit(LAS unsigned char* lds, const bf16_t* DIL, bf16_t* Y, bf16_t* ST, float* LSE, const float* BT, int b, int h, int c) {
    const int wid = __builtin_amdgcn_readfirstlane(otid() >> 6);
    LAS unsigned char* wl = lds + wid * DW_BYTES;
    for (int j = 0; j < 2; ++j) { const int wu = 2 * wid + j; dil_wave_unit<0>(wl, DIL, Y, ST, LSE, BT, b, h, 0, c * 16 + wu); }
    __syncthreads();
    for (int j = 0; j < 2; ++j) { const int wu = 2 * wid + j; dil_wave_unit<1>(wl, DIL, Y, ST, LSE, BT, b, h, wu >> 2, c * 4 + (wu & 3)); }
    __syncthreads();
    for (int j = 0; j < 2; ++j) { const int wu = 2 * wid + j; dil_wave_unit<2>(wl, DIL, Y, ST, LSE, BT, b, h, wu, c); }
    __syncthreads();
}

typedef __attribute__((address_space(1))) unsigned gu32;
#define XB_TMO      128
#define XB_XCNT(j)  (256  + 64 * (j))
#define XB_XSUB(j)  (1280 + 64 * (j))
#define XB_XGEN(j)  (2304 + 64 * (j))
#define XB_TOP      3328
#define XB_TOPGEN   3392
#define XCD_BAR_WORDS 3456
#define XB_SPIN_CAP (1u << 18)

__device__ __forceinline__ unsigned xb_ld(unsigned* p)              { return __hip_atomic_load(p, __ATOMIC_RELAXED, __HIP_MEMORY_SCOPE_AGENT); }
__device__ __forceinline__ unsigned xb_add(unsigned* p, unsigned v) { return __hip_atomic_fetch_add(p, v, __ATOMIC_RELAXED, __HIP_MEMORY_SCOPE_AGENT); }
__device__ __forceinline__ unsigned xb_xcc_id() { return (unsigned)__builtin_amdgcn_s_getreg((3 << 11) | 20) & 0xFu; }
#define XB_SPIN(cond, bar) do { unsigned _sp = 0; while (cond) { __builtin_amdgcn_s_sleep(1); \
    if ((++_sp & 255u) == 0u) { if (xb_ld(&(bar)[XB_TMO])) break; if (_sp > XB_SPIN_CAP) { atomicAdd(&(bar)[XB_TMO], 1u); break; } } } } while (0)

struct XcdBarrier {
    unsigned* bar; unsigned x;
    volatile LAS unsigned* st;
};

__device__ __forceinline__ XcdBarrier xcd_barrier_post(unsigned* bar, volatile LAS unsigned* st) {
    XcdBarrier b; b.bar = bar; b.x = xb_xcc_id(); b.st = st;
    if (threadIdx.x == 0) (void)xb_add(&bar[XB_XCNT(b.x)], 1u);
    return b;
}
__device__ __forceinline__ void xcd_barrier_complete(unsigned* bar, unsigned x, unsigned& nloc, unsigned& nx) {
    const unsigned G = gridDim.x * gridDim.y * gridDim.z;
    unsigned sum, cnt, mine, sp = 0u;
    for (;;) {
        sum = 0u; cnt = 0u; mine = 0u;
#pragma unroll
        for (unsigned j = 0; j < 16; ++j) { const unsigned c = xb_ld(&bar[XB_XCNT(j)]); sum += c; cnt += (c > 0u) ? 1u : 0u; mine = (j == x) ? c : mine; }
        if (sum == G) break;
        __builtin_amdgcn_s_sleep(1);
        if ((++sp & 255u) == 0u) { if (xb_ld(&bar[XB_TMO])) break; if (sp > XB_SPIN_CAP) { atomicAdd(&bar[XB_TMO], 1u); break; } }
    }
    nloc = mine > 0u ? mine : 1u; nx = cnt > 0u ? cnt : 1u;
}

__device__ __forceinline__ void xcd_barrier(const XcdBarrier& b) {
    asm volatile("s_waitcnt vmcnt(0)" ::: "memory");
    __syncthreads();
    if (threadIdx.x == 0) {
        unsigned* bar = b.bar;
        __builtin_amdgcn_s_waitcnt(0);
        unsigned nloc = b.st[0], nx = b.st[1];
        if (nloc == 0u) { xcd_barrier_complete(bar, b.x, nloc, nx); b.st[0] = nloc; b.st[1] = nx; }
        const unsigned old = xb_add(&bar[XB_XSUB(b.x)], 1u);
        const unsigned gen = old / nloc;
        if (old + 1u == (gen + 1u) * nloc) {
            __builtin_amdgcn_fence(__ATOMIC_RELEASE, "agent");
            asm volatile("s_waitcnt vmcnt(0)" ::: "memory");
            const unsigned og = xb_add(&bar[XB_TOP], 1u);
            const unsigned tg = og / nx;
            if (og + 1u == (tg + 1u) * nx) xb_add(&bar[XB_TOPGEN], 1u);
            else XB_SPIN(xb_ld(&bar[XB_TOPGEN]) == tg, bar);
            __builtin_amdgcn_fence(__ATOMIC_ACQUIRE, "agent");
            xb_add(&bar[XB_XGEN(b.x)], 1u);
            asm volatile("s_waitcnt vmcnt(0)" ::: "memory");
        } else {
            XB_SPIN(xb_ld(&bar[XB_XGEN(b.x)]) == gen, bar);
            __builtin_amdgcn_fence(__ATOMIC_ACQUIRE, "agent");
            asm volatile("s_waitcnt vmcnt(0)" ::: "memory");
        }
    }
    __syncthreads();
}

constexpr int NPHASE = 2 + DEPTH * 8;
__device__ __forceinline__ unsigned char* opaque_ptr(unsigned char* p) { asm volatile("" : "+s"(p)); return p; }
#define GEMM(EpiT, Ev, Ap, Bp, Nn, Kk, Ld) do { pg8::Gemm g_{(Ap), (Bp), NTOK, (Nn), (Kk), (Ld)}; pg8::StaticOrder S_; S_.init(NTOK, (Nn), G, obid()); \
        pg8::gemm_phase<EpiT, pg8::StaticOrder, true, true>(lds, g_, S_, (Ev)); } while (0)
#define BF(off) ((bf16_t*)(ws + (off)))
#define FP(off) ((float*)(ws + (off)))
#define WB(l_, off) ((bf16_t*)(ws + WS_W + (size_t)((l_) & 1) * WS_WSTRIDE + (off)))
__global__ void __launch_bounds__(NTHR, 2) mega_fwd(Params P0) {
    extern __shared__ __attribute__((aligned(16))) unsigned char lds_raw[];
    LAS unsigned char* lds = (LAS unsigned char*)lds_raw;
    cg::grid_group grid = cg::this_grid();
    { volatile LAS unsigned* misc = (volatile LAS unsigned*)(lds + RING_BYTES + 320); if (otid() < 32) misc[otid()] = 0u; }
    __syncthreads();
    XcdBarrier xbar = xcd_barrier_post((unsigned*)(P0.ws + WS_CTL) + 1024, (volatile LAS unsigned*)(lds + RING_BYTES + 320) + 8);
    { volatile LAS unsigned* misc = (volatile LAS unsigned*)(lds + RING_BYTES + 320);
      if (otid() == 0) { const unsigned x = xb_xcc_id(); misc[16] = xb_add((unsigned*)(P0.ws + WS_CTL) + 8192 + 64 * x, 1u); misc[17] = x; } }
    __syncthreads();
    const int ph_lo = P0.ph_lo, ph_hi = P0.ph_hi;
    for (int ph = ph_lo; ph < ph_hi; ++ph) {
        int G_ = (int)gridDim.x; asm volatile("" : "+s"(G_)); const int G = G_;
        typedef const __attribute__((address_space(4))) Params* kparams_t;
        kparams_t kp_ = (kparams_t)__builtin_amdgcn_kernarg_segment_ptr(); asm volatile("" : "+s"(kp_));
        const Params& P = *(const Params*)kp_;
        unsigned char* ws = opaque_ptr(P.ws);
        const int l = ph > 1 ? (ph - 2) / 8 : 0, k = ph > 1 ? (ph - 2) % 8 + 2 : ph;
        const size_t modl = (size_t)l * 16 * 6144;
        switch (k) {
        case 0: {
            phase0(P, lds, G);
            float* SSQ = FP(WS_SSQ);
            for (int i = obid() * NTHR + otid(); i < 2 * NTOK; i += G * NTHR) SSQ[i] = 0.f;
            __syncthreads();
            conv_weights(P, 0, ws + WS_W, lds, G);
        } break;
        case 1: {
            bias_phase(P, lds, G);
            prepass_phase(P.x, P.norm1_g, FP(WS_MOD), 1024, BF(WS_H), FP(WS_SSQ) + 2 * NTOK, G);
        } break;
        case 2: {
            pg8::EpiIn E{BF(WS_PA), BF(WS_DIL), BF(WS_GATES), FP(WS_SSQ), FP(WS_SSQ) + NTOK, P.q_norm_b + l * 64, P.k_norm_b + l * 64, FP(WS_SSQ) + 2 * NTOK, FP(WS_BW1) + (size_t)l * 16 * 4096};
            GEMM(pg8::EpiIn, E, BF(WS_H), WB(l, W_IN), NIN, 1024, 1024);
        } break;
        case 3: {
            { pg8::EpiRowScale E{BF(WS_H), 768, FP(WS_SSQ), 1.0f / 256.0f}; GEMM(pg8::EpiRowScale, E, BF(WS_PA), WB(l, W_Q), 768, 256, 512); }
            { pg8::EpiRowScale E{BF(WS_KVRAW), 1024, FP(WS_SSQ) + NTOK, 1.0f / 128.0f}; GEMM(pg8::EpiRowScale, E, BF(WS_PA) + 256, WB(l, W_KV), 1024, 256, 512); }
        } break;
        case 4: prep_phase(P, l, G); break;
        case 5: {
            { float* SSQ = FP(WS_SSQ); for (int i = obid() * NTHR + otid(); i < 4 * NTOK; i += G * NTHR) SSQ[i] = 0.f; }
            if (l + 1 < DEPTH) { conv_weights(P, l + 1, ws + WS_W + (size_t)((l + 1) & 1) * WS_WSTRIDE, lds, G); __syncthreads(); }
            bf16_t* Y = BF(WS_KVRAW);
            if (G == 256) { int xcd = obid() & 7, slot = obid() >> 3;
                { const unsigned* tk = (const unsigned*)(ws + WS_CTL) + 8192; bool even = true;
#pragma unroll
                  for (int x = 0; x < 8; ++x) even = even && (__hip_atomic_load(tk + 64 * x, __ATOMIC_RELAXED, __HIP_MEMORY_SCOPE_AGENT) == 32u);
                  if (even) { volatile LAS unsigned* misc = (volatile LAS unsigned*)(lds + RING_BYTES + 320); slot = (int)misc[16]; xcd = (int)misc[17]; } }
                slot = __builtin_amdgcn_readfirstlane(slot); xcd = __builtin_amdgcn_readfirstlane(xcd);
                for (int i = 0; i < 8; ++i) { const int bh = ((i * 2 + (slot >> 4)) << 3) + xcd; mla_unit(lds, BF(WS_H), BF(WS_K), BF(WS_V), Y, P.q_norm_a + l * 96, FP(WS_ROPE), bh >> 3, bh & 7, slot & 15); }
            } else { for (int u = obid(); u < NB * NH * 16; u += G) mla_unit(lds, BF(WS_H), BF(WS_K), BF(WS_V), Y, P.q_norm_a + l * 96, FP(WS_ROPE), u >> 7, (u >> 4) & 7, u & 15); }
            __syncthreads();
            for (int u = obid(); u < NB * NH * 4; u += G) dil_unit(lds, BF(WS_DIL), Y, BF(WS_PA), FP(WS_LSE), FP(WS_BT), u >> 5, (u >> 2) & 7, u & 3);
        } break;
        case 6: {
            pg8::EpiGate2 E{BF(WS_H), BF(WS_GATES)}; GEMM(pg8::EpiGate2, E, BF(WS_KVRAW), WB(l, W_A), 1024, 1024, 1024);
        } break;
        case 7: {
            pg8::EpiResid E{l == 0 ? P.x : P.out, P.out, FP(WS_MOD) + modl + 2048, BF(WS_KVRAW), P.norm2_g + l * DM, FP(WS_MOD) + modl + 4096, FP(WS_SSQ) + 3 * NTOK};
            GEMM(pg8::EpiResid, E, BF(WS_H), WB(l, W_O), 1024, 1024, 1024);
        } break;
        case 8: {
            pg8::EpiSwiGLU E{BF(WS_HID), FP(WS_SSQ) + 3 * NTOK, FP(WS_BW2) + (size_t)l * 16 * 5632}; GEMM(pg8::EpiSwiGLU, E, BF(WS_KVRAW), WB(l, W_1), 5632, 1024, 1024);
        } break;
        default: {
            const bool nxt = l + 1 < DEPTH; const size_t modn = (size_t)(l + 1) * 16 * 6144;
            pg8::EpiResid E{P.out, P.out, FP(WS_MOD) + modl + 5120, nxt ? BF(WS_H) : (bf16_t*)nullptr, P.norm1_g + (nxt ? (l + 1) * DM : 0), FP(WS_MOD) + (nxt ? modn + 1024 : 0), FP(WS_SSQ) + 2 * NTOK};
            GEMM(pg8::EpiResid, E, BF(WS_HID), WB(l, W_2), 1024, FFH, FFH);
        } break;
        }
        if (ph + 1 < ph_hi) { if (ph == ph_lo) grid.sync(); else xcd_barrier(xbar); }
    }
}

extern "C" void kernel_launch(void* const* d_in, const int* in_sizes, int n_in, void* d_out, int out_size, void* d_ws, size_t ws_size, hipStream_t stream) {
    static int grid = 0;
    if (grid == 0) {
        if (n_in != 23 || ws_size < WS_END) { fprintf(stderr, "kernel_launch: unexpected n_in %d / ws_size %zu\n", n_in, ws_size); grid = -1; return; }
        int dev = 0, cus = 0, per_cu = 0;
        (void)hipGetDevice(&dev); (void)hipDeviceGetAttribute(&cus, hipDeviceAttributeMultiprocessorCount, dev);
        if (hipFuncSetAttribute((const void*)mega_fwd, hipFuncAttributeMaxDynamicSharedMemorySize, LDS_BYTES) != hipSuccess) { fprintf(stderr, "kernel_launch: hipFuncSetAttribute failed\n"); grid = -1; return; }
        if (hipOccupancyMaxActiveBlocksPerMultiprocessor(&per_cu, (const void*)mega_fwd, NTHR, LDS_BYTES) != hipSuccess || per_cu < 1) { fprintf(stderr, "kernel_launch: occupancy query gave %d\n", per_cu); per_cu = 1; }
        (void)hipGetLastError();
        grid = cus * per_cu;
    }
    if (grid < 0) return;
    Params p{};
    const float** fp = (const float**)&p.x;
    p.x = (const float*)d_in[0]; p.c = (const float*)d_in[1]; p.pos = (const int*)d_in[2]; p.rel_bias = (const float*)d_in[3]; p.norm1_g = (const float*)d_in[4]; p.norm2_g = (const float*)d_in[5];
    p.ada_w = (const float*)d_in[6]; p.ada_b = (const float*)d_in[7]; p.w_in = (const float*)d_in[8]; p.q_a_norm = (const float*)d_in[9]; p.w_q_b = (const float*)d_in[10]; p.kv_a_norm = (const float*)d_in[11];
    p.w_kv_b = (const float*)d_in[12]; p.q_norm_a = (const float*)d_in[13]; p.k_norm_a = (const float*)d_in[14]; p.q_norm_b = (const float*)d_in[15]; p.k_norm_b = (const float*)d_in[16];
    p.w_branch_a = (const float*)d_in[17]; p.w_branch_b = (const float*)d_in[18]; p.w_out = (const float*)d_in[19]; p.w_ffn_gate = (const float*)d_in[20]; p.w_ffn_up = (const float*)d_in[21]; p.w_ffn_down = (const float*)d_in[22];
    (void)fp;
    p.out = (float*)d_out; p.ws = (unsigned char*)d_ws;
    for (int i = 0; i < 16; ++i) p.inv_freq[i] = (float)pow(10000.0, -(double)i / 16.0);
    p.ph_lo = 0; p.ph_hi = NPHASE;
    if (hipMemsetAsync((char*)d_ws + WS_CTL, 0, CTL_BYTES, stream) != hipSuccess) { fprintf(stderr, "kernel_launch: memset failed\n"); return; }
    void* args[] = {&p};
    hipError_t e = hipLaunchCooperativeKernel((const void*)mega_fwd, dim3(grid), dim3(NTHR), args, LDS_BYTES, stream);
    if (e != hipSuccess) fprintf(stderr, "kernel_launch: cooperative launch failed: %s (grid %d)\n", hipGetErrorString(e), grid);
}
```

```cpp
#include <hip/hip_runtime.h>
#include <hip/hip_cooperative_groups.h>
#include <cstdio>
#include <cstdint>
namespace cg = cooperative_groups;
__device__ __forceinline__ int otid() { int t = (int)threadIdx.x; asm volatile("" : "+v"(t)); return t; }
__device__ __forceinline__ int obid() { int b = (int)blockIdx.x; asm volatile("" : "+s"(b)); return b; }

#include <cmath>
namespace pg8 {
#define PG8_LAS __attribute__((address_space(3)))
typedef unsigned short bf16_t;
typedef short bf16x8 __attribute__((ext_vector_type(8)));
typedef float f32x4 __attribute__((ext_vector_type(4)));
typedef unsigned u32x4 __attribute__((ext_vector_type(4)));
constexpr int BM = 256, BK = 64, HALF = 128, HTB = HALF * BK * 2  , STAGE_BYTES = 8 * HTB, NXCD = 8, WGM = 8;

__host__ __device__ __forceinline__ int lds_byte(int r, int c) { const int st = (r >> 4) * 2 + (c >> 5), rr = r & 15, cc = c & 31, ob = rr * 64 + cc * 2; return st * 1024 + (ob ^ (((ob >> 9) & 1) << 5)); }
__host__ __device__ __forceinline__ void stage_rc(int b, int& R, int& C) { const int st = b / 1024, sb = b % 1024, swz = sb ^ (((sb >> 9) & 1) << 5); R = (st >> 1) * 16 + swz / 64; C = (st & 1) * 32 + (swz % 64) / 2; }
__host__ __device__ __forceinline__ int perm32(int rho) { const int n = rho >> 4, i = rho & 15; return 8 * (i >> 2) + 4 * n + (i & 3); }

struct Unit { int pm, pn; };
struct Gemm { const bf16_t* A; const bf16_t* Bt; int M, N, K, lda, asplit, aoff2; };

struct StaticOrder {
    int nM, nN, nwg, G, c;
    __host__ __device__ void init(int M, int N, int G_, int c_) { nM = M / BM; nN = N / BM; nwg = nM * nN; G = G_; c = c_; }
    __host__ __device__ bool next(int i, Unit& u) const {
        const long L = (long)i * G + c; if (L >= nwg) return false;
        int wgid = (int)L; { const int q = nwg / NXCD, r = nwg % NXCD, xcd = wgid % NXCD, off = wgid / NXCD; wgid = (xcd < r ? xcd * (q + 1) : r * (q + 1) + (xcd - r) * q) + off; }
        const int nig = WGM * nN, gid = wgid / nig, fm = gid * WGM, gsz = (nM - fm) < WGM ? (nM - fm) : WGM;
        u.pm = fm + ((wgid % nig) % gsz); u.pn = (wgid % nig) / gsz; return true;
    }
    __device__ __forceinline__ void a_ready(const Unit&) const {}
    __device__ __forceinline__ void done(const Unit&) const {}
};


__device__ __forceinline__ unsigned cvt_pk_bf16(float lo, float hi) { unsigned r; asm volatile("v_cvt_pk_bf16_f32 %0, %1, %2" : "=v"(r) : "v"(lo), "v"(hi)); return r; }
typedef unsigned u32x2 __attribute__((ext_vector_type(2)));
__device__ __forceinline__ float bf_lo(unsigned w) { return __builtin_bit_cast(float, w << 16); }
__device__ __forceinline__ float bf_hi(unsigned w) { return __builtin_bit_cast(float, w & 0xffff0000u); }
__device__ __forceinline__ float sigmoidf_(float x) { return 1.0f / (1.0f + __builtin_amdgcn_exp2f(-1.4426950408889634f * x)); }

constexpr float RMS_EPS = 1e-6f;
constexpr size_t DPLANE = (size_t)65536 * 512;
constexpr float LOG2E = 1.4426950408889634f;
constexpr float QSCALE_B = 0.125f * 1.4426950408889634f;
constexpr float QSCALE_A = 0.10206207261596575f * 1.4426950408889634f;

struct EpiIn {
    static constexpr bool PERM = false, AFTER_DRAIN = false, MIDHOOK = false;
    bf16_t* PA; bf16_t* DIL; bf16_t* GATES; float* ssq_q; float* ssq_kv; const float* qn; const float* kn; const float* ssq1; const float* bw;
    __device__ __forceinline__ void operator()(const f32x4 (&acc_)[2][2][4][2], const Unit& u, int wr, int wc, int fr, int fq) const {
        { const int ln_ = otid() & 63; fr = ln_ & 15; fq = ln_ >> 4; }
        const int pn = u.pn; const size_t rowb = (size_t)u.pm * BM + wr * 64 + fr;
        f32x4 bv[2][2]; float r8[2][4];
        { const float* bwp = bw + (size_t)(u.pm >> 4) * 4096 + pn * BM + wc * 32 + fq * 4;
#pragma unroll
          for (int bj = 0; bj < 2; ++bj)
#pragma unroll
              for (int n = 0; n < 2; ++n) bv[bj][n] = *(const f32x4*)(bwp + bj * HALF + n * 16);
#pragma unroll
          for (int ai = 0; ai < 2; ++ai)
#pragma unroll
              for (int m = 0; m < 4; ++m) r8[ai][m] = __builtin_amdgcn_rsqf(ssq1[rowb + ai * HALF + m * 16] * (1.0f / 1024.0f) + RMS_EPS); }
#define EPIIN_VAL(ai, bj, m, n) (acc_[ai][bj][m][n] * r8[ai][m] + bv[bj][n])
        if (pn < 2) {
            float* sq = pn == 0 ? ssq_q : ssq_kv;
#pragma unroll
            for (int ai = 0; ai < 2; ++ai)
#pragma unroll
                for (int m = 0; m < 4; ++m) { const size_t row = rowb + ai * HALF + m * 16; float s = 0.f;
#pragma unroll
                    for (int bj = 0; bj < 2; ++bj)
#pragma unroll
                        for (int n = 0; n < 2; ++n) { const f32x4 v = EPIIN_VAL(ai, bj, m, n);
                            u32x2 w; w.x = cvt_pk_bf16(v[0], v[1]); w.y = cvt_pk_bf16(v[2], v[3]);
                            *(u32x2*)(PA + row * 512 + pn * 256 + bj * HALF + wc * 32 + n * 16 + fq * 4) = w;
                            if (pn == 0 || bj == 0) s += (v[0] * v[0] + v[1] * v[1]) + (v[2] * v[2] + v[3] * v[3]); }
                    s += __shfl_xor(s, 16); s += __shfl_xor(s, 32);
                    if (fq == 0) atomicAdd(sq + row, s); }
        } else if (pn < 6) {
            const int sec = (pn - 2) >> 1, head = 4 * ((pn - 2) & 1) + wc; const float* gp = sec == 0 ? qn : kn; const float gs = sec == 0 ? QSCALE_B : 1.0f;
            f32x4 gv[2][2];
#pragma unroll
            for (int bj = 0; bj < 2; ++bj)
#pragma unroll
                for (int n = 0; n < 2; ++n) gv[bj][n] = *(const f32x4*)(gp + 32 * bj + 16 * n + 4 * fq) * gs;
#pragma unroll
            for (int ai = 0; ai < 2; ++ai)
#pragma unroll
                for (int m = 0; m < 4; ++m) { const size_t row = rowb + ai * HALF + m * 16; float s = 0.f;
#pragma unroll
                    for (int bj = 0; bj < 2; ++bj)
#pragma unroll
                        for (int n = 0; n < 2; ++n) { const f32x4 v = EPIIN_VAL(ai, bj, m, n); s += (v[0] * v[0] + v[1] * v[1]) + (v[2] * v[2] + v[3] * v[3]); }
                    s += __shfl_xor(s, 16); s += __shfl_xor(s, 32);
                    const float r = __builtin_amdgcn_rsqf(s * (1.0f / 64.0f) + RMS_EPS);
#pragma unroll
                    for (int bj = 0; bj < 2; ++bj)
#pragma unroll
                        for (int n = 0; n < 2; ++n) { const f32x4 v = EPIIN_VAL(ai, bj, m, n) * r * gv[bj][n];
                            u32x2 w; w.x = cvt_pk_bf16(v[0], v[1]); w.y = cvt_pk_bf16(v[2], v[3]);
                            *(u32x2*)(DIL + (size_t)sec * DPLANE + ((((row >> 12) * 8 + head) << 12) + (row & 4095)) * 64 + 32 * bj + 16 * n + 4 * fq) = w; } }
        } else if (pn < 8) {
#pragma unroll
            for (int ai = 0; ai < 2; ++ai)
#pragma unroll
                for (int m = 0; m < 4; ++m) { const size_t row = rowb + ai * HALF + m * 16;
#pragma unroll
                    for (int bj = 0; bj < 2; ++bj)
#pragma unroll
                        for (int n = 0; n < 2; ++n) { const f32x4 v = EPIIN_VAL(ai, bj, m, n);
                            u32x2 w; w.x = cvt_pk_bf16(v[0], v[1]); w.y = cvt_pk_bf16(v[2], v[3]);
                            *(u32x2*)(DIL + 2 * DPLANE + ((((row >> 12) * 8 + (pn - 6) * 4 + 2 * bj + (wc >> 1)) << 12) + (row & 4095)) * 64 + 32 * (wc & 1) + n * 16 + fq * 4) = w; } }
        } else {
#pragma unroll
            for (int ai = 0; ai < 2; ++ai)
#pragma unroll
                for (int m = 0; m < 4; ++m) { const size_t row = rowb + ai * HALF + m * 16;
#pragma unroll
                    for (int bj = 0; bj < 2; ++bj)
#pragma unroll
                        for (int n = 0; n < 2; ++n) { const f32x4 v = EPIIN_VAL(ai, bj, m, n);
                            u32x2 w; w.x = cvt_pk_bf16(sigmoidf_(v[0]), sigmoidf_(v[1])); w.y = cvt_pk_bf16(sigmoidf_(v[2]), sigmoidf_(v[3]));
                            *(u32x2*)(GATES + row * 2048 + (pn - 8) * 256 + bj * HALF + wc * 32 + n * 16 + fq * 4) = w; } }
        }
    }
};
#undef EPIIN_VAL
struct EpiRowScale2 {
    static constexpr bool PERM = true, AFTER_DRAIN = false, MIDHOOK = false;
    bf16_t* Oq; bf16_t* Okv; const float* ssq_q; const float* ssq_kv;
    __device__ __forceinline__ void operator()(const f32x4 (&acc)[2][2][4][2], const Unit& u, int wr, int wc, int fr, int fq) const {
        { const int ln_ = otid() & 63; fr = ln_ & 15; fq = ln_ >> 4; }
        const bool isq = u.pn < 3; const int pnl = isq ? u.pn : u.pn - 3; const int ldc = isq ? 768 : 1024; bf16_t* O = isq ? Oq : Okv; const float* ssq = isq ? ssq_q : ssq_kv; const float invk = isq ? 1.0f / 256.0f : 1.0f / 128.0f;
        const size_t rowb = (size_t)u.pm * BM + wr * 64 + fr; const int col0 = pnl * BM + wc * 32 + 8 * fq;
#pragma unroll
        for (int ai = 0; ai < 2; ++ai)
#pragma unroll
            for (int m = 0; m < 4; ++m) { const size_t row = rowb + ai * HALF + m * 16; const float r = __builtin_amdgcn_rsqf(ssq[row] * invk + RMS_EPS);
#pragma unroll
                for (int bj = 0; bj < 2; ++bj) { const f32x4 v0 = acc[ai][bj][m][0] * r, v1 = acc[ai][bj][m][1] * r;
                    u32x4 w; w.x = cvt_pk_bf16(v0[0], v0[1]); w.y = cvt_pk_bf16(v0[2], v0[3]); w.z = cvt_pk_bf16(v1[0], v1[1]); w.w = cvt_pk_bf16(v1[2], v1[3]);
                    *(u32x4*)(O + row * ldc + col0 + bj * HALF) = w; } }
    }
};
struct EpiRowScale {
    static constexpr bool PERM = true, AFTER_DRAIN = false, MIDHOOK = false;
    bf16_t* O; int ldc; const float* ssq; float invk;
    __device__ __forceinline__ void operator()(const f32x4 (&acc)[2][2][4][2], const Unit& u, int wr, int wc, int fr, int fq) const {
        { const int ln_ = otid() & 63; fr = ln_ & 15; fq = ln_ >> 4; }
        const size_t rowb = (size_t)u.pm * BM + wr * 64 + fr; const int col0 = u.pn * BM + wc * 32 + 8 * fq;
#pragma unroll
        for (int ai = 0; ai < 2; ++ai)
#pragma unroll
            for (int m = 0; m < 4; ++m) { const size_t row = rowb + ai * HALF + m * 16; const float r = __builtin_amdgcn_rsqf(ssq[row] * invk + RMS_EPS);
#pragma unroll
                for (int bj = 0; bj < 2; ++bj) { const f32x4 v0 = acc[ai][bj][m][0] * r, v1 = acc[ai][bj][m][1] * r;
                    u32x4 w; w.x = cvt_pk_bf16(v0[0], v0[1]); w.y = cvt_pk_bf16(v0[2], v0[3]); w.z = cvt_pk_bf16(v1[0], v1[1]); w.w = cvt_pk_bf16(v1[2], v1[3]);
                    *(u32x4*)(O + row * ldc + col0 + bj * HALF) = w; } }
    }
};
struct EpiGate2 {
    static constexpr bool PERM = true, AFTER_DRAIN = false, MIDHOOK = true;
    bf16_t* O; const bf16_t* SIG;
    __device__ __forceinline__ void mid(f32x4 (&acc)[2][2][4][2], const Unit& u, int wr, int wc) const {
        const int ln_ = otid() & 63, fr = ln_ & 15, fq = ln_ >> 4;
        const size_t rowb = (size_t)u.pm * BM + wr * 64 + fr; const int col0 = u.pn * BM + wc * 32 + 8 * fq;
#pragma unroll
        for (int ai = 0; ai < 2; ++ai)
#pragma unroll
            for (int m = 0; m < 4; ++m) { const bf16_t* sp = SIG + (rowb + ai * HALF + m * 16) * 2048 + col0;
#pragma unroll
                for (int bj = 0; bj < 2; ++bj) { const u32x4 sa = *(const u32x4*)(sp + bj * HALF), sb = *(const u32x4*)(sp + 1024 + bj * HALF);
                    f32x4& v0 = acc[ai][bj][m][0]; f32x4& v1 = acc[ai][bj][m][1];
                    v0[0] *= bf_lo(sa.x) * __builtin_amdgcn_rcpf(1e-30f + bf_lo(sb.x)); v0[1] *= bf_hi(sa.x) * __builtin_amdgcn_rcpf(1e-30f + bf_hi(sb.x));
                    v0[2] *= bf_lo(sa.y) * __builtin_amdgcn_rcpf(1e-30f + bf_lo(sb.y)); v0[3] *= bf_hi(sa.y) * __builtin_amdgcn_rcpf(1e-30f + bf_hi(sb.y));
                    v1[0] *= bf_lo(sa.z) * __builtin_amdgcn_rcpf(1e-30f + bf_lo(sb.z)); v1[1] *= bf_hi(sa.z) * __builtin_amdgcn_rcpf(1e-30f + bf_hi(sb.z));
                    v1[2] *= bf_lo(sa.w) * __builtin_amdgcn_rcpf(1e-30f + bf_lo(sb.w)); v1[3] *= bf_hi(sa.w) * __builtin_amdgcn_rcpf(1e-30f + bf_hi(sb.w)); }
                asm volatile("" ::: "memory"); }
    }
    __device__ __forceinline__ void operator()(const f32x4 (&acc)[2][2][4][2], const Unit& u, int wr, int wc, int fr, int fq) const {
        { const int ln_ = otid() & 63; fr = ln_ & 15; fq = ln_ >> 4; }
        const size_t rowb = (size_t)u.pm * BM + wr * 64 + fr; const int col0 = u.pn * BM + wc * 32 + 8 * fq;
#pragma unroll
        for (int ai = 0; ai < 2; ++ai)
#pragma unroll
            for (int m = 0; m < 4; ++m) { const size_t row = rowb + ai * HALF + m * 16;
#pragma unroll
                for (int bj = 0; bj < 2; ++bj) { const u32x4 sg = *(const u32x4*)(SIG + row * 2048 + 1024 + col0 + bj * HALF);
                    f32x4 v0 = acc[ai][bj][m][0], v1 = acc[ai][bj][m][1];
                    v0[0] *= bf_lo(sg.x); v0[1] *= bf_hi(sg.x); v0[2] *= bf_lo(sg.y); v0[3] *= bf_hi(sg.y);
                    v1[0] *= bf_lo(sg.z); v1[1] *= bf_hi(sg.z); v1[2] *= bf_lo(sg.w); v1[3] *= bf_hi(sg.w);
                    u32x4 w; w.x = cvt_pk_bf16(v0[0], v0[1]); w.y = cvt_pk_bf16(v0[2], v0[3]); w.z = cvt_pk_bf16(v1[0], v1[1]); w.w = cvt_pk_bf16(v1[2], v1[3]);
                    *(u32x4*)(O + row * 1024 + col0 + bj * HALF) = w; } }
    }
};
struct EpiResid {
    static constexpr bool PERM = false, AFTER_DRAIN = false, MIDHOOK = false;
    const float* xin; float* out; const float* gmod;
    bf16_t* XG; const float* gnorm; const float* scmod; float* ssq;
    __device__ __forceinline__ void operator()(const f32x4 (&acc)[2][2][4][2], const Unit& u, int wr, int wc, int fr, int fq) const {
        { const int ln_ = otid() & 63; fr = ln_ & 15; fq = ln_ >> 4; }
        const size_t rowb = (size_t)u.pm * BM + wr * 64 + fr; const int col0 = u.pn * BM + wc * 32 + 4 * fq; const float* gb = gmod + (size_t)(u.pm >> 4) * 6144;
        f32x4 gv[2][2], Gv[2][2];
#pragma unroll
        for (int bj = 0; bj < 2; ++bj)
#pragma unroll
            for (int n = 0; n < 2; ++n) { gv[bj][n] = *(const f32x4*)(gb + col0 + bj * HALF + n * 16);
                if (XG) Gv[bj][n] = *(const f32x4*)(gnorm + col0 + bj * HALF + n * 16) * (1.0f + *(const f32x4*)(scmod + (size_t)(u.pm >> 4) * 6144 + col0 + bj * HALF + n * 16)); }
#pragma unroll
        for (int ai = 0; ai < 2; ++ai)
#pragma unroll
            for (int m = 0; m < 4; ++m) { const size_t row = rowb + ai * HALF + m * 16; const size_t off = row * 1024 + col0; float s = 0.f;
#pragma unroll
                for (int bj = 0; bj < 2; ++bj)
#pragma unroll
                    for (int n = 0; n < 2; ++n) { const f32x4 xv = *(const f32x4*)(xin + off + bj * HALF + n * 16);
                        const f32x4 xn = xv + gv[bj][n] * acc[ai][bj][m][n];
                        *(f32x4*)(out + off + bj * HALF + n * 16) = xn;
                        if (XG) { s += (xn[0] * xn[0] + xn[1] * xn[1]) + (xn[2] * xn[2] + xn[3] * xn[3]); const f32x4 t = xn * Gv[bj][n];
                            u32x2 w; w.x = cvt_pk_bf16(t[0], t[1]); w.y = cvt_pk_bf16(t[2], t[3]); *(u32x2*)(XG + off + bj * HALF + n * 16) = w; } }
                if (XG) { s += __shfl_xor(s, 16); s += __shfl_xor(s, 32); if (fq == 0) atomicAdd(ssq + row, s); } }
    }
};
struct EpiSwiGLU {
    static constexpr bool PERM = true, AFTER_DRAIN = false, MIDHOOK = false;
    bf16_t* O; const float* ssq2; const float* bw;
    __device__ __forceinline__ void operator()(const f32x4 (&acc)[2][2][4][2], const Unit& u, int wr, int wc, int fr, int fq) const {
        { const int ln_ = otid() & 63; fr = ln_ & 15; fq = ln_ >> 4; }
        const size_t rowb = (size_t)u.pm * BM + wr * 64 + fr; const int col0 = u.pn * HALF + wc * 32 + 8 * fq;
        const float* bwp = bw + (size_t)(u.pm >> 4) * 5632 + u.pn * BM + wc * 32 + 8 * fq;
        const f32x4 bg0 = *(const f32x4*)bwp, bg1 = *(const f32x4*)(bwp + 4), bu0 = *(const f32x4*)(bwp + HALF), bu1 = *(const f32x4*)(bwp + HALF + 4);
#pragma unroll
        for (int ai = 0; ai < 2; ++ai)
#pragma unroll
            for (int m = 0; m < 4; ++m) { const size_t row = rowb + ai * HALF + m * 16; const float r = __builtin_amdgcn_rsqf(ssq2[row] * (1.0f / 1024.0f) + RMS_EPS);
                f32x4 g0 = acc[ai][0][m][0] * r + bg0, g1 = acc[ai][0][m][1] * r + bg1; const f32x4 u0 = acc[ai][1][m][0] * r + bu0, u1 = acc[ai][1][m][1] * r + bu1;
#pragma unroll
                for (int i = 0; i < 4; ++i) { g0[i] = g0[i] * sigmoidf_(g0[i]) * u0[i]; g1[i] = g1[i] * sigmoidf_(g1[i]) * u1[i]; }
                u32x4 w; w.x = cvt_pk_bf16(g0[0], g0[1]); w.y = cvt_pk_bf16(g0[2], g0[3]); w.z = cvt_pk_bf16(g1[0], g1[1]); w.w = cvt_pk_bf16(g1[2], g1[3]);
                *(u32x4*)(O + row * 2816 + col0) = w; }
    }
};

template <class Epi, class Sched, bool ALIGN_EPI = false, bool SP2 = false>
__device__ __forceinline__ void gemm_phase(PG8_LAS unsigned char* lds, const Gemm g, const Sched& S, const Epi& E) {
    const int tid = otid(), wid = __builtin_amdgcn_readfirstlane(tid >> 6), lane = tid & 63, wr = wid >> 2, wc = wid & 3, fr = lane & 15, fq = lane >> 4;
    const int K = g.K, lda = g.lda, nt = K / BK;
    unsigned voffA[2], voffB[2];
#pragma unroll
    for (int i = 0; i < 2; ++i) { int R, C; stage_rc(tid * 16 + i * 8192, R, C); const int Rb = Epi::PERM ? ((R & ~31) + perm32(R & 31)) : R;
        voffA[i] = (unsigned)(R * lda + C) * 2u; voffB[i] = (unsigned)(Rb * K + C) * 2u; }
    const size_t kstep = (size_t)(BK * 2);
    const size_t hstepB = (size_t)HALF * K * 2, hstepA = (size_t)HALF * lda * 2;
    const size_t tstepB = 2 * hstepB, tstepA = 2 * hstepA;
    const unsigned ldsw = (unsigned)wid * 1024u;
    const int aoff = lds_byte(wr * 64 + fr, fq * 8), boff = lds_byte(wc * 32 + fr, fq * 8);
#define PG8_SA(b, h) (((b) * 2 + (h)) * HTB)
#define PG8_SB(b, h) ((4 + (b) * 2 + (h)) * HTB)
#define PG8_STAGE(bufoff, gbase, voff) do { _Pragma("unroll") for (int _i = 0; _i < 2; ++_i) \
        __builtin_amdgcn_global_load_lds((const unsigned*)((const char*)(gbase) + (voff)[_i]), (PG8_LAS unsigned*)(lds + (bufoff) + ldsw + _i * 8192), 16, 0, 0); } while (0)
#define PG8_LDA(dst, b, h) do { _Pragma("unroll") for (int m = 0; m < 4; ++m) _Pragma("unroll") for (int k = 0; k < 2; ++k) dst[m][k] = *(const PG8_LAS bf16x8*)(lds + PG8_SA(b, h) + aoff + m * 2048 + k * 1024); } while (0)
#define PG8_LDB(dst, b, h) do { _Pragma("unroll") for (int n = 0; n < 2; ++n) _Pragma("unroll") for (int k = 0; k < 2; ++k) dst[n][k] = *(const PG8_LAS bf16x8*)(lds + PG8_SB(b, h) + boff + n * 2048 + k * 1024); } while (0)
#define PG8_MMA(ai, bj, At, Bt) do { __builtin_amdgcn_s_setprio(1); _Pragma("unroll") for (int m = 0; m < 4; ++m) _Pragma("unroll") for (int n = 0; n < 2; ++n) _Pragma("unroll") for (int k = 0; k < 2; ++k) \
        acc[ai][bj][m][n] = __builtin_amdgcn_mfma_f32_16x16x32_bf16(Bt[n][k], At[m][k], acc[ai][bj][m][n], 0, 0, 0); __builtin_amdgcn_s_setprio(0); } while (0)
#define PG8_WAIT_V(n) asm volatile("s_waitcnt vmcnt(" #n ")" ::: "memory")
#define PG8_WAIT_L(n) asm volatile("s_waitcnt lgkmcnt(" #n ")" ::: "memory")
#define PG8_BAR __builtin_amdgcn_s_barrier()
#define PG8_SCHED __builtin_amdgcn_sched_barrier(0)
    Unit cur, nxt; int ui = 0;
    if (!S.next(0, cur)) return;
    f32x4 acc[2][2][4][2];
#pragma unroll
    for (int a = 0; a < 2; ++a)
#pragma unroll
        for (int b = 0; b < 2; ++b)
#pragma unroll
            for (int m = 0; m < 4; ++m)
#pragma unroll
                for (int n = 0; n < 2; ++n) acc[a][b][m][n] = (f32x4){0.f, 0.f, 0.f, 0.f};
    bf16x8 At[4][2], B0[2][2], B1[2][2];
    const char* cA = (const char*)g.A + (size_t)cur.pm * tstepA + (cur.pn >= g.asplit ? (size_t)g.aoff2 * 2 : 0); const char* cB = (const char*)g.Bt + (size_t)cur.pn * tstepB;
    S.a_ready(cur);
    if constexpr (SP2) {
        PG8_STAGE(PG8_SB(0, 0), cB, voffB); PG8_STAGE(PG8_SB(0, 1), cB + hstepB, voffB); PG8_STAGE(PG8_SA(0, 0), cA, voffA); PG8_STAGE(PG8_SA(0, 1), cA + hstepA, voffA);
        if (wr == 1) PG8_BAR;
        PG8_WAIT_V(2); PG8_BAR;
        PG8_STAGE(PG8_SB(1, 0), cB + kstep, voffB); PG8_STAGE(PG8_SA(1, 0), cA + kstep, voffA); PG8_STAGE(PG8_SB(1, 1), cB + hstepB + kstep, voffB);
        PG8_WAIT_V(6); PG8_BAR;
    } else {
        PG8_STAGE(PG8_SB(0, 0), cB, voffB); PG8_STAGE(PG8_SA(0, 0), cA, voffA); PG8_STAGE(PG8_SB(0, 1), cB + hstepB, voffB); PG8_STAGE(PG8_SA(0, 1), cA + hstepA, voffA);
        if (wr == 1) PG8_BAR;
        PG8_WAIT_V(4); PG8_BAR;
        PG8_STAGE(PG8_SB(1, 0), cB + kstep, voffB); PG8_STAGE(PG8_SA(1, 0), cA + kstep, voffA); PG8_STAGE(PG8_SB(1, 1), cB + hstepB + kstep, voffB);
        PG8_WAIT_V(6); PG8_BAR;
    }
    for (;;) {
        const bool has_next = S.next(ui + 1, nxt);
        const char* nA = has_next ? (const char*)g.A + (size_t)nxt.pm * tstepA + (nxt.pn >= g.asplit ? (size_t)g.aoff2 * 2 : 0) : cA; const char* nB = has_next ? (const char*)g.Bt + (size_t)nxt.pn * tstepB : cB;
        for (int t = 0; t < nt; t += 2) {
            const bool last = (t == nt - 2);
            if constexpr (Epi::MIDHOOK) { if (t == (nt >> 1)) E.mid(acc, cur, wr, wc); }
            const char* a1 = cA + (size_t)(t + 1) * kstep;
            const char* a2 = last ? nA : cA + (size_t)(t + 2) * kstep; const char* b2 = last ? nB : cB + (size_t)(t + 2) * kstep;
            const char* a3 = a2 + kstep; const char* b3 = b2 + kstep;
            if (last && has_next) S.a_ready(nxt);
            if constexpr (SP2) {
            PG8_LDB(B0, 0, 0); PG8_LDB(B1, 0, 1); PG8_SCHED; PG8_LDA(At, 0, 0); PG8_STAGE(PG8_SA(1, 1), a1 + hstepA, voffA);
            PG8_WAIT_V(8); PG8_WAIT_L(0); PG8_BAR; PG8_MMA(0, 0, At, B0); PG8_MMA(0, 1, At, B1); PG8_BAR; PG8_SCHED;
            PG8_LDA(At, 0, 1); PG8_STAGE(PG8_SB(0, 0), b2, voffB); PG8_STAGE(PG8_SB(0, 1), b2 + hstepB, voffB); PG8_STAGE(PG8_SA(0, 0), a2, voffA);
            PG8_WAIT_V(8); PG8_WAIT_L(0); PG8_BAR; PG8_MMA(1, 0, At, B0); PG8_MMA(1, 1, At, B1); PG8_BAR; PG8_SCHED;
            PG8_LDB(B0, 1, 0); PG8_LDB(B1, 1, 1); PG8_SCHED; PG8_LDA(At, 1, 0); PG8_STAGE(PG8_SA(0, 1), a2 + hstepA, voffA);
            PG8_WAIT_V(8); PG8_WAIT_L(0); PG8_BAR; PG8_MMA(0, 0, At, B0); PG8_MMA(0, 1, At, B1); PG8_BAR; PG8_SCHED;
            PG8_LDA(At, 1, 1); PG8_STAGE(PG8_SB(1, 0), b3, voffB); PG8_STAGE(PG8_SB(1, 1), b3 + hstepB, voffB); PG8_STAGE(PG8_SA(1, 0), a3, voffA);
            PG8_WAIT_V(8); PG8_WAIT_L(0); PG8_BAR; PG8_MMA(1, 0, At, B0); PG8_MMA(1, 1, At, B1); PG8_BAR; PG8_SCHED;
            } else {
            PG8_LDB(B0, 0, 0); PG8_SCHED; PG8_LDA(At, 0, 0); PG8_STAGE(PG8_SA(1, 1), a1 + hstepA, voffA);
            PG8_WAIT_L(8); PG8_BAR; PG8_WAIT_L(0); PG8_MMA(0, 0, At, B0); PG8_BAR; PG8_SCHED;
            PG8_LDB(B1, 0, 1); PG8_STAGE(PG8_SB(0, 0), b2, voffB);
            PG8_BAR; PG8_WAIT_L(0); PG8_MMA(0, 1, At, B1); PG8_BAR;
            PG8_LDA(At, 0, 1); PG8_STAGE(PG8_SA(0, 0), a2, voffA);
            PG8_BAR; PG8_WAIT_L(0); PG8_MMA(1, 0, At, B0); PG8_BAR; PG8_SCHED;
            PG8_STAGE(PG8_SB(0, 1), b2 + hstepB, voffB);
            PG8_WAIT_V(6); PG8_BAR; PG8_MMA(1, 1, At, B1); PG8_BAR;
            PG8_LDB(B0, 1, 0); PG8_SCHED; PG8_LDA(At, 1, 0); PG8_STAGE(PG8_SA(0, 1), a2 + hstepA, voffA);
            PG8_WAIT_L(8); PG8_BAR; PG8_WAIT_L(0); PG8_MMA(0, 0, At, B0); PG8_BAR; PG8_SCHED;
            PG8_LDB(B1, 1, 1); PG8_STAGE(PG8_SB(1, 0), b3, voffB);
            PG8_BAR; PG8_WAIT_L(0); PG8_MMA(0, 1, At, B1); PG8_BAR;
            PG8_LDA(At, 1, 1); PG8_STAGE(PG8_SA(1, 0), a3, voffA);
            PG8_BAR; PG8_WAIT_L(0); PG8_MMA(1, 0, At, B0); PG8_BAR; PG8_SCHED;
            PG8_STAGE(PG8_SB(1, 1), b3 + hstepB, voffB);
            PG8_WAIT_V(6); PG8_BAR; PG8_MMA(1, 1, At, B1); PG8_BAR;
            }
        }
        if constexpr (ALIGN_EPI) { if (wr == 0) PG8_BAR; }
        if constexpr (!Epi::AFTER_DRAIN) { E(acc, cur, wr, wc, fr, fq); S.done(cur); }
        if (!has_next) break;
#pragma unroll
        for (int a = 0; a < 2; ++a)
#pragma unroll
            for (int b = 0; b < 2; ++b)
#pragma unroll
                for (int m = 0; m < 4; ++m)
#pragma unroll
                    for (int n = 0; n < 2; ++n) acc[a][b][m][n] = (f32x4){0.f, 0.f, 0.f, 0.f};
        cur = nxt; cA = nA; cB = nB; ++ui;
        if constexpr (ALIGN_EPI) { if (wr == 1) PG8_BAR; }
    }
    PG8_WAIT_V(0);
    if constexpr (!ALIGN_EPI) { if (wr == 0) PG8_BAR; }
    PG8_BAR;
    if constexpr (Epi::AFTER_DRAIN) { E.fused(acc, cur, wr, wc, fr, fq, lds, wid, lane); S.done(cur); }
#undef PG8_SA
#undef PG8_SB
#undef PG8_STAGE
#undef PG8_LDA
#undef PG8_LDB
#undef PG8_MMA
#undef PG8_WAIT_V
#undef PG8_WAIT_L
#undef PG8_BAR
#undef PG8_SCHED
}
}

constexpr int NB = 16, SEQ = 4096, DM = 1024, DEPTH = 4, NTOK = NB * SEQ, NH = 8, FFH = 2816, NIN = 4096, INC = 4000;
constexpr int NWAVES = 8, NTHR = 512;
constexpr int LDS_BYTES = 147456, RING_BYTES = 131072;
constexpr size_t MiB = 1u << 20;
constexpr size_t WS_H = 0;
constexpr size_t WS_PA = 128 * MiB;
constexpr size_t WS_DIL = 192 * MiB;
constexpr size_t WS_GATES = 384 * MiB;
constexpr size_t WS_HID = 128 * MiB;
constexpr size_t WS_KVRAW = 640 * MiB;
constexpr size_t WS_K = 768 * MiB;
constexpr size_t WS_V = 864 * MiB;
constexpr size_t WS_W = 928 * MiB, WS_WSTRIDE = 30 * MiB;
constexpr size_t W_IN = 0, W_Q = W_IN + (size_t)NIN * 1024 * 2, W_KV = W_Q + 768 * 256 * 2, W_A = W_KV + 1024 * 256 * 2, W_B = W_A + 1024 * 512 * 2,
                 W_O = W_B + 1024 * 512 * 2, W_1 = W_O + 1024 * 1024 * 2, W_2 = W_1 + (size_t)5632 * 1024 * 2, W_END = W_2 + (size_t)1024 * 2816 * 2;
constexpr size_t WS_MOD = 988 * MiB;
constexpr size_t WS_ROPE = 990 * MiB;
constexpr size_t WS_SSQ = 998 * MiB;
constexpr size_t WS_LSE = 999 * MiB;
constexpr size_t WS_BT = 1001 * MiB;
constexpr size_t WS_BW1 = 1002 * MiB;
constexpr size_t WS_BW2 = 1003 * MiB;
constexpr size_t WS_CTL = 1005 * MiB, CTL_BYTES = 65536;
constexpr size_t WS_END = 1006 * MiB;
static_assert(W_END <= WS_WSTRIDE && WS_W + 2 * WS_WSTRIDE <= WS_MOD, "weights fit");
static_assert(WS_HID + (size_t)NTOK * FFH * 2 <= WS_KVRAW, "hid overlay");

#define LAS __attribute__((address_space(3)))
typedef unsigned short bf16_t;
typedef short bf16x8 __attribute__((ext_vector_type(8)));
typedef short s16x4 __attribute__((ext_vector_type(4)));
typedef float f32x4 __attribute__((ext_vector_type(4)));
typedef float f32x16 __attribute__((ext_vector_type(16)));
typedef unsigned u32x4 __attribute__((ext_vector_type(4)));
typedef unsigned u32x2 __attribute__((ext_vector_type(2)));
using pg8::cvt_pk_bf16; using pg8::bf_lo; using pg8::bf_hi;

struct Params {
    const float *x, *c; const int* pos; const float *rel_bias, *norm1_g, *norm2_g, *ada_w, *ada_b, *w_in, *q_a_norm, *w_q_b, *kv_a_norm, *w_kv_b, *q_norm_a, *k_norm_a, *q_norm_b, *k_norm_b,
        *w_branch_a, *w_branch_b, *w_out, *w_ffn_gate, *w_ffn_up, *w_ffn_down;
    float* out; unsigned char* ws;
    float inv_freq[16];
    int ph_lo, ph_hi;
};

__device__ __forceinline__ float wave_sum(float v) {
#pragma unroll
    for (int o = 1; o < 64; o <<= 1) v += __shfl_xor(v, o);
    return v;
}
#define LDS_WAIT() asm volatile("s_waitcnt lgkmcnt(0)" ::: "memory")

__device__ __forceinline__ void phase0(const Params& P, LAS unsigned char* lds, int G) {
    const int tid = otid(), lane = tid & 63, wid = __builtin_amdgcn_readfirstlane(tid >> 6);
    float* MOD = (float*)(P.ws + WS_MOD); float* ROPE = (float*)(P.ws + WS_ROPE); float* BT = (float*)(P.ws + WS_BT);
    const int gtid = obid() * NTHR + tid, nthr = G * NTHR;
    for (int idx = gtid; idx < NTOK * 16; idx += nthr) { const int t = idx >> 4, i = idx & 15;
        const float ang = (float)P.pos[t] * P.inv_freq[i];
        double rev = (double)ang * 0.15915494309189535; rev -= __builtin_rint(rev); const float f = (float)rev;
        ROPE[t * 32 + i] = __builtin_amdgcn_cosf(f); ROPE[t * 32 + 16 + i] = __builtin_amdgcn_sinf(f); }
    for (int idx = gtid; idx < 3 * 8 * 129; idx += nthr) { const int j = idx % 129, h = (idx / 129) & 7, p = idx / (129 * 8);
        const int dil = p == 0 ? 1 : (p == 1 ? 4 : 16); const int rp = (j - 64) * dil; const int n = rp < 0 ? -rp : rp; int bk = rp > 0 ? 16 : 0;
        if (n < 8) bk += n; else { const float nf = (float)n; int lg = 8 + (int)(__logf(nf * 0.125f) / 4.852030263919617f * 8.0f); bk += lg < 15 ? lg : 15; }
        BT[idx] = P.rel_bias[bk * 8 + h] * pg8::LOG2E; }
    LAS float* sC = (LAS float*)lds;
    LAS float* red = (LAS float*)(lds + 65536);
    for (int i = tid; i < 16 * 1024; i += NTHR) { const float v = P.c[i]; sC[i] = v / (1.0f + __expf(-v)); }
    __syncthreads();
    for (int it = obid(); it < 4 * 96; it += G) { const int l = it / 96, cb = it % 96; const int col = cb * 64 + lane;
        float a[16];
#pragma unroll
        for (int b = 0; b < 16; ++b) a[b] = 0.f;
        const float* wp = P.ada_w + ((size_t)l * 1024 + wid * 128) * 6144 + col;
#pragma unroll 16
        for (int k = 0; k < 128; ++k) { const float w = wp[(size_t)k * 6144];
#pragma unroll
            for (int b = 0; b < 16; ++b) a[b] += sC[b * 1024 + wid * 128 + k] * w; }
#pragma unroll
        for (int b = 0; b < 16; ++b) red[(wid * 16 + b) * 64 + lane] = a[b];
        __syncthreads();
        for (int o = tid; o < 1024; o += NTHR) { const int b = o >> 6, ln = o & 63; float s = 0.f;
#pragma unroll
            for (int w = 0; w < 8; ++w) s += red[(w * 16 + b) * 64 + ln];
            MOD[((size_t)l * 16 + b) * 6144 + cb * 64 + ln] = s + P.ada_b[l * 6144 + cb * 64 + ln]; }
        __syncthreads();
    }
}

__device__ __forceinline__ void tr_item(const float* W, int Nsrc, int k0, int j0, const float* kscale, bf16_t* WT, int Kdst, int R0, LAS float* scr, int lane) {
    if (j0 >= 0) {
#pragma unroll 8
        for (int i = 0; i < 32; ++i) { const int kk = 2 * i + (lane >> 5); float v = W[(size_t)(k0 + kk) * Nsrc + j0 + (lane & 31)]; if (kscale) v *= kscale[k0 + kk]; scr[kk * 33 + (lane & 31)] = v; }
    } else {
#pragma unroll 8
        for (int i = 0; i < 32; ++i) { const int kk = 2 * i + (lane >> 5); scr[kk * 33 + (lane & 31)] = 0.f; }
    }
    LDS_WAIT();
    const int c = lane & 7;
#pragma unroll
    for (int j = 0; j < 4; ++j) { const int n = (lane >> 3) + 8 * j; const LAS float* s = scr + (8 * c) * 33 + n;
        u32x4 o; o.x = cvt_pk_bf16(s[0 * 33], s[1 * 33]); o.y = cvt_pk_bf16(s[2 * 33], s[3 * 33]); o.z = cvt_pk_bf16(s[4 * 33], s[5 * 33]); o.w = cvt_pk_bf16(s[6 * 33], s[7 * 33]);
        *(u32x4*)(WT + (size_t)(R0 + n) * Kdst + k0 + 8 * c) = o; }
    LDS_WAIT();
}
__device__ __forceinline__ int win_src_col(int R0) {
    const int pn = R0 >> 8, rho = R0 & 255;
    if (pn == 0) return rho;
    if (pn == 1) return rho < 160 ? 256 + rho : -1;
    if (pn < 6) { const int wc = (rho >> 5) & 3, dd = 32 * (rho >> 7); const int sec = (pn - 2) >> 1, head = 4 * ((pn - 2) & 1) + wc; return 416 + sec * 512 + head * 64 + dd; }
    if (pn < 8) return 416 + 1024 + (R0 - 1536);
    return 1952 + (R0 - 2048);
}
__device__ __forceinline__ void conv_weights(const Params& P, int l, unsigned char* wb, LAS unsigned char* lds, int G) {
    const int tid = otid(), lane = tid & 63, wid = __builtin_amdgcn_readfirstlane(tid >> 6);
    LAS float* scr = (LAS float*)(lds + wid * 16384);
    constexpr int I_IN = 16 * 128, I_Q = 4 * 24, I_KV = 4 * 32, I_A = 8 * 32, I_B = 8 * 32, I_O = 16 * 32, I_1 = 16 * 176, I_2 = 44 * 32;
    constexpr int NIT = I_IN + I_Q + I_KV + I_A + I_B + I_O + I_1 + I_2;
    for (int it = obid() * NWAVES + wid; it < NIT; it += G * NWAVES) {
        int r = it;
        if (r < I_IN) { const int kb = r / 128, rb = r % 128; tr_item(P.w_in + (size_t)l * 1024 * INC, INC, kb * 64, win_src_col(rb * 32), nullptr, (bf16_t*)(wb + W_IN), 1024, rb * 32, scr, lane); continue; } r -= I_IN;
        if (r < I_Q) { const int kb = r / 24, rb = r % 24; tr_item(P.w_q_b + (size_t)l * 256 * 768, 768, kb * 64, rb * 32, P.q_a_norm + l * 256, (bf16_t*)(wb + W_Q), 256, rb * 32, scr, lane); continue; } r -= I_Q;
        if (r < I_KV) { const int kb = r / 32, rb = r % 32; tr_item(P.w_kv_b + (size_t)l * 128 * 1024, 1024, kb * 64, kb < 2 ? rb * 32 : -1, P.kv_a_norm + l * 128, (bf16_t*)(wb + W_KV), 256, rb * 32, scr, lane); continue; } r -= I_KV;
        if (r < I_A) { const int kb = r / 32, rb = r % 32; tr_item(P.w_branch_a + (size_t)l * 512 * 1024, 1024, kb * 64, rb * 32, nullptr, (bf16_t*)(wb + W_A), 1024, rb * 32, scr, lane); continue; } r -= I_A;
        if (r < I_B) { const int kb = r / 32, rb = r % 32; tr_item(P.w_branch_b + (size_t)l * 512 * 1024, 1024, kb * 64, rb * 32, nullptr, (bf16_t*)(wb + W_A) + 512, 1024, rb * 32, scr, lane); continue; } r -= I_B;
        if (r < I_O) { const int kb = r / 32, rb = r % 32; tr_item(P.w_out + (size_t)l * 1024 * 1024, 1024, kb * 64, rb * 32, nullptr, (bf16_t*)(wb + W_O), 1024, rb * 32, scr, lane); continue; } r -= I_O;
        if (r < I_1) { const int kb = r / 176, rb = r % 176; const int R0 = rb * 32, pn = R0 >> 8, rho = R0 & 255;
            const float* src = (rho < 128 ? P.w_ffn_gate : P.w_ffn_up) + (size_t)l * 1024 * FFH;
            tr_item(src, FFH, kb * 64, pn * 128 + (rho & 127), nullptr, (bf16_t*)(wb + W_1), 1024, R0, scr, lane); continue; } r -= I_1;
        { const int kb = r / 32, rb = r % 32; tr_item(P.w_ffn_down + (size_t)l * FFH * 1024, 1024, kb * 64, rb * 32, nullptr, (bf16_t*)(wb + W_2), FFH, rb * 32, scr, lane); }
    }
}

__device__ __forceinline__ void norm_phase(const float* xin, const float* g, const float* mod  , int sh_off, int sc_off, bf16_t* H, int G) {
    const int tid = otid(), lane = tid & 63, wid = __builtin_amdgcn_readfirstlane(tid >> 6);
    for (int m = obid() * NWAVES + wid; m < NTOK; m += G * NWAVES) {
        const f32x4* xr = (const f32x4*)(xin + (size_t)m * DM) + lane; f32x4 v[4]; float s = 0.f;
#pragma unroll
        for (int j = 0; j < 4; ++j) { v[j] = xr[64 * j]; s += (v[j][0] * v[j][0] + v[j][1] * v[j][1]) + (v[j][2] * v[j][2] + v[j][3] * v[j][3]); }
        const float r = __builtin_amdgcn_rsqf(wave_sum(s) * (1.0f / DM) + pg8::RMS_EPS);
        const float* mb = mod + (size_t)(m >> 12) * 6144;
#pragma unroll
        for (int j = 0; j < 4; ++j) { const int col = 4 * lane + 256 * j;
            const f32x4 gv = *(const f32x4*)(g + col), sc = *(const f32x4*)(mb + sc_off + col), sh = *(const f32x4*)(mb + sh_off + col);
            const f32x4 o = (v[j] * r) * gv * (1.0f + sc) + sh;
            u32x2 w; w.x = cvt_pk_bf16(o[0], o[1]); w.y = cvt_pk_bf16(o[2], o[3]);
            *(u32x2*)(H + (size_t)m * DM + col) = w; }
    }
}

__device__ __forceinline__ void prepass_phase(const float* xin, const float* g, const float* mod  , int sc_off, bf16_t* XG, float* ssq, int G) {
    const int tid = otid(), lane = tid & 63, wid = __builtin_amdgcn_readfirstlane(tid >> 6);
    for (int m = obid() * NWAVES + wid; m < NTOK; m += G * NWAVES) {
        const f32x4* xr = (const f32x4*)(xin + (size_t)m * DM) + lane; float s = 0.f;
        const float* mb = mod + (size_t)(m >> 12) * 6144;
#pragma unroll
        for (int j = 0; j < 4; ++j) { const f32x4 v = xr[64 * j]; s += (v[0] * v[0] + v[1] * v[1]) + (v[2] * v[2] + v[3] * v[3]); const int col = 4 * lane + 256 * j;
            const f32x4 o = v * *(const f32x4*)(g + col) * (1.0f + *(const f32x4*)(mb + sc_off + col));
            u32x2 w; w.x = cvt_pk_bf16(o[0], o[1]); w.y = cvt_pk_bf16(o[2], o[3]);
            *(u32x2*)(XG + (size_t)m * DM + col) = w; }
        s = wave_sum(s);
        if (lane == 0) ssq[m] = s;
    }
}
__device__ __forceinline__ void bias_phase(const Params& P, LAS unsigned char* lds, int G) {
    const int tid = otid(), lane = tid & 63, wid = __builtin_amdgcn_readfirstlane(tid >> 6);
    const float* MOD = (const float*)(P.ws + WS_MOD); float* BW1 = (float*)(P.ws + WS_BW1); float* BW2 = (float*)(P.ws + WS_BW2);
    LAS float* sC = (LAS float*)lds;
    LAS float* red = (LAS float*)(lds + 65536);
    for (int it = obid(); it < 4 * 152; it += G) { const int l = it / 152, blk = it % 152; const bool ffn = blk >= 64; const int R0 = (ffn ? blk - 64 : blk) * 64;
        __syncthreads();
        for (int i = tid; i < 16 * 1024; i += NTHR) sC[i] = MOD[((size_t)l * 16 + (i >> 10)) * 6144 + (ffn ? 3072 : 0) + (i & 1023)];
        __syncthreads();
        const int R = R0 + lane; const float* wsrc; int j; size_t ncol;
        if (!ffn) { const int jb = win_src_col(R & ~31); j = jb < 0 ? -1 : jb + (R & 31); wsrc = P.w_in + (size_t)l * 1024 * INC; ncol = INC; }
        else { const int pn = R >> 8, rho = R & 255; j = pn * 128 + (rho & 127); wsrc = (rho < 128 ? P.w_ffn_gate : P.w_ffn_up) + (size_t)l * 1024 * FFH; ncol = FFH; }
        float a[16];
#pragma unroll
        for (int b = 0; b < 16; ++b) a[b] = 0.f;
        if (j >= 0) { const float* wp = wsrc + (size_t)(wid * 128) * ncol + j;
#pragma unroll 16
            for (int k = 0; k < 128; ++k) { const float w = wp[(size_t)k * ncol];
#pragma unroll
                for (int b = 0; b < 16; ++b) a[b] += sC[b * 1024 + wid * 128 + k] * w; } }
#pragma unroll
        for (int b = 0; b < 16; ++b) red[(wid * 16 + b) * 64 + lane] = a[b];
        __syncthreads();
        for (int o = tid; o < 1024; o += NTHR) { const int b = o >> 6, ln = o & 63; float s = 0.f;
#pragma unroll
            for (int w = 0; w < 8; ++w) s += red[(w * 16 + b) * 64 + ln];
            if (!ffn) BW1[((size_t)l * 16 + b) * 4096 + R0 + ln] = s; else BW2[((size_t)l * 16 + b) * 5632 + R0 + ln] = s; }
    }
    __syncthreads();
}

__device__ __forceinline__ void unpack8(const u32x4 w, float* f) { f[0] = bf_lo(w.x); f[1] = bf_hi(w.x); f[2] = bf_lo(w.y); f[3] = bf_hi(w.y); f[4] = bf_lo(w.z); f[5] = bf_hi(w.z); f[6] = bf_lo(w.w); f[7] = bf_hi(w.w); }
__device__ __forceinline__ u32x4 pack8(const float* f) { u32x4 w; w.x = cvt_pk_bf16(f[0], f[1]); w.y = cvt_pk_bf16(f[2], f[3]); w.z = cvt_pk_bf16(f[4], f[5]); w.w = cvt_pk_bf16(f[6], f[7]); return w; }
__device__ __forceinline__ float ssq8(const u32x4 w) { float f[8]; unpack8(w, f); return ((f[0] * f[0] + f[1] * f[1]) + (f[2] * f[2] + f[3] * f[3])) + ((f[4] * f[4] + f[5] * f[5]) + (f[6] * f[6] + f[7] * f[7])); }
__device__ __forceinline__ void head_norm_rope(const bf16_t* src_nope, const bf16_t* src_rope, bf16_t* dst, const float* gain, const float* rope, float oscale) {
    float s = 0.f;
#pragma unroll
    for (int c = 0; c < 8; ++c) s += ssq8(*(const u32x4*)(src_nope + 8 * c));
#pragma unroll
    for (int c = 0; c < 4; ++c) s += ssq8(*(const u32x4*)(src_rope + 8 * c));
    const float r = __builtin_amdgcn_rsqf(s * (1.0f / 96.0f) + pg8::RMS_EPS);
    asm volatile("" ::: "memory");
#pragma unroll
    for (int c = 0; c < 8; ++c) { float f[8]; unpack8(*(const u32x4*)(src_nope + 8 * c), f);
#pragma unroll
        for (int i = 0; i < 8; ++i) f[i] = f[i] * r * gain[8 * c + i] * oscale;
        *(u32x4*)(dst + 8 * c) = pack8(f); asm volatile("" ::: "memory"); }
    float x[32];
#pragma unroll
    for (int c = 0; c < 4; ++c) unpack8(*(const u32x4*)(src_rope + 8 * c), x + 8 * c);
#pragma unroll
    for (int i = 0; i < 32; ++i) x[i] = x[i] * r * gain[64 + i];
#pragma unroll
    for (int i = 0; i < 16; ++i) { const float cs = rope[i], sn = rope[16 + i]; const float x1 = x[i], x2 = x[16 + i]; x[i] = (x1 * cs - x2 * sn) * oscale; x[16 + i] = (x2 * cs + x1 * sn) * oscale; }
#pragma unroll
    for (int c = 0; c < 4; ++c) *(u32x4*)(dst + 64 + 8 * c) = pack8(x + 8 * c);
    asm volatile("" ::: "memory");
}
__device__ __forceinline__ void prep_phase(const Params& P, int l, int G) {
    const bf16_t* KVRAW = (const bf16_t*)(P.ws + WS_KVRAW); const bf16_t* PA = (const bf16_t*)(P.ws + WS_PA);
    bf16_t* K = (bf16_t*)(P.ws + WS_K); bf16_t* V = (bf16_t*)(P.ws + WS_V); const float* ROPE = (const float*)(P.ws + WS_ROPE);
    const float* kg = P.k_norm_a + l * 96;
    for (int idx = obid() * NTHR + otid(); idx < NTOK * NH; idx += G * NTHR) { const int t = idx >> 3, h = idx & 7;
        const float* rp = ROPE + (size_t)t * 32;
        const bf16_t* kp = KVRAW + (size_t)t * 1024 + h * 128;
        const size_t hrow = ((size_t)((t >> 12) * 8 + h) << 12) + (t & 4095);
        head_norm_rope(kp, PA + (size_t)t * 512 + 384, K + hrow * 96, kg, rp, 1.0f);
        bf16_t* vo = V + hrow * 64;
#pragma unroll
        for (int c = 0; c < 8; ++c) *(u32x4*)(vo + 8 * c) = *(const u32x4*)(kp + 64 + 8 * c);
    }
}
typedef short v4i16_t __attribute__((ext_vector_type(4)));
__device__ __forceinline__ s16x4 vtr(const LAS unsigned char* p) { return __builtin_bit_cast(s16x4, __builtin_amdgcn_ds_read_tr16_b64_v4i16((LAS v4i16_t*)p)); }
__device__ __forceinline__ bf16x8 cat8(s16x4 a, s16x4 b) { return (bf16x8){a[0], a[1], a[2], a[3], b[0], b[1], b[2], b[3]}; }
__device__ __forceinline__ bf16x8 packp(const f32x16& p, int o) {
    u32x4 w; w.x = cvt_pk_bf16(p[o + 0], p[o + 1]); w.y = cvt_pk_bf16(p[o + 2], p[o + 3]); w.z = cvt_pk_bf16(p[o + 4], p[o + 5]); w.w = cvt_pk_bf16(p[o + 6], p[o + 7]);
    return __builtin_bit_cast(bf16x8, w);
}
__device__ __forceinline__ float max16(const f32x16& p) {
    float a = fmaxf(fmaxf(p[0], p[1]), fmaxf(p[2], p[3])), b = fmaxf(fmaxf(p[4], p[5]), fmaxf(p[6], p[7]));
    float c = fmaxf(fmaxf(p[8], p[9]), fmaxf(p[10], p[11])), d = fmaxf(fmaxf(p[12], p[13]), fmaxf(p[14], p[15]));
    return fmaxf(fmaxf(a, b), fmaxf(c, d));
}
#define MFMA32(a, b, c) __builtin_amdgcn_mfma_f32_32x32x16_bf16((a), (b), (c), 0, 0, 0)
constexpr int KP = 208, VP = 192;
constexpr int KT_B = 64 * KP, VT_B = 64 * VP;
constexpr int MLA_K0 = 0, MLA_V0 = 2 * KT_B;

constexpr float MLA_THR = 8.0f;
__device__ __forceinline__ float max3f(float a, float b, float c) { float r; asm("v_max3_f32 %0, %1, %2, %3" : "=v"(r) : "v"(a), "v"(b), "v"(c)); return r; }
__device__ __forceinline__ float rowmax32(const f32x16& a, const f32x16& b) {
    float x = max3f(a[0], a[1], a[2]), y = max3f(b[0], b[1], b[2]);
    x = max3f(x, a[3], a[4]); y = max3f(y, b[3], b[4]); x = max3f(x, a[5], a[6]); y = max3f(y, b[5], b[6]); x = max3f(x, a[7], a[8]); y = max3f(y, b[7], b[8]);
    x = max3f(x, a[9], a[10]); y = max3f(y, b[9], b[10]); x = max3f(x, a[11], a[12]); y = max3f(y, b[11], b[12]); x = max3f(x, a[13], a[14]); y = max3f(y, b[13], b[14]);
    x = max3f(x, a[15], b[15]); x = max3f(x, y, y);
    return max3f(x, __shfl_xor(x, 32), x);
}
#define SBAR0() __builtin_amdgcn_sched_barrier(0)
__device__ __forceinline__ void mla_unit(LAS unsigned char* lds, const bf16_t* Q, const bf16_t* K, const bf16_t* V, bf16_t* Y, const float* qgain, const float* ROPE, int b, int h, int qb) {
    const int tid = otid(), lane = tid & 63, wid = __builtin_amdgcn_readfirstlane(tid >> 6), r32 = lane & 31, hi = lane >> 5;
    const size_t tok0 = (size_t)b * SEQ; const size_t qrow = tok0 + qb * 256 + wid * 32 + r32;
    bf16x8 qf[6];
    {
        const bf16_t* qp = Q + qrow * 768 + h * 96 + hi * 8; float f[6][8]; float s = 0.f;
#pragma unroll
        for (int d0 = 0; d0 < 6; ++d0) { unpack8(*(const u32x4*)(qp + d0 * 16), f[d0]);
#pragma unroll
            for (int i = 0; i < 8; ++i) s += f[d0][i] * f[d0][i]; }
        s += __shfl_xor(s, 32);
        const float r = __builtin_amdgcn_rsqf(s * (1.0f / 96.0f) + pg8::RMS_EPS);
#pragma unroll
        for (int d0 = 0; d0 < 6; ++d0)
#pragma unroll
            for (int i = 0; i < 8; ++i) f[d0][i] = f[d0][i] * r * qgain[d0 * 16 + hi * 8 + i];
        const float* rp = ROPE + qrow * 32 + hi * 8;
#pragma unroll
        for (int i = 0; i < 8; ++i) { const float cs = rp[i], sn = rp[16 + i]; const float x1 = f[4][i], x2 = f[5][i]; f[4][i] = x1 * cs - x2 * sn; f[5][i] = x2 * cs + x1 * sn; }
#pragma unroll
        for (int d0 = 0; d0 < 6; ++d0) {
#pragma unroll
            for (int i = 0; i < 8; ++i) f[d0][i] *= pg8::QSCALE_A;
            qf[d0] = __builtin_bit_cast(bf16x8, pack8(f[d0])); }
    }
    const int kr0 = tid / 12, kc0 = tid % 12, kr1 = (512 + tid) / 12, kc1 = (512 + tid) % 12, vr = tid >> 3, vc = tid & 7;
    const size_t hrow0 = (size_t)(b * 8 + h) * SEQ;
    const bf16_t* kg0 = K + (hrow0 + kr0) * 96 + kc0 * 8; const bf16_t* kg1 = K + (hrow0 + kr1) * 96 + kc1 * 8;
    const bf16_t* vg = V + (hrow0 + vr) * 64 + vc * 8;
    const int kl0 = kr0 * KP + kc0 * 16, kl1 = kr1 * KP + kc1 * 16, vl = vr * VP + vc * 16;
    const bool has1 = tid < 256;
    u32x4 ka0, kb0, ka1, kb1, vv0, vv1;
    ka0 = *(const u32x4*)kg0; if (has1) kb0 = *(const u32x4*)kg1; vv0 = *(const u32x4*)vg;
    ka1 = *(const u32x4*)(kg0 + (size_t)64 * 96); if (has1) kb1 = *(const u32x4*)(kg1 + (size_t)64 * 96);
    *(LAS u32x4*)(lds + MLA_K0 + kl0) = ka0; if (has1) *(LAS u32x4*)(lds + MLA_K0 + kl1) = kb0; *(LAS u32x4*)(lds + MLA_V0 + vl) = vv0;
    *(LAS u32x4*)(lds + MLA_K0 + KT_B + kl0) = ka1; if (has1) *(LAS u32x4*)(lds + MLA_K0 + KT_B + kl1) = kb1;
    ka0 = *(const u32x4*)(kg0 + (size_t)128 * 96); if (has1) kb0 = *(const u32x4*)(kg1 + (size_t)128 * 96); vv1 = *(const u32x4*)(vg + (size_t)64 * 64);
    __syncthreads();
    f32x16 o0, o1, negm;
#pragma unroll
    for (int i = 0; i < 16; ++i) { o0[i] = 0.f; o1[i] = 0.f; negm[i] = 0.f; }
    const int koff = r32 * KP + hi * 16;
    const int voff = (4 * hi + ((lane & 15) >> 2)) * VP + (16 * ((lane >> 4) & 1) + 4 * (lane & 3)) * 2;
    f32x16 p0, p1, n0, n1;
    { const LAS unsigned char* kb_ = lds + MLA_K0 + koff; p0 = negm; p1 = negm;
#pragma unroll
      for (int d0 = 0; d0 < 6; ++d0) { const bf16x8 a0 = *(const LAS bf16x8*)(kb_ + d0 * 32), a1 = *(const LAS bf16x8*)(kb_ + 32 * KP + d0 * 32); p0 = MFMA32(a0, qf[d0], p0); p1 = MFMA32(a1, qf[d0], p1); } }
    float m_ref, l_run = 0.f;
    { const float mx = rowmax32(p0, p1); m_ref = mx;
#pragma unroll
      for (int i = 0; i < 16; ++i) { p0[i] -= mx; p1[i] -= mx; negm[i] = -mx; } }
#define MLA_STEP(C0, C1, X0, X1, T, KAI, KBI, VVI, KAW, KBW, VVW) do { const int t_ = (T); const int cur = t_ & 1; \
        if (t_ + 3 < 64) { const size_t go = (size_t)(t_ + 3) * 64; KAI = *(const u32x4*)(kg0 + go * 96); if (has1) KBI = *(const u32x4*)(kg1 + go * 96); } \
        if (t_ + 2 < 64) { const size_t go = (size_t)(t_ + 2) * 64; VVI = *(const u32x4*)(vg + go * 64); } \
        bf16x8 kfr[12]; { const LAS unsigned char* kn = lds + MLA_K0 + (cur ^ 1) * KT_B + koff; \
            _Pragma("unroll") for (int d0 = 0; d0 < 6; ++d0) { kfr[2 * d0] = *(const LAS bf16x8*)(kn + d0 * 32); kfr[2 * d0 + 1] = *(const LAS bf16x8*)(kn + 32 * KP + d0 * 32); } } \
        SBAR0(); \
        const float mx = rowmax32(C0, C1); \
        if (__builtin_amdgcn_ballot_w64(mx > MLA_THR) != 0ull) { const float d = fmaxf(mx, 0.f); const float sc = __builtin_amdgcn_exp2f(-d); m_ref += d; l_run *= sc; \
            _Pragma("unroll") for (int i = 0; i < 16; ++i) { C0[i] -= d; C1[i] -= d; o0[i] *= sc; o1[i] *= sc; negm[i] = -m_ref; } } \
        SBAR0(); \
        X0 = negm; X1 = negm; \
        _Pragma("unroll") for (int d0 = 0; d0 < 6; ++d0) { X0 = MFMA32(kfr[2 * d0], qf[d0], X0); X1 = MFMA32(kfr[2 * d0 + 1], qf[d0], X1); } \
        SBAR0(); \
        float ls = 0.f; \
        _Pragma("unroll") for (int i = 0; i < 16; ++i) { C0[i] = __builtin_amdgcn_exp2f(C0[i]); C1[i] = __builtin_amdgcn_exp2f(C1[i]); ls += C0[i] + C1[i]; } \
        l_run += ls; \
        bf16x8 pb[4]; pb[0] = packp(C0, 0); pb[1] = packp(C0, 8); pb[2] = packp(C1, 0); pb[3] = packp(C1, 8); \
        const LAS unsigned char* vb_ = lds + MLA_V0 + cur * VT_B + voff; \
        _Pragma("unroll") for (int j = 0; j < 4; ++j) { const LAS unsigned char* vj = vb_ + 16 * j * VP; \
            const bf16x8 a0 = cat8(vtr(vj), vtr(vj + 8 * VP)); const bf16x8 a1 = cat8(vtr(vj + 64), vtr(vj + 8 * VP + 64)); \
            o0 = MFMA32(a0, pb[j], o0); o1 = MFMA32(a1, pb[j], o1); } \
        if (t_ + 2 < 64) { *(LAS u32x4*)(lds + MLA_K0 + cur * KT_B + kl0) = KAW; if (has1) *(LAS u32x4*)(lds + MLA_K0 + cur * KT_B + kl1) = KBW; } \
        if (t_ + 1 < 64) *(LAS u32x4*)(lds + MLA_V0 + (cur ^ 1) * VT_B + vl) = VVW; \
        __syncthreads(); } while (0)
    for (int t = 0; t < 64; t += 2) { MLA_STEP(p0, p1, n0, n1, t, ka1, kb1, vv0, ka0, kb0, vv1); MLA_STEP(n0, n1, p0, p1, t + 1, ka0, kb0, vv1, ka1, kb1, vv0); }
#undef MLA_STEP
    const float lt = l_run + __shfl_xor(l_run, 32); const float inv = 1.0f / lt;
    bf16_t* yp = Y + qrow * 1024 + h * 64 + 4 * hi;
#pragma unroll
    for (int g = 0; g < 4; ++g) {
        u32x2 w0; w0.x = cvt_pk_bf16(o0[4 * g] * inv, o0[4 * g + 1] * inv); w0.y = cvt_pk_bf16(o0[4 * g + 2] * inv, o0[4 * g + 3] * inv); *(u32x2*)(yp + 8 * g) = w0;
        u32x2 w1; w1.x = cvt_pk_bf16(o1[4 * g] * inv, o1[4 * g + 1] * inv); w1.y = cvt_pk_bf16(o1[4 * g + 2] * inv, o1[4 * g + 3] * inv); *(u32x2*)(yp + 32 + 8 * g) = w1; }
}

constexpr int DW_BYTES = 13440;
template <int DELTA>
__device__ __forceinline__ void dil_block(LAS unsigned char* wl, const bf16_t* kbase  , const bf16_t* vbase, size_t rstride  ,
                                          const bf16x8 (&qf)[2][4], f32x16 (&o)[2][2], float (&m_run)[2], float (&l_run)[2], int bvar, int voff, int lane, int r32, int hi, int btb) {
    u32x4 vv[8]; bf16x8 kf[2][4];
#pragma unroll
    for (int i = 0; i < 8; ++i) { const int idx = lane + 64 * i, row = idx >> 3, ch = idx & 7; vv[i] = *(const u32x4*)(vbase + (size_t)row * rstride + ch * 8); }
#pragma unroll
    for (int kvh = 0; kvh < 2; ++kvh)
#pragma unroll
        for (int d0 = 0; d0 < 4; ++d0) kf[kvh][d0] = *(const bf16x8*)(kbase + (size_t)(32 * kvh + r32) * rstride + d0 * 16);
    SBAR0();
#pragma unroll
    for (int i = 0; i < 8; ++i) { const int idx = lane + 64 * i, row = idx >> 3, ch = idx & 7; *(LAS u32x4*)(wl + row * VP + ch * 16) = vv[i]; }
    bf16x8 pb[2][4];
#pragma unroll
    for (int qh = 0; qh < 2; ++qh) {
        f32x16 s[2]; float mx = -1e30f;
#pragma unroll
        for (int kvh = 0; kvh < 2; ++kvh) {
            constexpr int dummy = 0; (void)dummy;
            const int toff = 64 * DELTA + 32 * (kvh - qh);
            if (toff > 64 || toff < -64) continue;
#pragma unroll
            for (int i = 0; i < 16; ++i) s[kvh][i] = 0.f;
#pragma unroll
            for (int d0 = 0; d0 < 4; ++d0) s[kvh] = MFMA32(kf[kvh][d0], qf[qh][d0], s[kvh]);
#pragma unroll
            for (int rr = 0; rr < 16; ++rr) { const int c4 = 4 * ((rr & 3) + 8 * (rr >> 2)); const float bias = *(const LAS float*)(wl + bvar + (VT_B + c4 + toff * 4));
                float v = s[kvh][rr] + bias;
                if (toff == 64) v = (bvar <= btb - c4) ? v : -1e30f;
                if (toff == -64) v = (bvar >= btb - c4) ? v : -1e30f;
                s[kvh][rr] = v; mx = fmaxf(mx, v); }
        }
        mx = fmaxf(mx, __shfl_xor(mx, 32));
        const float m_new = fmaxf(m_run[qh], mx); const float alpha = __builtin_amdgcn_exp2f(m_run[qh] - m_new); m_run[qh] = m_new;
        float ls = 0.f;
#pragma unroll
        for (int kvh = 0; kvh < 2; ++kvh) { const int toff = 64 * DELTA + 32 * (kvh - qh);
            if (toff > 64 || toff < -64) continue;
#pragma unroll
            for (int rr = 0; rr < 16; ++rr) { const float e = __builtin_amdgcn_exp2f(s[kvh][rr] - m_new); s[kvh][rr] = e; ls += e; }
            pb[qh][2 * kvh] = packp(s[kvh], 0); pb[qh][2 * kvh + 1] = packp(s[kvh], 8); }
        l_run[qh] = l_run[qh] * alpha + ls;
#pragma unroll
        for (int i = 0; i < 16; ++i) { o[qh][0][i] *= alpha; o[qh][1][i] *= alpha; }
    }
    LDS_WAIT();
#pragma unroll
    for (int j = 0; j < 4; ++j) { const LAS unsigned char* vj = wl + voff + 16 * j * VP;
        const bf16x8 a0 = cat8(vtr(vj), vtr(vj + 8 * VP)); const bf16x8 a1 = cat8(vtr(vj + 64), vtr(vj + 8 * VP + 64));
#pragma unroll
        for (int qh = 0; qh < 2; ++qh) { const int toff = 64 * DELTA + 32 * ((j >> 1) - qh);
            if (toff > 64 || toff < -64) continue;
            o[qh][0] = MFMA32(a0, pb[qh][j], o[qh][0]); o[qh][1] = MFMA32(a1, pb[qh][j], o[qh][1]); } }
    LDS_WAIT();
}
template <int P_>
__device__ __forceinline__ void dil_wave_unit(LAS unsigned char* wl, const bf16_t* DIL, bf16_t* Y, bf16_t* ST, float* LSE, const float* BT, int b, int h, int r, int nb) {
    constexpr int dil = P_ == 0 ? 1 : (P_ == 1 ? 4 : 16), nblk = 64 / dil; constexpr bool first = P_ == 0, last = P_ == 2;
    const int lane = otid() & 63, r32 = lane & 31, hi = lane >> 5;
    const size_t tok0 = (size_t)b * SEQ; const size_t rstride = (size_t)dil * 64;
    LAS float* bt = (LAS float*)(wl + VT_B);
    for (int i = lane; i < 257; i += 64) { int j = i - 64; j = j < 0 ? 0 : (j > 128 ? 128 : j); bt[i] = BT[(P_ * 8 + h) * 129 + j]; }
    const int btb = 128 * 4;
    const int bvar = btb + 4 * (4 * hi - r32);
    bf16x8 qf[2][4];
    const bf16_t* rowb = DIL + ((size_t)(b * 8 + h) * SEQ + (size_t)(64 * nb) * dil + r) * 64;
    constexpr size_t KOFF = pg8::DPLANE, VOFF = 2 * pg8::DPLANE;
#pragma unroll
    for (int qh = 0; qh < 2; ++qh)
#pragma unroll
        for (int d0 = 0; d0 < 4; ++d0) qf[qh][d0] = *(const bf16x8*)(rowb + (size_t)(32 * qh + r32) * rstride + hi * 8 + d0 * 16);
    f32x16 o[2][2];
#pragma unroll
    for (int a = 0; a < 2; ++a)
#pragma unroll
        for (int c = 0; c < 2; ++c)
#pragma unroll
            for (int i = 0; i < 16; ++i) o[a][c][i] = 0.f;
    float m_run[2] = {-1e30f, -1e30f}, l_run[2] = {0.f, 0.f};
    const int voff = (4 * hi + ((lane & 15) >> 2)) * VP + (16 * ((lane >> 4) & 1) + 4 * (lane & 3)) * 2;
    LDS_WAIT();
    dil_block<0>(wl, rowb + KOFF + hi * 8, rowb + VOFF, rstride, qf, o, m_run, l_run, bvar, voff, lane, r32, hi, btb);
    if (nb > 0) dil_block<-1>(wl, rowb - 64 * rstride + KOFF + hi * 8, rowb - 64 * rstride + VOFF, rstride, qf, o, m_run, l_run, bvar, voff, lane, r32, hi, btb);
    if (nb + 1 < nblk) dil_block<1>(wl, rowb + 64 * rstride + KOFF + hi * 8, rowb + 64 * rstride + VOFF, rstride, qf, o, m_run, l_run, bvar, voff, lane, r32, hi, btb);
    float lp[2]; u32x2 pv[2][8];
    if (!first) {
#pragma unroll
        for (int qh = 0; qh < 2; ++qh) { const size_t srow = (size_t)(b * 8 + h) * SEQ + (size_t)(64 * nb + 32 * qh + r32) * dil + r; lp[qh] = LSE[srow];
            const bf16_t* sp = ST + srow * 64 + 4 * hi;
#pragma unroll
            for (int e = 0; e < 8; ++e) pv[qh][e] = *(const u32x2*)(sp + 32 * (e >> 2) + 8 * (e & 3)); }
    }
#pragma unroll
    for (int qh = 0; qh < 2; ++qh) {
        const size_t spos = (size_t)(64 * nb + 32 * qh + r32) * dil + r; const size_t srow = (size_t)(b * 8 + h) * SEQ + spos;
        const float lt = l_run[qh] + __shfl_xor(l_run[qh], 32); const float inv = 1.0f / lt; const float lse2 = m_run[qh] + __builtin_amdgcn_logf(lt);
        float a_prev = 0.f, a_cur = inv, lse_new = lse2;
        if (!first) { const float M = fmaxf(lp[qh], lse2); const float wp = __builtin_amdgcn_exp2f(lp[qh] - M), wc = __builtin_amdgcn_exp2f(lse2 - M); const float den = wp + wc;
            a_prev = wp / den; a_cur = wc / den * inv; lse_new = M + __builtin_amdgcn_logf(den); }
        bf16_t* yp = last ? Y + (tok0 + spos) * 1024 + 512 + h * 64 + 4 * hi : ST + srow * 64 + 4 * hi;
#pragma unroll
        for (int e = 0; e < 8; ++e) { const int blk = e >> 2, g = e & 3;
            float v0 = o[qh][blk][4 * g] * a_cur, v1 = o[qh][blk][4 * g + 1] * a_cur, v2 = o[qh][blk][4 * g + 2] * a_cur, v3 = o[qh][blk][4 * g + 3] * a_cur;
            if (!first) { v0 += a_prev * bf_lo(pv[qh][e].x); v1 += a_prev * bf_hi(pv[qh][e].x); v2 += a_prev * bf_lo(pv[qh][e].y); v3 += a_prev * bf_hi(pv[qh][e].y); }
            u32x2 w; w.x = cvt_pk_bf16(v0, v1); w.y = cvt_pk_bf16(v2, v3); *(u32x2*)(yp + 32 * blk + 8 * g) = w; }
        if (!last && hi == 0) LSE[srow] = lse_new;
    }
}
__device__ __forceinline__ void dil_unit(LAS unsigned char* lds, const bf16_t* DIL, bf16_t* Y, bf16_t* ST, float* LSE, const float* BT, int b, int h, int c) {
    const int wid = __builtin_amdgcn_readfirstlane(otid() >> 6);
    LAS unsigned char* wl = lds + wid * DW_BYTES;
    for (int j = 0; j < 2; ++j) { const int wu = 2 * wid + j; dil_wave_unit<0>(wl, DIL, Y, ST, LSE, BT, b, h, 0, c * 16 + wu); }
    __syncthreads();
    for (int j = 0; j < 2; ++j) { const int wu = 2 * wid + j; dil_wave_unit<1>(wl, DIL, Y, ST, LSE, BT, b, h, wu >> 2, c * 4 + (wu & 3)); }
    __syncthreads();
    for (int j = 0; j < 2; ++j) { const int wu = 2 * wid + j; dil_wave_unit<2>(wl, DIL, Y, ST, LSE, BT, b, h, wu, c); }
    __syncthreads();
}

typedef __attribute__((address_space(1))) unsigned gu32;
#define XB_TMO      128
#define XB_XCNT(j)  (256  + 64 * (j))
#define XB_XSUB(j)  (1280 + 64 * (j))
#define XB_XGEN(j)  (2304 + 64 * (j))
#define XB_TOP      3328
#define XB_TOPGEN   3392
#define XCD_BAR_WORDS 3456
#define XB_SPIN_CAP (1u << 18)

__device__ __forceinline__ unsigned xb_ld(unsigned* p)              { return __hip_atomic_load(p, __ATOMIC_RELAXED, __HIP_MEMORY_SCOPE_AGENT); }
__device__ __forceinline__ unsigned xb_add(unsigned* p, unsigned v) { return __hip_atomic_fetch_add(p, v, __ATOMIC_RELAXED, __HIP_MEMORY_SCOPE_AGENT); }
__device__ __forceinline__ unsigned xb_xcc_id() { return (unsigned)__builtin_amdgcn_s_getreg((3 << 11) | 20) & 0xFu; }
#define XB_SPIN(cond, bar) do { unsigned _sp = 0; while (cond) { __builtin_amdgcn_s_sleep(1); \
    if ((++_sp & 255u) == 0u) { if (xb_ld(&(bar)[XB_TMO])) break; if (_sp > XB_SPIN_CAP) { atomicAdd(&(bar)[XB_TMO], 1u); break; } } } } while (0)

struct XcdBarrier {
    unsigned* bar; unsigned x;
    volatile LAS unsigned* st;
};

__device__ __forceinline__ XcdBarrier xcd_barrier_post(unsigned* bar, volatile LAS unsigned* st) {
    XcdBarrier b; b.bar = bar; b.x = xb_xcc_id(); b.st = st;
    if (threadIdx.x == 0) (void)xb_add(&bar[XB_XCNT(b.x)], 1u);
    return b;
}
__device__ __forceinline__ void xcd_barrier_complete(unsigned* bar, unsigned x, unsigned& nloc, unsigned& nx) {
    const unsigned G = gridDim.x * gridDim.y * gridDim.z;
    unsigned sum, cnt, mine, sp = 0u;
    for (;;) {
        sum = 0u; cnt = 0u; mine = 0u;
#pragma unroll
        for (unsigned j = 0; j < 16; ++j) { const unsigned c = xb_ld(&bar[XB_XCNT(j)]); sum += c; cnt += (c > 0u) ? 1u : 0u; mine = (j == x) ? c : mine; }
        if (sum == G) break;
        __builtin_amdgcn_s_sleep(1);
        if ((++sp & 255u) == 0u) { if (xb_ld(&bar[XB_TMO])) break; if (sp > XB_SPIN_CAP) { atomicAdd(&bar[XB_TMO], 1u); break; } }
    }
    nloc = mine > 0u ? mine : 1u; nx = cnt > 0u ? cnt : 1u;
}

__device__ __forceinline__ void xcd_barrier(const XcdBarrier& b) {
    asm volatile("s_waitcnt vmcnt(0)" ::: "memory");
    __syncthreads();
    if (threadIdx.x == 0) {
        unsigned* bar = b.bar;
        __builtin_amdgcn_s_waitcnt(0);
        unsigned nloc = b.st[0], nx = b.st[1];
        if (nloc == 0u) { xcd_barrier_complete(bar, b.x, nloc, nx); b.st[0] = nloc; b.st[1] = nx; }
        const unsigned old = xb_add(&bar[XB_XSUB(b.x)], 1u);
        const unsigned gen = old / nloc;
        if (old + 1u == (gen + 1u) * nloc) {
            __builtin_amdgcn_fence(__ATOMIC_RELEASE, "agent");
            asm volatile("s_waitcnt vmcnt(0)" ::: "memory");
            const unsigned og = xb_add(&bar[XB_TOP], 1u);
            const unsigned tg = og / nx;
            if (og + 1u == (tg + 1u) * nx) xb_add(&bar[XB_TOPGEN], 1u);
            else XB_SPIN(xb_ld(&bar[XB_TOPGEN]) == tg, bar);
            __builtin_amdgcn_fence(__ATOMIC_ACQUIRE, "agent");
            xb_add(&bar[XB_XGEN(b.x)], 1u);
            asm volatile("s_waitcnt vmcnt(0)" ::: "memory");
        } else {
            XB_SPIN(xb_ld(&bar[XB_XGEN(b.x)]) == gen, bar);
            __builtin_amdgcn_fence(__ATOMIC_ACQUIRE, "agent");
            asm volatile("s_waitcnt vmcnt(0)" ::: "memory");
        }
    }
    __syncthreads();
}

constexpr int NPHASE = 2 + DEPTH * 8;
__device__ __forceinline__ unsigned char* opaque_ptr(unsigned char* p) { asm volatile("" : "+s"(p)); return p; }
#define GEMM(EpiT, Ev, Ap, Bp, Nn, Kk, Ld) do { pg8::Gemm g_{(Ap), (Bp), NTOK, (Nn), (Kk), (Ld), 1 << 30, 0}; pg8::StaticOrder S_; S_.init(NTOK, (Nn), G, obid()); \
        pg8::gemm_phase<EpiT, pg8::StaticOrder, true, true>(lds, g_, S_, (Ev)); } while (0)
#define BF(off) ((bf16_t*)(ws + (off)))
#define FP(off) ((float*)(ws + (off)))
#define WB(l_, off) ((bf16_t*)(ws + WS_W + (size_t)((l_) & 1) * WS_WSTRIDE + (off)))
__global__ void __launch_bounds__(NTHR, 2) mega_fwd(Params P0) {
    extern __shared__ __attribute__((aligned(16))) unsigned char lds_raw[];
    LAS unsigned char* lds = (LAS unsigned char*)lds_raw;
    cg::grid_group grid = cg::this_grid();
    { volatile LAS unsigned* misc = (volatile LAS unsigned*)(lds + RING_BYTES + 320); if (otid() < 32) misc[otid()] = 0u; }
    __syncthreads();
    XcdBarrier xbar = xcd_barrier_post((unsigned*)(P0.ws + WS_CTL) + 1024, (volatile LAS unsigned*)(lds + RING_BYTES + 320) + 8);
    { volatile LAS unsigned* misc = (volatile LAS unsigned*)(lds + RING_BYTES + 320);
      if (otid() == 0) { const unsigned x = xb_xcc_id(); misc[16] = xb_add((unsigned*)(P0.ws + WS_CTL) + 8192 + 64 * x, 1u); misc[17] = x; } }
    __syncthreads();
    const int ph_lo = P0.ph_lo, ph_hi = P0.ph_hi;
    for (int ph = ph_lo; ph < ph_hi; ++ph) {
        int G_ = (int)gridDim.x; asm volatile("" : "+s"(G_)); const int G = G_;
        typedef const __attribute__((address_space(4))) Params* kparams_t;
        kparams_t kp_ = (kparams_t)__builtin_amdgcn_kernarg_segment_ptr(); asm volatile("" : "+s"(kp_));
        const Params& P = *(const Params*)kp_;
        unsigned char* ws = opaque_ptr(P.ws);
        const int l = ph > 1 ? (ph - 2) / 8 : 0, k = ph > 1 ? (ph - 2) % 8 + 2 : ph;
        const size_t modl = (size_t)l * 16 * 6144;
        switch (k) {
        case 0: {
            phase0(P, lds, G);
            float* SSQ = FP(WS_SSQ);
            for (int i = obid() * NTHR + otid(); i < 2 * NTOK; i += G * NTHR) SSQ[i] = 0.f;
            __syncthreads();
            conv_weights(P, 0, ws + WS_W, lds, G);
        } break;
        case 1: {
            bias_phase(P, lds, G);
            prepass_phase(P.x, P.norm1_g, FP(WS_MOD), 1024, BF(WS_H), FP(WS_SSQ) + 2 * NTOK, G);
        } break;
        case 2: {
            pg8::EpiIn E{BF(WS_PA), BF(WS_DIL), BF(WS_GATES), FP(WS_SSQ), FP(WS_SSQ) + NTOK, P.q_norm_b + l * 64, P.k_norm_b + l * 64, FP(WS_SSQ) + 2 * NTOK, FP(WS_BW1) + (size_t)l * 16 * 4096};
            GEMM(pg8::EpiIn, E, BF(WS_H), WB(l, W_IN), NIN, 1024, 1024);
        } break;
        case 3: {
            pg8::EpiRowScale2 E{BF(WS_H), BF(WS_KVRAW), FP(WS_SSQ), FP(WS_SSQ) + NTOK};
            { pg8::Gemm g_{BF(WS_PA), WB(l, W_Q), NTOK, 1792, 256, 512, 3, 256}; pg8::StaticOrder S_; S_.init(NTOK, 1792, G, obid()); pg8::gemm_phase<pg8::EpiRowScale2, pg8::StaticOrder, true, true>(lds, g_, S_, E); }
        } break;
        case 4: prep_phase(P, l, G); break;
        case 5: {
            { float* SSQ = FP(WS_SSQ); for (int i = obid() * NTHR + otid(); i < 4 * NTOK; i += G * NTHR) SSQ[i] = 0.f; }
            if (l + 1 < DEPTH) { conv_weights(P, l + 1, ws + WS_W + (size_t)((l + 1) & 1) * WS_WSTRIDE, lds, G); __syncthreads(); }
            bf16_t* Y = BF(WS_KVRAW);
            if (G == 256) { int xcd = obid() & 7, slot = obid() >> 3;
                { const unsigned* tk = (const unsigned*)(ws + WS_CTL) + 8192; bool even = true;
#pragma unroll
                  for (int x = 0; x < 8; ++x) even = even && (__hip_atomic_load(tk + 64 * x, __ATOMIC_RELAXED, __HIP_MEMORY_SCOPE_AGENT) == 32u);
                  if (even) { volatile LAS unsigned* misc = (volatile LAS unsigned*)(lds + RING_BYTES + 320); slot = (int)misc[16]; xcd = (int)misc[17]; } }
                slot = __builtin_amdgcn_readfirstlane(slot); xcd = __builtin_amdgcn_readfirstlane(xcd);
                for (int i = 0; i < 8; ++i) { const int bh = ((i * 2 + (slot >> 4)) << 3) + xcd; mla_unit(lds, BF(WS_H), BF(WS_K), BF(WS_V), Y, P.q_norm_a + l * 96, FP(WS_ROPE), bh >> 3, bh & 7, slot & 15); }
            } else { for (int u = obid(); u < NB * NH * 16; u += G) mla_unit(lds, BF(WS_H), BF(WS_K), BF(WS_V), Y, P.q_norm_a + l * 96, FP(WS_ROPE), u >> 7, (u >> 4) & 7, u & 15); }
            __syncthreads();
            for (int u = obid(); u < NB * NH * 4; u += G) dil_unit(lds, BF(WS_DIL), Y, BF(WS_PA), FP(WS_LSE), FP(WS_BT), u >> 5, (u >> 2) & 7, u & 3);
        } break;
        case 6: {
            pg8::EpiGate2 E{BF(WS_H), BF(WS_GATES)}; GEMM(pg8::EpiGate2, E, BF(WS_KVRAW), WB(l, W_A), 1024, 1024, 1024);
        } break;
        case 7: {
            pg8::EpiResid E{l == 0 ? P.x : P.out, P.out, FP(WS_MOD) + modl + 2048, BF(WS_KVRAW), P.norm2_g + l * DM, FP(WS_MOD) + modl + 4096, FP(WS_SSQ) + 3 * NTOK};
            GEMM(pg8::EpiResid, E, BF(WS_H), WB(l, W_O), 1024, 1024, 1024);
        } break;
        case 8: {
            pg8::EpiSwiGLU E{BF(WS_HID), FP(WS_SSQ) + 3 * NTOK, FP(WS_BW2) + (size_t)l * 16 * 5632}; GEMM(pg8::EpiSwiGLU, E, BF(WS_KVRAW), WB(l, W_1), 5632, 1024, 1024);
        } break;
        default: {
            const bool nxt = l + 1 < DEPTH; const size_t modn = (size_t)(l + 1) * 16 * 6144;
            pg8::EpiResid E{P.out, P.out, FP(WS_MOD) + modl + 5120, nxt ? BF(WS_H) : (bf16_t*)nullptr, P.norm1_g + (nxt ? (l + 1) * DM : 0), FP(WS_MOD) + (nxt ? modn + 1024 : 0), FP(WS_SSQ) + 2 * NTOK};
            GEMM(pg8::EpiResid, E, BF(WS_HID), WB(l, W_2), 1024, FFH, FFH);
        } break;
        }
        if (ph + 1 < ph_hi) { if (ph == ph_lo) grid.sync(); else xcd_barrier(xbar); }
    }
}

extern "C" void kernel_launch(void* const* d_in, const int* in_sizes, int n_in, void* d_out, int out_size, void* d_ws, size_t ws_size, hipStream_t stream) {
    static int grid = 0;
    if (grid == 0) {
        if (n_in != 23 || ws_size < WS_END) { fprintf(stderr, "kernel_launch: unexpected n_in %d / ws_size %zu\n", n_in, ws_size); grid = -1; return; }
        int dev = 0, cus = 0, per_cu = 0;
        (void)hipGetDevice(&dev); (void)hipDeviceGetAttribute(&cus, hipDeviceAttributeMultiprocessorCount, dev);
        if (hipFuncSetAttribute((const void*)mega_fwd, hipFuncAttributeMaxDynamicSharedMemorySize, LDS_BYTES) != hipSuccess) { fprintf(stderr, "kernel_launch: hipFuncSetAttribute failed\n"); grid = -1; return; }
        if (hipOccupancyMaxActiveBlocksPerMultiprocessor(&per_cu, (const void*)mega_fwd, NTHR, LDS_BYTES) != hipSuccess || per_cu < 1) { fprintf(stderr, "kernel_launch: occupancy query gave %d\n", per_cu); per_cu = 1; }
        (void)hipGetLastError();
        grid = cus * per_cu;
    }
    if (grid < 0) return;
    Params p{};
    const float** fp = (const float**)&p.x;
    p.x = (const float*)d_in[0]; p.c = (const float*)d_in[1]; p.pos = (const int*)d_in[2]; p.rel_bias = (const float*)d_in[3]; p.norm1_g = (const float*)d_in[4]; p.norm2_g = (const float*)d_in[5];
    p.ada_w = (const float*)d_in[6]; p.ada_b = (const float*)d_in[7]; p.w_in = (const float*)d_in[8]; p.q_a_norm = (const float*)d_in[9]; p.w_q_b = (const float*)d_in[10]; p.kv_a_norm = (const float*)d_in[11];
    p.w_kv_b = (const float*)d_in[12]; p.q_norm_a = (const float*)d_in[13]; p.k_norm_a = (const float*)d_in[14]; p.q_norm_b = (const float*)d_in[15]; p.k_norm_b = (const float*)d_in[16];
    p.w_branch_a = (const float*)d_in[17]; p.w_branch_b = (const float*)d_in[18]; p.w_out = (const float*)d_in[19]; p.w_ffn_gate = (const float*)d_in[20]; p.w_ffn_up = (const float*)d_in[21]; p.w_ffn_down = (const float*)d_in[22];
    (void)fp;
    p.out = (float*)d_out; p.ws = (unsigned char*)d_ws;
    for (int i = 0; i < 16; ++i) p.inv_freq[i] = (float)pow(10000.0, -(double)i / 16.0);
    p.ph_lo = 0; p.ph_hi = NPHASE;
    if (hipMemsetAsync((char*)d_ws + WS_CTL, 0, CTL_BYTES, stream) != hipSuccess) { fprintf(stderr, "kernel_launch: memset failed\n"); return; }
    void* args[] = {&p};
    hipError_t e = hipLaunchCooperativeKernel((const void*)mega_fwd, dim3(grid), dim3(NTHR), args, LDS_BYTES, stream);
    if (e != hipSuccess) fprintf(stderr, "kernel_launch: cooperative launch failed: %s (grid %d)\n", hipGetErrorString(e), grid);
}
```

```cpp
#include <hip/hip_runtime.h>
#include <hip/hip_cooperative_groups.h>
#include <cstdio>
#include <cstdint>
namespace cg = cooperative_groups;
__device__ __forceinline__ int otid() { int t = (int)threadIdx.x; asm volatile("" : "+v"(t)); return t; }
__device__ __forceinline__ int obid() { int b = (int)blockIdx.x; asm volatile("" : "+s"(b)); return b; }

#include <cmath>
namespace pg8 {
#define PG8_LAS __attribute__((address_space(3)))
typedef unsigned short bf16_t;
typedef short bf16x8 __attribute__((ext_vector_type(8)));
typedef float f32x4 __attribute__((ext_vector_type(4)));
typedef unsigned u32x4 __attribute__((ext_vector_type(4)));
constexpr int BM = 256, BK = 64, HALF = 128, HTB = HALF * BK * 2  , STAGE_BYTES = 8 * HTB, NXCD = 8, WGM = 8;

__host__ __device__ __forceinline__ int lds_byte(int r, int c) { const int st = (r >> 4) * 2 + (c >> 5), rr = r & 15, cc = c & 31, ob = rr * 64 + cc * 2; return st * 1024 + (ob ^ (((ob >> 9) & 1) << 5)); }
__host__ __device__ __forceinline__ void stage_rc(int b, int& R, int& C) { const int st = b / 1024, sb = b % 1024, swz = sb ^ (((sb >> 9) & 1) << 5); R = (st >> 1) * 16 + swz / 64; C = (st & 1) * 32 + (swz % 64) / 2; }
__host__ __device__ __forceinline__ int perm32(int rho) { const int n = rho >> 4, i = rho & 15; return 8 * (i >> 2) + 4 * n + (i & 3); }

struct Unit { int pm, pn; };
struct Gemm { const bf16_t* A; const bf16_t* Bt; int M, N, K, lda, asplit, aoff2; };

struct StaticOrder {
    int nM, nN, nwg, G, c;
    __host__ __device__ void init(int M, int N, int G_, int c_) { nM = M / BM; nN = N / BM; nwg = nM * nN; G = G_; c = c_; }
    __host__ __device__ bool next(int i, Unit& u) const {
        const long L = (long)i * G + c; if (L >= nwg) return false;
        int wgid = (int)L; { const int q = nwg / NXCD, r = nwg % NXCD, xcd = wgid % NXCD, off = wgid / NXCD; wgid = (xcd < r ? xcd * (q + 1) : r * (q + 1) + (xcd - r) * q) + off; }
        const int nig = WGM * nN, gid = wgid / nig, fm = gid * WGM, gsz = (nM - fm) < WGM ? (nM - fm) : WGM;
        u.pm = fm + ((wgid % nig) % gsz); u.pn = (wgid % nig) / gsz; return true;
    }
    __device__ __forceinline__ void a_ready(const Unit&) const {}
    __device__ __forceinline__ void done(const Unit&) const {}
};


__device__ __forceinline__ unsigned cvt_pk_bf16(float lo, float hi) { unsigned r; asm volatile("v_cvt_pk_bf16_f32 %0, %1, %2" : "=v"(r) : "v"(lo), "v"(hi)); return r; }
typedef unsigned u32x2 __attribute__((ext_vector_type(2)));
__device__ __forceinline__ float bf_lo(unsigned w) { return __builtin_bit_cast(float, w << 16); }
__device__ __forceinline__ float bf_hi(unsigned w) { return __builtin_bit_cast(float, w & 0xffff0000u); }
__device__ __forceinline__ float sigmoidf_(float x) { return 1.0f / (1.0f + __builtin_amdgcn_exp2f(-1.4426950408889634f * x)); }

constexpr float RMS_EPS = 1e-6f;
constexpr size_t DPLANE = (size_t)65536 * 512;
constexpr float LOG2E = 1.4426950408889634f;
constexpr float QSCALE_B = 0.125f * 1.4426950408889634f;
constexpr float QSCALE_A = 0.10206207261596575f * 1.4426950408889634f;

struct EpiIn {
    static constexpr bool PERM = false, AFTER_DRAIN = false, MIDHOOK = false;
    bf16_t* PA; bf16_t* DIL; bf16_t* GATES; float* ssq_q; float* ssq_kv; float* ssq_kr; const float* qn; const float* kn; const float* ssq1; const float* bw;
    __device__ __forceinline__ void operator()(const f32x4 (&acc_)[2][2][4][2], const Unit& u, int wr, int wc, int fr, int fq) const {
        { const int ln_ = otid() & 63; fr = ln_ & 15; fq = ln_ >> 4; }
        const int pn = u.pn; const size_t rowb = (size_t)u.pm * BM + wr * 64 + fr;
        f32x4 bv[2][2]; float r8[2][4];
        { const float* bwp = bw + (size_t)(u.pm >> 4) * 4096 + pn * BM + wc * 32 + fq * 4;
#pragma unroll
          for (int bj = 0; bj < 2; ++bj)
#pragma unroll
              for (int n = 0; n < 2; ++n) bv[bj][n] = *(const f32x4*)(bwp + bj * HALF + n * 16);
#pragma unroll
          for (int ai = 0; ai < 2; ++ai)
#pragma unroll
              for (int m = 0; m < 4; ++m) r8[ai][m] = __builtin_amdgcn_rsqf(ssq1[rowb + ai * HALF + m * 16] * (1.0f / 1024.0f) + RMS_EPS); }
#define EPIIN_VAL(ai, bj, m, n) (acc_[ai][bj][m][n] * r8[ai][m] + bv[bj][n])
        if (pn < 2) {
            float* sq = pn == 0 ? ssq_q : ssq_kv;
#pragma unroll
            for (int ai = 0; ai < 2; ++ai)
#pragma unroll
                for (int m = 0; m < 4; ++m) { const size_t row = rowb + ai * HALF + m * 16; float s = 0.f, s2 = 0.f;
#pragma unroll
                    for (int bj = 0; bj < 2; ++bj)
#pragma unroll
                        for (int n = 0; n < 2; ++n) { const f32x4 v = EPIIN_VAL(ai, bj, m, n);
                            u32x2 w; w.x = cvt_pk_bf16(v[0], v[1]); w.y = cvt_pk_bf16(v[2], v[3]);
                            *(u32x2*)(PA + row * 512 + pn * 256 + bj * HALF + wc * 32 + n * 16 + fq * 4) = w;
                            const float q = (v[0] * v[0] + v[1] * v[1]) + (v[2] * v[2] + v[3] * v[3]);
                            if (pn == 0 || bj == 0) s += q; else s2 += q; }
                    s += __shfl_xor(s, 16); s += __shfl_xor(s, 32);
                    if (fq == 0) atomicAdd(sq + row, s);
                    if (pn == 1 && wc == 0) { s2 += __shfl_xor(s2, 16); s2 += __shfl_xor(s2, 32); if (fq == 0) atomicAdd(ssq_kr + row, s2); } }
        } else if (pn < 6) {
            const int sec = (pn - 2) >> 1, head = 4 * ((pn - 2) & 1) + wc; const float* gp = sec == 0 ? qn : kn; const float gs = sec == 0 ? QSCALE_B : 1.0f;
            f32x4 gv[2][2];
#pragma unroll
            for (int bj = 0; bj < 2; ++bj)
#pragma unroll
                for (int n = 0; n < 2; ++n) gv[bj][n] = *(const f32x4*)(gp + 32 * bj + 16 * n + 4 * fq) * gs;
#pragma unroll
            for (int ai = 0; ai < 2; ++ai)
#pragma unroll
                for (int m = 0; m < 4; ++m) { const size_t row = rowb + ai * HALF + m * 16; float s = 0.f;
#pragma unroll
                    for (int bj = 0; bj < 2; ++bj)
#pragma unroll
                        for (int n = 0; n < 2; ++n) { const f32x4 v = EPIIN_VAL(ai, bj, m, n); s += (v[0] * v[0] + v[1] * v[1]) + (v[2] * v[2] + v[3] * v[3]); }
                    s += __shfl_xor(s, 16); s += __shfl_xor(s, 32);
                    const float r = __builtin_amdgcn_rsqf(s * (1.0f / 64.0f) + RMS_EPS);
#pragma unroll
                    for (int bj = 0; bj < 2; ++bj)
#pragma unroll
                        for (int n = 0; n < 2; ++n) { const f32x4 v = EPIIN_VAL(ai, bj, m, n) * r * gv[bj][n];
                            u32x2 w; w.x = cvt_pk_bf16(v[0], v[1]); w.y = cvt_pk_bf16(v[2], v[3]);
                            *(u32x2*)(DIL + (size_t)sec * DPLANE + ((((row >> 12) * 8 + head) << 12) + (row & 4095)) * 64 + 32 * bj + 16 * n + 4 * fq) = w; } }
        } else if (pn < 8) {
#pragma unroll
            for (int ai = 0; ai < 2; ++ai)
#pragma unroll
                for (int m = 0; m < 4; ++m) { const size_t row = rowb + ai * HALF + m * 16;
#pragma unroll
                    for (int bj = 0; bj < 2; ++bj)
#pragma unroll
                        for (int n = 0; n < 2; ++n) { const f32x4 v = EPIIN_VAL(ai, bj, m, n);
                            u32x2 w; w.x = cvt_pk_bf16(v[0], v[1]); w.y = cvt_pk_bf16(v[2], v[3]);
                            *(u32x2*)(DIL + 2 * DPLANE + ((((row >> 12) * 8 + (pn - 6) * 4 + 2 * bj + (wc >> 1)) << 12) + (row & 4095)) * 64 + 32 * (wc & 1) + n * 16 + fq * 4) = w; } }
        } else {
#pragma unroll
            for (int ai = 0; ai < 2; ++ai)
#pragma unroll
                for (int m = 0; m < 4; ++m) { const size_t row = rowb + ai * HALF + m * 16;
#pragma unroll
                    for (int bj = 0; bj < 2; ++bj)
#pragma unroll
                        for (int n = 0; n < 2; ++n) { const f32x4 v = EPIIN_VAL(ai, bj, m, n);
                            u32x2 w; w.x = cvt_pk_bf16(sigmoidf_(v[0]), sigmoidf_(v[1])); w.y = cvt_pk_bf16(sigmoidf_(v[2]), sigmoidf_(v[3]));
                            *(u32x2*)(GATES + row * 2048 + (pn - 8) * 256 + bj * HALF + wc * 32 + n * 16 + fq * 4) = w; } }
        }
    }
};
#undef EPIIN_VAL
struct EpiRowScale2 {
    static constexpr bool PERM = true, AFTER_DRAIN = false, MIDHOOK = false;
    unsigned char* ws; const float* kg;
    static constexpr size_t O_Q = 0, O_PA = 128u << 20, O_K = 768u << 20, O_V = 864u << 20, O_ROPE = 990u << 20, O_SSQ = 998u << 20, O_SSQKR = (1001u << 20) + 65536;
    __device__ __forceinline__ void operator()(const f32x4 (&acc)[2][2][4][2], const Unit& u, int wr, int wc, int fr, int fq) const {
        { const int ln_ = otid() & 63; fr = ln_ & 15; fq = ln_ >> 4; }
        bf16_t* Oq = (bf16_t*)(ws + O_Q); bf16_t* Kp = (bf16_t*)(ws + O_K); bf16_t* Vp = (bf16_t*)(ws + O_V); const bf16_t* PA = (const bf16_t*)(ws + O_PA); const float* ROPE = (const float*)(ws + O_ROPE);
        const float* ssq_q = (const float*)(ws + O_SSQ); const float* ssq_kv = ssq_q + 65536; const float* ssq_kr = (const float*)(ws + O_SSQKR);
        const size_t rowb = (size_t)u.pm * BM + wr * 64 + fr;
        if (u.pn < 3) {
            const int col0 = u.pn * BM + wc * 32 + 8 * fq;
#pragma unroll
            for (int ai = 0; ai < 2; ++ai)
#pragma unroll
                for (int m = 0; m < 4; ++m) { const size_t row = rowb + ai * HALF + m * 16; const float r = __builtin_amdgcn_rsqf(ssq_q[row] * (1.0f / 256.0f) + RMS_EPS);
#pragma unroll
                    for (int bj = 0; bj < 2; ++bj) { const f32x4 v0 = acc[ai][bj][m][0] * r, v1 = acc[ai][bj][m][1] * r;
                        u32x4 w; w.x = cvt_pk_bf16(v0[0], v0[1]); w.y = cvt_pk_bf16(v0[2], v0[3]); w.z = cvt_pk_bf16(v1[0], v1[1]); w.w = cvt_pk_bf16(v1[2], v1[3]);
                        *(u32x4*)(Oq + row * 768 + col0 + bj * HALF) = w; } }
        } else {
            const int head = (u.pn - 3) * 2 + (wc & 1); float rh8[2][4];
#pragma unroll
            for (int ai = 0; ai < 2; ++ai)
#pragma unroll
                for (int m = 0; m < 4; ++m) { const size_t row = rowb + ai * HALF + m * 16; const float r = __builtin_amdgcn_rsqf(ssq_kv[row] * (1.0f / 128.0f) + RMS_EPS);
                    const size_t hrow = ((((row >> 12) * 8 + head) << 12) + (row & 4095));
                    if (wc >= 2) {
#pragma unroll
                        for (int bj = 0; bj < 2; ++bj) { const f32x4 a = acc[ai][bj][m][0] * r, b = acc[ai][bj][m][1] * r;
                            u32x4 w; w.x = cvt_pk_bf16(a[0], a[1]); w.y = cvt_pk_bf16(a[2], a[3]); w.z = cvt_pk_bf16(b[0], b[1]); w.w = cvt_pk_bf16(b[2], b[3]);
                            *(u32x4*)(Vp + hrow * 64 + 32 * bj + 8 * fq) = w; }
                    } else {
                        float s = 0.f;
#pragma unroll
                        for (int bj = 0; bj < 2; ++bj) { const f32x4 a = acc[ai][bj][m][0], b = acc[ai][bj][m][1]; s += ((a[0] * a[0] + a[1] * a[1]) + (a[2] * a[2] + a[3] * a[3])) + ((b[0] * b[0] + b[1] * b[1]) + (b[2] * b[2] + b[3] * b[3])); }
                        s += __shfl_xor(s, 16); s += __shfl_xor(s, 32);
                        const float rh = __builtin_amdgcn_rsqf((s * r * r + ssq_kr[row]) * (1.0f / 96.0f) + RMS_EPS); const float rr = r * rh;
#pragma unroll
                        for (int bj = 0; bj < 2; ++bj) { const f32x4 a = acc[ai][bj][m][0] * rr * *(const f32x4*)(kg + 32 * bj + 8 * fq), b = acc[ai][bj][m][1] * rr * *(const f32x4*)(kg + 32 * bj + 8 * fq + 4);
                            u32x4 w; w.x = cvt_pk_bf16(a[0], a[1]); w.y = cvt_pk_bf16(a[2], a[3]); w.z = cvt_pk_bf16(b[0], b[1]); w.w = cvt_pk_bf16(b[2], b[3]);
                            *(u32x4*)(Kp + hrow * 96 + 32 * bj + 8 * fq) = w; }
                        rh8[ai][m] = rh;
                    }
                    asm volatile("" ::: "memory"); }
            if (wc < 2) {
#pragma unroll
                for (int ai = 0; ai < 2; ++ai)
#pragma unroll
                    for (int m = 0; m < 4; ++m) { const size_t row = rowb + ai * HALF + m * 16; const size_t hrow = ((((row >> 12) * 8 + head) << 12) + (row & 4095)); const float rh = rh8[ai][m];
                        const bf16_t* krp = PA + row * 512 + 384; const float* rp = ROPE + row * 32;
#pragma unroll
                        for (int e = 0; e < 2; ++e) { const int i0 = 4 * fq + 2 * e;
                            const unsigned xa = *(const unsigned*)(krp + i0), xb = *(const unsigned*)(krp + 16 + i0);
                            const float c0 = rp[i0], c1 = rp[i0 + 1], s0 = rp[16 + i0], s1 = rp[16 + i0 + 1];
                            const float a0 = bf_lo(xa) * rh * kg[64 + i0], a1 = bf_hi(xa) * rh * kg[64 + i0 + 1], b0 = bf_lo(xb) * rh * kg[80 + i0], b1 = bf_hi(xb) * rh * kg[80 + i0 + 1];
                            *(unsigned*)(Kp + hrow * 96 + 64 + i0) = cvt_pk_bf16(a0 * c0 - b0 * s0, a1 * c1 - b1 * s1);
                            *(unsigned*)(Kp + hrow * 96 + 80 + i0) = cvt_pk_bf16(b0 * c0 + a0 * s0, b1 * c1 + a1 * s1); }
                        asm volatile("" ::: "memory"); }
            }
        }
    }
};
struct EpiRowScale {
    static constexpr bool PERM = true, AFTER_DRAIN = false, MIDHOOK = false;
    bf16_t* O; int ldc; const float* ssq; float invk;
    __device__ __forceinline__ void operator()(const f32x4 (&acc)[2][2][4][2], const Unit& u, int wr, int wc, int fr, int fq) const {
        { const int ln_ = otid() & 63; fr = ln_ & 15; fq = ln_ >> 4; }
        const size_t rowb = (size_t)u.pm * BM + wr * 64 + fr; const int col0 = u.pn * BM + wc * 32 + 8 * fq;
#pragma unroll
        for (int ai = 0; ai < 2; ++ai)
#pragma unroll
            for (int m = 0; m < 4; ++m) { const size_t row = rowb + ai * HALF + m * 16; const float r = __builtin_amdgcn_rsqf(ssq[row] * invk + RMS_EPS);
#pragma unroll
                for (int bj = 0; bj < 2; ++bj) { const f32x4 v0 = acc[ai][bj][m][0] * r, v1 = acc[ai][bj][m][1] * r;
                    u32x4 w; w.x = cvt_pk_bf16(v0[0], v0[1]); w.y = cvt_pk_bf16(v0[2], v0[3]); w.z = cvt_pk_bf16(v1[0], v1[1]); w.w = cvt_pk_bf16(v1[2], v1[3]);
                    *(u32x4*)(O + row * ldc + col0 + bj * HALF) = w; } }
    }
};
struct EpiGate2 {
    static constexpr bool PERM = true, AFTER_DRAIN = false, MIDHOOK = true;
    bf16_t* O; const bf16_t* SIG;
    __device__ __forceinline__ void mid(f32x4 (&acc)[2][2][4][2], const Unit& u, int wr, int wc) const {
        const int ln_ = otid() & 63, fr = ln_ & 15, fq = ln_ >> 4;
        const size_t rowb = (size_t)u.pm * BM + wr * 64 + fr; const int col0 = u.pn * BM + wc * 32 + 8 * fq;
#pragma unroll
        for (int ai = 0; ai < 2; ++ai)
#pragma unroll
            for (int m = 0; m < 4; ++m) { const bf16_t* sp = SIG + (rowb + ai * HALF + m * 16) * 2048 + col0;
#pragma unroll
                for (int bj = 0; bj < 2; ++bj) { const u32x4 sa = *(const u32x4*)(sp + bj * HALF), sb = *(const u32x4*)(sp + 1024 + bj * HALF);
                    f32x4& v0 = acc[ai][bj][m][0]; f32x4& v1 = acc[ai][bj][m][1];
                    v0[0] *= bf_lo(sa.x) * __builtin_amdgcn_rcpf(1e-30f + bf_lo(sb.x)); v0[1] *= bf_hi(sa.x) * __builtin_amdgcn_rcpf(1e-30f + bf_hi(sb.x));
                    v0[2] *= bf_lo(sa.y) * __builtin_amdgcn_rcpf(1e-30f + bf_lo(sb.y)); v0[3] *= bf_hi(sa.y) * __builtin_amdgcn_rcpf(1e-30f + bf_hi(sb.y));
                    v1[0] *= bf_lo(sa.z) * __builtin_amdgcn_rcpf(1e-30f + bf_lo(sb.z)); v1[1] *= bf_hi(sa.z) * __builtin_amdgcn_rcpf(1e-30f + bf_hi(sb.z));
                    v1[2] *= bf_lo(sa.w) * __builtin_amdgcn_rcpf(1e-30f + bf_lo(sb.w)); v1[3] *= bf_hi(sa.w) * __builtin_amdgcn_rcpf(1e-30f + bf_hi(sb.w)); }
                asm volatile("" ::: "memory"); }
    }
    __device__ __forceinline__ void operator()(const f32x4 (&acc)[2][2][4][2], const Unit& u, int wr, int wc, int fr, int fq) const {
        { const int ln_ = otid() & 63; fr = ln_ & 15; fq = ln_ >> 4; }
        const size_t rowb = (size_t)u.pm * BM + wr * 64 + fr; const int col0 = u.pn * BM + wc * 32 + 8 * fq;
#pragma unroll
        for (int ai = 0; ai < 2; ++ai)
#pragma unroll
            for (int m = 0; m < 4; ++m) { const size_t row = rowb + ai * HALF + m * 16;
#pragma unroll
                for (int bj = 0; bj < 2; ++bj) { const u32x4 sg = *(const u32x4*)(SIG + row * 2048 + 1024 + col0 + bj * HALF);
                    f32x4 v0 = acc[ai][bj][m][0], v1 = acc[ai][bj][m][1];
                    v0[0] *= bf_lo(sg.x); v0[1] *= bf_hi(sg.x); v0[2] *= bf_lo(sg.y); v0[3] *= bf_hi(sg.y);
                    v1[0] *= bf_lo(sg.z); v1[1] *= bf_hi(sg.z); v1[2] *= bf_lo(sg.w); v1[3] *= bf_hi(sg.w);
                    u32x4 w; w.x = cvt_pk_bf16(v0[0], v0[1]); w.y = cvt_pk_bf16(v0[2], v0[3]); w.z = cvt_pk_bf16(v1[0], v1[1]); w.w = cvt_pk_bf16(v1[2], v1[3]);
                    *(u32x4*)(O + row * 1024 + col0 + bj * HALF) = w; } }
    }
};
struct EpiResid {
    static constexpr bool PERM = false, AFTER_DRAIN = false, MIDHOOK = false;
    const float* xin; float* out; const float* gmod;
    bf16_t* XG; const float* gnorm; const float* scmod; float* ssq;
    __device__ __forceinline__ void operator()(const f32x4 (&acc)[2][2][4][2], const Unit& u, int wr, int wc, int fr, int fq) const {
        { const int ln_ = otid() & 63; fr = ln_ & 15; fq = ln_ >> 4; }
        const size_t rowb = (size_t)u.pm * BM + wr * 64 + fr; const int col0 = u.pn * BM + wc * 32 + 4 * fq; const float* gb = gmod + (size_t)(u.pm >> 4) * 6144;
        f32x4 gv[2][2], Gv[2][2];
#pragma unroll
        for (int bj = 0; bj < 2; ++bj)
#pragma unroll
            for (int n = 0; n < 2; ++n) { gv[bj][n] = *(const f32x4*)(gb + col0 + bj * HALF + n * 16);
                if (XG) Gv[bj][n] = *(const f32x4*)(gnorm + col0 + bj * HALF + n * 16) * (1.0f + *(const f32x4*)(scmod + (size_t)(u.pm >> 4) * 6144 + col0 + bj * HALF + n * 16)); }
#pragma unroll
        for (int ai = 0; ai < 2; ++ai)
#pragma unroll
            for (int m = 0; m < 4; ++m) { const size_t row = rowb + ai * HALF + m * 16; const size_t off = row * 1024 + col0; float s = 0.f;
#pragma unroll
                for (int bj = 0; bj < 2; ++bj)
#pragma unroll
                    for (int n = 0; n < 2; ++n) { const f32x4 xv = *(const f32x4*)(xin + off + bj * HALF + n * 16);
                        const f32x4 xn = xv + gv[bj][n] * acc[ai][bj][m][n];
                        *(f32x4*)(out + off + bj * HALF + n * 16) = xn;
                        if (XG) { s += (xn[0] * xn[0] + xn[1] * xn[1]) + (xn[2] * xn[2] + xn[3] * xn[3]); const f32x4 t = xn * Gv[bj][n];
                            u32x2 w; w.x = cvt_pk_bf16(t[0], t[1]); w.y = cvt_pk_bf16(t[2], t[3]); *(u32x2*)(XG + off + bj * HALF + n * 16) = w; } }
                if (XG) { s += __shfl_xor(s, 16); s += __shfl_xor(s, 32); if (fq == 0) atomicAdd(ssq + row, s); } }
    }
};
struct EpiSwiGLU {
    static constexpr bool PERM = true, AFTER_DRAIN = false, MIDHOOK = false;
    bf16_t* O; const float* ssq2; const float* bw;
    __device__ __forceinline__ void operator()(const f32x4 (&acc)[2][2][4][2], const Unit& u, int wr, int wc, int fr, int fq) const {
        { const int ln_ = otid() & 63; fr = ln_ & 15; fq = ln_ >> 4; }
        const size_t rowb = (size_t)u.pm * BM + wr * 64 + fr; const int col0 = u.pn * HALF + wc * 32 + 8 * fq;
        const float* bwp = bw + (size_t)(u.pm >> 4) * 5632 + u.pn * BM + wc * 32 + 8 * fq;
        const f32x4 bg0 = *(const f32x4*)bwp, bg1 = *(const f32x4*)(bwp + 4), bu0 = *(const f32x4*)(bwp + HALF), bu1 = *(const f32x4*)(bwp + HALF + 4);
#pragma unroll
        for (int ai = 0; ai < 2; ++ai)
#pragma unroll
            for (int m = 0; m < 4; ++m) { const size_t row = rowb + ai * HALF + m * 16; const float r = __builtin_amdgcn_rsqf(ssq2[row] * (1.0f / 1024.0f) + RMS_EPS);
                f32x4 g0 = acc[ai][0][m][0] * r + bg0, g1 = acc[ai][0][m][1] * r + bg1; const f32x4 u0 = acc[ai][1][m][0] * r + bu0, u1 = acc[ai][1][m][1] * r + bu1;
#pragma unroll
                for (int i = 0; i < 4; ++i) { g0[i] = g0[i] * sigmoidf_(g0[i]) * u0[i]; g1[i] = g1[i] * sigmoidf_(g1[i]) * u1[i]; }
                u32x4 w; w.x = cvt_pk_bf16(g0[0], g0[1]); w.y = cvt_pk_bf16(g0[2], g0[3]); w.z = cvt_pk_bf16(g1[0], g1[1]); w.w = cvt_pk_bf16(g1[2], g1[3]);
                *(u32x4*)(O + row * 2816 + col0) = w; }
    }
};

template <class Epi, class Sched, bool ALIGN_EPI = false, bool SP2 = false>
__device__ __forceinline__ void gemm_phase(PG8_LAS unsigned char* lds, const Gemm g, const Sched& S, const Epi& E) {
    const int tid = otid(), wid = __builtin_amdgcn_readfirstlane(tid >> 6), lane = tid & 63, wr = wid >> 2, wc = wid & 3, fr = lane & 15, fq = lane >> 4;
    const int K = g.K, lda = g.lda, nt = K / BK;
    unsigned voffA[2], voffB[2];
#pragma unroll
    for (int i = 0; i < 2; ++i) { int R, C; stage_rc(tid * 16 + i * 8192, R, C); const int Rb = Epi::PERM ? ((R & ~31) + perm32(R & 31)) : R;
        voffA[i] = (unsigned)(R * lda + C) * 2u; voffB[i] = (unsigned)(Rb * K + C) * 2u; }
    const size_t kstep = (size_t)(BK * 2);
    const size_t hstepB = (size_t)HALF * K * 2, hstepA = (size_t)HALF * lda * 2;
    const size_t tstepB = 2 * hstepB, tstepA = 2 * hstepA;
    const unsigned ldsw = (unsigned)wid * 1024u;
    const int aoff = lds_byte(wr * 64 + fr, fq * 8), boff = lds_byte(wc * 32 + fr, fq * 8);
#define PG8_SA(b, h) (((b) * 2 + (h)) * HTB)
#define PG8_SB(b, h) ((4 + (b) * 2 + (h)) * HTB)
#define PG8_STAGE(bufoff, gbase, voff) do { _Pragma("unroll") for (int _i = 0; _i < 2; ++_i) \
        __builtin_amdgcn_global_load_lds((const unsigned*)((const char*)(gbase) + (voff)[_i]), (PG8_LAS unsigned*)(lds + (bufoff) + ldsw + _i * 8192), 16, 0, 0); } while (0)
#define PG8_LDA(dst, b, h) do { _Pragma("unroll") for (int m = 0; m < 4; ++m) _Pragma("unroll") for (int k = 0; k < 2; ++k) dst[m][k] = *(const PG8_LAS bf16x8*)(lds + PG8_SA(b, h) + aoff + m * 2048 + k * 1024); } while (0)
#define PG8_LDB(dst, b, h) do { _Pragma("unroll") for (int n = 0; n < 2; ++n) _Pragma("unroll") for (int k = 0; k < 2; ++k) dst[n][k] = *(const PG8_LAS bf16x8*)(lds + PG8_SB(b, h) + boff + n * 2048 + k * 1024); } while (0)
#define PG8_MMA(ai, bj, At, Bt) do { __builtin_amdgcn_s_setprio(1); _Pragma("unroll") for (int m = 0; m < 4; ++m) _Pragma("unroll") for (int n = 0; n < 2; ++n) _Pragma("unroll") for (int k = 0; k < 2; ++k) \
        acc[ai][bj][m][n] = __builtin_amdgcn_mfma_f32_16x16x32_bf16(Bt[n][k], At[m][k], acc[ai][bj][m][n], 0, 0, 0); __builtin_amdgcn_s_setprio(0); } while (0)
#define PG8_WAIT_V(n) asm volatile("s_waitcnt vmcnt(" #n ")" ::: "memory")
#define PG8_WAIT_L(n) asm volatile("s_waitcnt lgkmcnt(" #n ")" ::: "memory")
#define PG8_BAR __builtin_amdgcn_s_barrier()
#define PG8_SCHED __builtin_amdgcn_sched_barrier(0)
    Unit cur, nxt; int ui = 0;
    if (!S.next(0, cur)) return;
    f32x4 acc[2][2][4][2];
#pragma unroll
    for (int a = 0; a < 2; ++a)
#pragma unroll
        for (int b = 0; b < 2; ++b)
#pragma unroll
            for (int m = 0; m < 4; ++m)
#pragma unroll
                for (int n = 0; n < 2; ++n) acc[a][b][m][n] = (f32x4){0.f, 0.f, 0.f, 0.f};
    bf16x8 At[4][2], B0[2][2], B1[2][2];
    const char* cA = (const char*)g.A + (size_t)cur.pm * tstepA + (cur.pn >= g.asplit ? (size_t)g.aoff2 * 2 : 0); const char* cB = (const char*)g.Bt + (size_t)cur.pn * tstepB;
    S.a_ready(cur);
    if constexpr (SP2) {
        PG8_STAGE(PG8_SB(0, 0), cB, voffB); PG8_STAGE(PG8_SB(0, 1), cB + hstepB, voffB); PG8_STAGE(PG8_SA(0, 0), cA, voffA); PG8_STAGE(PG8_SA(0, 1), cA + hstepA, voffA);
        if (wr == 1) PG8_BAR;
        PG8_WAIT_V(2); PG8_BAR;
        PG8_STAGE(PG8_SB(1, 0), cB + kstep, voffB); PG8_STAGE(PG8_SA(1, 0), cA + kstep, voffA); PG8_STAGE(PG8_SB(1, 1), cB + hstepB + kstep, voffB);
        PG8_WAIT_V(6); PG8_BAR;
    } else {
        PG8_STAGE(PG8_SB(0, 0), cB, voffB); PG8_STAGE(PG8_SA(0, 0), cA, voffA); PG8_STAGE(PG8_SB(0, 1), cB + hstepB, voffB); PG8_STAGE(PG8_SA(0, 1), cA + hstepA, voffA);
        if (wr == 1) PG8_BAR;
        PG8_WAIT_V(4); PG8_BAR;
        PG8_STAGE(PG8_SB(1, 0), cB + kstep, voffB); PG8_STAGE(PG8_SA(1, 0), cA + kstep, voffA); PG8_STAGE(PG8_SB(1, 1), cB + hstepB + kstep, voffB);
        PG8_WAIT_V(6); PG8_BAR;
    }
    for (;;) {
        const bool has_next = S.next(ui + 1, nxt);
        const char* nA = has_next ? (const char*)g.A + (size_t)nxt.pm * tstepA + (nxt.pn >= g.asplit ? (size_t)g.aoff2 * 2 : 0) : cA; const char* nB = has_next ? (const char*)g.Bt + (size_t)nxt.pn * tstepB : cB;
        for (int t = 0; t < nt; t += 2) {
            const bool last = (t == nt - 2);
            if constexpr (Epi::MIDHOOK) { if (t == (nt >> 1)) E.mid(acc, cur, wr, wc); }
            const char* a1 = cA + (size_t)(t + 1) * kstep;
            const char* a2 = last ? nA : cA + (size_t)(t + 2) * kstep; const char* b2 = last ? nB : cB + (size_t)(t + 2) * kstep;
            const char* a3 = a2 + kstep; const char* b3 = b2 + kstep;
            if (last && has_next) S.a_ready(nxt);
            if constexpr (SP2) {
            PG8_LDB(B0, 0, 0); PG8_LDB(B1, 0, 1); PG8_SCHED; PG8_LDA(At, 0, 0); PG8_STAGE(PG8_SA(1, 1), a1 + hstepA, voffA);
            PG8_WAIT_V(8); PG8_WAIT_L(0); PG8_BAR; PG8_MMA(0, 0, At, B0); PG8_MMA(0, 1, At, B1); PG8_BAR; PG8_SCHED;
            PG8_LDA(At, 0, 1); PG8_STAGE(PG8_SB(0, 0), b2, voffB); PG8_STAGE(PG8_SB(0, 1), b2 + hstepB, voffB); PG8_STAGE(PG8_SA(0, 0), a2, voffA);
            PG8_WAIT_V(8); PG8_WAIT_L(0); PG8_BAR; PG8_MMA(1, 0, At, B0); PG8_MMA(1, 1, At, B1); PG8_BAR; PG8_SCHED;
            PG8_LDB(B0, 1, 0); PG8_LDB(B1, 1, 1); PG8_SCHED; PG8_LDA(At, 1, 0); PG8_STAGE(PG8_SA(0, 1), a2 + hstepA, voffA);
            PG8_WAIT_V(8); PG8_WAIT_L(0); PG8_BAR; PG8_MMA(0, 0, At, B0); PG8_MMA(0, 1, At, B1); PG8_BAR; PG8_SCHED;
            PG8_LDA(At, 1, 1); PG8_STAGE(PG8_SB(1, 0), b3, voffB); PG8_STAGE(PG8_SB(1, 1), b3 + hstepB, voffB); PG8_STAGE(PG8_SA(1, 0), a3, voffA);
            PG8_WAIT_V(8); PG8_WAIT_L(0); PG8_BAR; PG8_MMA(1, 0, At, B0); PG8_MMA(1, 1, At, B1); PG8_BAR; PG8_SCHED;
            } else {
            PG8_LDB(B0, 0, 0); PG8_SCHED; PG8_LDA(At, 0, 0); PG8_STAGE(PG8_SA(1, 1), a1 + hstepA, voffA);
            PG8_WAIT_L(8); PG8_BAR; PG8_WAIT_L(0); PG8_MMA(0, 0, At, B0); PG8_BAR; PG8_SCHED;
            PG8_LDB(B1, 0, 1); PG8_STAGE(PG8_SB(0, 0), b2, voffB);
            PG8_BAR; PG8_WAIT_L(0); PG8_MMA(0, 1, At, B1); PG8_BAR;
            PG8_LDA(At, 0, 1); PG8_STAGE(PG8_SA(0, 0), a2, voffA);
            PG8_BAR; PG8_WAIT_L(0); PG8_MMA(1, 0, At, B0); PG8_BAR; PG8_SCHED;
            PG8_STAGE(PG8_SB(0, 1), b2 + hstepB, voffB);
            PG8_WAIT_V(6); PG8_BAR; PG8_MMA(1, 1, At, B1); PG8_BAR;
            PG8_LDB(B0, 1, 0); PG8_SCHED; PG8_LDA(At, 1, 0); PG8_STAGE(PG8_SA(0, 1), a2 + hstepA, voffA);
            PG8_WAIT_L(8); PG8_BAR; PG8_WAIT_L(0); PG8_MMA(0, 0, At, B0); PG8_BAR; PG8_SCHED;
            PG8_LDB(B1, 1, 1); PG8_STAGE(PG8_SB(1, 0), b3, voffB);
            PG8_BAR; PG8_WAIT_L(0); PG8_MMA(0, 1, At, B1); PG8_BAR;
            PG8_LDA(At, 1, 1); PG8_STAGE(PG8_SA(1, 0), a3, voffA);
            PG8_BAR; PG8_WAIT_L(0); PG8_MMA(1, 0, At, B0); PG8_BAR; PG8_SCHED;
            PG8_STAGE(PG8_SB(1, 1), b3 + hstepB, voffB);
            PG8_WAIT_V(6); PG8_BAR; PG8_MMA(1, 1, At, B1); PG8_BAR;
            }
        }
        if constexpr (ALIGN_EPI) { if (wr == 0) PG8_BAR; }
        if constexpr (!Epi::AFTER_DRAIN) { E(acc, cur, wr, wc, fr, fq); S.done(cur); }
        if (!has_next) break;
#pragma unroll
        for (int a = 0; a < 2; ++a)
#pragma unroll
            for (int b = 0; b < 2; ++b)
#pragma unroll
                for (int m = 0; m < 4; ++m)
#pragma unroll
                    for (int n = 0; n < 2; ++n) acc[a][b][m][n] = (f32x4){0.f, 0.f, 0.f, 0.f};
        cur = nxt; cA = nA; cB = nB; ++ui;
        if constexpr (ALIGN_EPI) { if (wr == 1) PG8_BAR; }
    }
    PG8_WAIT_V(0);
    if constexpr (!ALIGN_EPI) { if (wr == 0) PG8_BAR; }
    PG8_BAR;
    if constexpr (Epi::AFTER_DRAIN) { E.fused(acc, cur, wr, wc, fr, fq, lds, wid, lane); S.done(cur); }
#undef PG8_SA
#undef PG8_SB
#undef PG8_STAGE
#undef PG8_LDA
#undef PG8_LDB
#undef PG8_MMA
#undef PG8_WAIT_V
#undef PG8_WAIT_L
#undef PG8_BAR
#undef PG8_SCHED
}
}

constexpr int NB = 16, SEQ = 4096, DM = 1024, DEPTH = 4, NTOK = NB * SEQ, NH = 8, FFH = 2816, NIN = 4096, INC = 4000;
constexpr int NWAVES = 8, NTHR = 512;
constexpr int LDS_BYTES = 147456, RING_BYTES = 131072;
constexpr size_t MiB = 1u << 20;
constexpr size_t WS_H = 0;
constexpr size_t WS_PA = 128 * MiB;
constexpr size_t WS_DIL = 192 * MiB;
constexpr size_t WS_GATES = 384 * MiB;
constexpr size_t WS_HID = 128 * MiB;
constexpr size_t WS_KVRAW = 640 * MiB;
constexpr size_t WS_K = 768 * MiB;
constexpr size_t WS_V = 864 * MiB;
constexpr size_t WS_W = 928 * MiB, WS_WSTRIDE = 30 * MiB;
constexpr size_t W_IN = 0, W_Q = W_IN + (size_t)NIN * 1024 * 2, W_KV = W_Q + 768 * 256 * 2, W_A = W_KV + 1024 * 256 * 2, W_B = W_A + 1024 * 512 * 2,
                 W_O = W_B + 1024 * 512 * 2, W_1 = W_O + 1024 * 1024 * 2, W_2 = W_1 + (size_t)5632 * 1024 * 2, W_END = W_2 + (size_t)1024 * 2816 * 2;
constexpr size_t WS_MOD = 988 * MiB;
constexpr size_t WS_ROPE = 990 * MiB;
constexpr size_t WS_SSQ = 998 * MiB;
constexpr size_t WS_LSE = 999 * MiB;
constexpr size_t WS_BT = 1001 * MiB;
constexpr size_t WS_SSQKR = 1001 * MiB + 65536;
constexpr size_t WS_BW1 = 1002 * MiB;
constexpr size_t WS_BW2 = 1003 * MiB;
constexpr size_t WS_CTL = 1005 * MiB, CTL_BYTES = 65536;
constexpr size_t WS_END = 1006 * MiB;
static_assert(W_END <= WS_WSTRIDE && WS_W + 2 * WS_WSTRIDE <= WS_MOD, "weights fit");
static_assert(pg8::EpiRowScale2::O_Q == WS_H && pg8::EpiRowScale2::O_PA == WS_PA && pg8::EpiRowScale2::O_K == WS_K && pg8::EpiRowScale2::O_V == WS_V && pg8::EpiRowScale2::O_ROPE == WS_ROPE && pg8::EpiRowScale2::O_SSQ == WS_SSQ && pg8::EpiRowScale2::O_SSQKR == WS_SSQKR, "EpiRowScale2 offsets");
static_assert(WS_HID + (size_t)NTOK * FFH * 2 <= WS_KVRAW, "hid overlay");

#define LAS __attribute__((address_space(3)))
typedef unsigned short bf16_t;
typedef short bf16x8 __attribute__((ext_vector_type(8)));
typedef short s16x4 __attribute__((ext_vector_type(4)));
typedef float f32x4 __attribute__((ext_vector_type(4)));
typedef float f32x16 __attribute__((ext_vector_type(16)));
typedef unsigned u32x4 __attribute__((ext_vector_type(4)));
typedef unsigned u32x2 __attribute__((ext_vector_type(2)));
using pg8::cvt_pk_bf16; using pg8::bf_lo; using pg8::bf_hi;

struct Params {
    const float *x, *c; const int* pos; const float *rel_bias, *norm1_g, *norm2_g, *ada_w, *ada_b, *w_in, *q_a_norm, *w_q_b, *kv_a_norm, *w_kv_b, *q_norm_a, *k_norm_a, *q_norm_b, *k_norm_b,
        *w_branch_a, *w_branch_b, *w_out, *w_ffn_gate, *w_ffn_up, *w_ffn_down;
    float* out; unsigned char* ws;
    float inv_freq[16];
    int ph_lo, ph_hi;
};

__device__ __forceinline__ float wave_sum(float v) {
#pragma unroll
    for (int o = 1; o < 64; o <<= 1) v += __shfl_xor(v, o);
    return v;
}
#define LDS_WAIT() asm volatile("s_waitcnt lgkmcnt(0)" ::: "memory")

__device__ __forceinline__ void phase0(const Params& P, LAS unsigned char* lds, int G) {
    const int tid = otid(), lane = tid & 63, wid = __builtin_amdgcn_readfirstlane(tid >> 6);
    float* MOD = (float*)(P.ws + WS_MOD); float* ROPE = (float*)(P.ws + WS_ROPE); float* BT = (float*)(P.ws + WS_BT);
    const int gtid = obid() * NTHR + tid, nthr = G * NTHR;
    for (int idx = gtid; idx < NTOK * 16; idx += nthr) { const int t = idx >> 4, i = idx & 15;
        const float ang = (float)P.pos[t] * P.inv_freq[i];
        double rev = (double)ang * 0.15915494309189535; rev -= __builtin_rint(rev); const float f = (float)rev;
        ROPE[t * 32 + i] = __builtin_amdgcn_cosf(f); ROPE[t * 32 + 16 + i] = __builtin_amdgcn_sinf(f); }
    for (int idx = gtid; idx < 3 * 8 * 129; idx += nthr) { const int j = idx % 129, h = (idx / 129) & 7, p = idx / (129 * 8);
        const int dil = p == 0 ? 1 : (p == 1 ? 4 : 16); const int rp = (j - 64) * dil; const int n = rp < 0 ? -rp : rp; int bk = rp > 0 ? 16 : 0;
        if (n < 8) bk += n; else { const float nf = (float)n; int lg = 8 + (int)(__logf(nf * 0.125f) / 4.852030263919617f * 8.0f); bk += lg < 15 ? lg : 15; }
        BT[idx] = P.rel_bias[bk * 8 + h] * pg8::LOG2E; }
    LAS float* sC = (LAS float*)lds;
    LAS float* red = (LAS float*)(lds + 65536);
    for (int i = tid; i < 16 * 1024; i += NTHR) { const float v = P.c[i]; sC[i] = v / (1.0f + __expf(-v)); }
    __syncthreads();
    for (int it = obid(); it < 4 * 96; it += G) { const int l = it / 96, cb = it % 96; const int col = cb * 64 + lane;
        float a[16];
#pragma unroll
        for (int b = 0; b < 16; ++b) a[b] = 0.f;
        const float* wp = P.ada_w + ((size_t)l * 1024 + wid * 128) * 6144 + col;
#pragma unroll 16
        for (int k = 0; k < 128; ++k) { const float w = wp[(size_t)k * 6144];
#pragma unroll
            for (int b = 0; b < 16; ++b) a[b] += sC[b * 1024 + wid * 128 + k] * w; }
#pragma unroll
        for (int b = 0; b < 16; ++b) red[(wid * 16 + b) * 64 + lane] = a[b];
        __syncthreads();
        for (int o = tid; o < 1024; o += NTHR) { const int b = o >> 6, ln = o & 63; float s = 0.f;
#pragma unroll
            for (int w = 0; w < 8; ++w) s += red[(w * 16 + b) * 64 + ln];
            MOD[((size_t)l * 16 + b) * 6144 + cb * 64 + ln] = s + P.ada_b[l * 6144 + cb * 64 + ln]; }
        __syncthreads();
    }
}

__device__ __forceinline__ void tr_item(const float* W, int Nsrc, int k0, int j0, const float* kscale, bf16_t* WT, int Kdst, int R0, LAS float* scr, int lane) {
    if (j0 >= 0) {
#pragma unroll 8
        for (int i = 0; i < 32; ++i) { const int kk = 2 * i + (lane >> 5); float v = W[(size_t)(k0 + kk) * Nsrc + j0 + (lane & 31)]; if (kscale) v *= kscale[k0 + kk]; scr[kk * 33 + (lane & 31)] = v; }
    } else {
#pragma unroll 8
        for (int i = 0; i < 32; ++i) { const int kk = 2 * i + (lane >> 5); scr[kk * 33 + (lane & 31)] = 0.f; }
    }
    LDS_WAIT();
    const int c = lane & 7;
#pragma unroll
    for (int j = 0; j < 4; ++j) { const int n = (lane >> 3) + 8 * j; const LAS float* s = scr + (8 * c) * 33 + n;
        u32x4 o; o.x = cvt_pk_bf16(s[0 * 33], s[1 * 33]); o.y = cvt_pk_bf16(s[2 * 33], s[3 * 33]); o.z = cvt_pk_bf16(s[4 * 33], s[5 * 33]); o.w = cvt_pk_bf16(s[6 * 33], s[7 * 33]);
        *(u32x4*)(WT + (size_t)(R0 + n) * Kdst + k0 + 8 * c) = o; }
    LDS_WAIT();
}
__device__ __forceinline__ int win_src_col(int R0) {
    const int pn = R0 >> 8, rho = R0 & 255;
    if (pn == 0) return rho;
    if (pn == 1) return rho < 160 ? 256 + rho : -1;
    if (pn < 6) { const int wc = (rho >> 5) & 3, dd = 32 * (rho >> 7); const int sec = (pn - 2) >> 1, head = 4 * ((pn - 2) & 1) + wc; return 416 + sec * 512 + head * 64 + dd; }
    if (pn < 8) return 416 + 1024 + (R0 - 1536);
    return 1952 + (R0 - 2048);
}
__device__ __forceinline__ void conv_weights(const Params& P, int l, unsigned char* wb, LAS unsigned char* lds, int G) {
    const int tid = otid(), lane = tid & 63, wid = __builtin_amdgcn_readfirstlane(tid >> 6);
    LAS float* scr = (LAS float*)(lds + wid * 16384);
    constexpr int I_IN = 16 * 128, I_Q = 4 * 24, I_KV = 4 * 32, I_A = 8 * 32, I_B = 8 * 32, I_O = 16 * 32, I_1 = 16 * 176, I_2 = 44 * 32;
    constexpr int NIT = I_IN + I_Q + I_KV + I_A + I_B + I_O + I_1 + I_2;
    for (int it = obid() * NWAVES + wid; it < NIT; it += G * NWAVES) {
        int r = it;
        if (r < I_IN) { const int kb = r / 128, rb = r % 128; tr_item(P.w_in + (size_t)l * 1024 * INC, INC, kb * 64, win_src_col(rb * 32), nullptr, (bf16_t*)(wb + W_IN), 1024, rb * 32, scr, lane); continue; } r -= I_IN;
        if (r < I_Q) { const int kb = r / 24, rb = r % 24; tr_item(P.w_q_b + (size_t)l * 256 * 768, 768, kb * 64, rb * 32, P.q_a_norm + l * 256, (bf16_t*)(wb + W_Q), 256, rb * 32, scr, lane); continue; } r -= I_Q;
        if (r < I_KV) { const int kb = r / 32, rb = r % 32; const int R0 = rb * 32, pnl = R0 >> 8, rho = R0 & 255, wcq = (rho >> 5) & 3;
            const int jsrc = (pnl * 2 + (wcq & 1)) * 128 + (wcq >= 2 ? 64 : 0) + 32 * (rho >> 7);
            tr_item(P.w_kv_b + (size_t)l * 128 * 1024, 1024, kb * 64, kb < 2 ? jsrc : -1, P.kv_a_norm + l * 128, (bf16_t*)(wb + W_KV), 256, R0, scr, lane); continue; } r -= I_KV;
        if (r < I_A) { const int kb = r / 32, rb = r % 32; tr_item(P.w_branch_a + (size_t)l * 512 * 1024, 1024, kb * 64, rb * 32, nullptr, (bf16_t*)(wb + W_A), 1024, rb * 32, scr, lane); continue; } r -= I_A;
        if (r < I_B) { const int kb = r / 32, rb = r % 32; tr_item(P.w_branch_b + (size_t)l * 512 * 1024, 1024, kb * 64, rb * 32, nullptr, (bf16_t*)(wb + W_A) + 512, 1024, rb * 32, scr, lane); continue; } r -= I_B;
        if (r < I_O) { const int kb = r / 32, rb = r % 32; tr_item(P.w_out + (size_t)l * 1024 * 1024, 1024, kb * 64, rb * 32, nullptr, (bf16_t*)(wb + W_O), 1024, rb * 32, scr, lane); continue; } r -= I_O;
        if (r < I_1) { const int kb = r / 176, rb = r % 176; const int R0 = rb * 32, pn = R0 >> 8, rho = R0 & 255;
            const float* src = (rho < 128 ? P.w_ffn_gate : P.w_ffn_up) + (size_t)l * 1024 * FFH;
            tr_item(src, FFH, kb * 64, pn * 128 + (rho & 127), nullptr, (bf16_t*)(wb + W_1), 1024, R0, scr, lane); continue; } r -= I_1;
        { const int kb = r / 32, rb = r % 32; tr_item(P.w_ffn_down + (size_t)l * FFH * 1024, 1024, kb * 64, rb * 32, nullptr, (bf16_t*)(wb + W_2), FFH, rb * 32, scr, lane); }
    }
}

__device__ __forceinline__ void norm_phase(const float* xin, const float* g, const float* mod  , int sh_off, int sc_off, bf16_t* H, int G) {
    const int tid = otid(), lane = tid & 63, wid = __builtin_amdgcn_readfirstlane(tid >> 6);
    for (int m = obid() * NWAVES + wid; m < NTOK; m += G * NWAVES) {
        const f32x4* xr = (const f32x4*)(xin + (size_t)m * DM) + lane; f32x4 v[4]; float s = 0.f;
#pragma unroll
        for (int j = 0; j < 4; ++j) { v[j] = xr[64 * j]; s += (v[j][0] * v[j][0] + v[j][1] * v[j][1]) + (v[j][2] * v[j][2] + v[j][3] * v[j][3]); }
        const float r = __builtin_amdgcn_rsqf(wave_sum(s) * (1.0f / DM) + pg8::RMS_EPS);
        const float* mb = mod + (size_t)(m >> 12) * 6144;
#pragma unroll
        for (int j = 0; j < 4; ++j) { const int col = 4 * lane + 256 * j;
            const f32x4 gv = *(const f32x4*)(g + col), sc = *(const f32x4*)(mb + sc_off + col), sh = *(const f32x4*)(mb + sh_off + col);
            const f32x4 o = (v[j] * r) * gv * (1.0f + sc) + sh;
            u32x2 w; w.x = cvt_pk_bf16(o[0], o[1]); w.y = cvt_pk_bf16(o[2], o[3]);
            *(u32x2*)(H + (size_t)m * DM + col) = w; }
    }
}

__device__ __forceinline__ void prepass_phase(const float* xin, const float* g, const float* mod  , int sc_off, bf16_t* XG, float* ssq, int G) {
    const int tid = otid(), lane = tid & 63, wid = __builtin_amdgcn_readfirstlane(tid >> 6);
    for (int m = obid() * NWAVES + wid; m < NTOK; m += G * NWAVES) {
        const f32x4* xr = (const f32x4*)(xin + (size_t)m * DM) + lane; float s = 0.f;
        const float* mb = mod + (size_t)(m >> 12) * 6144;
#pragma unroll
        for (int j = 0; j < 4; ++j) { const f32x4 v = xr[64 * j]; s += (v[0] * v[0] + v[1] * v[1]) + (v[2] * v[2] + v[3] * v[3]); const int col = 4 * lane + 256 * j;
            const f32x4 o = v * *(const f32x4*)(g + col) * (1.0f + *(const f32x4*)(mb + sc_off + col));
            u32x2 w; w.x = cvt_pk_bf16(o[0], o[1]); w.y = cvt_pk_bf16(o[2], o[3]);
            *(u32x2*)(XG + (size_t)m * DM + col) = w; }
        s = wave_sum(s);
        if (lane == 0) ssq[m] = s;
    }
}
__device__ __forceinline__ void bias_phase(const Params& P, LAS unsigned char* lds, int G) {
    const int tid = otid(), lane = tid & 63, wid = __builtin_amdgcn_readfirstlane(tid >> 6);
    const float* MOD = (const float*)(P.ws + WS_MOD); float* BW1 = (float*)(P.ws + WS_BW1); float* BW2 = (float*)(P.ws + WS_BW2);
    LAS float* sC = (LAS float*)lds;
    LAS float* red = (LAS float*)(lds + 65536);
    for (int it = obid(); it < 4 * 152; it += G) { const int l = it / 152, blk = it % 152; const bool ffn = blk >= 64; const int R0 = (ffn ? blk - 64 : blk) * 64;
        __syncthreads();
        for (int i = tid; i < 16 * 1024; i += NTHR) sC[i] = MOD[((size_t)l * 16 + (i >> 10)) * 6144 + (ffn ? 3072 : 0) + (i & 1023)];
        __syncthreads();
        const int R = R0 + lane; const float* wsrc; int j; size_t ncol;
        if (!ffn) { const int jb = win_src_col(R & ~31); j = jb < 0 ? -1 : jb + (R & 31); wsrc = P.w_in + (size_t)l * 1024 * INC; ncol = INC; }
        else { const int pn = R >> 8, rho = R & 255; j = pn * 128 + (rho & 127); wsrc = (rho < 128 ? P.w_ffn_gate : P.w_ffn_up) + (size_t)l * 1024 * FFH; ncol = FFH; }
        float a[16];
#pragma unroll
        for (int b = 0; b < 16; ++b) a[b] = 0.f;
        if (j >= 0) { const float* wp = wsrc + (size_t)(wid * 128) * ncol + j;
#pragma unroll 16
            for (int k = 0; k < 128; ++k) { const float w = wp[(size_t)k * ncol];
#pragma unroll
                for (int b = 0; b < 16; ++b) a[b] += sC[b * 1024 + wid * 128 + k] * w; } }
#pragma unroll
        for (int b = 0; b < 16; ++b) red[(wid * 16 + b) * 64 + lane] = a[b];
        __syncthreads();
        for (int o = tid; o < 1024; o += NTHR) { const int b = o >> 6, ln = o & 63; float s = 0.f;
#pragma unroll
            for (int w = 0; w < 8; ++w) s += red[(w * 16 + b) * 64 + ln];
            if (!ffn) BW1[((size_t)l * 16 + b) * 4096 + R0 + ln] = s; else BW2[((size_t)l * 16 + b) * 5632 + R0 + ln] = s; }
    }
    __syncthreads();
}

__device__ __forceinline__ void unpack8(const u32x4 w, float* f) { f[0] = bf_lo(w.x); f[1] = bf_hi(w.x); f[2] = bf_lo(w.y); f[3] = bf_hi(w.y); f[4] = bf_lo(w.z); f[5] = bf_hi(w.z); f[6] = bf_lo(w.w); f[7] = bf_hi(w.w); }
__device__ __forceinline__ u32x4 pack8(const float* f) { u32x4 w; w.x = cvt_pk_bf16(f[0], f[1]); w.y = cvt_pk_bf16(f[2], f[3]); w.z = cvt_pk_bf16(f[4], f[5]); w.w = cvt_pk_bf16(f[6], f[7]); return w; }
__device__ __forceinline__ float ssq8(const u32x4 w) { float f[8]; unpack8(w, f); return ((f[0] * f[0] + f[1] * f[1]) + (f[2] * f[2] + f[3] * f[3])) + ((f[4] * f[4] + f[5] * f[5]) + (f[6] * f[6] + f[7] * f[7])); }
__device__ __forceinline__ void head_norm_rope(const bf16_t* src_nope, const bf16_t* src_rope, bf16_t* dst, const float* gain, const float* rope, float oscale) {
    float s = 0.f;
#pragma unroll
    for (int c = 0; c < 8; ++c) s += ssq8(*(const u32x4*)(src_nope + 8 * c));
#pragma unroll
    for (int c = 0; c < 4; ++c) s += ssq8(*(const u32x4*)(src_rope + 8 * c));
    const float r = __builtin_amdgcn_rsqf(s * (1.0f / 96.0f) + pg8::RMS_EPS);
    asm volatile("" ::: "memory");
#pragma unroll
    for (int c = 0; c < 8; ++c) { float f[8]; unpack8(*(const u32x4*)(src_nope + 8 * c), f);
#pragma unroll
        for (int i = 0; i < 8; ++i) f[i] = f[i] * r * gain[8 * c + i] * oscale;
        *(u32x4*)(dst + 8 * c) = pack8(f); asm volatile("" ::: "memory"); }
    float x[32];
#pragma unroll
    for (int c = 0; c < 4; ++c) unpack8(*(const u32x4*)(src_rope + 8 * c), x + 8 * c);
#pragma unroll
    for (int i = 0; i < 32; ++i) x[i] = x[i] * r * gain[64 + i];
#pragma unroll
    for (int i = 0; i < 16; ++i) { const float cs = rope[i], sn = rope[16 + i]; const float x1 = x[i], x2 = x[16 + i]; x[i] = (x1 * cs - x2 * sn) * oscale; x[16 + i] = (x2 * cs + x1 * sn) * oscale; }
#pragma unroll
    for (int c = 0; c < 4; ++c) *(u32x4*)(dst + 64 + 8 * c) = pack8(x + 8 * c);
    asm volatile("" ::: "memory");
}
__device__ __forceinline__ void prep_phase(const Params& P, int l, int G) {
    const bf16_t* KVRAW = (const bf16_t*)(P.ws + WS_KVRAW); const bf16_t* PA = (const bf16_t*)(P.ws + WS_PA);
    bf16_t* K = (bf16_t*)(P.ws + WS_K); const float* ROPE = (const float*)(P.ws + WS_ROPE);
    const float* kg = P.k_norm_a + l * 96;
    for (int idx = obid() * NTHR + otid(); idx < NTOK * NH; idx += G * NTHR) { const int t = idx >> 3, h = idx & 7;
        const float* rp = ROPE + (size_t)t * 32;
        const bf16_t* kp = KVRAW + (size_t)t * 1024 + h * 128;
        const size_t hrow = ((size_t)((t >> 12) * 8 + h) << 12) + (t & 4095);
        head_norm_rope(kp, PA + (size_t)t * 512 + 384, K + hrow * 96, kg, rp, 1.0f);
    }
}
typedef short v4i16_t __attribute__((ext_vector_type(4)));
__device__ __forceinline__ s16x4 vtr(const LAS unsigned char* p) { return __builtin_bit_cast(s16x4, __builtin_amdgcn_ds_read_tr16_b64_v4i16((LAS v4i16_t*)p)); }
__device__ __forceinline__ bf16x8 cat8(s16x4 a, s16x4 b) { return (bf16x8){a[0], a[1], a[2], a[3], b[0], b[1], b[2], b[3]}; }
__device__ __forceinline__ bf16x8 packp(const f32x16& p, int o) {
    u32x4 w; w.x = cvt_pk_bf16(p[o + 0], p[o + 1]); w.y = cvt_pk_bf16(p[o + 2], p[o + 3]); w.z = cvt_pk_bf16(p[o + 4], p[o + 5]); w.w = cvt_pk_bf16(p[o + 6], p[o + 7]);
    return __builtin_bit_cast(bf16x8, w);
}
__device__ __forceinline__ float max16(const f32x16& p) {
    float a = fmaxf(fmaxf(p[0], p[1]), fmaxf(p[2], p[3])), b = fmaxf(fmaxf(p[4], p[5]), fmaxf(p[6], p[7]));
    float c = fmaxf(fmaxf(p[8], p[9]), fmaxf(p[10], p[11])), d = fmaxf(fmaxf(p[12], p[13]), fmaxf(p[14], p[15]));
    return fmaxf(fmaxf(a, b), fmaxf(c, d));
}
#define MFMA32(a, b, c) __builtin_amdgcn_mfma_f32_32x32x16_bf16((a), (b), (c), 0, 0, 0)
constexpr int KP = 208, VP = 192;
constexpr int KT_B = 64 * KP, VT_B = 64 * VP;
constexpr int MLA_K0 = 0, MLA_V0 = 2 * KT_B;

constexpr float MLA_THR = 8.0f;
__device__ __forceinline__ float max3f(float a, float b, float c) { float r; asm("v_max3_f32 %0, %1, %2, %3" : "=v"(r) : "v"(a), "v"(b), "v"(c)); return r; }
__device__ __forceinline__ float rowmax32(const f32x16& a, const f32x16& b) {
    float x = max3f(a[0], a[1], a[2]), y = max3f(b[0], b[1], b[2]);
    x = max3f(x, a[3], a[4]); y = max3f(y, b[3], b[4]); x = max3f(x, a[5], a[6]); y = max3f(y, b[5], b[6]); x = max3f(x, a[7], a[8]); y = max3f(y, b[7], b[8]);
    x = max3f(x, a[9], a[10]); y = max3f(y, b[9], b[10]); x = max3f(x, a[11], a[12]); y = max3f(y, b[11], b[12]); x = max3f(x, a[13], a[14]); y = max3f(y, b[13], b[14]);
    x = max3f(x, a[15], b[15]); x = max3f(x, y, y);
    return max3f(x, __shfl_xor(x, 32), x);
}
#define SBAR0() __builtin_amdgcn_sched_barrier(0)
__device__ __forceinline__ void mla_unit(LAS unsigned char* lds, const bf16_t* Q, const bf16_t* K, const bf16_t* V, bf16_t* Y, const float* qgain, const float* ROPE, int b, int h, int qb) {
    const int tid = otid(), lane = tid & 63, wid = __builtin_amdgcn_readfirstlane(tid >> 6), r32 = lane & 31, hi = lane >> 5;
    const size_t tok0 = (size_t)b * SEQ; const size_t qrow = tok0 + qb * 256 + wid * 32 + r32;
    bf16x8 qf[6];
    {
        const bf16_t* qp = Q + qrow * 768 + h * 96 + hi * 8; float f[6][8]; float s = 0.f;
#pragma unroll
        for (int d0 = 0; d0 < 6; ++d0) { unpack8(*(const u32x4*)(qp + d0 * 16), f[d0]);
#pragma unroll
            for (int i = 0; i < 8; ++i) s += f[d0][i] * f[d0][i]; }
        s += __shfl_xor(s, 32);
        const float r = __builtin_amdgcn_rsqf(s * (1.0f / 96.0f) + pg8::RMS_EPS);
#pragma unroll
        for (int d0 = 0; d0 < 6; ++d0)
#pragma unroll
            for (int i = 0; i < 8; ++i) f[d0][i] = f[d0][i] * r * qgain[d0 * 16 + hi * 8 + i];
        const float* rp = ROPE + qrow * 32 + hi * 8;
#pragma unroll
        for (int i = 0; i < 8; ++i) { const float cs = rp[i], sn = rp[16 + i]; const float x1 = f[4][i], x2 = f[5][i]; f[4][i] = x1 * cs - x2 * sn; f[5][i] = x2 * cs + x1 * sn; }
#pragma unroll
        for (int d0 = 0; d0 < 6; ++d0) {
#pragma unroll
            for (int i = 0; i < 8; ++i) f[d0][i] *= pg8::QSCALE_A;
            qf[d0] = __builtin_bit_cast(bf16x8, pack8(f[d0])); }
    }
    const int kr0 = tid / 12, kc0 = tid % 12, kr1 = (512 + tid) / 12, kc1 = (512 + tid) % 12, vr = tid >> 3, vc = tid & 7;
    const size_t hrow0 = (size_t)(b * 8 + h) * SEQ;
    const bf16_t* kg0 = K + (hrow0 + kr0) * 96 + kc0 * 8; const bf16_t* kg1 = K + (hrow0 + kr1) * 96 + kc1 * 8;
    const bf16_t* vg = V + (hrow0 + vr) * 64 + vc * 8;
    const int kl0 = kr0 * KP + kc0 * 16, kl1 = kr1 * KP + kc1 * 16, vl = vr * VP + vc * 16;
    const bool has1 = tid < 256;
    u32x4 ka0, kb0, ka1, kb1, vv0, vv1;
    ka0 = *(const u32x4*)kg0; if (has1) kb0 = *(const u32x4*)kg1; vv0 = *(const u32x4*)vg;
    ka1 = *(const u32x4*)(kg0 + (size_t)64 * 96); if (has1) kb1 = *(const u32x4*)(kg1 + (size_t)64 * 96);
    *(LAS u32x4*)(lds + MLA_K0 + kl0) = ka0; if (has1) *(LAS u32x4*)(lds + MLA_K0 + kl1) = kb0; *(LAS u32x4*)(lds + MLA_V0 + vl) = vv0;
    *(LAS u32x4*)(lds + MLA_K0 + KT_B + kl0) = ka1; if (has1) *(LAS u32x4*)(lds + MLA_K0 + KT_B + kl1) = kb1;
    ka0 = *(const u32x4*)(kg0 + (size_t)128 * 96); if (has1) kb0 = *(const u32x4*)(kg1 + (size_t)128 * 96); vv1 = *(const u32x4*)(vg + (size_t)64 * 64);
    __syncthreads();
    f32x16 o0, o1, negm;
#pragma unroll
    for (int i = 0; i < 16; ++i) { o0[i] = 0.f; o1[i] = 0.f; negm[i] = 0.f; }
    const int koff = r32 * KP + hi * 16;
    const int voff = (4 * hi + ((lane & 15) >> 2)) * VP + (16 * ((lane >> 4) & 1) + 4 * (lane & 3)) * 2;
    f32x16 p0, p1, n0, n1;
    { const LAS unsigned char* kb_ = lds + MLA_K0 + koff; p0 = negm; p1 = negm;
#pragma unroll
      for (int d0 = 0; d0 < 6; ++d0) { const bf16x8 a0 = *(const LAS bf16x8*)(kb_ + d0 * 32), a1 = *(const LAS bf16x8*)(kb_ + 32 * KP + d0 * 32); p0 = MFMA32(a0, qf[d0], p0); p1 = MFMA32(a1, qf[d0], p1); } }
    float m_ref, l_run = 0.f;
    { const float mx = rowmax32(p0, p1); m_ref = mx;
#pragma unroll
      for (int i = 0; i < 16; ++i) { p0[i] -= mx; p1[i] -= mx; negm[i] = -mx; } }
#define MLA_STEP(C0, C1, X0, X1, T, KAI, KBI, VVI, KAW, KBW, VVW) do { const int t_ = (T); const int cur = t_ & 1; \
        if (t_ + 3 < 64) { const size_t go = (size_t)(t_ + 3) * 64; KAI = *(const u32x4*)(kg0 + go * 96); if (has1) KBI = *(const u32x4*)(kg1 + go * 96); } \
        if (t_ + 2 < 64) { const size_t go = (size_t)(t_ + 2) * 64; VVI = *(const u32x4*)(vg + go * 64); } \
        bf16x8 kfr[12]; { const LAS unsigned char* kn = lds + MLA_K0 + (cur ^ 1) * KT_B + koff; \
            _Pragma("unroll") for (int d0 = 0; d0 < 6; ++d0) { kfr[2 * d0] = *(const LAS bf16x8*)(kn + d0 * 32); kfr[2 * d0 + 1] = *(const LAS bf16x8*)(kn + 32 * KP + d0 * 32); } } \
        SBAR0(); \
        const float mx = rowmax32(C0, C1); \
        if (__builtin_amdgcn_ballot_w64(mx > MLA_THR) != 0ull) { const float d = fmaxf(mx, 0.f); const float sc = __builtin_amdgcn_exp2f(-d); m_ref += d; l_run *= sc; \
            _Pragma("unroll") for (int i = 0; i < 16; ++i) { C0[i] -= d; C1[i] -= d; o0[i] *= sc; o1[i] *= sc; negm[i] = -m_ref; } } \
        SBAR0(); \
        X0 = negm; X1 = negm; \
        _Pragma("unroll") for (int d0 = 0; d0 < 6; ++d0) { X0 = MFMA32(kfr[2 * d0], qf[d0], X0); X1 = MFMA32(kfr[2 * d0 + 1], qf[d0], X1); } \
        SBAR0(); \
        float ls = 0.f; \
        _Pragma("unroll") for (int i = 0; i < 16; ++i) { C0[i] = __builtin_amdgcn_exp2f(C0[i]); C1[i] = __builtin_amdgcn_exp2f(C1[i]); ls += C0[i] + C1[i]; } \
        l_run += ls; \
        bf16x8 pb[4]; pb[0] = packp(C0, 0); pb[1] = packp(C0, 8); pb[2] = packp(C1, 0); pb[3] = packp(C1, 8); \
        const LAS unsigned char* vb_ = lds + MLA_V0 + cur * VT_B + voff; \
        _Pragma("unroll") for (int j = 0; j < 4; ++j) { const LAS unsigned char* vj = vb_ + 16 * j * VP; \
            const bf16x8 a0 = cat8(vtr(vj), vtr(vj + 8 * VP)); const bf16x8 a1 = cat8(vtr(vj + 64), vtr(vj + 8 * VP + 64)); \
            o0 = MFMA32(a0, pb[j], o0); o1 = MFMA32(a1, pb[j], o1); } \
        if (t_ + 2 < 64) { *(LAS u32x4*)(lds + MLA_K0 + cur * KT_B + kl0) = KAW; if (has1) *(LAS u32x4*)(lds + MLA_K0 + cur * KT_B + kl1) = KBW; } \
        if (t_ + 1 < 64) *(LAS u32x4*)(lds + MLA_V0 + (cur ^ 1) * VT_B + vl) = VVW; \
        __syncthreads(); } while (0)
    for (int t = 0; t < 64; t += 2) { MLA_STEP(p0, p1, n0, n1, t, ka1, kb1, vv0, ka0, kb0, vv1); MLA_STEP(n0, n1, p0, p1, t + 1, ka0, kb0, vv1, ka1, kb1, vv0); }
#undef MLA_STEP
    const float lt = l_run + __shfl_xor(l_run, 32); const float inv = 1.0f / lt;
    bf16_t* yp = Y + qrow * 1024 + h * 64 + 4 * hi;
#pragma unroll
    for (int g = 0; g < 4; ++g) {
        u32x2 w0; w0.x = cvt_pk_bf16(o0[4 * g] * inv, o0[4 * g + 1] * inv); w0.y = cvt_pk_bf16(o0[4 * g + 2] * inv, o0[4 * g + 3] * inv); *(u32x2*)(yp + 8 * g) = w0;
        u32x2 w1; w1.x = cvt_pk_bf16(o1[4 * g] * inv, o1[4 * g + 1] * inv); w1.y = cvt_pk_bf16(o1[4 * g + 2] * inv, o1[4 * g + 3] * inv); *(u32x2*)(yp + 32 + 8 * g) = w1; }
}

constexpr int DW_BYTES = 13440;
template <int DELTA>
__device__ __forceinline__ void dil_block(LAS unsigned char* wl, const bf16_t* kbase  , const bf16_t* vbase, size_t rstride  ,
                                          const bf16x8 (&qf)[2][4], f32x16 (&o)[2][2], float (&m_run)[2], float (&l_run)[2], int bvar, int voff, int lane, int r32, int hi, int btb) {
    u32x4 vv[8]; bf16x8 kf[2][4];
#pragma unroll
    for (int i = 0; i < 8; ++i) { const int idx = lane + 64 * i, row = idx >> 3, ch = idx & 7; vv[i] = *(const u32x4*)(vbase + (size_t)row * rstride + ch * 8); }
#pragma unroll
    for (int kvh = 0; kvh < 2; ++kvh)
#pragma unroll
        for (int d0 = 0; d0 < 4; ++d0) kf[kvh][d0] = *(const bf16x8*)(kbase + (size_t)(32 * kvh + r32) * rstride + d0 * 16);
    SBAR0();
#pragma unroll
    for (int i = 0; i < 8; ++i) { const int idx = lane + 64 * i, row = idx >> 3, ch = idx & 7; *(LAS u32x4*)(wl + row * VP + ch * 16) = vv[i]; }
    bf16x8 pb[2][4];
#pragma unroll
    for (int qh = 0; qh < 2; ++qh) {
        f32x16 s[2]; float mx = -1e30f;
#pragma unroll
        for (int kvh = 0; kvh < 2; ++kvh) {
            constexpr int dummy = 0; (void)dummy;
            const int toff = 64 * DELTA + 32 * (kvh - qh);
            if (toff > 64 || toff < -64) continue;
#pragma unroll
            for (int i = 0; i < 16; ++i) s[kvh][i] = 0.f;
#pragma unroll
            for (int d0 = 0; d0 < 4; ++d0) s[kvh] = MFMA32(kf[kvh][d0], qf[qh][d0], s[kvh]);
#pragma unroll
            for (int rr = 0; rr < 16; ++rr) { const int c4 = 4 * ((rr & 3) + 8 * (rr >> 2)); const float bias = *(const LAS float*)(wl + bvar + (VT_B + c4 + toff * 4));
                float v = s[kvh][rr] + bias;
                if (toff == 64) v = (bvar <= btb - c4) ? v : -1e30f;
                if (toff == -64) v = (bvar >= btb - c4) ? v : -1e30f;
                s[kvh][rr] = v; mx = fmaxf(mx, v); }
        }
        mx = fmaxf(mx, __shfl_xor(mx, 32));
        const float m_new = fmaxf(m_run[qh], mx); const float alpha = __builtin_amdgcn_exp2f(m_run[qh] - m_new); m_run[qh] = m_new;
        float ls = 0.f;
#pragma unroll
        for (int kvh = 0; kvh < 2; ++kvh) { const int toff = 64 * DELTA + 32 * (kvh - qh);
            if (toff > 64 || toff < -64) continue;
#pragma unroll
            for (int rr = 0; rr < 16; ++rr) { const float e = __builtin_amdgcn_exp2f(s[kvh][rr] - m_new); s[kvh][rr] = e; ls += e; }
            pb[qh][2 * kvh] = packp(s[kvh], 0); pb[qh][2 * kvh + 1] = packp(s[kvh], 8); }
        l_run[qh] = l_run[qh] * alpha + ls;
#pragma unroll
        for (int i = 0; i < 16; ++i) { o[qh][0][i] *= alpha; o[qh][1][i] *= alpha; }
    }
    LDS_WAIT();
#pragma unroll
    for (int j = 0; j < 4; ++j) { const LAS unsigned char* vj = wl + voff + 16 * j * VP;
        const bf16x8 a0 = cat8(vtr(vj), vtr(vj + 8 * VP)); const bf16x8 a1 = cat8(vtr(vj + 64), vtr(vj + 8 * VP + 64));
#pragma unroll
        for (int qh = 0; qh < 2; ++qh) { const int toff = 64 * DELTA + 32 * ((j >> 1) - qh);
            if (toff > 64 || toff < -64) continue;
            o[qh][0] = MFMA32(a0, pb[qh][j], o[qh][0]); o[qh][1] = MFMA32(a1, pb[qh][j], o[qh][1]); } }
    LDS_WAIT();
}
template <int P_>
__device__ __forceinline__ void dil_wave_unit(LAS unsigned char* wl, const bf16_t* DIL, bf16_t* Y, bf16_t* ST, float* LSE, const float* BT, int b, int h, int r, int nb) {
    constexpr int dil = P_ == 0 ? 1 : (P_ == 1 ? 4 : 16), nblk = 64 / dil; constexpr bool first = P_ == 0, last = P_ == 2;
    const int lane = otid() & 63, r32 = lane & 31, hi = lane >> 5;
    const size_t tok0 = (size_t)b * SEQ; const size_t rstride = (size_t)dil * 64;
    LAS float* bt = (LAS float*)(wl + VT_B);
    for (int i = lane; i < 257; i += 64) { int j = i - 64; j = j < 0 ? 0 : (j > 128 ? 128 : j); bt[i] = BT[(P_ * 8 + h) * 129 + j]; }
    const int btb = 128 * 4;
    const int bvar = btb + 4 * (4 * hi - r32);
    bf16x8 qf[2][4];
    const bf16_t* rowb = DIL + ((size_t)(b * 8 + h) * SEQ + (size_t)(64 * nb) * dil + r) * 64;
    constexpr size_t KOFF = pg8::DPLANE, VOFF = 2 * pg8::DPLANE;
#pragma unroll
    for (int qh = 0; qh < 2; ++qh)
#pragma unroll
        for (int d0 = 0; d0 < 4; ++d0) qf[qh][d0] = *(const bf16x8*)(rowb + (size_t)(32 * qh + r32) * rstride + hi * 8 + d0 * 16);
    f32x16 o[2][2];
#pragma unroll
    for (int a = 0; a < 2; ++a)
#pragma unroll
        for (int c = 0; c < 2; ++c)
#pragma unroll
            for (int i = 0; i < 16; ++i) o[a][c][i] = 0.f;
    float m_run[2] = {-1e30f, -1e30f}, l_run[2] = {0.f, 0.f};
    const int voff = (4 * hi + ((lane & 15) >> 2)) * VP + (16 * ((lane >> 4) & 1) + 4 * (lane & 3)) * 2;
    LDS_WAIT();
    dil_block<0>(wl, rowb + KOFF + hi * 8, rowb + VOFF, rstride, qf, o, m_run, l_run, bvar, voff, lane, r32, hi, btb);
    if (nb > 0) dil_block<-1>(wl, rowb - 64 * rstride + KOFF + hi * 8, rowb - 64 * rstride + VOFF, rstride, qf, o, m_run, l_run, bvar, voff, lane, r32, hi, btb);
    if (nb + 1 < nblk) dil_block<1>(wl, rowb + 64 * rstride + KOFF + hi * 8, rowb + 64 * rstride + VOFF, rstride, qf, o, m_run, l_run, bvar, voff, lane, r32, hi, btb);
    float lp[2]; u32x2 pv[2][8];
    if (!first) {
#pragma unroll
        for (int qh = 0; qh < 2; ++qh) { const size_t srow = (size_t)(b * 8 + h) * SEQ + (size_t)(64 * nb + 32 * qh + r32) * dil + r; lp[qh] = LSE[srow];
            const bf16_t* sp = ST + srow * 64 + 4 * hi;
#pragma unroll
            for (int e = 0; e < 8; ++e) pv[qh][e] = *(const u32x2*)(sp + 32 * (e >> 2) + 8 * (e & 3)); }
    }
#pragma unroll
    for (int qh = 0; qh < 2; ++qh) {
        const size_t spos = (size_t)(64 * nb + 32 * qh + r32) * dil + r; const size_t srow = (size_t)(b * 8 + h) * SEQ + spos;
        const float lt = l_run[qh] + __shfl_xor(l_run[qh], 32); const float inv = 1.0f / lt; const float lse2 = m_run[qh] + __builtin_amdgcn_logf(lt);
        float a_prev = 0.f, a_cur = inv, lse_new = lse2;
        if (!first) { const float M = fmaxf(lp[qh], lse2); const float wp = __builtin_amdgcn_exp2f(lp[qh] - M), wc = __builtin_amdgcn_exp2f(lse2 - M); const float den = wp + wc;
            a_prev = wp / den; a_cur = wc / den * inv; lse_new = M + __builtin_amdgcn_logf(den); }
        bf16_t* yp = last ? Y + (tok0 + spos) * 1024 + 512 + h * 64 + 4 * hi : ST + srow * 64 + 4 * hi;
#pragma unroll
        for (int e = 0; e < 8; ++e) { const int blk = e >> 2, g = e & 3;
            float v0 = o[qh][blk][4 * g] * a_cur, v1 = o[qh][blk][4 * g + 1] * a_cur, v2 = o[qh][blk][4 * g + 2] * a_cur, v3 = o[qh][blk][4 * g + 3] * a_cur;
            if (!first) { v0 += a_prev * bf_lo(pv[qh][e].x); v1 += a_prev * bf_hi(pv[qh][e].x); v2 += a_prev * bf_lo(pv[qh][e].y); v3 += a_prev * bf_hi(pv[qh][e].y); }
            u32x2 w; w.x = cvt_pk_bf16(v0, v1); w.y = cvt_pk_bf16(v2, v3); *(u32x2*)(yp + 32 * blk + 8 * g) = w; }
        if (!last && hi == 0) LSE[srow] = lse_new;
    }
}
__device__ __forceinline__ void dil_unit(LAS unsigned char* lds, const bf16_t* DIL, bf16_t* Y, bf16_t* ST, float* LSE, const float* BT, int b, int h, int c) {
    const int wid = __builtin_amdgcn_readfirstlane(otid() >> 6);
    LAS unsigned char* wl = lds + wid * DW_BYTES;
    for (int j = 0; j < 2; ++j) { const int wu = 2 * wid + j; dil_wave_unit<0>(wl, DIL, Y, ST, LSE, BT, b, h, 0, c * 16 + wu); }
    __syncthreads();
    for (int j = 0; j < 2; ++j) { const int wu = 2 * wid + j; dil_wave_unit<1>(wl, DIL, Y, ST, LSE, BT, b, h, wu >> 2, c * 4 + (wu & 3)); }
    __syncthreads();
    for (int j = 0; j < 2; ++j) { const int wu = 2 * wid + j; dil_wave_unit<2>(wl, DIL, Y, ST, LSE, BT, b, h, wu, c); }
    __syncthreads();
}

typedef __attribute__((address_space(1))) unsigned gu32;
#define XB_TMO      128
#define XB_XCNT(j)  (256  + 64 * (j))
#define XB_XSUB(j)  (1280 + 64 * (j))
#define XB_XGEN(j)  (2304 + 64 * (j))
#define XB_TOP      3328
#define XB_TOPGEN   3392
#define XCD_BAR_WORDS 3456
#define XB_SPIN_CAP (1u << 18)

__device__ __forceinline__ unsigned xb_ld(unsigned* p)              { return __hip_atomic_load(p, __ATOMIC_RELAXED, __HIP_MEMORY_SCOPE_AGENT); }
__device__ __forceinline__ unsigned xb_add(unsigned* p, unsigned v) { return __hip_atomic_fetch_add(p, v, __ATOMIC_RELAXED, __HIP_MEMORY_SCOPE_AGENT); }
__device__ __forceinline__ unsigned xb_xcc_id() { return (unsigned)__builtin_amdgcn_s_getreg((3 << 11) | 20) & 0xFu; }
#define XB_SPIN(cond, bar) do { unsigned _sp = 0; while (cond) { __builtin_amdgcn_s_sleep(1); \
    if ((++_sp & 255u) == 0u) { if (xb_ld(&(bar)[XB_TMO])) break; if (_sp > XB_SPIN_CAP) { atomicAdd(&(bar)[XB_TMO], 1u); break; } } } } while (0)

struct XcdBarrier {
    unsigned* bar; unsigned x;
    volatile LAS unsigned* st;
};

__device__ __forceinline__ XcdBarrier xcd_barrier_post(unsigned* bar, volatile LAS unsigned* st) {
    XcdBarrier b; b.bar = bar; b.x = xb_xcc_id(); b.st = st;
    if (threadIdx.x == 0) (void)xb_add(&bar[XB_XCNT(b.x)], 1u);
    return b;
}
__device__ __forceinline__ void xcd_barrier_complete(unsigned* bar, unsigned x, unsigned& nloc, unsigned& nx) {
    const unsigned G = gridDim.x * gridDim.y * gridDim.z;
    unsigned sum, cnt, mine, sp = 0u;
    for (;;) {
        sum = 0u; cnt = 0u; mine = 0u;
#pragma unroll
        for (unsigned j = 0; j < 16; ++j) { const unsigned c = xb_ld(&bar[XB_XCNT(j)]); sum += c; cnt += (c > 0u) ? 1u : 0u; mine = (j == x) ? c : mine; }
        if (sum == G) break;
        __builtin_amdgcn_s_sleep(1);
        if ((++sp & 255u) == 0u) { if (xb_ld(&bar[XB_TMO])) break; if (sp > XB_SPIN_CAP) { atomicAdd(&bar[XB_TMO], 1u); break; } }
    }
    nloc = mine > 0u ? mine : 1u; nx = cnt > 0u ? cnt : 1u;
}

__device__ __forceinline__ void xcd_barrier(const XcdBarrier& b) {
    asm volatile("s_waitcnt vmcnt(0)" ::: "memory");
    __syncthreads();
    if (threadIdx.x == 0) {
        unsigned* bar = b.bar;
        __builtin_amdgcn_s_waitcnt(0);
        unsigned nloc = b.st[0], nx = b.st[1];
        if (nloc == 0u) { xcd_barrier_complete(bar, b.x, nloc, nx); b.st[0] = nloc; b.st[1] = nx; }
        const unsigned old = xb_add(&bar[XB_XSUB(b.x)], 1u);
        const unsigned gen = old / nloc;
        if (old + 1u == (gen + 1u) * nloc) {
            __builtin_amdgcn_fence(__ATOMIC_RELEASE, "agent");
            asm volatile("s_waitcnt vmcnt(0)" ::: "memory");
            const unsigned og = xb_add(&bar[XB_TOP], 1u);
            const unsigned tg = og / nx;
            if (og + 1u == (tg + 1u) * nx) xb_add(&bar[XB_TOPGEN], 1u);
            else XB_SPIN(xb_ld(&bar[XB_TOPGEN]) == tg, bar);
            __builtin_amdgcn_fence(__ATOMIC_ACQUIRE, "agent");
            xb_add(&bar[XB_XGEN(b.x)], 1u);
            asm volatile("s_waitcnt vmcnt(0)" ::: "memory");
        } else {
            XB_SPIN(xb_ld(&bar[XB_XGEN(b.x)]) == gen, bar);
            __builtin_amdgcn_fence(__ATOMIC_ACQUIRE, "agent");
            asm volatile("s_waitcnt vmcnt(0)" ::: "memory");
        }
    }
    __syncthreads();
}

constexpr int NPHASE = 2 + DEPTH * 7;
__device__ __forceinline__ unsigned char* opaque_ptr(unsigned char* p) { asm volatile("" : "+s"(p)); return p; }
#define GEMM(EpiT, Ev, Ap, Bp, Nn, Kk, Ld) do { pg8::Gemm g_{(Ap), (Bp), NTOK, (Nn), (Kk), (Ld), 1 << 30, 0}; pg8::StaticOrder S_; S_.init(NTOK, (Nn), G, obid()); \
        pg8::gemm_phase<EpiT, pg8::StaticOrder, true, true>(lds, g_, S_, (Ev)); } while (0)
#define BF(off) ((bf16_t*)(ws + (off)))
#define FP(off) ((float*)(ws + (off)))
#define WB(l_, off) ((bf16_t*)(ws + WS_W + (size_t)((l_) & 1) * WS_WSTRIDE + (off)))
__global__ void __launch_bounds__(NTHR, 2) mega_fwd(Params P0) {
    extern __shared__ __attribute__((aligned(16))) unsigned char lds_raw[];
    LAS unsigned char* lds = (LAS unsigned char*)lds_raw;
    cg::grid_group grid = cg::this_grid();
    { volatile LAS unsigned* misc = (volatile LAS unsigned*)(lds + RING_BYTES + 320); if (otid() < 32) misc[otid()] = 0u; }
    __syncthreads();
    XcdBarrier xbar = xcd_barrier_post((unsigned*)(P0.ws + WS_CTL) + 1024, (volatile LAS unsigned*)(lds + RING_BYTES + 320) + 8);
    { volatile LAS unsigned* misc = (volatile LAS unsigned*)(lds + RING_BYTES + 320);
      if (otid() == 0) { const unsigned x = xb_xcc_id(); misc[16] = xb_add((unsigned*)(P0.ws + WS_CTL) + 8192 + 64 * x, 1u); misc[17] = x; } }
    __syncthreads();
    const int ph_lo = P0.ph_lo, ph_hi = P0.ph_hi;
    for (int ph = ph_lo; ph < ph_hi; ++ph) {
        int G_ = (int)gridDim.x; asm volatile("" : "+s"(G_)); const int G = G_;
        typedef const __attribute__((address_space(4))) Params* kparams_t;
        kparams_t kp_ = (kparams_t)__builtin_amdgcn_kernarg_segment_ptr(); asm volatile("" : "+s"(kp_));
        const Params& P = *(const Params*)kp_;
        unsigned char* ws = opaque_ptr(P.ws);
        const int l = ph > 1 ? (ph - 2) / 7 : 0, kk_ = ph > 1 ? (ph - 2) % 7 + 2 : ph; const int k = kk_ >= 4 ? kk_ + 1 : kk_;
        const size_t modl = (size_t)l * 16 * 6144;
        switch (k) {
        case 0: {
            phase0(P, lds, G);
            float* SSQ = FP(WS_SSQ);
            float* SKR = FP(WS_SSQKR);
            for (int i = obid() * NTHR + otid(); i < 2 * NTOK; i += G * NTHR) { SSQ[i] = 0.f; if (i < NTOK) SKR[i] = 0.f; }
            __syncthreads();
            conv_weights(P, 0, ws + WS_W, lds, G);
        } break;
        case 1: {
            bias_phase(P, lds, G);
            prepass_phase(P.x, P.norm1_g, FP(WS_MOD), 1024, BF(WS_H), FP(WS_SSQ) + 2 * NTOK, G);
        } break;
        case 2: {
            pg8::EpiIn E{BF(WS_PA), BF(WS_DIL), BF(WS_GATES), FP(WS_SSQ), FP(WS_SSQ) + NTOK, FP(WS_SSQKR), P.q_norm_b + l * 64, P.k_norm_b + l * 64, FP(WS_SSQ) + 2 * NTOK, FP(WS_BW1) + (size_t)l * 16 * 4096};
            GEMM(pg8::EpiIn, E, BF(WS_H), WB(l, W_IN), NIN, 1024, 1024);
        } break;
        case 3: {
            pg8::EpiRowScale2 E{ws, P.k_norm_a + l * 96};
            { pg8::Gemm g_{BF(WS_PA), WB(l, W_Q), NTOK, 1792, 256, 512, 3, 256}; pg8::StaticOrder S_; S_.init(NTOK, 1792, G, obid()); pg8::gemm_phase<pg8::EpiRowScale2, pg8::StaticOrder, true, true>(lds, g_, S_, E); }
        } break;
        case 5: {
            { float* SSQ = FP(WS_SSQ); float* SKR = FP(WS_SSQKR); for (int i = obid() * NTHR + otid(); i < 4 * NTOK; i += G * NTHR) { SSQ[i] = 0.f; if (i < NTOK) SKR[i] = 0.f; } }
            if (l + 1 < DEPTH) { conv_weights(P, l + 1, ws + WS_W + (size_t)((l + 1) & 1) * WS_WSTRIDE, lds, G); __syncthreads(); }
            bf16_t* Y = BF(WS_KVRAW);
            if (G == 256) { int xcd = obid() & 7, slot = obid() >> 3;
                { const unsigned* tk = (const unsigned*)(ws + WS_CTL) + 8192; bool even = true;
#pragma unroll
                  for (int x = 0; x < 8; ++x) even = even && (__hip_atomic_load(tk + 64 * x, __ATOMIC_RELAXED, __HIP_MEMORY_SCOPE_AGENT) == 32u);
                  if (even) { volatile LAS unsigned* misc = (volatile LAS unsigned*)(lds + RING_BYTES + 320); slot = (int)misc[16]; xcd = (int)misc[17]; } }
                slot = __builtin_amdgcn_readfirstlane(slot); xcd = __builtin_amdgcn_readfirstlane(xcd);
                for (int i = 0; i < 8; ++i) { const int bh = ((i * 2 + (slot >> 4)) << 3) + xcd; mla_unit(lds, BF(WS_H), BF(WS_K), BF(WS_V), Y, P.q_norm_a + l * 96, FP(WS_ROPE), bh >> 3, bh & 7, slot & 15); }
            } else { for (int u = obid(); u < NB * NH * 16; u += G) mla_unit(lds, BF(WS_H), BF(WS_K), BF(WS_V), Y, P.q_norm_a + l * 96, FP(WS_ROPE), u >> 7, (u >> 4) & 7, u & 15); }
            __syncthreads();
            for (int u = obid(); u < NB * NH * 4; u += G) dil_unit(lds, BF(WS_DIL), Y, BF(WS_PA), FP(WS_LSE), FP(WS_BT), u >> 5, (u >> 2) & 7, u & 3);
        } break;
        case 6: {
            pg8::EpiGate2 E{BF(WS_H), BF(WS_GATES)}; GEMM(pg8::EpiGate2, E, BF(WS_KVRAW), WB(l, W_A), 1024, 1024, 1024);
        } break;
        case 7: {
            pg8::EpiResid E{l == 0 ? P.x : P.out, P.out, FP(WS_MOD) + modl + 2048, BF(WS_KVRAW), P.norm2_g + l * DM, FP(WS_MOD) + modl + 4096, FP(WS_SSQ) + 3 * NTOK};
            GEMM(pg8::EpiResid, E, BF(WS_H), WB(l, W_O), 1024, 1024, 1024);
        } break;
        case 8: {
            pg8::EpiSwiGLU E{BF(WS_HID), FP(WS_SSQ) + 3 * NTOK, FP(WS_BW2) + (size_t)l * 16 * 5632}; GEMM(pg8::EpiSwiGLU, E, BF(WS_KVRAW), WB(l, W_1), 5632, 1024, 1024);
        } break;
        default: {
            const bool nxt = l + 1 < DEPTH; const size_t modn = (size_t)(l + 1) * 16 * 6144;
            pg8::EpiResid E{P.out, P.out, FP(WS_MOD) + modl + 5120, nxt ? BF(WS_H) : (bf16_t*)nullptr, P.norm1_g + (nxt ? (l + 1) * DM : 0), FP(WS_MOD) + (nxt ? modn + 1024 : 0), FP(WS_SSQ) + 2 * NTOK};
            GEMM(pg8::EpiResid, E, BF(WS_HID), WB(l, W_2), 1024, FFH, FFH);
        } break;
        }
        if (ph + 1 < ph_hi) { if (ph == ph_lo) grid.sync(); else xcd_barrier(xbar); }
    }
}

extern "C" void kernel_launch(void* const* d_in, const int* in_sizes, int n_in, void* d_out, int out_size, void* d_ws, size_t ws_size, hipStream_t stream) {
    static int grid = 0;
    if (grid == 0) {
        if (n_in != 23 || ws_size < WS_END) { fprintf(stderr, "kernel_launch: unexpected n_in %d / ws_size %zu\n", n_in, ws_size); grid = -1; return; }
        int dev = 0, cus = 0, per_cu = 0;
        (void)hipGetDevice(&dev); (void)hipDeviceGetAttribute(&cus, hipDeviceAttributeMultiprocessorCount, dev);
        if (hipFuncSetAttribute((const void*)mega_fwd, hipFuncAttributeMaxDynamicSharedMemorySize, LDS_BYTES) != hipSuccess) { fprintf(stderr, "kernel_launch: hipFuncSetAttribute failed\n"); grid = -1; return; }
        if (hipOccupancyMaxActiveBlocksPerMultiprocessor(&per_cu, (const void*)mega_fwd, NTHR, LDS_BYTES) != hipSuccess || per_cu < 1) { fprintf(stderr, "kernel_launch: occupancy query gave %d\n", per_cu); per_cu = 1; }
        (void)hipGetLastError();
        grid = cus * per_cu;
    }
    if (grid < 0) return;
    Params p{};
    const float** fp = (const float**)&p.x;
    p.x = (const float*)d_in[0]; p.c = (const float*)d_in[1]; p.pos = (const int*)d_in[2]; p.rel_bias = (const float*)d_in[3]; p.norm1_g = (const float*)d_in[4]; p.norm2_g = (const float*)d_in[5];
    p.ada_w = (const float*)d_in[6]; p.ada_b = (const float*)d_in[7]; p.w_in = (const float*)d_in[8]; p.q_a_norm = (const float*)d_in[9]; p.w_q_b = (const float*)d_in[10]; p.kv_a_norm = (const float*)d_in[11];
    p.w_kv_b = (const float*)d_in[12]; p.q_norm_a = (const float*)d_in[13]; p.k_norm_a = (const float*)d_in[14]; p.q_norm_b = (const float*)d_in[15]; p.k_norm_b = (const float*)d_in[16];
    p.w_branch_a = (const float*)d_in[17]; p.w_branch_b = (const float*)d_in[18]; p.w_out = (const float*)d_in[19]; p.w_ffn_gate = (const float*)d_in[20]; p.w_ffn_up = (const float*)d_in[21]; p.w_ffn_down = (const float*)d_in[22];
    (void)fp;
    p.out = (float*)d_out; p.ws = (unsigned char*)d_ws;
    for (int i = 0; i < 16; ++i) p.inv_freq[i] = (float)pow(10000.0, -(double)i / 16.0);
    p.ph_lo = 0; p.ph_hi = NPHASE;
    if (hipMemsetAsync((char*)d_ws + WS_CTL, 0, CTL_BYTES, stream) != hipSuccess) { fprintf(stderr, "kernel_launch: memset failed\n"); return; }
    void* args[] = {&p};
    hipError_t e = hipLaunchCooperativeKernel((const void*)mega_fwd, dim3(grid), dim3(NTHR), args, LDS_BYTES, stream);
    if (e != hipSuccess) fprintf(stderr, "kernel_launch: cooperative launch failed: %s (grid %d)\n", hipGetErrorString(e), grid);
}
```

```cpp
#include <hip/hip_runtime.h>
#include <hip/hip_cooperative_groups.h>
#include <cstdio>
#include <cstdint>
namespace cg = cooperative_groups;
__device__ __forceinline__ int otid() { int t = (int)threadIdx.x; asm volatile("" : "+v"(t)); return t; }
__device__ __forceinline__ int obid() { int b = (int)blockIdx.x; asm volatile("" : "+s"(b)); return b; }

#include <cmath>
namespace pg8 {
#define PG8_LAS __attribute__((address_space(3)))
typedef unsigned short bf16_t;
typedef short bf16x8 __attribute__((ext_vector_type(8)));
typedef float f32x4 __attribute__((ext_vector_type(4)));
typedef unsigned u32x4 __attribute__((ext_vector_type(4)));
constexpr int BM = 256, BK = 64, HALF = 128, HTB = HALF * BK * 2  , STAGE_BYTES = 8 * HTB, NXCD = 8, WGM = 8;

__host__ __device__ __forceinline__ int lds_byte(int r, int c) { const int st = (r >> 4) * 2 + (c >> 5), rr = r & 15, cc = c & 31, ob = rr * 64 + cc * 2; return st * 1024 + (ob ^ (((ob >> 9) & 1) << 5)); }
__host__ __device__ __forceinline__ void stage_rc(int b, int& R, int& C) { const int st = b / 1024, sb = b % 1024, swz = sb ^ (((sb >> 9) & 1) << 5); R = (st >> 1) * 16 + swz / 64; C = (st & 1) * 32 + (swz % 64) / 2; }
__host__ __device__ __forceinline__ int perm32(int rho) { const int n = rho >> 4, i = rho & 15; return 8 * (i >> 2) + 4 * n + (i & 3); }

struct Unit { int pm, pn; };
struct Gemm { const bf16_t* A; const bf16_t* Bt; int M, N, K, lda, asplit, aoff2; };

struct StaticOrder {
    int nM, nN, nwg, G, c;
    __host__ __device__ void init(int M, int N, int G_, int c_) { nM = M / BM; nN = N / BM; nwg = nM * nN; G = G_; c = c_; }
    __host__ __device__ bool next(int i, Unit& u) const {
        const long L = (long)i * G + c; if (L >= nwg) return false;
        int wgid = (int)L; { const int q = nwg / NXCD, r = nwg % NXCD, xcd = wgid % NXCD, off = wgid / NXCD; wgid = (xcd < r ? xcd * (q + 1) : r * (q + 1) + (xcd - r) * q) + off; }
        const int nig = WGM * nN, gid = wgid / nig, fm = gid * WGM, gsz = (nM - fm) < WGM ? (nM - fm) : WGM;
        u.pm = fm + ((wgid % nig) % gsz); u.pn = (wgid % nig) / gsz; return true;
    }
    __device__ __forceinline__ void a_ready(const Unit&) const {}
    __device__ __forceinline__ void done(const Unit&) const {}
};


__device__ __forceinline__ unsigned cvt_pk_bf16(float lo, float hi) { unsigned r; asm volatile("v_cvt_pk_bf16_f32 %0, %1, %2" : "=v"(r) : "v"(lo), "v"(hi)); return r; }
typedef unsigned u32x2 __attribute__((ext_vector_type(2)));
__device__ __forceinline__ float bf_lo(unsigned w) { return __builtin_bit_cast(float, w << 16); }
__device__ __forceinline__ float bf_hi(unsigned w) { return __builtin_bit_cast(float, w & 0xffff0000u); }
__device__ __forceinline__ float sigmoidf_(float x) { return 1.0f / (1.0f + __builtin_amdgcn_exp2f(-1.4426950408889634f * x)); }

constexpr float RMS_EPS = 1e-6f;
constexpr size_t DPLANE = (size_t)65536 * 512;
constexpr float LOG2E = 1.4426950408889634f;
constexpr float QSCALE_B = 0.125f * 1.4426950408889634f;
constexpr float QSCALE_A = 0.10206207261596575f * 1.4426950408889634f;

struct EpiIn {
    static constexpr bool PERM = false, AFTER_DRAIN = false, MIDHOOK = false;
    bf16_t* PA; bf16_t* DIL; bf16_t* GATES; float* ssq_q; float* ssq_kv; float* ssq_kr; const float* qn; const float* kn; const float* ssq1; const float* bw;
    __device__ __forceinline__ void operator()(const f32x4 (&acc_)[2][2][4][2], const Unit& u, int wr, int wc, int fr, int fq) const {
        { const int ln_ = otid() & 63; fr = ln_ & 15; fq = ln_ >> 4; }
        const int pn = u.pn; const size_t rowb = (size_t)u.pm * BM + wr * 64 + fr;
        f32x4 bv[2][2]; float r8[2][4];
        { const float* bwp = bw + (size_t)(u.pm >> 4) * 4096 + pn * BM + wc * 32 + fq * 4;
#pragma unroll
          for (int bj = 0; bj < 2; ++bj)
#pragma unroll
              for (int n = 0; n < 2; ++n) bv[bj][n] = *(const f32x4*)(bwp + bj * HALF + n * 16);
#pragma unroll
          for (int ai = 0; ai < 2; ++ai)
#pragma unroll
              for (int m = 0; m < 4; ++m) r8[ai][m] = __builtin_amdgcn_rsqf(ssq1[rowb + ai * HALF + m * 16] * (1.0f / 1024.0f) + RMS_EPS); }
#define EPIIN_VAL(ai, bj, m, n) (acc_[ai][bj][m][n] * r8[ai][m] + bv[bj][n])
        if (pn < 2) {
            float* sq = pn == 0 ? ssq_q : ssq_kv;
#pragma unroll
            for (int ai = 0; ai < 2; ++ai)
#pragma unroll
                for (int m = 0; m < 4; ++m) { const size_t row = rowb + ai * HALF + m * 16; float s = 0.f, s2 = 0.f;
#pragma unroll
                    for (int bj = 0; bj < 2; ++bj)
#pragma unroll
                        for (int n = 0; n < 2; ++n) { const f32x4 v = EPIIN_VAL(ai, bj, m, n);
                            u32x2 w; w.x = cvt_pk_bf16(v[0], v[1]); w.y = cvt_pk_bf16(v[2], v[3]);
                            *(u32x2*)(PA + row * 512 + pn * 256 + bj * HALF + wc * 32 + n * 16 + fq * 4) = w;
                            const float q = (v[0] * v[0] + v[1] * v[1]) + (v[2] * v[2] + v[3] * v[3]);
                            if (pn == 0 || bj == 0) s += q; else s2 += q; }
                    s += __shfl_xor(s, 16); s += __shfl_xor(s, 32);
                    if (fq == 0) atomicAdd(sq + row, s);
                    if (pn == 1 && wc == 0) { s2 += __shfl_xor(s2, 16); s2 += __shfl_xor(s2, 32); if (fq == 0) atomicAdd(ssq_kr + row, s2); } }
        } else if (pn < 6) {
            const int sec = (pn - 2) >> 1, head = 4 * ((pn - 2) & 1) + wc; const float* gp = sec == 0 ? qn : kn; const float gs = sec == 0 ? QSCALE_B : 1.0f;
            f32x4 gv[2][2];
#pragma unroll
            for (int bj = 0; bj < 2; ++bj)
#pragma unroll
                for (int n = 0; n < 2; ++n) gv[bj][n] = *(const f32x4*)(gp + 32 * bj + 16 * n + 4 * fq) * gs;
#pragma unroll
            for (int ai = 0; ai < 2; ++ai)
#pragma unroll
                for (int m = 0; m < 4; ++m) { const size_t row = rowb + ai * HALF + m * 16; float s = 0.f;
#pragma unroll
                    for (int bj = 0; bj < 2; ++bj)
#pragma unroll
                        for (int n = 0; n < 2; ++n) { const f32x4 v = EPIIN_VAL(ai, bj, m, n); s += (v[0] * v[0] + v[1] * v[1]) + (v[2] * v[2] + v[3] * v[3]); }
                    s += __shfl_xor(s, 16); s += __shfl_xor(s, 32);
                    const float r = __builtin_amdgcn_rsqf(s * (1.0f / 64.0f) + RMS_EPS);
#pragma unroll
                    for (int bj = 0; bj < 2; ++bj)
#pragma unroll
                        for (int n = 0; n < 2; ++n) { const f32x4 v = EPIIN_VAL(ai, bj, m, n) * r * gv[bj][n];
                            u32x2 w; w.x = cvt_pk_bf16(v[0], v[1]); w.y = cvt_pk_bf16(v[2], v[3]);
                            *(u32x2*)(DIL + (size_t)sec * DPLANE + ((((row >> 12) * 8 + head) << 12) + (row & 4095)) * 64 + 32 * bj + 16 * n + 4 * fq) = w; } }
        } else if (pn < 8) {
#pragma unroll
            for (int ai = 0; ai < 2; ++ai)
#pragma unroll
                for (int m = 0; m < 4; ++m) { const size_t row = rowb + ai * HALF + m * 16;
#pragma unroll
                    for (int bj = 0; bj < 2; ++bj)
#pragma unroll
                        for (int n = 0; n < 2; ++n) { const f32x4 v = EPIIN_VAL(ai, bj, m, n);
                            u32x2 w; w.x = cvt_pk_bf16(v[0], v[1]); w.y = cvt_pk_bf16(v[2], v[3]);
                            *(u32x2*)(DIL + 2 * DPLANE + ((((row >> 12) * 8 + (pn - 6) * 4 + 2 * bj + (wc >> 1)) << 12) + (row & 4095)) * 64 + 32 * (wc & 1) + n * 16 + fq * 4) = w; } }
        } else {
#pragma unroll
            for (int ai = 0; ai < 2; ++ai)
#pragma unroll
                for (int m = 0; m < 4; ++m) { const size_t row = rowb + ai * HALF + m * 16;
#pragma unroll
                    for (int bj = 0; bj < 2; ++bj)
#pragma unroll
                        for (int n = 0; n < 2; ++n) { const f32x4 v = EPIIN_VAL(ai, bj, m, n);
                            u32x2 w; w.x = cvt_pk_bf16(sigmoidf_(v[0]), sigmoidf_(v[1])); w.y = cvt_pk_bf16(sigmoidf_(v[2]), sigmoidf_(v[3]));
                            *(u32x2*)(GATES + row * 2048 + (pn - 8) * 256 + bj * HALF + wc * 32 + n * 16 + fq * 4) = w; } }
        }
    }
};
#undef EPIIN_VAL
struct EpiRowScale2 {
    static constexpr bool PERM = true, AFTER_DRAIN = false, MIDHOOK = false;
    unsigned char* ws; const float* kg;
    static constexpr size_t O_Q = 0, O_PA = 128u << 20, O_K = 768u << 20, O_V = 864u << 20, O_ROPE = 990u << 20, O_SSQ = 998u << 20, O_SSQKR = (1001u << 20) + 65536;
    __device__ __forceinline__ void operator()(const f32x4 (&acc)[2][2][4][2], const Unit& u, int wr, int wc, int fr, int fq) const {
        { const int ln_ = otid() & 63; fr = ln_ & 15; fq = ln_ >> 4; }
        bf16_t* Oq = (bf16_t*)(ws + O_Q); bf16_t* Kp = (bf16_t*)(ws + O_K); bf16_t* Vp = (bf16_t*)(ws + O_V); const bf16_t* PA = (const bf16_t*)(ws + O_PA); const float* ROPE = (const float*)(ws + O_ROPE);
        const float* ssq_q = (const float*)(ws + O_SSQ); const float* ssq_kv = ssq_q + 65536; const float* ssq_kr = (const float*)(ws + O_SSQKR);
        const size_t rowb = (size_t)u.pm * BM + wr * 64 + fr;
        if (u.pn < 3) {
            const int col0 = u.pn * BM + wc * 32 + 8 * fq;
#pragma unroll
            for (int ai = 0; ai < 2; ++ai)
#pragma unroll
                for (int m = 0; m < 4; ++m) { const size_t row = rowb + ai * HALF + m * 16; const float r = __builtin_amdgcn_rsqf(ssq_q[row] * (1.0f / 256.0f) + RMS_EPS);
#pragma unroll
                    for (int bj = 0; bj < 2; ++bj) { const f32x4 v0 = acc[ai][bj][m][0] * r, v1 = acc[ai][bj][m][1] * r;
                        u32x4 w; w.x = cvt_pk_bf16(v0[0], v0[1]); w.y = cvt_pk_bf16(v0[2], v0[3]); w.z = cvt_pk_bf16(v1[0], v1[1]); w.w = cvt_pk_bf16(v1[2], v1[3]);
                        *(u32x4*)(Oq + row * 768 + col0 + bj * HALF) = w; } }
        } else {
            const int head = (u.pn - 3) * 2 + (wc & 1); float rh8[2][4];
#pragma unroll
            for (int ai = 0; ai < 2; ++ai)
#pragma unroll
                for (int m = 0; m < 4; ++m) { const size_t row = rowb + ai * HALF + m * 16; const float r = __builtin_amdgcn_rsqf(ssq_kv[row] * (1.0f / 128.0f) + RMS_EPS);
                    const size_t hrow = ((((row >> 12) * 8 + head) << 12) + (row & 4095));
                    if (wc >= 2) {
#pragma unroll
                        for (int bj = 0; bj < 2; ++bj) { const f32x4 a = acc[ai][bj][m][0] * r, b = acc[ai][bj][m][1] * r;
                            u32x4 w; w.x = cvt_pk_bf16(a[0], a[1]); w.y = cvt_pk_bf16(a[2], a[3]); w.z = cvt_pk_bf16(b[0], b[1]); w.w = cvt_pk_bf16(b[2], b[3]);
                            *(u32x4*)(Vp + hrow * 64 + 32 * bj + 8 * fq) = w; }
                    } else {
                        float s = 0.f;
#pragma unroll
                        for (int bj = 0; bj < 2; ++bj) { const f32x4 a = acc[ai][bj][m][0], b = acc[ai][bj][m][1]; s += ((a[0] * a[0] + a[1] * a[1]) + (a[2] * a[2] + a[3] * a[3])) + ((b[0] * b[0] + b[1] * b[1]) + (b[2] * b[2] + b[3] * b[3])); }
                        s += __shfl_xor(s, 16); s += __shfl_xor(s, 32);
                        const float rh = __builtin_amdgcn_rsqf((s * r * r + ssq_kr[row]) * (1.0f / 96.0f) + RMS_EPS); const float rr = r * rh;
#pragma unroll
                        for (int bj = 0; bj < 2; ++bj) { const f32x4 a = acc[ai][bj][m][0] * rr * *(const f32x4*)(kg + 32 * bj + 8 * fq), b = acc[ai][bj][m][1] * rr * *(const f32x4*)(kg + 32 * bj + 8 * fq + 4);
                            u32x4 w; w.x = cvt_pk_bf16(a[0], a[1]); w.y = cvt_pk_bf16(a[2], a[3]); w.z = cvt_pk_bf16(b[0], b[1]); w.w = cvt_pk_bf16(b[2], b[3]);
                            *(u32x4*)(Kp + hrow * 96 + 32 * bj + 8 * fq) = w; }
                        rh8[ai][m] = rh;
                    }
                    asm volatile("" ::: "memory"); }
            if (wc < 2) {
#pragma unroll
                for (int ai = 0; ai < 2; ++ai)
#pragma unroll
                    for (int m = 0; m < 4; ++m) { const size_t row = rowb + ai * HALF + m * 16; const size_t hrow = ((((row >> 12) * 8 + head) << 12) + (row & 4095)); const float rh = rh8[ai][m];
                        const bf16_t* krp = PA + row * 512 + 384; const float* rp = ROPE + row * 32;
#pragma unroll
                        for (int e = 0; e < 2; ++e) { const int i0 = 4 * fq + 2 * e;
                            const unsigned xa = *(const unsigned*)(krp + i0), xb = *(const unsigned*)(krp + 16 + i0);
                            const float c0 = rp[i0], c1 = rp[i0 + 1], s0 = rp[16 + i0], s1 = rp[16 + i0 + 1];
                            const float a0 = bf_lo(xa) * rh * kg[64 + i0], a1 = bf_hi(xa) * rh * kg[64 + i0 + 1], b0 = bf_lo(xb) * rh * kg[80 + i0], b1 = bf_hi(xb) * rh * kg[80 + i0 + 1];
                            *(unsigned*)(Kp + hrow * 96 + 64 + i0) = cvt_pk_bf16(a0 * c0 - b0 * s0, a1 * c1 - b1 * s1);
                            *(unsigned*)(Kp + hrow * 96 + 80 + i0) = cvt_pk_bf16(b0 * c0 + a0 * s0, b1 * c1 + a1 * s1); }
                        asm volatile("" ::: "memory"); }
            }
        }
    }
};
struct EpiRowScale {
    static constexpr bool PERM = true, AFTER_DRAIN = false, MIDHOOK = false;
    bf16_t* O; int ldc; const float* ssq; float invk;
    __device__ __forceinline__ void operator()(const f32x4 (&acc)[2][2][4][2], const Unit& u, int wr, int wc, int fr, int fq) const {
        { const int ln_ = otid() & 63; fr = ln_ & 15; fq = ln_ >> 4; }
        const size_t rowb = (size_t)u.pm * BM + wr * 64 + fr; const int col0 = u.pn * BM + wc * 32 + 8 * fq;
#pragma unroll
        for (int ai = 0; ai < 2; ++ai)
#pragma unroll
            for (int m = 0; m < 4; ++m) { const size_t row = rowb + ai * HALF + m * 16; const float r = __builtin_amdgcn_rsqf(ssq[row] * invk + RMS_EPS);
#pragma unroll
                for (int bj = 0; bj < 2; ++bj) { const f32x4 v0 = acc[ai][bj][m][0] * r, v1 = acc[ai][bj][m][1] * r;
                    u32x4 w; w.x = cvt_pk_bf16(v0[0], v0[1]); w.y = cvt_pk_bf16(v0[2], v0[3]); w.z = cvt_pk_bf16(v1[0], v1[1]); w.w = cvt_pk_bf16(v1[2], v1[3]);
                    *(u32x4*)(O + row * ldc + col0 + bj * HALF) = w; } }
    }
};
struct EpiGate2 {
    static constexpr bool PERM = true, AFTER_DRAIN = false, MIDHOOK = true;
    bf16_t* O; const bf16_t* SIG;
    __device__ __forceinline__ void mid(f32x4 (&acc)[2][2][4][2], const Unit& u, int wr, int wc) const {
        const int ln_ = otid() & 63, fr = ln_ & 15, fq = ln_ >> 4;
        const size_t rowb = (size_t)u.pm * BM + wr * 64 + fr; const int col0 = u.pn * BM + wc * 32 + 8 * fq;
#pragma unroll
        for (int ai = 0; ai < 2; ++ai)
#pragma unroll
            for (int m = 0; m < 4; ++m) { const bf16_t* sp = SIG + (rowb + ai * HALF + m * 16) * 2048 + col0;
#pragma unroll
                for (int bj = 0; bj < 2; ++bj) { const u32x4 sa = *(const u32x4*)(sp + bj * HALF), sb = *(const u32x4*)(sp + 1024 + bj * HALF);
                    f32x4& v0 = acc[ai][bj][m][0]; f32x4& v1 = acc[ai][bj][m][1];
                    v0[0] *= bf_lo(sa.x) * __builtin_amdgcn_rcpf(1e-30f + bf_lo(sb.x)); v0[1] *= bf_hi(sa.x) * __builtin_amdgcn_rcpf(1e-30f + bf_hi(sb.x));
                    v0[2] *= bf_lo(sa.y) * __builtin_amdgcn_rcpf(1e-30f + bf_lo(sb.y)); v0[3] *= bf_hi(sa.y) * __builtin_amdgcn_rcpf(1e-30f + bf_hi(sb.y));
                    v1[0] *= bf_lo(sa.z) * __builtin_amdgcn_rcpf(1e-30f + bf_lo(sb.z)); v1[1] *= bf_hi(sa.z) * __builtin_amdgcn_rcpf(1e-30f + bf_hi(sb.z));
                    v1[2] *= bf_lo(sa.w) * __builtin_amdgcn_rcpf(1e-30f + bf_lo(sb.w)); v1[3] *= bf_hi(sa.w) * __builtin_amdgcn_rcpf(1e-30f + bf_hi(sb.w)); }
                asm volatile("" ::: "memory"); }
    }
    __device__ __forceinline__ void operator()(const f32x4 (&acc)[2][2][4][2], const Unit& u, int wr, int wc, int fr, int fq) const {
        { const int ln_ = otid() & 63; fr = ln_ & 15; fq = ln_ >> 4; }
        const size_t rowb = (size_t)u.pm * BM + wr * 64 + fr; const int col0 = u.pn * BM + wc * 32 + 8 * fq;
#pragma unroll
        for (int ai = 0; ai < 2; ++ai)
#pragma unroll
            for (int m = 0; m < 4; ++m) { const size_t row = rowb + ai * HALF + m * 16;
#pragma unroll
                for (int bj = 0; bj < 2; ++bj) { const u32x4 sg = *(const u32x4*)(SIG + row * 2048 + 1024 + col0 + bj * HALF);
                    f32x4 v0 = acc[ai][bj][m][0], v1 = acc[ai][bj][m][1];
                    v0[0] *= bf_lo(sg.x); v0[1] *= bf_hi(sg.x); v0[2] *= bf_lo(sg.y); v0[3] *= bf_hi(sg.y);
                    v1[0] *= bf_lo(sg.z); v1[1] *= bf_hi(sg.z); v1[2] *= bf_lo(sg.w); v1[3] *= bf_hi(sg.w);
                    u32x4 w; w.x = cvt_pk_bf16(v0[0], v0[1]); w.y = cvt_pk_bf16(v0[2], v0[3]); w.z = cvt_pk_bf16(v1[0], v1[1]); w.w = cvt_pk_bf16(v1[2], v1[3]);
                    *(u32x4*)(O + row * 1024 + col0 + bj * HALF) = w; } }
    }
};
struct EpiResid {
    static constexpr bool PERM = false, AFTER_DRAIN = false, MIDHOOK = false;
    const __attribute__((address_space(1))) float* xin; __attribute__((address_space(1))) float* out; const float* gmod;
    bf16_t* XG; const float* gnorm; const float* scmod; float* ssq;
    __device__ __forceinline__ void operator()(const f32x4 (&acc)[2][2][4][2], const Unit& u, int wr, int wc, int fr, int fq) const {
        { const int ln_ = otid() & 63; fr = ln_ & 15; fq = ln_ >> 4; }
        const size_t rowb = (size_t)u.pm * BM + wr * 64 + fr; const int col0 = u.pn * BM + wc * 32 + 4 * fq; const float* gb = gmod + (size_t)(u.pm >> 4) * 6144;
        f32x4 gv[2][2], Gv[2][2];
#pragma unroll
        for (int bj = 0; bj < 2; ++bj)
#pragma unroll
            for (int n = 0; n < 2; ++n) { gv[bj][n] = *(const f32x4*)(gb + col0 + bj * HALF + n * 16);
                if (XG) Gv[bj][n] = *(const f32x4*)(gnorm + col0 + bj * HALF + n * 16) * (1.0f + *(const f32x4*)(scmod + (size_t)(u.pm >> 4) * 6144 + col0 + bj * HALF + n * 16)); }
#pragma unroll
        for (int ai = 0; ai < 2; ++ai)
#pragma unroll
            for (int m = 0; m < 4; ++m) { const size_t row = rowb + ai * HALF + m * 16; const size_t off = row * 1024 + col0; float s = 0.f;
#pragma unroll
                for (int bj = 0; bj < 2; ++bj)
#pragma unroll
                    for (int n = 0; n < 2; ++n) { const f32x4 xv = *(const __attribute__((address_space(1))) f32x4*)(xin + off + bj * HALF + n * 16);
                        const f32x4 xn = xv + gv[bj][n] * acc[ai][bj][m][n];
                        *(__attribute__((address_space(1))) f32x4*)(out + off + bj * HALF + n * 16) = xn;
                        if (XG) { s += (xn[0] * xn[0] + xn[1] * xn[1]) + (xn[2] * xn[2] + xn[3] * xn[3]); const f32x4 t = xn * Gv[bj][n];
                            u32x2 w; w.x = cvt_pk_bf16(t[0], t[1]); w.y = cvt_pk_bf16(t[2], t[3]); *(u32x2*)(XG + off + bj * HALF + n * 16) = w; } }
                if (XG) { s += __shfl_xor(s, 16); s += __shfl_xor(s, 32); if (fq == 0) atomicAdd(ssq + row, s); } }
    }
};
struct EpiSwiGLU {
    static constexpr bool PERM = true, AFTER_DRAIN = false, MIDHOOK = false;
    bf16_t* O; const float* ssq2; const float* bw;
    __device__ __forceinline__ void operator()(const f32x4 (&acc)[2][2][4][2], const Unit& u, int wr, int wc, int fr, int fq) const {
        { const int ln_ = otid() & 63; fr = ln_ & 15; fq = ln_ >> 4; }
        const size_t rowb = (size_t)u.pm * BM + wr * 64 + fr; const int col0 = u.pn * HALF + wc * 32 + 8 * fq;
        const float* bwp = bw + (size_t)(u.pm >> 4) * 5632 + u.pn * BM + wc * 32 + 8 * fq;
        const f32x4 bg0 = *(const f32x4*)bwp, bg1 = *(const f32x4*)(bwp + 4), bu0 = *(const f32x4*)(bwp + HALF), bu1 = *(const f32x4*)(bwp + HALF + 4);
#pragma unroll
        for (int ai = 0; ai < 2; ++ai)
#pragma unroll
            for (int m = 0; m < 4; ++m) { const size_t row = rowb + ai * HALF + m * 16; const float r = __builtin_amdgcn_rsqf(ssq2[row] * (1.0f / 1024.0f) + RMS_EPS);
                f32x4 g0 = acc[ai][0][m][0] * r + bg0, g1 = acc[ai][0][m][1] * r + bg1; const f32x4 u0 = acc[ai][1][m][0] * r + bu0, u1 = acc[ai][1][m][1] * r + bu1;
#pragma unroll
                for (int i = 0; i < 4; ++i) { g0[i] = g0[i] * sigmoidf_(g0[i]) * u0[i]; g1[i] = g1[i] * sigmoidf_(g1[i]) * u1[i]; }
                u32x4 w; w.x = cvt_pk_bf16(g0[0], g0[1]); w.y = cvt_pk_bf16(g0[2], g0[3]); w.z = cvt_pk_bf16(g1[0], g1[1]); w.w = cvt_pk_bf16(g1[2], g1[3]);
                *(u32x4*)(O + row * 2816 + col0) = w; }
    }
};

template <class Epi, class Sched, bool ALIGN_EPI = false, bool SP2 = false>
__device__ __forceinline__ void gemm_phase(PG8_LAS unsigned char* lds, const Gemm g, const Sched& S, const Epi& E) {
    const int tid = otid(), wid = __builtin_amdgcn_readfirstlane(tid >> 6), lane = tid & 63, wr = wid >> 2, wc = wid & 3, fr = lane & 15, fq = lane >> 4;
    const int K = g.K, lda = g.lda, nt = K / BK;
    unsigned voffA[2], voffB[2];
#pragma unroll
    for (int i = 0; i < 2; ++i) { int R, C; stage_rc(tid * 16 + i * 8192, R, C); const int Rb = Epi::PERM ? ((R & ~31) + perm32(R & 31)) : R;
        voffA[i] = (unsigned)(R * lda + C) * 2u; voffB[i] = (unsigned)(Rb * K + C) * 2u; }
    const size_t kstep = (size_t)(BK * 2);
    const size_t hstepB = (size_t)HALF * K * 2, hstepA = (size_t)HALF * lda * 2;
    const size_t tstepB = 2 * hstepB, tstepA = 2 * hstepA;
    const unsigned ldsw = (unsigned)wid * 1024u;
    const int aoff = lds_byte(wr * 64 + fr, fq * 8), boff = lds_byte(wc * 32 + fr, fq * 8);
#define PG8_SA(b, h) (((b) * 2 + (h)) * HTB)
#define PG8_SB(b, h) ((4 + (b) * 2 + (h)) * HTB)
#define PG8_STAGE(bufoff, gbase, voff) do { _Pragma("unroll") for (int _i = 0; _i < 2; ++_i) \
        __builtin_amdgcn_global_load_lds((const unsigned*)((const char*)(gbase) + (voff)[_i]), (PG8_LAS unsigned*)(lds + (bufoff) + ldsw + _i * 8192), 16, 0, 0); } while (0)
#define PG8_LDA(dst, b, h) do { _Pragma("unroll") for (int m = 0; m < 4; ++m) _Pragma("unroll") for (int k = 0; k < 2; ++k) dst[m][k] = *(const PG8_LAS bf16x8*)(lds + PG8_SA(b, h) + aoff + m * 2048 + k * 1024); } while (0)
#define PG8_LDB(dst, b, h) do { _Pragma("unroll") for (int n = 0; n < 2; ++n) _Pragma("unroll") for (int k = 0; k < 2; ++k) dst[n][k] = *(const PG8_LAS bf16x8*)(lds + PG8_SB(b, h) + boff + n * 2048 + k * 1024); } while (0)
#define PG8_MMA(ai, bj, At, Bt) do { __builtin_amdgcn_s_setprio(1); _Pragma("unroll") for (int m = 0; m < 4; ++m) _Pragma("unroll") for (int n = 0; n < 2; ++n) _Pragma("unroll") for (int k = 0; k < 2; ++k) \
        acc[ai][bj][m][n] = __builtin_amdgcn_mfma_f32_16x16x32_bf16(Bt[n][k], At[m][k], acc[ai][bj][m][n], 0, 0, 0); __builtin_amdgcn_s_setprio(0); } while (0)
#define PG8_WAIT_V(n) asm volatile("s_waitcnt vmcnt(" #n ")" ::: "memory")
#define PG8_WAIT_L(n) asm volatile("s_waitcnt lgkmcnt(" #n ")" ::: "memory")
#define PG8_BAR __builtin_amdgcn_s_barrier()
#define PG8_SCHED __builtin_amdgcn_sched_barrier(0)
    Unit cur, nxt; int ui = 0;
    if (!S.next(0, cur)) return;
    f32x4 acc[2][2][4][2];
#pragma unroll
    for (int a = 0; a < 2; ++a)
#pragma unroll
        for (int b = 0; b < 2; ++b)
#pragma unroll
            for (int m = 0; m < 4; ++m)
#pragma unroll
                for (int n = 0; n < 2; ++n) acc[a][b][m][n] = (f32x4){0.f, 0.f, 0.f, 0.f};
    bf16x8 At[4][2], B0[2][2], B1[2][2];
    const char* cA = (const char*)g.A + (size_t)cur.pm * tstepA + (cur.pn >= g.asplit ? (size_t)g.aoff2 * 2 : 0); const char* cB = (const char*)g.Bt + (size_t)cur.pn * tstepB;
    S.a_ready(cur);
    if constexpr (SP2) {
        PG8_STAGE(PG8_SB(0, 0), cB, voffB); PG8_STAGE(PG8_SB(0, 1), cB + hstepB, voffB); PG8_STAGE(PG8_SA(0, 0), cA, voffA); PG8_STAGE(PG8_SA(0, 1), cA + hstepA, voffA);
        if (wr == 1) PG8_BAR;
        PG8_WAIT_V(2); PG8_BAR;
        PG8_STAGE(PG8_SB(1, 0), cB + kstep, voffB); PG8_STAGE(PG8_SA(1, 0), cA + kstep, voffA); PG8_STAGE(PG8_SB(1, 1), cB + hstepB + kstep, voffB);
        PG8_WAIT_V(6); PG8_BAR;
    } else {
        PG8_STAGE(PG8_SB(0, 0), cB, voffB); PG8_STAGE(PG8_SA(0, 0), cA, voffA); PG8_STAGE(PG8_SB(0, 1), cB + hstepB, voffB); PG8_STAGE(PG8_SA(0, 1), cA + hstepA, voffA);
        if (wr == 1) PG8_BAR;
        PG8_WAIT_V(4); PG8_BAR;
        PG8_STAGE(PG8_SB(1, 0), cB + kstep, voffB); PG8_STAGE(PG8_SA(1, 0), cA + kstep, voffA); PG8_STAGE(PG8_SB(1, 1), cB + hstepB + kstep, voffB);
        PG8_WAIT_V(6); PG8_BAR;
    }
    for (;;) {
        const bool has_next = S.next(ui + 1, nxt);
        const char* nA = has_next ? (const char*)g.A + (size_t)nxt.pm * tstepA + (nxt.pn >= g.asplit ? (size_t)g.aoff2 * 2 : 0) : cA; const char* nB = has_next ? (const char*)g.Bt + (size_t)nxt.pn * tstepB : cB;
        for (int t = 0; t < nt; t += 2) {
            const bool last = (t == nt - 2);
            if constexpr (Epi::MIDHOOK) { if (t == (nt >> 1)) E.mid(acc, cur, wr, wc); }
            const char* a1 = cA + (size_t)(t + 1) * kstep;
            const char* a2 = last ? nA : cA + (size_t)(t + 2) * kstep; const char* b2 = last ? nB : cB + (size_t)(t + 2) * kstep;
            const char* a3 = a2 + kstep; const char* b3 = b2 + kstep;
            if (last && has_next) S.a_ready(nxt);
            if constexpr (SP2) {
            PG8_LDB(B0, 0, 0); PG8_LDB(B1, 0, 1); PG8_SCHED; PG8_LDA(At, 0, 0); PG8_STAGE(PG8_SA(1, 1), a1 + hstepA, voffA);
            PG8_WAIT_V(8); PG8_WAIT_L(0); PG8_BAR; PG8_MMA(0, 0, At, B0); PG8_MMA(0, 1, At, B1); PG8_BAR; PG8_SCHED;
            PG8_LDA(At, 0, 1); PG8_STAGE(PG8_SB(0, 0), b2, voffB); PG8_STAGE(PG8_SB(0, 1), b2 + hstepB, voffB); PG8_STAGE(PG8_SA(0, 0), a2, voffA);
            PG8_WAIT_V(8); PG8_WAIT_L(0); PG8_BAR; PG8_MMA(1, 0, At, B0); PG8_MMA(1, 1, At, B1); PG8_BAR; PG8_SCHED;
            PG8_LDB(B0, 1, 0); PG8_LDB(B1, 1, 1); PG8_SCHED; PG8_LDA(At, 1, 0); PG8_STAGE(PG8_SA(0, 1), a2 + hstepA, voffA);
            PG8_WAIT_V(8); PG8_WAIT_L(0); PG8_BAR; PG8_MMA(0, 0, At, B0); PG8_MMA(0, 1, At, B1); PG8_BAR; PG8_SCHED;
            PG8_LDA(At, 1, 1); PG8_STAGE(PG8_SB(1, 0), b3, voffB); PG8_STAGE(PG8_SB(1, 1), b3 + hstepB, voffB); PG8_STAGE(PG8_SA(1, 0), a3, voffA);
            PG8_WAIT_V(8); PG8_WAIT_L(0); PG8_BAR; PG8_MMA(1, 0, At, B0); PG8_MMA(1, 1, At, B1); PG8_BAR; PG8_SCHED;
            } else {
            PG8_LDB(B0, 0, 0); PG8_SCHED; PG8_LDA(At, 0, 0); PG8_STAGE(PG8_SA(1, 1), a1 + hstepA, voffA);
            PG8_WAIT_L(8); PG8_BAR; PG8_WAIT_L(0); PG8_MMA(0, 0, At, B0); PG8_BAR; PG8_SCHED;
            PG8_LDB(B1, 0, 1); PG8_STAGE(PG8_SB(0, 0), b2, voffB);
            PG8_BAR; PG8_WAIT_L(0); PG8_MMA(0, 1, At, B1); PG8_BAR;
            PG8_LDA(At, 0, 1); PG8_STAGE(PG8_SA(0, 0), a2, voffA);
            PG8_BAR; PG8_WAIT_L(0); PG8_MMA(1, 0, At, B0); PG8_BAR; PG8_SCHED;
            PG8_STAGE(PG8_SB(0, 1), b2 + hstepB, voffB);
            PG8_WAIT_V(6); PG8_BAR; PG8_MMA(1, 1, At, B1); PG8_BAR;
            PG8_LDB(B0, 1, 0); PG8_SCHED; PG8_LDA(At, 1, 0); PG8_STAGE(PG8_SA(0, 1), a2 + hstepA, voffA);
            PG8_WAIT_L(8); PG8_BAR; PG8_WAIT_L(0); PG8_MMA(0, 0, At, B0); PG8_BAR; PG8_SCHED;
            PG8_LDB(B1, 1, 1); PG8_STAGE(PG8_SB(1, 0), b3, voffB);
            PG8_BAR; PG8_WAIT_L(0); PG8_MMA(0, 1, At, B1); PG8_BAR;
            PG8_LDA(At, 1, 1); PG8_STAGE(PG8_SA(1, 0), a3, voffA);
            PG8_BAR; PG8_WAIT_L(0); PG8_MMA(1, 0, At, B0); PG8_BAR; PG8_SCHED;
            PG8_STAGE(PG8_SB(1, 1), b3 + hstepB, voffB);
            PG8_WAIT_V(6); PG8_BAR; PG8_MMA(1, 1, At, B1); PG8_BAR;
            }
        }
        if constexpr (ALIGN_EPI) { if (wr == 0) PG8_BAR; }
        if constexpr (!Epi::AFTER_DRAIN) { E(acc, cur, wr, wc, fr, fq); S.done(cur); }
        if (!has_next) break;
#pragma unroll
        for (int a = 0; a < 2; ++a)
#pragma unroll
            for (int b = 0; b < 2; ++b)
#pragma unroll
                for (int m = 0; m < 4; ++m)
#pragma unroll
                    for (int n = 0; n < 2; ++n) acc[a][b][m][n] = (f32x4){0.f, 0.f, 0.f, 0.f};
        cur = nxt; cA = nA; cB = nB; ++ui;
        if constexpr (ALIGN_EPI) { if (wr == 1) PG8_BAR; }
    }
    PG8_WAIT_V(0);
    if constexpr (!ALIGN_EPI) { if (wr == 0) PG8_BAR; }
    PG8_BAR;
    if constexpr (Epi::AFTER_DRAIN) { E.fused(acc, cur, wr, wc, fr, fq, lds, wid, lane); S.done(cur); }
#undef PG8_SA
#undef PG8_SB
#undef PG8_STAGE
#undef PG8_LDA
#undef PG8_LDB
#undef PG8_MMA
#undef PG8_WAIT_V
#undef PG8_WAIT_L
#undef PG8_BAR
#undef PG8_SCHED
}
}

constexpr int NB = 16, SEQ = 4096, DM = 1024, DEPTH = 4, NTOK = NB * SEQ, NH = 8, FFH = 2816, NIN = 4096, INC = 4000;
constexpr int NWAVES = 8, NTHR = 512;
constexpr int LDS_BYTES = 147456, RING_BYTES = 131072;
constexpr size_t MiB = 1u << 20;
constexpr size_t WS_H = 0;
constexpr size_t WS_PA = 128 * MiB;
constexpr size_t WS_DIL = 192 * MiB;
constexpr size_t WS_GATES = 384 * MiB;
constexpr size_t WS_HID = 128 * MiB;
constexpr size_t WS_KVRAW = 640 * MiB;
constexpr size_t WS_K = 768 * MiB;
constexpr size_t WS_V = 864 * MiB;
constexpr size_t WS_W = 928 * MiB, WS_WSTRIDE = 30 * MiB;
constexpr size_t W_IN = 0, W_Q = W_IN + (size_t)NIN * 1024 * 2, W_KV = W_Q + 768 * 256 * 2, W_A = W_KV + 1024 * 256 * 2, W_B = W_A + 1024 * 512 * 2,
                 W_O = W_B + 1024 * 512 * 2, W_1 = W_O + 1024 * 1024 * 2, W_2 = W_1 + (size_t)5632 * 1024 * 2, W_END = W_2 + (size_t)1024 * 2816 * 2;
constexpr size_t WS_MOD = 988 * MiB;
constexpr size_t WS_ROPE = 990 * MiB;
constexpr size_t WS_SSQ = 998 * MiB;
constexpr size_t WS_LSE = 999 * MiB;
constexpr size_t WS_BT = 1001 * MiB;
constexpr size_t WS_SSQKR = 1001 * MiB + 65536;
constexpr size_t WS_BW1 = 1002 * MiB;
constexpr size_t WS_BW2 = 1003 * MiB;
constexpr size_t WS_CTL = 1005 * MiB, CTL_BYTES = 65536;
constexpr size_t WS_END = 1006 * MiB;
static_assert(W_END <= WS_WSTRIDE && WS_W + 2 * WS_WSTRIDE <= WS_MOD, "weights fit");
static_assert(pg8::EpiRowScale2::O_Q == WS_H && pg8::EpiRowScale2::O_PA == WS_PA && pg8::EpiRowScale2::O_K == WS_K && pg8::EpiRowScale2::O_V == WS_V && pg8::EpiRowScale2::O_ROPE == WS_ROPE && pg8::EpiRowScale2::O_SSQ == WS_SSQ && pg8::EpiRowScale2::O_SSQKR == WS_SSQKR, "EpiRowScale2 offsets");
static_assert(WS_HID + (size_t)NTOK * FFH * 2 <= WS_KVRAW, "hid overlay");

#define LAS __attribute__((address_space(3)))
typedef unsigned short bf16_t;
typedef short bf16x8 __attribute__((ext_vector_type(8)));
typedef short s16x4 __attribute__((ext_vector_type(4)));
typedef float f32x4 __attribute__((ext_vector_type(4)));
typedef float f32x16 __attribute__((ext_vector_type(16)));
typedef unsigned u32x4 __attribute__((ext_vector_type(4)));
typedef unsigned u32x2 __attribute__((ext_vector_type(2)));
using pg8::cvt_pk_bf16; using pg8::bf_lo; using pg8::bf_hi;

struct Params {
    const float *x, *c; const int* pos; const float *rel_bias, *norm1_g, *norm2_g, *ada_w, *ada_b, *w_in, *q_a_norm, *w_q_b, *kv_a_norm, *w_kv_b, *q_norm_a, *k_norm_a, *q_norm_b, *k_norm_b,
        *w_branch_a, *w_branch_b, *w_out, *w_ffn_gate, *w_ffn_up, *w_ffn_down;
    float* out; unsigned char* ws;
    float inv_freq[16];
    int ph_lo, ph_hi;
};

__device__ __forceinline__ float wave_sum(float v) {
#pragma unroll
    for (int o = 1; o < 64; o <<= 1) v += __shfl_xor(v, o);
    return v;
}
#define LDS_WAIT() asm volatile("s_waitcnt lgkmcnt(0)" ::: "memory")

__device__ __forceinline__ void phase0(const Params& P, LAS unsigned char* lds, int G) {
    const int tid = otid(), lane = tid & 63, wid = __builtin_amdgcn_readfirstlane(tid >> 6);
    float* MOD = (float*)(P.ws + WS_MOD); float* ROPE = (float*)(P.ws + WS_ROPE); float* BT = (float*)(P.ws + WS_BT);
    const int gtid = obid() * NTHR + tid, nthr = G * NTHR;
    for (int idx = gtid; idx < NTOK * 16; idx += nthr) { const int t = idx >> 4, i = idx & 15;
        const float ang = (float)P.pos[t] * P.inv_freq[i];
        double rev = (double)ang * 0.15915494309189535; rev -= __builtin_rint(rev); const float f = (float)rev;
        ROPE[t * 32 + i] = __builtin_amdgcn_cosf(f); ROPE[t * 32 + 16 + i] = __builtin_amdgcn_sinf(f); }
    for (int idx = gtid; idx < 3 * 8 * 129; idx += nthr) { const int j = idx % 129, h = (idx / 129) & 7, p = idx / (129 * 8);
        const int dil = p == 0 ? 1 : (p == 1 ? 4 : 16); const int rp = (j - 64) * dil; const int n = rp < 0 ? -rp : rp; int bk = rp > 0 ? 16 : 0;
        if (n < 8) bk += n; else { const float nf = (float)n; int lg = 8 + (int)(__logf(nf * 0.125f) / 4.852030263919617f * 8.0f); bk += lg < 15 ? lg : 15; }
        BT[idx] = P.rel_bias[bk * 8 + h] * pg8::LOG2E; }
    LAS float* sC = (LAS float*)lds;
    LAS float* red = (LAS float*)(lds + 65536);
    for (int i = tid; i < 16 * 1024; i += NTHR) { const float v = P.c[i]; sC[i] = v / (1.0f + __expf(-v)); }
    __syncthreads();
    for (int it = obid(); it < 4 * 96; it += G) { const int l = it / 96, cb = it % 96; const int col = cb * 64 + lane;
        float a[16];
#pragma unroll
        for (int b = 0; b < 16; ++b) a[b] = 0.f;
        const float* wp = P.ada_w + ((size_t)l * 1024 + wid * 128) * 6144 + col;
#pragma unroll 16
        for (int k = 0; k < 128; ++k) { const float w = wp[(size_t)k * 6144];
#pragma unroll
            for (int b = 0; b < 16; ++b) a[b] += sC[b * 1024 + wid * 128 + k] * w; }
#pragma unroll
        for (int b = 0; b < 16; ++b) red[(wid * 16 + b) * 64 + lane] = a[b];
        __syncthreads();
        for (int o = tid; o < 1024; o += NTHR) { const int b = o >> 6, ln = o & 63; float s = 0.f;
#pragma unroll
            for (int w = 0; w < 8; ++w) s += red[(w * 16 + b) * 64 + ln];
            MOD[((size_t)l * 16 + b) * 6144 + cb * 64 + ln] = s + P.ada_b[l * 6144 + cb * 64 + ln]; }
        __syncthreads();
    }
}

__device__ __forceinline__ void tr_item(const float* W, int Nsrc, int k0, int j0, const float* kscale, bf16_t* WT, int Kdst, int R0, LAS float* scr, int lane) {
    if (j0 >= 0) {
#pragma unroll 8
        for (int i = 0; i < 32; ++i) { const int kk = 2 * i + (lane >> 5); float v = W[(size_t)(k0 + kk) * Nsrc + j0 + (lane & 31)]; if (kscale) v *= kscale[k0 + kk]; scr[kk * 33 + (lane & 31)] = v; }
    } else {
#pragma unroll 8
        for (int i = 0; i < 32; ++i) { const int kk = 2 * i + (lane >> 5); scr[kk * 33 + (lane & 31)] = 0.f; }
    }
    LDS_WAIT();
    const int c = lane & 7;
#pragma unroll
    for (int j = 0; j < 4; ++j) { const int n = (lane >> 3) + 8 * j; const LAS float* s = scr + (8 * c) * 33 + n;
        u32x4 o; o.x = cvt_pk_bf16(s[0 * 33], s[1 * 33]); o.y = cvt_pk_bf16(s[2 * 33], s[3 * 33]); o.z = cvt_pk_bf16(s[4 * 33], s[5 * 33]); o.w = cvt_pk_bf16(s[6 * 33], s[7 * 33]);
        *(u32x4*)(WT + (size_t)(R0 + n) * Kdst + k0 + 8 * c) = o; }
    LDS_WAIT();
}
__device__ __forceinline__ int win_src_col(int R0) {
    const int pn = R0 >> 8, rho = R0 & 255;
    if (pn == 0) return rho;
    if (pn == 1) return rho < 160 ? 256 + rho : -1;
    if (pn < 6) { const int wc = (rho >> 5) & 3, dd = 32 * (rho >> 7); const int sec = (pn - 2) >> 1, head = 4 * ((pn - 2) & 1) + wc; return 416 + sec * 512 + head * 64 + dd; }
    if (pn < 8) return 416 + 1024 + (R0 - 1536);
    return 1952 + (R0 - 2048);
}
__device__ __forceinline__ void conv_weights(const Params& P, int l, unsigned char* wb, LAS unsigned char* lds, int G) {
    const int tid = otid(), lane = tid & 63, wid = __builtin_amdgcn_readfirstlane(tid >> 6);
    LAS float* scr = (LAS float*)(lds + wid * 16384);
    constexpr int I_IN = 16 * 128, I_Q = 4 * 24, I_KV = 4 * 32, I_A = 8 * 32, I_B = 8 * 32, I_O = 16 * 32, I_1 = 16 * 176, I_2 = 44 * 32;
    constexpr int NIT = I_IN + I_Q + I_KV + I_A + I_B + I_O + I_1 + I_2;
    for (int it = obid() * NWAVES + wid; it < NIT; it += G * NWAVES) {
        int r = it;
        if (r < I_IN) { const int kb = r / 128, rb = r % 128; tr_item(P.w_in + (size_t)l * 1024 * INC, INC, kb * 64, win_src_col(rb * 32), nullptr, (bf16_t*)(wb + W_IN), 1024, rb * 32, scr, lane); continue; } r -= I_IN;
        if (r < I_Q) { const int kb = r / 24, rb = r % 24; tr_item(P.w_q_b + (size_t)l * 256 * 768, 768, kb * 64, rb * 32, P.q_a_norm + l * 256, (bf16_t*)(wb + W_Q), 256, rb * 32, scr, lane); continue; } r -= I_Q;
        if (r < I_KV) { const int kb = r / 32, rb = r % 32; const int R0 = rb * 32, pnl = R0 >> 8, rho = R0 & 255, wcq = (rho >> 5) & 3;
            const int jsrc = (pnl * 2 + (wcq & 1)) * 128 + (wcq >= 2 ? 64 : 0) + 32 * (rho >> 7);
            tr_item(P.w_kv_b + (size_t)l * 128 * 1024, 1024, kb * 64, kb < 2 ? jsrc : -1, P.kv_a_norm + l * 128, (bf16_t*)(wb + W_KV), 256, R0, scr, lane); continue; } r -= I_KV;
        if (r < I_A) { const int kb = r / 32, rb = r % 32; tr_item(P.w_branch_a + (size_t)l * 512 * 1024, 1024, kb * 64, rb * 32, nullptr, (bf16_t*)(wb + W_A), 1024, rb * 32, scr, lane); continue; } r -= I_A;
        if (r < I_B) { const int kb = r / 32, rb = r % 32; tr_item(P.w_branch_b + (size_t)l * 512 * 1024, 1024, kb * 64, rb * 32, nullptr, (bf16_t*)(wb + W_A) + 512, 1024, rb * 32, scr, lane); continue; } r -= I_B;
        if (r < I_O) { const int kb = r / 32, rb = r % 32; tr_item(P.w_out + (size_t)l * 1024 * 1024, 1024, kb * 64, rb * 32, nullptr, (bf16_t*)(wb + W_O), 1024, rb * 32, scr, lane); continue; } r -= I_O;
        if (r < I_1) { const int kb = r / 176, rb = r % 176; const int R0 = rb * 32, pn = R0 >> 8, rho = R0 & 255;
            const float* src = (rho < 128 ? P.w_ffn_gate : P.w_ffn_up) + (size_t)l * 1024 * FFH;
            tr_item(src, FFH, kb * 64, pn * 128 + (rho & 127), nullptr, (bf16_t*)(wb + W_1), 1024, R0, scr, lane); continue; } r -= I_1;
        { const int kb = r / 32, rb = r % 32; tr_item(P.w_ffn_down + (size_t)l * FFH * 1024, 1024, kb * 64, rb * 32, nullptr, (bf16_t*)(wb + W_2), FFH, rb * 32, scr, lane); }
    }
}

__device__ __forceinline__ void norm_phase(const float* xin, const float* g, const float* mod  , int sh_off, int sc_off, bf16_t* H, int G) {
    const int tid = otid(), lane = tid & 63, wid = __builtin_amdgcn_readfirstlane(tid >> 6);
    for (int m = obid() * NWAVES + wid; m < NTOK; m += G * NWAVES) {
        const f32x4* xr = (const f32x4*)(xin + (size_t)m * DM) + lane; f32x4 v[4]; float s = 0.f;
#pragma unroll
        for (int j = 0; j < 4; ++j) { v[j] = xr[64 * j]; s += (v[j][0] * v[j][0] + v[j][1] * v[j][1]) + (v[j][2] * v[j][2] + v[j][3] * v[j][3]); }
        const float r = __builtin_amdgcn_rsqf(wave_sum(s) * (1.0f / DM) + pg8::RMS_EPS);
        const float* mb = mod + (size_t)(m >> 12) * 6144;
#pragma unroll
        for (int j = 0; j < 4; ++j) { const int col = 4 * lane + 256 * j;
            const f32x4 gv = *(const f32x4*)(g + col), sc = *(const f32x4*)(mb + sc_off + col), sh = *(const f32x4*)(mb + sh_off + col);
            const f32x4 o = (v[j] * r) * gv * (1.0f + sc) + sh;
            u32x2 w; w.x = cvt_pk_bf16(o[0], o[1]); w.y = cvt_pk_bf16(o[2], o[3]);
            *(u32x2*)(H + (size_t)m * DM + col) = w; }
    }
}

__device__ __forceinline__ void prepass_phase(const float* xin, const float* g, const float* mod  , int sc_off, bf16_t* XG, float* ssq, int G) {
    const int tid = otid(), lane = tid & 63, wid = __builtin_amdgcn_readfirstlane(tid >> 6);
    for (int m = obid() * NWAVES + wid; m < NTOK; m += G * NWAVES) {
        const f32x4* xr = (const f32x4*)(xin + (size_t)m * DM) + lane; float s = 0.f;
        const float* mb = mod + (size_t)(m >> 12) * 6144;
#pragma unroll
        for (int j = 0; j < 4; ++j) { const f32x4 v = xr[64 * j]; s += (v[0] * v[0] + v[1] * v[1]) + (v[2] * v[2] + v[3] * v[3]); const int col = 4 * lane + 256 * j;
            const f32x4 o = v * *(const f32x4*)(g + col) * (1.0f + *(const f32x4*)(mb + sc_off + col));
            u32x2 w; w.x = cvt_pk_bf16(o[0], o[1]); w.y = cvt_pk_bf16(o[2], o[3]);
            *(u32x2*)(XG + (size_t)m * DM + col) = w; }
        s = wave_sum(s);
        if (lane == 0) ssq[m] = s;
    }
}
__device__ __forceinline__ void bias_phase(const Params& P, LAS unsigned char* lds, int G) {
    const int tid = otid(), lane = tid & 63, wid = __builtin_amdgcn_readfirstlane(tid >> 6);
    const float* MOD = (const float*)(P.ws + WS_MOD); float* BW1 = (float*)(P.ws + WS_BW1); float* BW2 = (float*)(P.ws + WS_BW2);
    LAS float* sC = (LAS float*)lds;
    LAS float* red = (LAS float*)(lds + 65536);
    for (int it = obid(); it < 4 * 152; it += G) { const int l = it / 152, blk = it % 152; const bool ffn = blk >= 64; const int R0 = (ffn ? blk - 64 : blk) * 64;
        __syncthreads();
        for (int i = tid; i < 16 * 1024; i += NTHR) sC[i] = MOD[((size_t)l * 16 + (i >> 10)) * 6144 + (ffn ? 3072 : 0) + (i & 1023)];
        __syncthreads();
        const int R = R0 + lane; const float* wsrc; int j; size_t ncol;
        if (!ffn) { const int jb = win_src_col(R & ~31); j = jb < 0 ? -1 : jb + (R & 31); wsrc = P.w_in + (size_t)l * 1024 * INC; ncol = INC; }
        else { const int pn = R >> 8, rho = R & 255; j = pn * 128 + (rho & 127); wsrc = (rho < 128 ? P.w_ffn_gate : P.w_ffn_up) + (size_t)l * 1024 * FFH; ncol = FFH; }
        float a[16];
#pragma unroll
        for (int b = 0; b < 16; ++b) a[b] = 0.f;
        if (j >= 0) { const float* wp = wsrc + (size_t)(wid * 128) * ncol + j;
#pragma unroll 16
            for (int k = 0; k < 128; ++k) { const float w = wp[(size_t)k * ncol];
#pragma unroll
                for (int b = 0; b < 16; ++b) a[b] += sC[b * 1024 + wid * 128 + k] * w; } }
#pragma unroll
        for (int b = 0; b < 16; ++b) red[(wid * 16 + b) * 64 + lane] = a[b];
        __syncthreads();
        for (int o = tid; o < 1024; o += NTHR) { const int b = o >> 6, ln = o & 63; float s = 0.f;
#pragma unroll
            for (int w = 0; w < 8; ++w) s += red[(w * 16 + b) * 64 + ln];
            if (!ffn) BW1[((size_t)l * 16 + b) * 4096 + R0 + ln] = s; else BW2[((size_t)l * 16 + b) * 5632 + R0 + ln] = s; }
    }
    __syncthreads();
}

__device__ __forceinline__ void unpack8(const u32x4 w, float* f) { f[0] = bf_lo(w.x); f[1] = bf_hi(w.x); f[2] = bf_lo(w.y); f[3] = bf_hi(w.y); f[4] = bf_lo(w.z); f[5] = bf_hi(w.z); f[6] = bf_lo(w.w); f[7] = bf_hi(w.w); }
__device__ __forceinline__ u32x4 pack8(const float* f) { u32x4 w; w.x = cvt_pk_bf16(f[0], f[1]); w.y = cvt_pk_bf16(f[2], f[3]); w.z = cvt_pk_bf16(f[4], f[5]); w.w = cvt_pk_bf16(f[6], f[7]); return w; }
__device__ __forceinline__ float ssq8(const u32x4 w) { float f[8]; unpack8(w, f); return ((f[0] * f[0] + f[1] * f[1]) + (f[2] * f[2] + f[3] * f[3])) + ((f[4] * f[4] + f[5] * f[5]) + (f[6] * f[6] + f[7] * f[7])); }
__device__ __forceinline__ void head_norm_rope(const bf16_t* src_nope, const bf16_t* src_rope, bf16_t* dst, const float* gain, const float* rope, float oscale) {
    float s = 0.f;
#pragma unroll
    for (int c = 0; c < 8; ++c) s += ssq8(*(const u32x4*)(src_nope + 8 * c));
#pragma unroll
    for (int c = 0; c < 4; ++c) s += ssq8(*(const u32x4*)(src_rope + 8 * c));
    const float r = __builtin_amdgcn_rsqf(s * (1.0f / 96.0f) + pg8::RMS_EPS);
    asm volatile("" ::: "memory");
#pragma unroll
    for (int c = 0; c < 8; ++c) { float f[8]; unpack8(*(const u32x4*)(src_nope + 8 * c), f);
#pragma unroll
        for (int i = 0; i < 8; ++i) f[i] = f[i] * r * gain[8 * c + i] * oscale;
        *(u32x4*)(dst + 8 * c) = pack8(f); asm volatile("" ::: "memory"); }
    float x[32];
#pragma unroll
    for (int c = 0; c < 4; ++c) unpack8(*(const u32x4*)(src_rope + 8 * c), x + 8 * c);
#pragma unroll
    for (int i = 0; i < 32; ++i) x[i] = x[i] * r * gain[64 + i];
#pragma unroll
    for (int i = 0; i < 16; ++i) { const float cs = rope[i], sn = rope[16 + i]; const float x1 = x[i], x2 = x[16 + i]; x[i] = (x1 * cs - x2 * sn) * oscale; x[16 + i] = (x2 * cs + x1 * sn) * oscale; }
#pragma unroll
    for (int c = 0; c < 4; ++c) *(u32x4*)(dst + 64 + 8 * c) = pack8(x + 8 * c);
    asm volatile("" ::: "memory");
}
__device__ __forceinline__ void prep_phase(const Params& P, int l, int G) {
    const bf16_t* KVRAW = (const bf16_t*)(P.ws + WS_KVRAW); const bf16_t* PA = (const bf16_t*)(P.ws + WS_PA);
    bf16_t* K = (bf16_t*)(P.ws + WS_K); const float* ROPE = (const float*)(P.ws + WS_ROPE);
    const float* kg = P.k_norm_a + l * 96;
    for (int idx = obid() * NTHR + otid(); idx < NTOK * NH; idx += G * NTHR) { const int t = idx >> 3, h = idx & 7;
        const float* rp = ROPE + (size_t)t * 32;
        const bf16_t* kp = KVRAW + (size_t)t * 1024 + h * 128;
        const size_t hrow = ((size_t)((t >> 12) * 8 + h) << 12) + (t & 4095);
        head_norm_rope(kp, PA + (size_t)t * 512 + 384, K + hrow * 96, kg, rp, 1.0f);
    }
}
typedef short v4i16_t __attribute__((ext_vector_type(4)));
__device__ __forceinline__ s16x4 vtr(const LAS unsigned char* p) { return __builtin_bit_cast(s16x4, __builtin_amdgcn_ds_read_tr16_b64_v4i16((LAS v4i16_t*)p)); }
__device__ __forceinline__ bf16x8 cat8(s16x4 a, s16x4 b) { return (bf16x8){a[0], a[1], a[2], a[3], b[0], b[1], b[2], b[3]}; }
__device__ __forceinline__ bf16x8 packp(const f32x16& p, int o) {
    u32x4 w; w.x = cvt_pk_bf16(p[o + 0], p[o + 1]); w.y = cvt_pk_bf16(p[o + 2], p[o + 3]); w.z = cvt_pk_bf16(p[o + 4], p[o + 5]); w.w = cvt_pk_bf16(p[o + 6], p[o + 7]);
    return __builtin_bit_cast(bf16x8, w);
}
__device__ __forceinline__ float max16(const f32x16& p) {
    float a = fmaxf(fmaxf(p[0], p[1]), fmaxf(p[2], p[3])), b = fmaxf(fmaxf(p[4], p[5]), fmaxf(p[6], p[7]));
    float c = fmaxf(fmaxf(p[8], p[9]), fmaxf(p[10], p[11])), d = fmaxf(fmaxf(p[12], p[13]), fmaxf(p[14], p[15]));
    return fmaxf(fmaxf(a, b), fmaxf(c, d));
}
#define MFMA32(a, b, c) __builtin_amdgcn_mfma_f32_32x32x16_bf16((a), (b), (c), 0, 0, 0)
constexpr int KP = 208, VP = 192;
constexpr int KT_B = 64 * KP, VT_B = 64 * VP;
constexpr int MLA_K0 = 0, MLA_V0 = 2 * KT_B;

constexpr float MLA_THR = 8.0f;
__device__ __forceinline__ float max3f(float a, float b, float c) { float r; asm("v_max3_f32 %0, %1, %2, %3" : "=v"(r) : "v"(a), "v"(b), "v"(c)); return r; }
__device__ __forceinline__ float rowmax32(const f32x16& a, const f32x16& b) {
    float x = max3f(a[0], a[1], a[2]), y = max3f(b[0], b[1], b[2]);
    x = max3f(x, a[3], a[4]); y = max3f(y, b[3], b[4]); x = max3f(x, a[5], a[6]); y = max3f(y, b[5], b[6]); x = max3f(x, a[7], a[8]); y = max3f(y, b[7], b[8]);
    x = max3f(x, a[9], a[10]); y = max3f(y, b[9], b[10]); x = max3f(x, a[11], a[12]); y = max3f(y, b[11], b[12]); x = max3f(x, a[13], a[14]); y = max3f(y, b[13], b[14]);
    x = max3f(x, a[15], b[15]); x = max3f(x, y, y);
    return max3f(x, __shfl_xor(x, 32), x);
}
#define SBAR0() __builtin_amdgcn_sched_barrier(0)
__device__ __forceinline__ void mla_unit(LAS unsigned char* lds, const bf16_t* Q, const bf16_t* K, const bf16_t* V, bf16_t* Y, const float* qgain, const float* ROPE, int b, int h, int qb) {
    const int tid = otid(), lane = tid & 63, wid = __builtin_amdgcn_readfirstlane(tid >> 6), r32 = lane & 31, hi = lane >> 5;
    const size_t tok0 = (size_t)b * SEQ; const size_t qrow = tok0 + qb * 256 + wid * 32 + r32;
    bf16x8 qf[6];
    {
        const bf16_t* qp = Q + qrow * 768 + h * 96 + hi * 8; float f[6][8]; float s = 0.f;
#pragma unroll
        for (int d0 = 0; d0 < 6; ++d0) { unpack8(*(const u32x4*)(qp + d0 * 16), f[d0]);
#pragma unroll
            for (int i = 0; i < 8; ++i) s += f[d0][i] * f[d0][i]; }
        s += __shfl_xor(s, 32);
        const float r = __builtin_amdgcn_rsqf(s * (1.0f / 96.0f) + pg8::RMS_EPS);
#pragma unroll
        for (int d0 = 0; d0 < 6; ++d0)
#pragma unroll
            for (int i = 0; i < 8; ++i) f[d0][i] = f[d0][i] * r * qgain[d0 * 16 + hi * 8 + i];
        const float* rp = ROPE + qrow * 32 + hi * 8;
#pragma unroll
        for (int i = 0; i < 8; ++i) { const float cs = rp[i], sn = rp[16 + i]; const float x1 = f[4][i], x2 = f[5][i]; f[4][i] = x1 * cs - x2 * sn; f[5][i] = x2 * cs + x1 * sn; }
#pragma unroll
        for (int d0 = 0; d0 < 6; ++d0) {
#pragma unroll
            for (int i = 0; i < 8; ++i) f[d0][i] *= pg8::QSCALE_A;
            qf[d0] = __builtin_bit_cast(bf16x8, pack8(f[d0])); }
    }
    const int kr0 = tid / 12, kc0 = tid % 12, kr1 = (512 + tid) / 12, kc1 = (512 + tid) % 12, vr = tid >> 3, vc = tid & 7;
    const size_t hrow0 = (size_t)(b * 8 + h) * SEQ;
    const bf16_t* kg0 = K + (hrow0 + kr0) * 96 + kc0 * 8; const bf16_t* kg1 = K + (hrow0 + kr1) * 96 + kc1 * 8;
    const bf16_t* vg = V + (hrow0 + vr) * 64 + vc * 8;
    const int kl0 = kr0 * KP + kc0 * 16, kl1 = kr1 * KP + kc1 * 16, vl = vr * VP + vc * 16;
    const bool has1 = tid < 256;
    u32x4 ka0, kb0, ka1, kb1, vv0, vv1;
    ka0 = *(const u32x4*)kg0; if (has1) kb0 = *(const u32x4*)kg1; vv0 = *(const u32x4*)vg;
    ka1 = *(const u32x4*)(kg0 + (size_t)64 * 96); if (has1) kb1 = *(const u32x4*)(kg1 + (size_t)64 * 96);
    *(LAS u32x4*)(lds + MLA_K0 + kl0) = ka0; if (has1) *(LAS u32x4*)(lds + MLA_K0 + kl1) = kb0; *(LAS u32x4*)(lds + MLA_V0 + vl) = vv0;
    *(LAS u32x4*)(lds + MLA_K0 + KT_B + kl0) = ka1; if (has1) *(LAS u32x4*)(lds + MLA_K0 + KT_B + kl1) = kb1;
    ka0 = *(const u32x4*)(kg0 + (size_t)128 * 96); if (has1) kb0 = *(const u32x4*)(kg1 + (size_t)128 * 96); vv1 = *(const u32x4*)(vg + (size_t)64 * 64);
    __syncthreads();
    f32x16 o0, o1, negm;
#pragma unroll
    for (int i = 0; i < 16; ++i) { o0[i] = 0.f; o1[i] = 0.f; negm[i] = 0.f; }
    const int koff = r32 * KP + hi * 16;
    const int voff = (4 * hi + ((lane & 15) >> 2)) * VP + (16 * ((lane >> 4) & 1) + 4 * (lane & 3)) * 2;
    f32x16 p0, p1, n0, n1;
    { const LAS unsigned char* kb_ = lds + MLA_K0 + koff; p0 = negm; p1 = negm;
#pragma unroll
      for (int d0 = 0; d0 < 6; ++d0) { const bf16x8 a0 = *(const LAS bf16x8*)(kb_ + d0 * 32), a1 = *(const LAS bf16x8*)(kb_ + 32 * KP + d0 * 32); p0 = MFMA32(a0, qf[d0], p0); p1 = MFMA32(a1, qf[d0], p1); } }
    float m_ref, l_run = 0.f;
    { const float mx = rowmax32(p0, p1); m_ref = mx;
#pragma unroll
      for (int i = 0; i < 16; ++i) { p0[i] -= mx; p1[i] -= mx; negm[i] = -mx; } }
#define MLA_STEP(C0, C1, X0, X1, T, KAI, KBI, VVI, KAW, KBW, VVW) do { const int t_ = (T); const int cur = t_ & 1; \
        if (t_ + 3 < 64) { const size_t go = (size_t)(t_ + 3) * 64; KAI = *(const u32x4*)(kg0 + go * 96); if (has1) KBI = *(const u32x4*)(kg1 + go * 96); } \
        if (t_ + 2 < 64) { const size_t go = (size_t)(t_ + 2) * 64; VVI = *(const u32x4*)(vg + go * 64); } \
        bf16x8 kfr[12]; { const LAS unsigned char* kn = lds + MLA_K0 + (cur ^ 1) * KT_B + koff; \
            _Pragma("unroll") for (int d0 = 0; d0 < 6; ++d0) { kfr[2 * d0] = *(const LAS bf16x8*)(kn + d0 * 32); kfr[2 * d0 + 1] = *(const LAS bf16x8*)(kn + 32 * KP + d0 * 32); } } \
        SBAR0(); \
        const float mx = rowmax32(C0, C1); \
        if (__builtin_amdgcn_ballot_w64(mx > MLA_THR) != 0ull) { const float d = fmaxf(mx, 0.f); const float sc = __builtin_amdgcn_exp2f(-d); m_ref += d; l_run *= sc; \
            _Pragma("unroll") for (int i = 0; i < 16; ++i) { C0[i] -= d; C1[i] -= d; o0[i] *= sc; o1[i] *= sc; negm[i] = -m_ref; } } \
        SBAR0(); \
        X0 = negm; X1 = negm; \
        _Pragma("unroll") for (int d0 = 0; d0 < 6; ++d0) { X0 = MFMA32(kfr[2 * d0], qf[d0], X0); X1 = MFMA32(kfr[2 * d0 + 1], qf[d0], X1); } \
        SBAR0(); \
        float ls = 0.f; \
        _Pragma("unroll") for (int i = 0; i < 16; ++i) { C0[i] = __builtin_amdgcn_exp2f(C0[i]); C1[i] = __builtin_amdgcn_exp2f(C1[i]); ls += C0[i] + C1[i]; } \
        l_run += ls; \
        bf16x8 pb[4]; pb[0] = packp(C0, 0); pb[1] = packp(C0, 8); pb[2] = packp(C1, 0); pb[3] = packp(C1, 8); \
        const LAS unsigned char* vb_ = lds + MLA_V0 + cur * VT_B + voff; \
        _Pragma("unroll") for (int j = 0; j < 4; ++j) { const LAS unsigned char* vj = vb_ + 16 * j * VP; \
            const bf16x8 a0 = cat8(vtr(vj), vtr(vj + 8 * VP)); const bf16x8 a1 = cat8(vtr(vj + 64), vtr(vj + 8 * VP + 64)); \
            o0 = MFMA32(a0, pb[j], o0); o1 = MFMA32(a1, pb[j], o1); } \
        if (t_ + 2 < 64) { *(LAS u32x4*)(lds + MLA_K0 + cur * KT_B + kl0) = KAW; if (has1) *(LAS u32x4*)(lds + MLA_K0 + cur * KT_B + kl1) = KBW; } \
        if (t_ + 1 < 64) *(LAS u32x4*)(lds + MLA_V0 + (cur ^ 1) * VT_B + vl) = VVW; \
        __syncthreads(); } while (0)
    for (int t = 0; t < 64; t += 2) { MLA_STEP(p0, p1, n0, n1, t, ka1, kb1, vv0, ka0, kb0, vv1); MLA_STEP(n0, n1, p0, p1, t + 1, ka0, kb0, vv1, ka1, kb1, vv0); }
#undef MLA_STEP
    const float lt = l_run + __shfl_xor(l_run, 32); const float inv = 1.0f / lt;
    bf16_t* yp = Y + qrow * 1024 + h * 64 + 4 * hi;
#pragma unroll
    for (int g = 0; g < 4; ++g) {
        u32x2 w0; w0.x = cvt_pk_bf16(o0[4 * g] * inv, o0[4 * g + 1] * inv); w0.y = cvt_pk_bf16(o0[4 * g + 2] * inv, o0[4 * g + 3] * inv); *(u32x2*)(yp + 8 * g) = w0;
        u32x2 w1; w1.x = cvt_pk_bf16(o1[4 * g] * inv, o1[4 * g + 1] * inv); w1.y = cvt_pk_bf16(o1[4 * g + 2] * inv, o1[4 * g + 3] * inv); *(u32x2*)(yp + 32 + 8 * g) = w1; }
}

constexpr int DW_BYTES = 13440;
template <int DELTA>
__device__ __forceinline__ void dil_block(LAS unsigned char* wl, const bf16_t* kbase  , const bf16_t* vbase, size_t rstride  ,
                                          const bf16x8 (&qf)[2][4], f32x16 (&o)[2][2], float (&m_run)[2], float (&l_run)[2], int bvar, int voff, int lane, int r32, int hi, int btb) {
    u32x4 vv[8]; bf16x8 kf[2][4];
#pragma unroll
    for (int i = 0; i < 8; ++i) { const int idx = lane + 64 * i, row = idx >> 3, ch = idx & 7; vv[i] = *(const u32x4*)(vbase + (size_t)row * rstride + ch * 8); }
#pragma unroll
    for (int kvh = 0; kvh < 2; ++kvh)
#pragma unroll
        for (int d0 = 0; d0 < 4; ++d0) kf[kvh][d0] = *(const bf16x8*)(kbase + (size_t)(32 * kvh + r32) * rstride + d0 * 16);
    SBAR0();
#pragma unroll
    for (int i = 0; i < 8; ++i) { const int idx = lane + 64 * i, row = idx >> 3, ch = idx & 7; *(LAS u32x4*)(wl + row * VP + ch * 16) = vv[i]; }
    bf16x8 pb[2][4];
#pragma unroll
    for (int qh = 0; qh < 2; ++qh) {
        f32x16 s[2]; float mx = -1e30f;
#pragma unroll
        for (int kvh = 0; kvh < 2; ++kvh) {
            constexpr int dummy = 0; (void)dummy;
            const int toff = 64 * DELTA + 32 * (kvh - qh);
            if (toff > 64 || toff < -64) continue;
#pragma unroll
            for (int i = 0; i < 16; ++i) s[kvh][i] = 0.f;
#pragma unroll
            for (int d0 = 0; d0 < 4; ++d0) s[kvh] = MFMA32(kf[kvh][d0], qf[qh][d0], s[kvh]);
#pragma unroll
            for (int rr = 0; rr < 16; ++rr) { const int c4 = 4 * ((rr & 3) + 8 * (rr >> 2)); const float bias = *(const LAS float*)(wl + bvar + (VT_B + c4 + toff * 4));
                float v = s[kvh][rr] + bias;
                if (toff == 64) v = (bvar <= btb - c4) ? v : -1e30f;
                if (toff == -64) v = (bvar >= btb - c4) ? v : -1e30f;
                s[kvh][rr] = v; mx = fmaxf(mx, v); }
        }
        mx = fmaxf(mx, __shfl_xor(mx, 32));
        const float m_new = fmaxf(m_run[qh], mx); const float alpha = __builtin_amdgcn_exp2f(m_run[qh] - m_new); m_run[qh] = m_new;
        float ls = 0.f;
#pragma unroll
        for (int kvh = 0; kvh < 2; ++kvh) { const int toff = 64 * DELTA + 32 * (kvh - qh);
            if (toff > 64 || toff < -64) continue;
#pragma unroll
            for (int rr = 0; rr < 16; ++rr) { const float e = __builtin_amdgcn_exp2f(s[kvh][rr] - m_new); s[kvh][rr] = e; ls += e; }
            pb[qh][2 * kvh] = packp(s[kvh], 0); pb[qh][2 * kvh + 1] = packp(s[kvh], 8); }
        l_run[qh] = l_run[qh] * alpha + ls;
#pragma unroll
        for (int i = 0; i < 16; ++i) { o[qh][0][i] *= alpha; o[qh][1][i] *= alpha; }
    }
    LDS_WAIT();
#pragma unroll
    for (int j = 0; j < 4; ++j) { const LAS unsigned char* vj = wl + voff + 16 * j * VP;
        const bf16x8 a0 = cat8(vtr(vj), vtr(vj + 8 * VP)); const bf16x8 a1 = cat8(vtr(vj + 64), vtr(vj + 8 * VP + 64));
#pragma unroll
        for (int qh = 0; qh < 2; ++qh) { const int toff = 64 * DELTA + 32 * ((j >> 1) - qh);
            if (toff > 64 || toff < -64) continue;
            o[qh][0] = MFMA32(a0, pb[qh][j], o[qh][0]); o[qh][1] = MFMA32(a1, pb[qh][j], o[qh][1]); } }
    LDS_WAIT();
}
template <int P_>
__device__ __forceinline__ void dil_wave_unit(LAS unsigned char* wl, const bf16_t* DIL, bf16_t* Y, bf16_t* ST, float* LSE, const float* BT, int b, int h, int r, int nb) {
    constexpr int dil = P_ == 0 ? 1 : (P_ == 1 ? 4 : 16), nblk = 64 / dil; constexpr bool first = P_ == 0, last = P_ == 2;
    const int lane = otid() & 63, r32 = lane & 31, hi = lane >> 5;
    const size_t tok0 = (size_t)b * SEQ; const size_t rstride = (size_t)dil * 64;
    LAS float* bt = (LAS float*)(wl + VT_B);
    for (int i = lane; i < 257; i += 64) { int j = i - 64; j = j < 0 ? 0 : (j > 128 ? 128 : j); bt[i] = BT[(P_ * 8 + h) * 129 + j]; }
    const int btb = 128 * 4;
    const int bvar = btb + 4 * (4 * hi - r32);
    bf16x8 qf[2][4];
    const bf16_t* rowb = DIL + ((size_t)(b * 8 + h) * SEQ + (size_t)(64 * nb) * dil + r) * 64;
    constexpr size_t KOFF = pg8::DPLANE, VOFF = 2 * pg8::DPLANE;
#pragma unroll
    for (int qh = 0; qh < 2; ++qh)
#pragma unroll
        for (int d0 = 0; d0 < 4; ++d0) qf[qh][d0] = *(const bf16x8*)(rowb + (size_t)(32 * qh + r32) * rstride + hi * 8 + d0 * 16);
    f32x16 o[2][2];
#pragma unroll
    for (int a = 0; a < 2; ++a)
#pragma unroll
        for (int c = 0; c < 2; ++c)
#pragma unroll
            for (int i = 0; i < 16; ++i) o[a][c][i] = 0.f;
    float m_run[2] = {-1e30f, -1e30f}, l_run[2] = {0.f, 0.f};
    const int voff = (4 * hi + ((lane & 15) >> 2)) * VP + (16 * ((lane >> 4) & 1) + 4 * (lane & 3)) * 2;
    LDS_WAIT();
    dil_block<0>(wl, rowb + KOFF + hi * 8, rowb + VOFF, rstride, qf, o, m_run, l_run, bvar, voff, lane, r32, hi, btb);
    if (nb > 0) dil_block<-1>(wl, rowb - 64 * rstride + KOFF + hi * 8, rowb - 64 * rstride + VOFF, rstride, qf, o, m_run, l_run, bvar, voff, lane, r32, hi, btb);
    if (nb + 1 < nblk) dil_block<1>(wl, rowb + 64 * rstride + KOFF + hi * 8, rowb + 64 * rstride + VOFF, rstride, qf, o, m_run, l_run, bvar, voff, lane, r32, hi, btb);
    float lp[2]; u32x2 pv[2][8];
    if (!first) {
#pragma unroll
        for (int qh = 0; qh < 2; ++qh) { const size_t srow = (size_t)(b * 8 + h) * SEQ + (size_t)(64 * nb + 32 * qh + r32) * dil + r; lp[qh] = LSE[srow];
            const bf16_t* sp = ST + srow * 64 + 4 * hi;
#pragma unroll
            for (int e = 0; e < 8; ++e) pv[qh][e] = *(const u32x2*)(sp + 32 * (e >> 2) + 8 * (e & 3)); }
    }
#pragma unroll
    for (int qh = 0; qh < 2; ++qh) {
        const size_t spos = (size_t)(64 * nb + 32 * qh + r32) * dil + r; const size_t srow = (size_t)(b * 8 + h) * SEQ + spos;
        const float lt = l_run[qh] + __shfl_xor(l_run[qh], 32); const float inv = 1.0f / lt; const float lse2 = m_run[qh] + __builtin_amdgcn_logf(lt);
        float a_prev = 0.f, a_cur = inv, lse_new = lse2;
        if (!first) { const float M = fmaxf(lp[qh], lse2); const float wp = __builtin_amdgcn_exp2f(lp[qh] - M), wc = __builtin_amdgcn_exp2f(lse2 - M); const float den = wp + wc;
            a_prev = wp / den; a_cur = wc / den * inv; lse_new = M + __builtin_amdgcn_logf(den); }
        bf16_t* yp = last ? Y + (tok0 + spos) * 1024 + 512 + h * 64 + 4 * hi : ST + srow * 64 + 4 * hi;
#pragma unroll
        for (int e = 0; e < 8; ++e) { const int blk = e >> 2, g = e & 3;
            float v0 = o[qh][blk][4 * g] * a_cur, v1 = o[qh][blk][4 * g + 1] * a_cur, v2 = o[qh][blk][4 * g + 2] * a_cur, v3 = o[qh][blk][4 * g + 3] * a_cur;
            if (!first) { v0 += a_prev * bf_lo(pv[qh][e].x); v1 += a_prev * bf_hi(pv[qh][e].x); v2 += a_prev * bf_lo(pv[qh][e].y); v3 += a_prev * bf_hi(pv[qh][e].y); }
            u32x2 w; w.x = cvt_pk_bf16(v0, v1); w.y = cvt_pk_bf16(v2, v3); *(u32x2*)(yp + 32 * blk + 8 * g) = w; }
        if (!last && hi == 0) LSE[srow] = lse_new;
    }
}
__device__ __forceinline__ void dil_unit(LAS unsigned char* lds, const bf16_t* DIL, bf16_t* Y, bf16_t* ST, float* LSE, const float* BT, int b, int h, int c) {
    const int wid = __builtin_amdgcn_readfirstlane(otid() >> 6);
    LAS unsigned char* wl = lds + wid * DW_BYTES;
    for (int j = 0; j < 2; ++j) { const int wu = 2 * wid + j; dil_wave_unit<0>(wl, DIL, Y, ST, LSE, BT, b, h, 0, c * 16 + wu); }
    __syncthreads();
    for (int j = 0; j < 2; ++j) { const int wu = 2 * wid + j; dil_wave_unit<1>(wl, DIL, Y, ST, LSE, BT, b, h, wu >> 2, c * 4 + (wu & 3)); }
    __syncthreads();
    for (int j = 0; j < 2; ++j) { const int wu = 2 * wid + j; dil_wave_unit<2>(wl, DIL, Y, ST, LSE, BT, b, h, wu, c); }
    __syncthreads();
}

typedef __attribute__((address_space(1))) unsigned gu32;
#define XB_TMO      128
#define XB_XCNT(j)  (256  + 64 * (j))
#define XB_XSUB(j)  (1280 + 64 * (j))
#define XB_XGEN(j)  (2304 + 64 * (j))
#define XB_TOP      3328
#define XB_TOPGEN   3392
#define XCD_BAR_WORDS 3456
#define XB_SPIN_CAP (1u << 18)

__device__ __forceinline__ unsigned xb_ld(unsigned* p)              { return __hip_atomic_load(p, __ATOMIC_RELAXED, __HIP_MEMORY_SCOPE_AGENT); }
__device__ __forceinline__ unsigned xb_add(unsigned* p, unsigned v) { return __hip_atomic_fetch_add(p, v, __ATOMIC_RELAXED, __HIP_MEMORY_SCOPE_AGENT); }
__device__ __forceinline__ unsigned xb_xcc_id() { return (unsigned)__builtin_amdgcn_s_getreg((3 << 11) | 20) & 0xFu; }
#define XB_SPIN(cond, bar) do { unsigned _sp = 0; while (cond) { __builtin_amdgcn_s_sleep(1); \
    if ((++_sp & 255u) == 0u) { if (xb_ld(&(bar)[XB_TMO])) break; if (_sp > XB_SPIN_CAP) { atomicAdd(&(bar)[XB_TMO], 1u); break; } } } } while (0)

struct XcdBarrier {
    unsigned* bar; unsigned x;
    volatile LAS unsigned* st;
};

__device__ __forceinline__ XcdBarrier xcd_barrier_post(unsigned* bar, volatile LAS unsigned* st) {
    XcdBarrier b; b.bar = bar; b.x = xb_xcc_id(); b.st = st;
    if (threadIdx.x == 0) (void)xb_add(&bar[XB_XCNT(b.x)], 1u);
    return b;
}
__device__ __forceinline__ void xcd_barrier_complete(unsigned* bar, unsigned x, unsigned& nloc, unsigned& nx) {
    const unsigned G = gridDim.x * gridDim.y * gridDim.z;
    unsigned sum, cnt, mine, sp = 0u;
    for (;;) {
        sum = 0u; cnt = 0u; mine = 0u;
#pragma unroll
        for (unsigned j = 0; j < 16; ++j) { const unsigned c = xb_ld(&bar[XB_XCNT(j)]); sum += c; cnt += (c > 0u) ? 1u : 0u; mine = (j == x) ? c : mine; }
        if (sum == G) break;
        __builtin_amdgcn_s_sleep(1);
        if ((++sp & 255u) == 0u) { if (xb_ld(&bar[XB_TMO])) break; if (sp > XB_SPIN_CAP) { atomicAdd(&bar[XB_TMO], 1u); break; } }
    }
    nloc = mine > 0u ? mine : 1u; nx = cnt > 0u ? cnt : 1u;
}

__device__ __forceinline__ void xcd_barrier(const XcdBarrier& b) {
    asm volatile("s_waitcnt vmcnt(0)" ::: "memory");
    __syncthreads();
    if (threadIdx.x == 0) {
        unsigned* bar = b.bar;
        __builtin_amdgcn_s_waitcnt(0);
        unsigned nloc = b.st[0], nx = b.st[1];
        if (nloc == 0u) { xcd_barrier_complete(bar, b.x, nloc, nx); b.st[0] = nloc; b.st[1] = nx; }
        const unsigned old = xb_add(&bar[XB_XSUB(b.x)], 1u);
        const unsigned gen = old / nloc;
        if (old + 1u == (gen + 1u) * nloc) {
            __builtin_amdgcn_fence(__ATOMIC_RELEASE, "agent");
            asm volatile("s_waitcnt vmcnt(0)" ::: "memory");
            const unsigned og = xb_add(&bar[XB_TOP], 1u);
            const unsigned tg = og / nx;
            if (og + 1u == (tg + 1u) * nx) xb_add(&bar[XB_TOPGEN], 1u);
            else XB_SPIN(xb_ld(&bar[XB_TOPGEN]) == tg, bar);
            __builtin_amdgcn_fence(__ATOMIC_ACQUIRE, "agent");
            xb_add(&bar[XB_XGEN(b.x)], 1u);
            asm volatile("s_waitcnt vmcnt(0)" ::: "memory");
        } else {
            XB_SPIN(xb_ld(&bar[XB_XGEN(b.x)]) == gen, bar);
            __builtin_amdgcn_fence(__ATOMIC_ACQUIRE, "agent");
            asm volatile("s_waitcnt vmcnt(0)" ::: "memory");
        }
    }
    __syncthreads();
}

constexpr int NPHASE = 2 + DEPTH * 7;
__device__ __forceinline__ unsigned char* opaque_ptr(unsigned char* p) { asm volatile("" : "+s"(p)); return p; }
#define GEMM(EpiT, Ev, Ap, Bp, Nn, Kk, Ld) do { pg8::Gemm g_{(Ap), (Bp), NTOK, (Nn), (Kk), (Ld), 1 << 30, 0}; pg8::StaticOrder S_; S_.init(NTOK, (Nn), G, obid()); \
        pg8::gemm_phase<EpiT, pg8::StaticOrder, true, true>(lds, g_, S_, (Ev)); } while (0)
#define BF(off) ((bf16_t*)(unsigned char*)(ws + (off)))
#define FP(off) ((float*)(unsigned char*)(ws + (off)))
#define WB(l_, off) ((bf16_t*)(unsigned char*)(ws + WS_W + (size_t)((l_) & 1) * WS_WSTRIDE + (off)))
__global__ void __launch_bounds__(NTHR, 2) mega_fwd(Params P0) {
    extern __shared__ __attribute__((aligned(16))) unsigned char lds_raw[];
    LAS unsigned char* lds = (LAS unsigned char*)lds_raw;
    cg::grid_group grid = cg::this_grid();
    { volatile LAS unsigned* misc = (volatile LAS unsigned*)(lds + RING_BYTES + 320); if (otid() < 32) misc[otid()] = 0u; }
    __syncthreads();
    XcdBarrier xbar = xcd_barrier_post((unsigned*)(P0.ws + WS_CTL) + 1024, (volatile LAS unsigned*)(lds + RING_BYTES + 320) + 8);
    { volatile LAS unsigned* misc = (volatile LAS unsigned*)(lds + RING_BYTES + 320);
      if (otid() == 0) { const unsigned x = xb_xcc_id(); misc[16] = xb_add((unsigned*)(P0.ws + WS_CTL) + 8192 + 64 * x, 1u); misc[17] = x; } }
    __syncthreads();
    const int ph_lo = P0.ph_lo, ph_hi = P0.ph_hi;
    for (int ph = ph_lo; ph < ph_hi; ++ph) {
        int G_ = (int)gridDim.x; asm volatile("" : "+s"(G_)); const int G = G_;
        typedef const __attribute__((address_space(4))) Params* kparams_t;
        kparams_t kp_ = (kparams_t)__builtin_amdgcn_kernarg_segment_ptr(); asm volatile("" : "+s"(kp_));
        const Params& P = *(const Params*)kp_;
        __attribute__((address_space(1))) unsigned char* ws = (__attribute__((address_space(1))) unsigned char*)opaque_ptr(P.ws);
        const int l = ph > 1 ? (ph - 2) / 7 : 0, kk_ = ph > 1 ? (ph - 2) % 7 + 2 : ph; const int k = kk_ >= 4 ? kk_ + 1 : kk_;
        const size_t modl = (size_t)l * 16 * 6144;
        switch (k) {
        case 0: {
            phase0(P, lds, G);
            float* SSQ = FP(WS_SSQ);
            float* SKR = FP(WS_SSQKR);
            for (int i = obid() * NTHR + otid(); i < 2 * NTOK; i += G * NTHR) { SSQ[i] = 0.f; if (i < NTOK) SKR[i] = 0.f; }
            __syncthreads();
            conv_weights(P, 0, (unsigned char*)(ws + WS_W), lds, G);
        } break;
        case 1: {
            bias_phase(P, lds, G);
            prepass_phase(P.x, P.norm1_g, FP(WS_MOD), 1024, BF(WS_H), FP(WS_SSQ) + 2 * NTOK, G);
        } break;
        case 2: {
            pg8::EpiIn E{BF(WS_PA), BF(WS_DIL), BF(WS_GATES), FP(WS_SSQ), FP(WS_SSQ) + NTOK, FP(WS_SSQKR), P.q_norm_b + l * 64, P.k_norm_b + l * 64, FP(WS_SSQ) + 2 * NTOK, FP(WS_BW1) + (size_t)l * 16 * 4096};
            GEMM(pg8::EpiIn, E, BF(WS_H), WB(l, W_IN), NIN, 1024, 1024);
        } break;
        case 3: {
            pg8::EpiRowScale2 E{(unsigned char*)ws, P.k_norm_a + l * 96};
            { pg8::Gemm g_{BF(WS_PA), WB(l, W_Q), NTOK, 1792, 256, 512, 3, 256}; pg8::StaticOrder S_; S_.init(NTOK, 1792, G, obid()); pg8::gemm_phase<pg8::EpiRowScale2, pg8::StaticOrder, true, true>(lds, g_, S_, E); }
        } break;
        case 5: {
            { float* SSQ = FP(WS_SSQ); float* SKR = FP(WS_SSQKR); for (int i = obid() * NTHR + otid(); i < 4 * NTOK; i += G * NTHR) { SSQ[i] = 0.f; if (i < NTOK) SKR[i] = 0.f; } }
            if (l + 1 < DEPTH) { conv_weights(P, l + 1, (unsigned char*)(ws + WS_W + (size_t)((l + 1) & 1) * WS_WSTRIDE), lds, G); __syncthreads(); }
            bf16_t* Y = BF(WS_KVRAW);
            if (G == 256) { int xcd = obid() & 7, slot = obid() >> 3;
                { const unsigned* tk = (const unsigned*)(ws + WS_CTL) + 8192; bool even = true;
#pragma unroll
                  for (int x = 0; x < 8; ++x) even = even && (__hip_atomic_load(tk + 64 * x, __ATOMIC_RELAXED, __HIP_MEMORY_SCOPE_AGENT) == 32u);
                  if (even) { volatile LAS unsigned* misc = (volatile LAS unsigned*)(lds + RING_BYTES + 320); slot = (int)misc[16]; xcd = (int)misc[17]; } }
                slot = __builtin_amdgcn_readfirstlane(slot); xcd = __builtin_amdgcn_readfirstlane(xcd);
                for (int i = 0; i < 8; ++i) { const int bh = ((i * 2 + (slot >> 4)) << 3) + xcd; mla_unit(lds, BF(WS_H), BF(WS_K), BF(WS_V), Y, P.q_norm_a + l * 96, FP(WS_ROPE), bh >> 3, bh & 7, slot & 15); }
            } else { for (int u = obid(); u < NB * NH * 16; u += G) mla_unit(lds, BF(WS_H), BF(WS_K), BF(WS_V), Y, P.q_norm_a + l * 96, FP(WS_ROPE), u >> 7, (u >> 4) & 7, u & 15); }
            __syncthreads();
            for (int u = obid(); u < NB * NH * 4; u += G) dil_unit(lds, BF(WS_DIL), Y, BF(WS_PA), FP(WS_LSE), FP(WS_BT), u >> 5, (u >> 2) & 7, u & 3);
        } break;
        case 6: {
            pg8::EpiGate2 E{BF(WS_H), BF(WS_GATES)}; GEMM(pg8::EpiGate2, E, BF(WS_KVRAW), WB(l, W_A), 1024, 1024, 1024);
        } break;
        case 7: {
            pg8::EpiResid E{(const __attribute__((address_space(1))) float*)(l == 0 ? P.x : P.out), (__attribute__((address_space(1))) float*)P.out, FP(WS_MOD) + modl + 2048, BF(WS_KVRAW), P.norm2_g + l * DM, FP(WS_MOD) + modl + 4096, FP(WS_SSQ) + 3 * NTOK};
            GEMM(pg8::EpiResid, E, BF(WS_H), WB(l, W_O), 1024, 1024, 1024);
        } break;
        case 8: {
            pg8::EpiSwiGLU E{BF(WS_HID), FP(WS_SSQ) + 3 * NTOK, FP(WS_BW2) + (size_t)l * 16 * 5632}; GEMM(pg8::EpiSwiGLU, E, BF(WS_KVRAW), WB(l, W_1), 5632, 1024, 1024);
        } break;
        default: {
            const bool nxt = l + 1 < DEPTH; const size_t modn = (size_t)(l + 1) * 16 * 6144;
            pg8::EpiResid E{(const __attribute__((address_space(1))) float*)P.out, (__attribute__((address_space(1))) float*)P.out, FP(WS_MOD) + modl + 5120, nxt ? BF(WS_H) : (bf16_t*)nullptr, P.norm1_g + (nxt ? (l + 1) * DM : 0), FP(WS_MOD) + (nxt ? modn + 1024 : 0), FP(WS_SSQ) + 2 * NTOK};
            GEMM(pg8::EpiResid, E, BF(WS_HID), WB(l, W_2), 1024, FFH, FFH);
        } break;
        }
        if (ph + 1 < ph_hi) { if (ph == ph_lo) grid.sync(); else xcd_barrier(xbar); }
    }
}

extern "C" void kernel_launch(void* const* d_in, const int* in_sizes, int n_in, void* d_out, int out_size, void* d_ws, size_t ws_size, hipStream_t stream) {
    static int grid = 0;
    if (grid == 0) {
        if (n_in != 23 || ws_size < WS_END) { fprintf(stderr, "kernel_launch: unexpected n_in %d / ws_size %zu\n", n_in, ws_size); grid = -1; return; }
        int dev = 0, cus = 0, per_cu = 0;
        (void)hipGetDevice(&dev); (void)hipDeviceGetAttribute(&cus, hipDeviceAttributeMultiprocessorCount, dev);
        if (hipFuncSetAttribute((const void*)mega_fwd, hipFuncAttributeMaxDynamicSharedMemorySize, LDS_BYTES) != hipSuccess) { fprintf(stderr, "kernel_launch: hipFuncSetAttribute failed\n"); grid = -1; return; }
        if (hipOccupancyMaxActiveBlocksPerMultiprocessor(&per_cu, (const void*)mega_fwd, NTHR, LDS_BYTES) != hipSuccess || per_cu < 1) { fprintf(stderr, "kernel_launch: occupancy query gave %d\n", per_cu); per_cu = 1; }
        (void)hipGetLastError();
        grid = cus * per_cu;
    }
    if (grid < 0) return;
    Params p{};
    const float** fp = (const float**)&p.x;
    p.x = (const float*)d_in[0]; p.c = (const float*)d_in[1]; p.pos = (const int*)d_in[2]; p.rel_bias = (const float*)d_in[3]; p.norm1_g = (const float*)d_in[4]; p.norm2_g = (const float*)d_in[5];
    p.ada_w = (const float*)d_in[6]; p.ada_b = (const float*)d_in[7]; p.w_in = (const float*)d_in[8]; p.q_a_norm = (const float*)d_in[9]; p.w_q_b = (const float*)d_in[10]; p.kv_a_norm = (const float*)d_in[11];
    p.w_kv_b = (const float*)d_in[12]; p.q_norm_a = (const float*)d_in[13]; p.k_norm_a = (const float*)d_in[14]; p.q_norm_b = (const float*)d_in[15]; p.k_norm_b = (const float*)d_in[16];
    p.w_branch_a = (const float*)d_in[17]; p.w_branch_b = (const float*)d_in[18]; p.w_out = (const float*)d_in[19]; p.w_ffn_gate = (const float*)d_in[20]; p.w_ffn_up = (const float*)d_in[21]; p.w_ffn_down = (const float*)d_in[22];
    (void)fp;
    p.out = (float*)d_out; p.ws = (unsigned char*)d_ws;
    for (int i = 0; i < 16; ++i) p.inv_freq[i] = (float)pow(10000.0, -(double)i / 16.0);
    p.ph_lo = 0; p.ph_hi = NPHASE;
    if (hipMemsetAsync((char*)d_ws + WS_CTL, 0, CTL_BYTES, stream) != hipSuccess) { fprintf(stderr, "kernel_launch: memset failed\n"); return; }
    void* args[] = {&p};
    hipError_t e = hipLaunchCooperativeKernel((const void*)mega_fwd, dim3(grid), dim3(NTHR), args, LDS_BYTES, stream);
    if (e != hipSuccess) fprintf(stderr, "kernel_launch: cooperative launch failed: %s (grid %d)\n", hipGetErrorString(e), grid);
}
```

```cpp
#include <hip/hip_runtime.h>
#include <hip/hip_cooperative_groups.h>
#include <cstdio>
#include <cstdint>
namespace cg = cooperative_groups;
__device__ __forceinline__ int otid() { int t = (int)threadIdx.x; asm volatile("" : "+v"(t)); return t; }
__device__ __forceinline__ int obid() { int b = (int)blockIdx.x; asm volatile("" : "+s"(b)); return b; }

#include <cmath>
namespace pg8 {
#define PG8_LAS __attribute__((address_space(3)))
typedef unsigned short bf16_t;
typedef short bf16x8 __attribute__((ext_vector_type(8)));
typedef float f32x4 __attribute__((ext_vector_type(4)));
typedef unsigned u32x4 __attribute__((ext_vector_type(4)));
constexpr int BM = 256, BK = 64, HALF = 128, HTB = HALF * BK * 2  , STAGE_BYTES = 8 * HTB, NXCD = 8, WGM = 8;

__host__ __device__ __forceinline__ int lds_byte(int r, int c) { const int st = (r >> 4) * 2 + (c >> 5), rr = r & 15, cc = c & 31, ob = rr * 64 + cc * 2; return st * 1024 + (ob ^ (((ob >> 9) & 1) << 5)); }
__host__ __device__ __forceinline__ void stage_rc(int b, int& R, int& C) { const int st = b / 1024, sb = b % 1024, swz = sb ^ (((sb >> 9) & 1) << 5); R = (st >> 1) * 16 + swz / 64; C = (st & 1) * 32 + (swz % 64) / 2; }
__host__ __device__ __forceinline__ int perm32(int rho) { const int n = rho >> 4, i = rho & 15; return 8 * (i >> 2) + 4 * n + (i & 3); }

struct Unit { int pm, pn; };
struct Gemm { const bf16_t* A; const bf16_t* Bt; int M, N, K, lda, asplit, aoff2; };

struct StaticOrder {
    int nM, nN, nwg, G, c;
    __host__ __device__ void init(int M, int N, int G_, int c_) { nM = M / BM; nN = N / BM; nwg = nM * nN; G = G_; c = c_; }
    __host__ __device__ bool next(int i, Unit& u) const {
        const long L = (long)i * G + c; if (L >= nwg) return false;
        int wgid = (int)L; { const int q = nwg / NXCD, r = nwg % NXCD, xcd = wgid % NXCD, off = wgid / NXCD; wgid = (xcd < r ? xcd * (q + 1) : r * (q + 1) + (xcd - r) * q) + off; }
        const int nig = WGM * nN, gid = wgid / nig, fm = gid * WGM, gsz = (nM - fm) < WGM ? (nM - fm) : WGM;
        u.pm = fm + ((wgid % nig) % gsz); u.pn = (wgid % nig) / gsz; return true;
    }
    __device__ __forceinline__ void a_ready(const Unit&) const {}
    __device__ __forceinline__ void done(const Unit&) const {}
};


__device__ __forceinline__ unsigned cvt_pk_bf16(float lo, float hi) { unsigned r; asm volatile("v_cvt_pk_bf16_f32 %0, %1, %2" : "=v"(r) : "v"(lo), "v"(hi)); return r; }
typedef unsigned u32x2 __attribute__((ext_vector_type(2)));
__device__ __forceinline__ float bf_lo(unsigned w) { return __builtin_bit_cast(float, w << 16); }
__device__ __forceinline__ float bf_hi(unsigned w) { return __builtin_bit_cast(float, w & 0xffff0000u); }
__device__ __forceinline__ float sigmoidf_(float x) { return 1.0f / (1.0f + __builtin_amdgcn_exp2f(-1.4426950408889634f * x)); }

constexpr float RMS_EPS = 1e-6f;
constexpr size_t DPLANE = (size_t)65536 * 512;
constexpr float LOG2E = 1.4426950408889634f;
constexpr float QSCALE_B = 0.125f * 1.4426950408889634f;
constexpr float QSCALE_A = 0.10206207261596575f * 1.4426950408889634f;

struct EpiIn {
    static constexpr bool PERM = false, AFTER_DRAIN = false, MIDHOOK = false;
    bf16_t* PA; bf16_t* DIL; bf16_t* GATES; float* ssq_q; float* ssq_kv; float* ssq_kr; const float* qn; const float* kn; const float* ssq1; const float* bw;
    __device__ __forceinline__ void operator()(const f32x4 (&acc_)[2][2][4][2], const Unit& u, int wr, int wc, int fr, int fq) const {
        { const int ln_ = otid() & 63; fr = ln_ & 15; fq = ln_ >> 4; }
        const int pn = u.pn; const size_t rowb = (size_t)u.pm * BM + wr * 64 + fr;
        f32x4 bv[2][2]; float r8[2][4];
        { const float* bwp = bw + (size_t)(u.pm >> 4) * 4096 + pn * BM + wc * 32 + fq * 4;
#pragma unroll
          for (int bj = 0; bj < 2; ++bj)
#pragma unroll
              for (int n = 0; n < 2; ++n) bv[bj][n] = *(const f32x4*)(bwp + bj * HALF + n * 16);
#pragma unroll
          for (int ai = 0; ai < 2; ++ai)
#pragma unroll
              for (int m = 0; m < 4; ++m) r8[ai][m] = __builtin_amdgcn_rsqf(ssq1[rowb + ai * HALF + m * 16] * (1.0f / 1024.0f) + RMS_EPS); }
#define EPIIN_VAL(ai, bj, m, n) (acc_[ai][bj][m][n] * r8[ai][m] + bv[bj][n])
        if (pn < 2) {
            float* sq = pn == 0 ? ssq_q : ssq_kv;
#pragma unroll
            for (int ai = 0; ai < 2; ++ai)
#pragma unroll
                for (int m = 0; m < 4; ++m) { const size_t row = rowb + ai * HALF + m * 16; float s = 0.f, s2 = 0.f;
#pragma unroll
                    for (int bj = 0; bj < 2; ++bj)
#pragma unroll
                        for (int n = 0; n < 2; ++n) { const f32x4 v = EPIIN_VAL(ai, bj, m, n);
                            u32x2 w; w.x = cvt_pk_bf16(v[0], v[1]); w.y = cvt_pk_bf16(v[2], v[3]);
                            *(u32x2*)(PA + row * 512 + pn * 256 + bj * HALF + wc * 32 + n * 16 + fq * 4) = w;
                            const float q = (v[0] * v[0] + v[1] * v[1]) + (v[2] * v[2] + v[3] * v[3]);
                            if (pn == 0 || bj == 0) s += q; else s2 += q; }
                    s += __shfl_xor(s, 16); s += __shfl_xor(s, 32);
                    if (fq == 0) atomicAdd(sq + row, s);
                    if (pn == 1 && wc == 0) { s2 += __shfl_xor(s2, 16); s2 += __shfl_xor(s2, 32); if (fq == 0) atomicAdd(ssq_kr + row, s2); } }
        } else if (pn < 6) {
            const int sec = (pn - 2) >> 1, head = 4 * ((pn - 2) & 1) + wc; const float* gp = sec == 0 ? qn : kn; const float gs = sec == 0 ? QSCALE_B : 1.0f;
            f32x4 gv[2][2];
#pragma unroll
            for (int bj = 0; bj < 2; ++bj)
#pragma unroll
                for (int n = 0; n < 2; ++n) gv[bj][n] = *(const f32x4*)(gp + 32 * bj + 16 * n + 4 * fq) * gs;
#pragma unroll
            for (int ai = 0; ai < 2; ++ai)
#pragma unroll
                for (int m = 0; m < 4; ++m) { const size_t row = rowb + ai * HALF + m * 16; float s = 0.f;
#pragma unroll
                    for (int bj = 0; bj < 2; ++bj)
#pragma unroll
                        for (int n = 0; n < 2; ++n) { const f32x4 v = EPIIN_VAL(ai, bj, m, n); s += (v[0] * v[0] + v[1] * v[1]) + (v[2] * v[2] + v[3] * v[3]); }
                    s += __shfl_xor(s, 16); s += __shfl_xor(s, 32);
                    const float r = __builtin_amdgcn_rsqf(s * (1.0f / 64.0f) + RMS_EPS);
#pragma unroll
                    for (int bj = 0; bj < 2; ++bj)
#pragma unroll
                        for (int n = 0; n < 2; ++n) { const f32x4 v = EPIIN_VAL(ai, bj, m, n) * r * gv[bj][n];
                            u32x2 w; w.x = cvt_pk_bf16(v[0], v[1]); w.y = cvt_pk_bf16(v[2], v[3]);
                            *(u32x2*)(DIL + (size_t)sec * DPLANE + ((((row >> 12) * 8 + head) << 12) + (row & 4095)) * 64 + 32 * bj + 16 * n + 4 * fq) = w; } }
        } else if (pn < 8) {
#pragma unroll
            for (int ai = 0; ai < 2; ++ai)
#pragma unroll
                for (int m = 0; m < 4; ++m) { const size_t row = rowb + ai * HALF + m * 16;
#pragma unroll
                    for (int bj = 0; bj < 2; ++bj)
#pragma unroll
                        for (int n = 0; n < 2; ++n) { const f32x4 v = EPIIN_VAL(ai, bj, m, n);
                            u32x2 w; w.x = cvt_pk_bf16(v[0], v[1]); w.y = cvt_pk_bf16(v[2], v[3]);
                            *(u32x2*)(DIL + 2 * DPLANE + ((((row >> 12) * 8 + (pn - 6) * 4 + 2 * bj + (wc >> 1)) << 12) + (row & 4095)) * 64 + 32 * (wc & 1) + n * 16 + fq * 4) = w; } }
        } else {
#pragma unroll
            for (int ai = 0; ai < 2; ++ai)
#pragma unroll
                for (int m = 0; m < 4; ++m) { const size_t row = rowb + ai * HALF + m * 16;
#pragma unroll
                    for (int bj = 0; bj < 2; ++bj)
#pragma unroll
                        for (int n = 0; n < 2; ++n) { const f32x4 v = EPIIN_VAL(ai, bj, m, n);
                            u32x2 w; w.x = cvt_pk_bf16(sigmoidf_(v[0]), sigmoidf_(v[1])); w.y = cvt_pk_bf16(sigmoidf_(v[2]), sigmoidf_(v[3]));
                            *(u32x2*)(GATES + row * 2048 + (pn - 8) * 256 + bj * HALF + wc * 32 + n * 16 + fq * 4) = w; } }
        }
    }
};
#undef EPIIN_VAL
struct EpiRowScale2 {
    static constexpr bool PERM = true, AFTER_DRAIN = false, MIDHOOK = false;
    unsigned char* ws; const float* kg;
    static constexpr size_t O_Q = 0, O_PA = 128u << 20, O_K = 768u << 20, O_V = 864u << 20, O_ROPE = 990u << 20, O_SSQ = 998u << 20, O_SSQKR = (1001u << 20) + 65536;
    __device__ __forceinline__ void operator()(const f32x4 (&acc)[2][2][4][2], const Unit& u, int wr, int wc, int fr, int fq) const {
        { const int ln_ = otid() & 63; fr = ln_ & 15; fq = ln_ >> 4; }
        bf16_t* Oq = (bf16_t*)(ws + O_Q); bf16_t* Kp = (bf16_t*)(ws + O_K); bf16_t* Vp = (bf16_t*)(ws + O_V); const bf16_t* PA = (const bf16_t*)(ws + O_PA); const float* ROPE = (const float*)(ws + O_ROPE);
        const float* ssq_q = (const float*)(ws + O_SSQ); const float* ssq_kv = ssq_q + 65536; const float* ssq_kr = (const float*)(ws + O_SSQKR);
        const size_t rowb = (size_t)u.pm * BM + wr * 64 + fr;
        if (u.pn < 3) {
            const int col0 = u.pn * BM + wc * 32 + 8 * fq;
#pragma unroll
            for (int ai = 0; ai < 2; ++ai)
#pragma unroll
                for (int m = 0; m < 4; ++m) { const size_t row = rowb + ai * HALF + m * 16; const float r = __builtin_amdgcn_rsqf(ssq_q[row] * (1.0f / 256.0f) + RMS_EPS);
#pragma unroll
                    for (int bj = 0; bj < 2; ++bj) { const f32x4 v0 = acc[ai][bj][m][0] * r, v1 = acc[ai][bj][m][1] * r;
                        u32x4 w; w.x = cvt_pk_bf16(v0[0], v0[1]); w.y = cvt_pk_bf16(v0[2], v0[3]); w.z = cvt_pk_bf16(v1[0], v1[1]); w.w = cvt_pk_bf16(v1[2], v1[3]);
                        *(u32x4*)(Oq + row * 768 + col0 + bj * HALF) = w; } }
        } else {
            const int head = (u.pn - 3) * 2 + (wc & 1); float rh8[2][4];
#pragma unroll
            for (int ai = 0; ai < 2; ++ai)
#pragma unroll
                for (int m = 0; m < 4; ++m) { const size_t row = rowb + ai * HALF + m * 16; const float r = __builtin_amdgcn_rsqf(ssq_kv[row] * (1.0f / 128.0f) + RMS_EPS);
                    const size_t hrow = ((((row >> 12) * 8 + head) << 12) + (row & 4095));
                    if (wc >= 2) {
#pragma unroll
                        for (int bj = 0; bj < 2; ++bj) { const f32x4 a = acc[ai][bj][m][0] * r, b = acc[ai][bj][m][1] * r;
                            u32x4 w; w.x = cvt_pk_bf16(a[0], a[1]); w.y = cvt_pk_bf16(a[2], a[3]); w.z = cvt_pk_bf16(b[0], b[1]); w.w = cvt_pk_bf16(b[2], b[3]);
                            *(u32x4*)(Vp + hrow * 64 + 32 * bj + 8 * fq) = w; }
                    } else {
                        float s = 0.f;
#pragma unroll
                        for (int bj = 0; bj < 2; ++bj) { const f32x4 a = acc[ai][bj][m][0], b = acc[ai][bj][m][1]; s += ((a[0] * a[0] + a[1] * a[1]) + (a[2] * a[2] + a[3] * a[3])) + ((b[0] * b[0] + b[1] * b[1]) + (b[2] * b[2] + b[3] * b[3])); }
                        s += __shfl_xor(s, 16); s += __shfl_xor(s, 32);
                        const float rh = __builtin_amdgcn_rsqf((s * r * r + ssq_kr[row]) * (1.0f / 96.0f) + RMS_EPS); const float rr = r * rh;
#pragma unroll
                        for (int bj = 0; bj < 2; ++bj) { const f32x4 a = acc[ai][bj][m][0] * rr * *(const f32x4*)(kg + 32 * bj + 8 * fq), b = acc[ai][bj][m][1] * rr * *(const f32x4*)(kg + 32 * bj + 8 * fq + 4);
                            u32x4 w; w.x = cvt_pk_bf16(a[0], a[1]); w.y = cvt_pk_bf16(a[2], a[3]); w.z = cvt_pk_bf16(b[0], b[1]); w.w = cvt_pk_bf16(b[2], b[3]);
                            *(u32x4*)(Kp + hrow * 96 + 32 * bj + 8 * fq) = w; }
                        rh8[ai][m] = rh;
                    }
                    asm volatile("" ::: "memory"); }
            if (wc < 2) {
#pragma unroll
                for (int ai = 0; ai < 2; ++ai)
#pragma unroll
                    for (int m = 0; m < 4; ++m) { const size_t row = rowb + ai * HALF + m * 16; const size_t hrow = ((((row >> 12) * 8 + head) << 12) + (row & 4095)); const float rh = rh8[ai][m];
                        const bf16_t* krp = PA + row * 512 + 384; const float* rp = ROPE + row * 32;
#pragma unroll
                        for (int e = 0; e < 2; ++e) { const int i0 = 4 * fq + 2 * e;
                            const unsigned xa = *(const unsigned*)(krp + i0), xb = *(const unsigned*)(krp + 16 + i0);
                            const float c0 = rp[i0], c1 = rp[i0 + 1], s0 = rp[16 + i0], s1 = rp[16 + i0 + 1];
                            const float a0 = bf_lo(xa) * rh * kg[64 + i0], a1 = bf_hi(xa) * rh * kg[64 + i0 + 1], b0 = bf_lo(xb) * rh * kg[80 + i0], b1 = bf_hi(xb) * rh * kg[80 + i0 + 1];
                            *(unsigned*)(Kp + hrow * 96 + 64 + i0) = cvt_pk_bf16(a0 * c0 - b0 * s0, a1 * c1 - b1 * s1);
                            *(unsigned*)(Kp + hrow * 96 + 80 + i0) = cvt_pk_bf16(b0 * c0 + a0 * s0, b1 * c1 + a1 * s1); }
                        asm volatile("" ::: "memory"); }
            }
        }
    }
};
struct EpiRowScale {
    static constexpr bool PERM = true, AFTER_DRAIN = false, MIDHOOK = false;
    bf16_t* O; int ldc; const float* ssq; float invk;
    __device__ __forceinline__ void operator()(const f32x4 (&acc)[2][2][4][2], const Unit& u, int wr, int wc, int fr, int fq) const {
        { const int ln_ = otid() & 63; fr = ln_ & 15; fq = ln_ >> 4; }
        const size_t rowb = (size_t)u.pm * BM + wr * 64 + fr; const int col0 = u.pn * BM + wc * 32 + 8 * fq;
#pragma unroll
        for (int ai = 0; ai < 2; ++ai)
#pragma unroll
            for (int m = 0; m < 4; ++m) { const size_t row = rowb + ai * HALF + m * 16; const float r = __builtin_amdgcn_rsqf(ssq[row] * invk + RMS_EPS);
#pragma unroll
                for (int bj = 0; bj < 2; ++bj) { const f32x4 v0 = acc[ai][bj][m][0] * r, v1 = acc[ai][bj][m][1] * r;
                    u32x4 w; w.x = cvt_pk_bf16(v0[0], v0[1]); w.y = cvt_pk_bf16(v0[2], v0[3]); w.z = cvt_pk_bf16(v1[0], v1[1]); w.w = cvt_pk_bf16(v1[2], v1[3]);
                    *(u32x4*)(O + row * ldc + col0 + bj * HALF) = w; } }
    }
};
struct EpiGate2 {
    static constexpr bool PERM = true, AFTER_DRAIN = false, MIDHOOK = true;
    bf16_t* O; const bf16_t* SIG;
    __device__ __forceinline__ void mid(f32x4 (&acc)[2][2][4][2], const Unit& u, int wr, int wc) const {
        const int ln_ = otid() & 63, fr = ln_ & 15, fq = ln_ >> 4;
        const size_t rowb = (size_t)u.pm * BM + wr * 64 + fr; const int col0 = u.pn * BM + wc * 32 + 8 * fq;
#pragma unroll
        for (int ai = 0; ai < 2; ++ai)
#pragma unroll
            for (int m = 0; m < 4; ++m) { const bf16_t* sp = SIG + (rowb + ai * HALF + m * 16) * 2048 + col0;
#pragma unroll
                for (int bj = 0; bj < 2; ++bj) { const u32x4 sa = *(const u32x4*)(sp + bj * HALF), sb = *(const u32x4*)(sp + 1024 + bj * HALF);
                    f32x4& v0 = acc[ai][bj][m][0]; f32x4& v1 = acc[ai][bj][m][1];
                    v0[0] *= bf_lo(sa.x) * __builtin_amdgcn_rcpf(1e-30f + bf_lo(sb.x)); v0[1] *= bf_hi(sa.x) * __builtin_amdgcn_rcpf(1e-30f + bf_hi(sb.x));
                    v0[2] *= bf_lo(sa.y) * __builtin_amdgcn_rcpf(1e-30f + bf_lo(sb.y)); v0[3] *= bf_hi(sa.y) * __builtin_amdgcn_rcpf(1e-30f + bf_hi(sb.y));
                    v1[0] *= bf_lo(sa.z) * __builtin_amdgcn_rcpf(1e-30f + bf_lo(sb.z)); v1[1] *= bf_hi(sa.z) * __builtin_amdgcn_rcpf(1e-30f + bf_hi(sb.z));
                    v1[2] *= bf_lo(sa.w) * __builtin_amdgcn_rcpf(1e-30f + bf_lo(sb.w)); v1[3] *= bf_hi(sa.w) * __builtin_amdgcn_rcpf(1e-30f + bf_hi(sb.w)); }
                asm volatile("" ::: "memory"); }
    }
    __device__ __forceinline__ void operator()(const f32x4 (&acc)[2][2][4][2], const Unit& u, int wr, int wc, int fr, int fq) const {
        { const int ln_ = otid() & 63; fr = ln_ & 15; fq = ln_ >> 4; }
        const size_t rowb = (size_t)u.pm * BM + wr * 64 + fr; const int col0 = u.pn * BM + wc * 32 + 8 * fq;
#pragma unroll
        for (int ai = 0; ai < 2; ++ai)
#pragma unroll
            for (int m = 0; m < 4; ++m) { const size_t row = rowb + ai * HALF + m * 16;
#pragma unroll
                for (int bj = 0; bj < 2; ++bj) { const u32x4 sg = *(const u32x4*)(SIG + row * 2048 + 1024 + col0 + bj * HALF);
                    f32x4 v0 = acc[ai][bj][m][0], v1 = acc[ai][bj][m][1];
                    v0[0] *= bf_lo(sg.x); v0[1] *= bf_hi(sg.x); v0[2] *= bf_lo(sg.y); v0[3] *= bf_hi(sg.y);
                    v1[0] *= bf_lo(sg.z); v1[1] *= bf_hi(sg.z); v1[2] *= bf_lo(sg.w); v1[3] *= bf_hi(sg.w);
                    u32x4 w; w.x = cvt_pk_bf16(v0[0], v0[1]); w.y = cvt_pk_bf16(v0[2], v0[3]); w.z = cvt_pk_bf16(v1[0], v1[1]); w.w = cvt_pk_bf16(v1[2], v1[3]);
                    *(u32x4*)(O + row * 1024 + col0 + bj * HALF) = w; } }
    }
};
struct EpiResid {
    static constexpr bool PERM = false, AFTER_DRAIN = false, MIDHOOK = false;
    const __attribute__((address_space(1))) float* xin; __attribute__((address_space(1))) float* out; const float* gmod;
    bf16_t* XG; const float* gnorm; const float* scmod; float* ssq;
    __device__ __forceinline__ void operator()(const f32x4 (&acc)[2][2][4][2], const Unit& u, int wr, int wc, int fr, int fq) const {
        { const int ln_ = otid() & 63; fr = ln_ & 15; fq = ln_ >> 4; }
        const size_t rowb = (size_t)u.pm * BM + wr * 64 + fr; const int col0 = u.pn * BM + wc * 32 + 4 * fq; const float* gb = gmod + (size_t)(u.pm >> 4) * 6144;
        f32x4 gv[2][2], Gv[2][2];
#pragma unroll
        for (int bj = 0; bj < 2; ++bj)
#pragma unroll
            for (int n = 0; n < 2; ++n) { gv[bj][n] = *(const f32x4*)(gb + col0 + bj * HALF + n * 16);
                if (XG) Gv[bj][n] = *(const f32x4*)(gnorm + col0 + bj * HALF + n * 16) * (1.0f + *(const f32x4*)(scmod + (size_t)(u.pm >> 4) * 6144 + col0 + bj * HALF + n * 16)); }
#pragma unroll
        for (int ai = 0; ai < 2; ++ai)
#pragma unroll
            for (int m = 0; m < 4; ++m) { const size_t row = rowb + ai * HALF + m * 16; const size_t off = row * 1024 + col0; float s = 0.f;
#pragma unroll
                for (int bj = 0; bj < 2; ++bj)
#pragma unroll
                    for (int n = 0; n < 2; ++n) { const f32x4 xv = *(const __attribute__((address_space(1))) f32x4*)(xin + off + bj * HALF + n * 16);
                        const f32x4 xn = xv + gv[bj][n] * acc[ai][bj][m][n];
                        *(__attribute__((address_space(1))) f32x4*)(out + off + bj * HALF + n * 16) = xn;
                        if (XG) { s += (xn[0] * xn[0] + xn[1] * xn[1]) + (xn[2] * xn[2] + xn[3] * xn[3]); const f32x4 t = xn * Gv[bj][n];
                            u32x2 w; w.x = cvt_pk_bf16(t[0], t[1]); w.y = cvt_pk_bf16(t[2], t[3]); *(u32x2*)(XG + off + bj * HALF + n * 16) = w; } }
                if (XG) { s += __shfl_xor(s, 16); s += __shfl_xor(s, 32); if (fq == 0) atomicAdd(ssq + row, s); } }
    }
};
struct EpiSwiGLU {
    static constexpr bool PERM = true, AFTER_DRAIN = false, MIDHOOK = false;
    bf16_t* O; const float* ssq2; const float* bw;
    __device__ __forceinline__ void operator()(const f32x4 (&acc)[2][2][4][2], const Unit& u, int wr, int wc, int fr, int fq) const {
        { const int ln_ = otid() & 63; fr = ln_ & 15; fq = ln_ >> 4; }
        const size_t rowb = (size_t)u.pm * BM + wr * 64 + fr; const int col0 = u.pn * HALF + wc * 32 + 8 * fq;
        const float* bwp = bw + (size_t)(u.pm >> 4) * 5632 + u.pn * BM + wc * 32 + 8 * fq;
        const f32x4 bg0 = *(const f32x4*)bwp, bg1 = *(const f32x4*)(bwp + 4), bu0 = *(const f32x4*)(bwp + HALF), bu1 = *(const f32x4*)(bwp + HALF + 4);
#pragma unroll
        for (int ai = 0; ai < 2; ++ai)
#pragma unroll
            for (int m = 0; m < 4; ++m) { const size_t row = rowb + ai * HALF + m * 16; const float r = __builtin_amdgcn_rsqf(ssq2[row] * (1.0f / 1024.0f) + RMS_EPS);
                f32x4 g0 = acc[ai][0][m][0] * r + bg0, g1 = acc[ai][0][m][1] * r + bg1; const f32x4 u0 = acc[ai][1][m][0] * r + bu0, u1 = acc[ai][1][m][1] * r + bu1;
#pragma unroll
                for (int i = 0; i < 4; ++i) { g0[i] = g0[i] * sigmoidf_(g0[i]) * u0[i]; g1[i] = g1[i] * sigmoidf_(g1[i]) * u1[i]; }
                u32x4 w; w.x = cvt_pk_bf16(g0[0], g0[1]); w.y = cvt_pk_bf16(g0[2], g0[3]); w.z = cvt_pk_bf16(g1[0], g1[1]); w.w = cvt_pk_bf16(g1[2], g1[3]);
                *(u32x4*)(O + row * 2816 + col0) = w; }
    }
};

template <class Epi, class Sched, bool ALIGN_EPI = false, bool SP2 = false>
__device__ __forceinline__ void gemm_phase(PG8_LAS unsigned char* lds, const Gemm g, const Sched& S, const Epi& E) {
    const int tid = otid(), wid = __builtin_amdgcn_readfirstlane(tid >> 6), lane = tid & 63, wr = wid >> 2, wc = wid & 3, fr = lane & 15, fq = lane >> 4;
    const int K = g.K, lda = g.lda, nt = K / BK;
    unsigned voffA[2], voffB[2];
#pragma unroll
    for (int i = 0; i < 2; ++i) { int R, C; stage_rc(tid * 16 + i * 8192, R, C); const int Rb = Epi::PERM ? ((R & ~31) + perm32(R & 31)) : R;
        voffA[i] = (unsigned)(R * lda + C) * 2u; voffB[i] = (unsigned)(Rb * K + C) * 2u; }
    const size_t kstep = (size_t)(BK * 2);
    const size_t hstepB = (size_t)HALF * K * 2, hstepA = (size_t)HALF * lda * 2;
    const size_t tstepB = 2 * hstepB, tstepA = 2 * hstepA;
    const unsigned ldsw = (unsigned)wid * 1024u;
    const int aoff = lds_byte(wr * 64 + fr, fq * 8), boff = lds_byte(wc * 32 + fr, fq * 8);
#define PG8_SA(b, h) (((b) * 2 + (h)) * HTB)
#define PG8_SB(b, h) ((4 + (b) * 2 + (h)) * HTB)
#define PG8_STAGE(bufoff, gbase, voff) do { _Pragma("unroll") for (int _i = 0; _i < 2; ++_i) \
        __builtin_amdgcn_global_load_lds((const unsigned*)((const char*)(gbase) + (voff)[_i]), (PG8_LAS unsigned*)(lds + (bufoff) + ldsw + _i * 8192), 16, 0, 0); } while (0)
#define PG8_LDA(dst, b, h) do { _Pragma("unroll") for (int m = 0; m < 4; ++m) _Pragma("unroll") for (int k = 0; k < 2; ++k) dst[m][k] = *(const PG8_LAS bf16x8*)(lds + PG8_SA(b, h) + aoff + m * 2048 + k * 1024); } while (0)
#define PG8_LDB(dst, b, h) do { _Pragma("unroll") for (int n = 0; n < 2; ++n) _Pragma("unroll") for (int k = 0; k < 2; ++k) dst[n][k] = *(const PG8_LAS bf16x8*)(lds + PG8_SB(b, h) + boff + n * 2048 + k * 1024); } while (0)
#define PG8_MMA(ai, bj, At, Bt) do { __builtin_amdgcn_s_setprio(1); _Pragma("unroll") for (int m = 0; m < 4; ++m) _Pragma("unroll") for (int n = 0; n < 2; ++n) _Pragma("unroll") for (int k = 0; k < 2; ++k) \
        acc[ai][bj][m][n] = __builtin_amdgcn_mfma_f32_16x16x32_bf16(Bt[n][k], At[m][k], acc[ai][bj][m][n], 0, 0, 0); __builtin_amdgcn_s_setprio(0); } while (0)
#define PG8_WAIT_V(n) asm volatile("s_waitcnt vmcnt(" #n ")" ::: "memory")
#define PG8_WAIT_L(n) asm volatile("s_waitcnt lgkmcnt(" #n ")" ::: "memory")
#define PG8_BAR __builtin_amdgcn_s_barrier()
#define PG8_SCHED __builtin_amdgcn_sched_barrier(0)
    Unit cur, nxt; int ui = 0;
    if (!S.next(0, cur)) return;
    f32x4 acc[2][2][4][2];
#pragma unroll
    for (int a = 0; a < 2; ++a)
#pragma unroll
        for (int b = 0; b < 2; ++b)
#pragma unroll
            for (int m = 0; m < 4; ++m)
#pragma unroll
                for (int n = 0; n < 2; ++n) acc[a][b][m][n] = (f32x4){0.f, 0.f, 0.f, 0.f};
    bf16x8 At[4][2], B0[2][2], B1[2][2];
    const char* cA = (const char*)g.A + (size_t)cur.pm * tstepA + (cur.pn >= g.asplit ? (size_t)g.aoff2 * 2 : 0); const char* cB = (const char*)g.Bt + (size_t)cur.pn * tstepB;
    S.a_ready(cur);
    if constexpr (SP2) {
        PG8_STAGE(PG8_SB(0, 0), cB, voffB); PG8_STAGE(PG8_SB(0, 1), cB + hstepB, voffB); PG8_STAGE(PG8_SA(0, 0), cA, voffA); PG8_STAGE(PG8_SA(0, 1), cA + hstepA, voffA);
        if (wr == 1) PG8_BAR;
        PG8_WAIT_V(2); PG8_BAR;
        PG8_STAGE(PG8_SB(1, 0), cB + kstep, voffB); PG8_STAGE(PG8_SA(1, 0), cA + kstep, voffA); PG8_STAGE(PG8_SB(1, 1), cB + hstepB + kstep, voffB);
        PG8_WAIT_V(6); PG8_BAR;
    } else {
        PG8_STAGE(PG8_SB(0, 0), cB, voffB); PG8_STAGE(PG8_SA(0, 0), cA, voffA); PG8_STAGE(PG8_SB(0, 1), cB + hstepB, voffB); PG8_STAGE(PG8_SA(0, 1), cA + hstepA, voffA);
        if (wr == 1) PG8_BAR;
        PG8_WAIT_V(4); PG8_BAR;
        PG8_STAGE(PG8_SB(1, 0), cB + kstep, voffB); PG8_STAGE(PG8_SA(1, 0), cA + kstep, voffA); PG8_STAGE(PG8_SB(1, 1), cB + hstepB + kstep, voffB);
        PG8_WAIT_V(6); PG8_BAR;
    }
    for (;;) {
        const bool has_next = S.next(ui + 1, nxt);
        const char* nA = has_next ? (const char*)g.A + (size_t)nxt.pm * tstepA + (nxt.pn >= g.asplit ? (size_t)g.aoff2 * 2 : 0) : cA; const char* nB = has_next ? (const char*)g.Bt + (size_t)nxt.pn * tstepB : cB;
        for (int t = 0; t < nt; t += 2) {
            const bool last = (t == nt - 2);
            if constexpr (Epi::MIDHOOK) { if (t == (nt >> 1)) E.mid(acc, cur, wr, wc); }
            const char* a1 = cA + (size_t)(t + 1) * kstep;
            const char* a2 = last ? nA : cA + (size_t)(t + 2) * kstep; const char* b2 = last ? nB : cB + (size_t)(t + 2) * kstep;
            const char* a3 = a2 + kstep; const char* b3 = b2 + kstep;
            if (last && has_next) S.a_ready(nxt);
            if constexpr (SP2) {
            PG8_LDB(B0, 0, 0); PG8_LDB(B1, 0, 1); PG8_SCHED; PG8_LDA(At, 0, 0); PG8_STAGE(PG8_SA(1, 1), a1 + hstepA, voffA);
            PG8_WAIT_V(8); PG8_WAIT_L(0); PG8_BAR; PG8_MMA(0, 0, At, B0); PG8_MMA(0, 1, At, B1); PG8_BAR; PG8_SCHED;
            PG8_LDA(At, 0, 1); PG8_STAGE(PG8_SB(0, 0), b2, voffB); PG8_STAGE(PG8_SB(0, 1), b2 + hstepB, voffB); PG8_STAGE(PG8_SA(0, 0), a2, voffA);
            PG8_WAIT_V(8); PG8_WAIT_L(0); PG8_BAR; PG8_MMA(1, 0, At, B0); PG8_MMA(1, 1, At, B1); PG8_BAR; PG8_SCHED;
            PG8_LDB(B0, 1, 0); PG8_LDB(B1, 1, 1); PG8_SCHED; PG8_LDA(At, 1, 0); PG8_STAGE(PG8_SA(0, 1), a2 + hstepA, voffA);
            PG8_WAIT_V(8); PG8_WAIT_L(0); PG8_BAR; PG8_MMA(0, 0, At, B0); PG8_MMA(0, 1, At, B1); PG8_BAR; PG8_SCHED;
            PG8_LDA(At, 1, 1); PG8_STAGE(PG8_SB(1, 0), b3, voffB); PG8_STAGE(PG8_SB(1, 1), b3 + hstepB, voffB); PG8_STAGE(PG8_SA(1, 0), a3, voffA);
            PG8_WAIT_V(8); PG8_WAIT_L(0); PG8_BAR; PG8_MMA(1, 0, At, B0); PG8_MMA(1, 1, At, B1); PG8_BAR; PG8_SCHED;
            } else {
            PG8_LDB(B0, 0, 0); PG8_SCHED; PG8_LDA(At, 0, 0); PG8_STAGE(PG8_SA(1, 1), a1 + hstepA, voffA);
            PG8_WAIT_L(8); PG8_BAR; PG8_WAIT_L(0); PG8_MMA(0, 0, At, B0); PG8_BAR; PG8_SCHED;
            PG8_LDB(B1, 0, 1); PG8_STAGE(PG8_SB(0, 0), b2, voffB);
            PG8_BAR; PG8_WAIT_L(0); PG8_MMA(0, 1, At, B1); PG8_BAR;
            PG8_LDA(At, 0, 1); PG8_STAGE(PG8_SA(0, 0), a2, voffA);
            PG8_BAR; PG8_WAIT_L(0); PG8_MMA(1, 0, At, B0); PG8_BAR; PG8_SCHED;
            PG8_STAGE(PG8_SB(0, 1), b2 + hstepB, voffB);
            PG8_WAIT_V(6); PG8_BAR; PG8_MMA(1, 1, At, B1); PG8_BAR;
            PG8_LDB(B0, 1, 0); PG8_SCHED; PG8_LDA(At, 1, 0); PG8_STAGE(PG8_SA(0, 1), a2 + hstepA, voffA);
            PG8_WAIT_L(8); PG8_BAR; PG8_WAIT_L(0); PG8_MMA(0, 0, At, B0); PG8_BAR; PG8_SCHED;
            PG8_LDB(B1, 1, 1); PG8_STAGE(PG8_SB(1, 0), b3, voffB);
            PG8_BAR; PG8_WAIT_L(0); PG8_MMA(0, 1, At, B1); PG8_BAR;
            PG8_LDA(At, 1, 1); PG8_STAGE(PG8_SA(1, 0), a3, voffA);
            PG8_BAR; PG8_WAIT_L(0); PG8_MMA(1, 0, At, B0); PG8_BAR; PG8_SCHED;
            PG8_STAGE(PG8_SB(1, 1), b3 + hstepB, voffB);
            PG8_WAIT_V(6); PG8_BAR; PG8_MMA(1, 1, At, B1); PG8_BAR;
            }
        }
        if constexpr (ALIGN_EPI) { if (wr == 0) PG8_BAR; }
        if constexpr (!Epi::AFTER_DRAIN) { E(acc, cur, wr, wc, fr, fq); S.done(cur); }
        if (!has_next) break;
#pragma unroll
        for (int a = 0; a < 2; ++a)
#pragma unroll
            for (int b = 0; b < 2; ++b)
#pragma unroll
                for (int m = 0; m < 4; ++m)
#pragma unroll
                    for (int n = 0; n < 2; ++n) acc[a][b][m][n] = (f32x4){0.f, 0.f, 0.f, 0.f};
        cur = nxt; cA = nA; cB = nB; ++ui;
        if constexpr (ALIGN_EPI) { if (wr == 1) PG8_BAR; }
    }
    PG8_WAIT_V(0);
    if constexpr (!ALIGN_EPI) { if (wr == 0) PG8_BAR; }
    PG8_BAR;
    if constexpr (Epi::AFTER_DRAIN) { E.fused(acc, cur, wr, wc, fr, fq, lds, wid, lane); S.done(cur); }
#undef PG8_SA
#undef PG8_SB
#undef PG8_STAGE
#undef PG8_LDA
#undef PG8_LDB
#undef PG8_MMA
#undef PG8_WAIT_V
#undef PG8_WAIT_L
#undef PG8_BAR
#undef PG8_SCHED
}
}

constexpr int NB = 16, SEQ = 4096, DM = 1024, DEPTH = 4, NTOK = NB * SEQ, NH = 8, FFH = 2816, NIN = 4096, INC = 4000;
constexpr int NWAVES = 8, NTHR = 512;
constexpr int LDS_BYTES = 147456, RING_BYTES = 131072;
constexpr size_t MiB = 1u << 20;
constexpr size_t WS_H = 0;
constexpr size_t WS_PA = 128 * MiB;
constexpr size_t WS_DIL = 192 * MiB;
constexpr size_t WS_GATES = 384 * MiB;
constexpr size_t WS_HID = 128 * MiB;
constexpr size_t WS_KVRAW = 640 * MiB;
constexpr size_t WS_K = 768 * MiB;
constexpr size_t WS_V = 864 * MiB;
constexpr size_t WS_W = 928 * MiB, WS_WSTRIDE = 30 * MiB;
constexpr size_t W_IN = 0, W_Q = W_IN + (size_t)NIN * 1024 * 2, W_KV = W_Q + 768 * 256 * 2, W_A = W_KV + 1024 * 256 * 2, W_B = W_A + 1024 * 512 * 2,
                 W_O = W_B + 1024 * 512 * 2, W_1 = W_O + 1024 * 1024 * 2, W_2 = W_1 + (size_t)5632 * 1024 * 2, W_END = W_2 + (size_t)1024 * 2816 * 2;
constexpr size_t WS_MOD = 988 * MiB;
constexpr size_t WS_ROPE = 990 * MiB;
constexpr size_t WS_SSQ = 998 * MiB;
constexpr size_t WS_LSE = 999 * MiB;
constexpr size_t WS_BT = 1001 * MiB;
constexpr size_t WS_SSQKR = 1001 * MiB + 65536;
constexpr size_t WS_BW1 = 1002 * MiB;
constexpr size_t WS_BW2 = 1003 * MiB;
constexpr size_t WS_CTL = 1005 * MiB, CTL_BYTES = 65536;
constexpr size_t WS_END = 1006 * MiB;
static_assert(W_END <= WS_WSTRIDE && WS_W + 2 * WS_WSTRIDE <= WS_MOD, "weights fit");
static_assert(pg8::EpiRowScale2::O_Q == WS_H && pg8::EpiRowScale2::O_PA == WS_PA && pg8::EpiRowScale2::O_K == WS_K && pg8::EpiRowScale2::O_V == WS_V && pg8::EpiRowScale2::O_ROPE == WS_ROPE && pg8::EpiRowScale2::O_SSQ == WS_SSQ && pg8::EpiRowScale2::O_SSQKR == WS_SSQKR, "EpiRowScale2 offsets");
static_assert(WS_HID + (size_t)NTOK * FFH * 2 <= WS_KVRAW, "hid overlay");

#define LAS __attribute__((address_space(3)))
typedef unsigned short bf16_t;
typedef short bf16x8 __attribute__((ext_vector_type(8)));
typedef short s16x4 __attribute__((ext_vector_type(4)));
typedef float f32x4 __attribute__((ext_vector_type(4)));
typedef float f32x16 __attribute__((ext_vector_type(16)));
typedef unsigned u32x4 __attribute__((ext_vector_type(4)));
typedef unsigned u32x2 __attribute__((ext_vector_type(2)));
using pg8::cvt_pk_bf16; using pg8::bf_lo; using pg8::bf_hi;

struct Params {
    const float *x, *c; const int* pos; const float *rel_bias, *norm1_g, *norm2_g, *ada_w, *ada_b, *w_in, *q_a_norm, *w_q_b, *kv_a_norm, *w_kv_b, *q_norm_a, *k_norm_a, *q_norm_b, *k_norm_b,
        *w_branch_a, *w_branch_b, *w_out, *w_ffn_gate, *w_ffn_up, *w_ffn_down;
    float* out; unsigned char* ws;
    float inv_freq[16];
    int ph_lo, ph_hi;
};

__device__ __forceinline__ float wave_sum(float v) {
#pragma unroll
    for (int o = 1; o < 64; o <<= 1) v += __shfl_xor(v, o);
    return v;
}
#define LDS_WAIT() asm volatile("s_waitcnt lgkmcnt(0)" ::: "memory")

__device__ __forceinline__ void phase0(const Params& P, LAS unsigned char* lds, int G) {
    const int tid = otid(), lane = tid & 63, wid = __builtin_amdgcn_readfirstlane(tid >> 6);
    float* MOD = (float*)(P.ws + WS_MOD); float* ROPE = (float*)(P.ws + WS_ROPE); float* BT = (float*)(P.ws + WS_BT);
    const int gtid = obid() * NTHR + tid, nthr = G * NTHR;
    for (int idx = gtid; idx < NTOK * 16; idx += nthr) { const int t = idx >> 4, i = idx & 15;
        const float ang = (float)P.pos[t] * P.inv_freq[i];
        double rev = (double)ang * 0.15915494309189535; rev -= __builtin_rint(rev); const float f = (float)rev;
        ROPE[t * 32 + i] = __builtin_amdgcn_cosf(f); ROPE[t * 32 + 16 + i] = __builtin_amdgcn_sinf(f); }
    for (int idx = gtid; idx < 3 * 8 * 129; idx += nthr) { const int j = idx % 129, h = (idx / 129) & 7, p = idx / (129 * 8);
        const int dil = p == 0 ? 1 : (p == 1 ? 4 : 16); const int rp = (j - 64) * dil; const int n = rp < 0 ? -rp : rp; int bk = rp > 0 ? 16 : 0;
        if (n < 8) bk += n; else { const float nf = (float)n; int lg = 8 + (int)(__logf(nf * 0.125f) / 4.852030263919617f * 8.0f); bk += lg < 15 ? lg : 15; }
        BT[idx] = P.rel_bias[bk * 8 + h] * pg8::LOG2E; }
    LAS float* sC = (LAS float*)lds;
    LAS float* red = (LAS float*)(lds + 65536);
    for (int i = tid; i < 16 * 1024; i += NTHR) { const float v = P.c[i]; sC[i] = v / (1.0f + __expf(-v)); }
    __syncthreads();
    for (int it = obid(); it < 4 * 96; it += G) { const int l = it / 96, cb = it % 96; const int col = cb * 64 + lane;
        float a[16];
#pragma unroll
        for (int b = 0; b < 16; ++b) a[b] = 0.f;
        const float* wp = P.ada_w + ((size_t)l * 1024 + wid * 128) * 6144 + col;
#pragma unroll 16
        for (int k = 0; k < 128; ++k) { const float w = wp[(size_t)k * 6144];
#pragma unroll
            for (int b = 0; b < 16; ++b) a[b] += sC[b * 1024 + wid * 128 + k] * w; }
#pragma unroll
        for (int b = 0; b < 16; ++b) red[(wid * 16 + b) * 64 + lane] = a[b];
        __syncthreads();
        for (int o = tid; o < 1024; o += NTHR) { const int b = o >> 6, ln = o & 63; float s = 0.f;
#pragma unroll
            for (int w = 0; w < 8; ++w) s += red[(w * 16 + b) * 64 + ln];
            MOD[((size_t)l * 16 + b) * 6144 + cb * 64 + ln] = s + P.ada_b[l * 6144 + cb * 64 + ln]; }
        __syncthreads();
    }
}

__device__ __forceinline__ void tr_item(const float* W, int Nsrc, int k0, int j0, const float* kscale, bf16_t* WT, int Kdst, int R0, LAS float* scr, int lane) {
    if (j0 >= 0) {
#pragma unroll 8
        for (int i = 0; i < 32; ++i) { const int kk = 2 * i + (lane >> 5); float v = W[(size_t)(k0 + kk) * Nsrc + j0 + (lane & 31)]; if (kscale) v *= kscale[k0 + kk]; scr[kk * 33 + (lane & 31)] = v; }
    } else {
#pragma unroll 8
        for (int i = 0; i < 32; ++i) { const int kk = 2 * i + (lane >> 5); scr[kk * 33 + (lane & 31)] = 0.f; }
    }
    LDS_WAIT();
    const int c = lane & 7;
#pragma unroll
    for (int j = 0; j < 4; ++j) { const int n = (lane >> 3) + 8 * j; const LAS float* s = scr + (8 * c) * 33 + n;
        u32x4 o; o.x = cvt_pk_bf16(s[0 * 33], s[1 * 33]); o.y = cvt_pk_bf16(s[2 * 33], s[3 * 33]); o.z = cvt_pk_bf16(s[4 * 33], s[5 * 33]); o.w = cvt_pk_bf16(s[6 * 33], s[7 * 33]);
        *(u32x4*)(WT + (size_t)(R0 + n) * Kdst + k0 + 8 * c) = o; }
    LDS_WAIT();
}
__device__ __forceinline__ int win_src_col(int R0) {
    const int pn = R0 >> 8, rho = R0 & 255;
    if (pn == 0) return rho;
    if (pn == 1) return rho < 160 ? 256 + rho : -1;
    if (pn < 6) { const int wc = (rho >> 5) & 3, dd = 32 * (rho >> 7); const int sec = (pn - 2) >> 1, head = 4 * ((pn - 2) & 1) + wc; return 416 + sec * 512 + head * 64 + dd; }
    if (pn < 8) return 416 + 1024 + (R0 - 1536);
    return 1952 + (R0 - 2048);
}
__device__ __forceinline__ void conv_weights(const Params& P, int l, unsigned char* wb, LAS unsigned char* lds, int G) {
    const int tid = otid(), lane = tid & 63, wid = __builtin_amdgcn_readfirstlane(tid >> 6);
    LAS float* scr = (LAS float*)(lds + wid * 16384);
    constexpr int I_IN = 16 * 128, I_Q = 4 * 24, I_KV = 4 * 32, I_A = 8 * 32, I_B = 8 * 32, I_O = 16 * 32, I_1 = 16 * 176, I_2 = 44 * 32;
    constexpr int NIT = I_IN + I_Q + I_KV + I_A + I_B + I_O + I_1 + I_2;
    for (int it = obid() * NWAVES + wid; it < NIT; it += G * NWAVES) {
        int r = it;
        if (r < I_IN) { const int kb = r / 128, rb = r % 128; tr_item(P.w_in + (size_t)l * 1024 * INC, INC, kb * 64, win_src_col(rb * 32), nullptr, (bf16_t*)(wb + W_IN), 1024, rb * 32, scr, lane); continue; } r -= I_IN;
        if (r < I_Q) { const int kb = r / 24, rb = r % 24; tr_item(P.w_q_b + (size_t)l * 256 * 768, 768, kb * 64, rb * 32, P.q_a_norm + l * 256, (bf16_t*)(wb + W_Q), 256, rb * 32, scr, lane); continue; } r -= I_Q;
        if (r < I_KV) { const int kb = r / 32, rb = r % 32; const int R0 = rb * 32, pnl = R0 >> 8, rho = R0 & 255, wcq = (rho >> 5) & 3;
            const int jsrc = (pnl * 2 + (wcq & 1)) * 128 + (wcq >= 2 ? 64 : 0) + 32 * (rho >> 7);
            tr_item(P.w_kv_b + (size_t)l * 128 * 1024, 1024, kb * 64, kb < 2 ? jsrc : -1, P.kv_a_norm + l * 128, (bf16_t*)(wb + W_KV), 256, R0, scr, lane); continue; } r -= I_KV;
        if (r < I_A) { const int kb = r / 32, rb = r % 32; tr_item(P.w_branch_a + (size_t)l * 512 * 1024, 1024, kb * 64, rb * 32, nullptr, (bf16_t*)(wb + W_A), 1024, rb * 32, scr, lane); continue; } r -= I_A;
        if (r < I_B) { const int kb = r / 32, rb = r % 32; tr_item(P.w_branch_b + (size_t)l * 512 * 1024, 1024, kb * 64, rb * 32, nullptr, (bf16_t*)(wb + W_A) + 512, 1024, rb * 32, scr, lane); continue; } r -= I_B;
        if (r < I_O) { const int kb = r / 32, rb = r % 32; tr_item(P.w_out + (size_t)l * 1024 * 1024, 1024, kb * 64, rb * 32, nullptr, (bf16_t*)(wb + W_O), 1024, rb * 32, scr, lane); continue; } r -= I_O;
        if (r < I_1) { const int kb = r / 176, rb = r % 176; const int R0 = rb * 32, pn = R0 >> 8, rho = R0 & 255;
            const float* src = (rho < 128 ? P.w_ffn_gate : P.w_ffn_up) + (size_t)l * 1024 * FFH;
            tr_item(src, FFH, kb * 64, pn * 128 + (rho & 127), nullptr, (bf16_t*)(wb + W_1), 1024, R0, scr, lane); continue; } r -= I_1;
        { const int kb = r / 32, rb = r % 32; tr_item(P.w_ffn_down + (size_t)l * FFH * 1024, 1024, kb * 64, rb * 32, nullptr, (bf16_t*)(wb + W_2), FFH, rb * 32, scr, lane); }
    }
}

__device__ __forceinline__ void norm_phase(const float* xin, const float* g, const float* mod  , int sh_off, int sc_off, bf16_t* H, int G) {
    const int tid = otid(), lane = tid & 63, wid = __builtin_amdgcn_readfirstlane(tid >> 6);
    for (int m = obid() * NWAVES + wid; m < NTOK; m += G * NWAVES) {
        const f32x4* xr = (const f32x4*)(xin + (size_t)m * DM) + lane; f32x4 v[4]; float s = 0.f;
#pragma unroll
        for (int j = 0; j < 4; ++j) { v[j] = xr[64 * j]; s += (v[j][0] * v[j][0] + v[j][1] * v[j][1]) + (v[j][2] * v[j][2] + v[j][3] * v[j][3]); }
        const float r = __builtin_amdgcn_rsqf(wave_sum(s) * (1.0f / DM) + pg8::RMS_EPS);
        const float* mb = mod + (size_t)(m >> 12) * 6144;
#pragma unroll
        for (int j = 0; j < 4; ++j) { const int col = 4 * lane + 256 * j;
            const f32x4 gv = *(const f32x4*)(g + col), sc = *(const f32x4*)(mb + sc_off + col), sh = *(const f32x4*)(mb + sh_off + col);
            const f32x4 o = (v[j] * r) * gv * (1.0f + sc) + sh;
            u32x2 w; w.x = cvt_pk_bf16(o[0], o[1]); w.y = cvt_pk_bf16(o[2], o[3]);
            *(u32x2*)(H + (size_t)m * DM + col) = w; }
    }
}

__device__ __forceinline__ void prepass_phase(const float* xin, const float* g, const float* mod  , int sc_off, bf16_t* XG, float* ssq, int G) {
    const int tid = otid(), lane = tid & 63, wid = __builtin_amdgcn_readfirstlane(tid >> 6);
    for (int m = obid() * NWAVES + wid; m < NTOK; m += G * NWAVES) {
        const f32x4* xr = (const f32x4*)(xin + (size_t)m * DM) + lane; float s = 0.f;
        const float* mb = mod + (size_t)(m >> 12) * 6144;
#pragma unroll
        for (int j = 0; j < 4; ++j) { const f32x4 v = xr[64 * j]; s += (v[0] * v[0] + v[1] * v[1]) + (v[2] * v[2] + v[3] * v[3]); const int col = 4 * lane + 256 * j;
            const f32x4 o = v * *(const f32x4*)(g + col) * (1.0f + *(const f32x4*)(mb + sc_off + col));
            u32x2 w; w.x = cvt_pk_bf16(o[0], o[1]); w.y = cvt_pk_bf16(o[2], o[3]);
            *(u32x2*)(XG + (size_t)m * DM + col) = w; }
        s = wave_sum(s);
        if (lane == 0) ssq[m] = s;
    }
}
__device__ __forceinline__ void bias_phase(const Params& P, LAS unsigned char* lds, int G) {
    const int tid = otid(), lane = tid & 63, wid = __builtin_amdgcn_readfirstlane(tid >> 6);
    const float* MOD = (const float*)(P.ws + WS_MOD); float* BW1 = (float*)(P.ws + WS_BW1); float* BW2 = (float*)(P.ws + WS_BW2);
    LAS float* sC = (LAS float*)lds;
    LAS float* red = (LAS float*)(lds + 65536);
    for (int it = obid(); it < 4 * 152; it += G) { const int l = it / 152, blk = it % 152; const bool ffn = blk >= 64; const int R0 = (ffn ? blk - 64 : blk) * 64;
        __syncthreads();
        for (int i = tid; i < 16 * 1024; i += NTHR) sC[i] = MOD[((size_t)l * 16 + (i >> 10)) * 6144 + (ffn ? 3072 : 0) + (i & 1023)];
        __syncthreads();
        const int R = R0 + lane; const float* wsrc; int j; size_t ncol;
        if (!ffn) { const int jb = win_src_col(R & ~31); j = jb < 0 ? -1 : jb + (R & 31); wsrc = P.w_in + (size_t)l * 1024 * INC; ncol = INC; }
        else { const int pn = R >> 8, rho = R & 255; j = pn * 128 + (rho & 127); wsrc = (rho < 128 ? P.w_ffn_gate : P.w_ffn_up) + (size_t)l * 1024 * FFH; ncol = FFH; }
        float a[16];
#pragma unroll
        for (int b = 0; b < 16; ++b) a[b] = 0.f;
        if (j >= 0) { const float* wp = wsrc + (size_t)(wid * 128) * ncol + j;
#pragma unroll 16
            for (int k = 0; k < 128; ++k) { const float w = wp[(size_t)k * ncol];
#pragma unroll
                for (int b = 0; b < 16; ++b) a[b] += sC[b * 1024 + wid * 128 + k] * w; } }
#pragma unroll
        for (int b = 0; b < 16; ++b) red[(wid * 16 + b) * 64 + lane] = a[b];
        __syncthreads();
        for (int o = tid; o < 1024; o += NTHR) { const int b = o >> 6, ln = o & 63; float s = 0.f;
#pragma unroll
            for (int w = 0; w < 8; ++w) s += red[(w * 16 + b) * 64 + ln];
            if (!ffn) BW1[((size_t)l * 16 + b) * 4096 + R0 + ln] = s; else BW2[((size_t)l * 16 + b) * 5632 + R0 + ln] = s; }
    }
    __syncthreads();
}

__device__ __forceinline__ void unpack8(const u32x4 w, float* f) { f[0] = bf_lo(w.x); f[1] = bf_hi(w.x); f[2] = bf_lo(w.y); f[3] = bf_hi(w.y); f[4] = bf_lo(w.z); f[5] = bf_hi(w.z); f[6] = bf_lo(w.w); f[7] = bf_hi(w.w); }
__device__ __forceinline__ u32x4 pack8(const float* f) { u32x4 w; w.x = cvt_pk_bf16(f[0], f[1]); w.y = cvt_pk_bf16(f[2], f[3]); w.z = cvt_pk_bf16(f[4], f[5]); w.w = cvt_pk_bf16(f[6], f[7]); return w; }
__device__ __forceinline__ float ssq8(const u32x4 w) { float f[8]; unpack8(w, f); return ((f[0] * f[0] + f[1] * f[1]) + (f[2] * f[2] + f[3] * f[3])) + ((f[4] * f[4] + f[5] * f[5]) + (f[6] * f[6] + f[7] * f[7])); }
__device__ __forceinline__ void head_norm_rope(const bf16_t* src_nope, const bf16_t* src_rope, bf16_t* dst, const float* gain, const float* rope, float oscale) {
    float s = 0.f;
#pragma unroll
    for (int c = 0; c < 8; ++c) s += ssq8(*(const u32x4*)(src_nope + 8 * c));
#pragma unroll
    for (int c = 0; c < 4; ++c) s += ssq8(*(const u32x4*)(src_rope + 8 * c));
    const float r = __builtin_amdgcn_rsqf(s * (1.0f / 96.0f) + pg8::RMS_EPS);
    asm volatile("" ::: "memory");
#pragma unroll
    for (int c = 0; c < 8; ++c) { float f[8]; unpack8(*(const u32x4*)(src_nope + 8 * c), f);
#pragma unroll
        for (int i = 0; i < 8; ++i) f[i] = f[i] * r * gain[8 * c + i] * oscale;
        *(u32x4*)(dst + 8 * c) = pack8(f); asm volatile("" ::: "memory"); }
    float x[32];
#pragma unroll
    for (int c = 0; c < 4; ++c) unpack8(*(const u32x4*)(src_rope + 8 * c), x + 8 * c);
#pragma unroll
    for (int i = 0; i < 32; ++i) x[i] = x[i] * r * gain[64 + i];
#pragma unroll
    for (int i = 0; i < 16; ++i) { const float cs = rope[i], sn = rope[16 + i]; const float x1 = x[i], x2 = x[16 + i]; x[i] = (x1 * cs - x2 * sn) * oscale; x[16 + i] = (x2 * cs + x1 * sn) * oscale; }
#pragma unroll
    for (int c = 0; c < 4; ++c) *(u32x4*)(dst + 64 + 8 * c) = pack8(x + 8 * c);
    asm volatile("" ::: "memory");
}
__device__ __forceinline__ void prep_phase(const Params& P, int l, int G) {
    const bf16_t* KVRAW = (const bf16_t*)(P.ws + WS_KVRAW); const bf16_t* PA = (const bf16_t*)(P.ws + WS_PA);
    bf16_t* K = (bf16_t*)(P.ws + WS_K); const float* ROPE = (const float*)(P.ws + WS_ROPE);
    const float* kg = P.k_norm_a + l * 96;
    for (int idx = obid() * NTHR + otid(); idx < NTOK * NH; idx += G * NTHR) { const int t = idx >> 3, h = idx & 7;
        const float* rp = ROPE + (size_t)t * 32;
        const bf16_t* kp = KVRAW + (size_t)t * 1024 + h * 128;
        const size_t hrow = ((size_t)((t >> 12) * 8 + h) << 12) + (t & 4095);
        head_norm_rope(kp, PA + (size_t)t * 512 + 384, K + hrow * 96, kg, rp, 1.0f);
    }
}
typedef short v4i16_t __attribute__((ext_vector_type(4)));
__device__ __forceinline__ s16x4 vtr(const LAS unsigned char* p) { return __builtin_bit_cast(s16x4, __builtin_amdgcn_ds_read_tr16_b64_v4i16((LAS v4i16_t*)p)); }
__device__ __forceinline__ bf16x8 cat8(s16x4 a, s16x4 b) { return (bf16x8){a[0], a[1], a[2], a[3], b[0], b[1], b[2], b[3]}; }
__device__ __forceinline__ bf16x8 packp(const f32x16& p, int o) {
    u32x4 w; w.x = cvt_pk_bf16(p[o + 0], p[o + 1]); w.y = cvt_pk_bf16(p[o + 2], p[o + 3]); w.z = cvt_pk_bf16(p[o + 4], p[o + 5]); w.w = cvt_pk_bf16(p[o + 6], p[o + 7]);
    return __builtin_bit_cast(bf16x8, w);
}
__device__ __forceinline__ float max16(const f32x16& p) {
    float a = fmaxf(fmaxf(p[0], p[1]), fmaxf(p[2], p[3])), b = fmaxf(fmaxf(p[4], p[5]), fmaxf(p[6], p[7]));
    float c = fmaxf(fmaxf(p[8], p[9]), fmaxf(p[10], p[11])), d = fmaxf(fmaxf(p[12], p[13]), fmaxf(p[14], p[15]));
    return fmaxf(fmaxf(a, b), fmaxf(c, d));
}
#define MFMA32(a, b, c) __builtin_amdgcn_mfma_f32_32x32x16_bf16((a), (b), (c), 0, 0, 0)
constexpr int KP = 208, VP = 192;
constexpr int KT_B = 64 * KP, VT_B = 64 * VP;
constexpr int MLA_K0 = 0, MLA_V0 = 2 * KT_B;

constexpr float MLA_THR = 8.0f;
__device__ __forceinline__ float max3f(float a, float b, float c) { float r; asm("v_max3_f32 %0, %1, %2, %3" : "=v"(r) : "v"(a), "v"(b), "v"(c)); return r; }
__device__ __forceinline__ float rowmax32(const f32x16& a, const f32x16& b) {
    float x = max3f(a[0], a[1], a[2]), y = max3f(b[0], b[1], b[2]);
    x = max3f(x, a[3], a[4]); y = max3f(y, b[3], b[4]); x = max3f(x, a[5], a[6]); y = max3f(y, b[5], b[6]); x = max3f(x, a[7], a[8]); y = max3f(y, b[7], b[8]);
    x = max3f(x, a[9], a[10]); y = max3f(y, b[9], b[10]); x = max3f(x, a[11], a[12]); y = max3f(y, b[11], b[12]); x = max3f(x, a[13], a[14]); y = max3f(y, b[13], b[14]);
    x = max3f(x, a[15], b[15]); x = max3f(x, y, y);
    return max3f(x, __shfl_xor(x, 32), x);
}
#define SBAR0() __builtin_amdgcn_sched_barrier(0)
__device__ __forceinline__ void mla_unit(LAS unsigned char* lds, const bf16_t* Q, const bf16_t* K, const bf16_t* V, bf16_t* Y, const float* qgain, const float* ROPE, int b, int h, int qb) {
    const int tid = otid(), lane = tid & 63, wid = __builtin_amdgcn_readfirstlane(tid >> 6), r32 = lane & 31, hi = lane >> 5;
    const size_t tok0 = (size_t)b * SEQ; const size_t qrow = tok0 + qb * 256 + wid * 32 + r32;
    bf16x8 qf[6];
    {
        const bf16_t* qp = Q + qrow * 768 + h * 96 + hi * 8; float f[6][8]; float s = 0.f;
#pragma unroll
        for (int d0 = 0; d0 < 6; ++d0) { unpack8(*(const u32x4*)(qp + d0 * 16), f[d0]);
#pragma unroll
            for (int i = 0; i < 8; ++i) s += f[d0][i] * f[d0][i]; }
        s += __shfl_xor(s, 32);
        const float r = __builtin_amdgcn_rsqf(s * (1.0f / 96.0f) + pg8::RMS_EPS);
#pragma unroll
        for (int d0 = 0; d0 < 6; ++d0)
#pragma unroll
            for (int i = 0; i < 8; ++i) f[d0][i] = f[d0][i] * r * qgain[d0 * 16 + hi * 8 + i];
        const float* rp = ROPE + qrow * 32 + hi * 8;
#pragma unroll
        for (int i = 0; i < 8; ++i) { const float cs = rp[i], sn = rp[16 + i]; const float x1 = f[4][i], x2 = f[5][i]; f[4][i] = x1 * cs - x2 * sn; f[5][i] = x2 * cs + x1 * sn; }
#pragma unroll
        for (int d0 = 0; d0 < 6; ++d0) {
#pragma unroll
            for (int i = 0; i < 8; ++i) f[d0][i] *= pg8::QSCALE_A;
            qf[d0] = __builtin_bit_cast(bf16x8, pack8(f[d0])); }
    }
    const int kr0 = tid / 12, kc0 = tid % 12, kr1 = (512 + tid) / 12, kc1 = (512 + tid) % 12, vr = tid >> 3, vc = tid & 7;
    const size_t hrow0 = (size_t)(b * 8 + h) * SEQ;
    const bf16_t* kg0 = K + (hrow0 + kr0) * 96 + kc0 * 8; const bf16_t* kg1 = K + (hrow0 + kr1) * 96 + kc1 * 8;
    const bf16_t* vg = V + (hrow0 + vr) * 64 + vc * 8;
    const int kl0 = kr0 * KP + kc0 * 16, kl1 = kr1 * KP + kc1 * 16, vl = vr * VP + vc * 16;
    const bool has1 = tid < 256;
    u32x4 ka0, kb0, ka1, kb1, vv0, vv1;
    ka0 = *(const u32x4*)kg0; if (has1) kb0 = *(const u32x4*)kg1; vv0 = *(const u32x4*)vg;
    ka1 = *(const u32x4*)(kg0 + (size_t)64 * 96); if (has1) kb1 = *(const u32x4*)(kg1 + (size_t)64 * 96);
    *(LAS u32x4*)(lds + MLA_K0 + kl0) = ka0; if (has1) *(LAS u32x4*)(lds + MLA_K0 + kl1) = kb0; *(LAS u32x4*)(lds + MLA_V0 + vl) = vv0;
    *(LAS u32x4*)(lds + MLA_K0 + KT_B + kl0) = ka1; if (has1) *(LAS u32x4*)(lds + MLA_K0 + KT_B + kl1) = kb1;
    ka0 = *(const u32x4*)(kg0 + (size_t)128 * 96); if (has1) kb0 = *(const u32x4*)(kg1 + (size_t)128 * 96); vv1 = *(const u32x4*)(vg + (size_t)64 * 64);
    __syncthreads();
    f32x16 o0, o1, negm;
#pragma unroll
    for (int i = 0; i < 16; ++i) { o0[i] = 0.f; o1[i] = 0.f; negm[i] = 0.f; }
    const int koff = r32 * KP + hi * 16;
    const int voff = (4 * hi + ((lane & 15) >> 2)) * VP + (16 * ((lane >> 4) & 1) + 4 * (lane & 3)) * 2;
    f32x16 p0, p1, n0, n1;
    { const LAS unsigned char* kb_ = lds + MLA_K0 + koff; p0 = negm; p1 = negm;
#pragma unroll
      for (int d0 = 0; d0 < 6; ++d0) { const bf16x8 a0 = *(const LAS bf16x8*)(kb_ + d0 * 32), a1 = *(const LAS bf16x8*)(kb_ + 32 * KP + d0 * 32); p0 = MFMA32(a0, qf[d0], p0); p1 = MFMA32(a1, qf[d0], p1); } }
    float m_ref, l_run = 0.f;
    { const float mx = rowmax32(p0, p1); m_ref = mx;
#pragma unroll
      for (int i = 0; i < 16; ++i) { p0[i] -= mx; p1[i] -= mx; negm[i] = -mx; } }
#define MLA_STEP(C0, C1, X0, X1, T, KAI, KBI, VVI, KAW, KBW, VVW) do { const int t_ = (T); const int cur = t_ & 1; \
        if (t_ + 3 < 64) { const size_t go = (size_t)(t_ + 3) * 64; KAI = *(const u32x4*)(kg0 + go * 96); if (has1) KBI = *(const u32x4*)(kg1 + go * 96); } \
        if (t_ + 2 < 64) { const size_t go = (size_t)(t_ + 2) * 64; VVI = *(const u32x4*)(vg + go * 64); } \
        bf16x8 kfr[12]; { const LAS unsigned char* kn = lds + MLA_K0 + (cur ^ 1) * KT_B + koff; \
            _Pragma("unroll") for (int d0 = 0; d0 < 6; ++d0) { kfr[2 * d0] = *(const LAS bf16x8*)(kn + d0 * 32); kfr[2 * d0 + 1] = *(const LAS bf16x8*)(kn + 32 * KP + d0 * 32); } } \
        SBAR0(); \
        const float mx = rowmax32(C0, C1); \
        if (__builtin_amdgcn_ballot_w64(mx > MLA_THR) != 0ull) { const float d = fmaxf(mx, 0.f); const float sc = __builtin_amdgcn_exp2f(-d); m_ref += d; l_run *= sc; \
            _Pragma("unroll") for (int i = 0; i < 16; ++i) { C0[i] -= d; C1[i] -= d; o0[i] *= sc; o1[i] *= sc; negm[i] = -m_ref; } } \
        SBAR0(); \
        X0 = negm; X1 = negm; \
        _Pragma("unroll") for (int d0 = 0; d0 < 6; ++d0) { X0 = MFMA32(kfr[2 * d0], qf[d0], X0); X1 = MFMA32(kfr[2 * d0 + 1], qf[d0], X1); } \
        SBAR0(); \
        float ls = 0.f; \
        _Pragma("unroll") for (int i = 0; i < 16; ++i) { C0[i] = __builtin_amdgcn_exp2f(C0[i]); C1[i] = __builtin_amdgcn_exp2f(C1[i]); ls += C0[i] + C1[i]; } \
        l_run += ls; \
        bf16x8 pb[4]; pb[0] = packp(C0, 0); pb[1] = packp(C0, 8); pb[2] = packp(C1, 0); pb[3] = packp(C1, 8); \
        const LAS unsigned char* vb_ = lds + MLA_V0 + cur * VT_B + voff; \
        _Pragma("unroll") for (int j = 0; j < 4; ++j) { const LAS unsigned char* vj = vb_ + 16 * j * VP; \
            const bf16x8 a0 = cat8(vtr(vj), vtr(vj + 8 * VP)); const bf16x8 a1 = cat8(vtr(vj + 64), vtr(vj + 8 * VP + 64)); \
            o0 = MFMA32(a0, pb[j], o0); o1 = MFMA32(a1, pb[j], o1); } \
        if (t_ + 2 < 64) { *(LAS u32x4*)(lds + MLA_K0 + cur * KT_B + kl0) = KAW; if (has1) *(LAS u32x4*)(lds + MLA_K0 + cur * KT_B + kl1) = KBW; } \
        if (t_ + 1 < 64) *(LAS u32x4*)(lds + MLA_V0 + (cur ^ 1) * VT_B + vl) = VVW; \
        __syncthreads(); } while (0)
    if (wid >= 4) __builtin_amdgcn_s_setprio(1);
    for (int t = 0; t < 64; t += 2) { MLA_STEP(p0, p1, n0, n1, t, ka1, kb1, vv0, ka0, kb0, vv1); MLA_STEP(n0, n1, p0, p1, t + 1, ka0, kb0, vv1, ka1, kb1, vv0); }
    __builtin_amdgcn_s_setprio(0);
#undef MLA_STEP
    const float lt = l_run + __shfl_xor(l_run, 32); const float inv = 1.0f / lt;
    bf16_t* yp = Y + qrow * 1024 + h * 64 + 4 * hi;
#pragma unroll
    for (int g = 0; g < 4; ++g) {
        u32x2 w0; w0.x = cvt_pk_bf16(o0[4 * g] * inv, o0[4 * g + 1] * inv); w0.y = cvt_pk_bf16(o0[4 * g + 2] * inv, o0[4 * g + 3] * inv); *(u32x2*)(yp + 8 * g) = w0;
        u32x2 w1; w1.x = cvt_pk_bf16(o1[4 * g] * inv, o1[4 * g + 1] * inv); w1.y = cvt_pk_bf16(o1[4 * g + 2] * inv, o1[4 * g + 3] * inv); *(u32x2*)(yp + 32 + 8 * g) = w1; }
}

constexpr int DW_BYTES = 13440;
template <int DELTA>
__device__ __forceinline__ void dil_block(LAS unsigned char* wl, const bf16_t* kbase  , const bf16_t* vbase, size_t rstride  ,
                                          const bf16x8 (&qf)[2][4], f32x16 (&o)[2][2], float (&m_run)[2], float (&l_run)[2], int bvar, int voff, int lane, int r32, int hi, int btb) {
    u32x4 vv[8]; bf16x8 kf[2][4];
#pragma unroll
    for (int i = 0; i < 8; ++i) { const int idx = lane + 64 * i, row = idx >> 3, ch = idx & 7; vv[i] = *(const u32x4*)(vbase + (size_t)row * rstride + ch * 8); }
#pragma unroll
    for (int kvh = 0; kvh < 2; ++kvh)
#pragma unroll
        for (int d0 = 0; d0 < 4; ++d0) kf[kvh][d0] = *(const bf16x8*)(kbase + (size_t)(32 * kvh + r32) * rstride + d0 * 16);
    SBAR0();
#pragma unroll
    for (int i = 0; i < 8; ++i) { const int idx = lane + 64 * i, row = idx >> 3, ch = idx & 7; *(LAS u32x4*)(wl + row * VP + ch * 16) = vv[i]; }
    bf16x8 pb[2][4];
#pragma unroll
    for (int qh = 0; qh < 2; ++qh) {
        f32x16 s[2]; float mx = -1e30f;
#pragma unroll
        for (int kvh = 0; kvh < 2; ++kvh) {
            constexpr int dummy = 0; (void)dummy;
            const int toff = 64 * DELTA + 32 * (kvh - qh);
            if (toff > 64 || toff < -64) continue;
#pragma unroll
            for (int i = 0; i < 16; ++i) s[kvh][i] = 0.f;
#pragma unroll
            for (int d0 = 0; d0 < 4; ++d0) s[kvh] = MFMA32(kf[kvh][d0], qf[qh][d0], s[kvh]);
#pragma unroll
            for (int rr = 0; rr < 16; ++rr) { const int c4 = 4 * ((rr & 3) + 8 * (rr >> 2)); const float bias = *(const LAS float*)(wl + bvar + (VT_B + c4 + toff * 4));
                float v = s[kvh][rr] + bias;
                if (toff == 64) v = (bvar <= btb - c4) ? v : -1e30f;
                if (toff == -64) v = (bvar >= btb - c4) ? v : -1e30f;
                s[kvh][rr] = v; mx = fmaxf(mx, v); }
        }
        mx = fmaxf(mx, __shfl_xor(mx, 32));
        const float m_new = fmaxf(m_run[qh], mx); const float alpha = __builtin_amdgcn_exp2f(m_run[qh] - m_new); m_run[qh] = m_new;
        float ls = 0.f;
#pragma unroll
        for (int kvh = 0; kvh < 2; ++kvh) { const int toff = 64 * DELTA + 32 * (kvh - qh);
            if (toff > 64 || toff < -64) continue;
#pragma unroll
            for (int rr = 0; rr < 16; ++rr) { const float e = __builtin_amdgcn_exp2f(s[kvh][rr] - m_new); s[kvh][rr] = e; ls += e; }
            pb[qh][2 * kvh] = packp(s[kvh], 0); pb[qh][2 * kvh + 1] = packp(s[kvh], 8); }
        l_run[qh] = l_run[qh] * alpha + ls;
#pragma unroll
        for (int i = 0; i < 16; ++i) { o[qh][0][i] *= alpha; o[qh][1][i] *= alpha; }
    }
    LDS_WAIT();
#pragma unroll
    for (int j = 0; j < 4; ++j) { const LAS unsigned char* vj = wl + voff + 16 * j * VP;
        const bf16x8 a0 = cat8(vtr(vj), vtr(vj + 8 * VP)); const bf16x8 a1 = cat8(vtr(vj + 64), vtr(vj + 8 * VP + 64));
#pragma unroll
        for (int qh = 0; qh < 2; ++qh) { const int toff = 64 * DELTA + 32 * ((j >> 1) - qh);
            if (toff > 64 || toff < -64) continue;
            o[qh][0] = MFMA32(a0, pb[qh][j], o[qh][0]); o[qh][1] = MFMA32(a1, pb[qh][j], o[qh][1]); } }
    LDS_WAIT();
}
template <int P_>
__device__ __forceinline__ void dil_wave_unit(LAS unsigned char* wl, const bf16_t* DIL, bf16_t* Y, bf16_t* ST, float* LSE, const float* BT, int b, int h, int r, int nb) {
    constexpr int dil = P_ == 0 ? 1 : (P_ == 1 ? 4 : 16), nblk = 64 / dil; constexpr bool first = P_ == 0, last = P_ == 2;
    const int lane = otid() & 63, r32 = lane & 31, hi = lane >> 5;
    const size_t tok0 = (size_t)b * SEQ; const size_t rstride = (size_t)dil * 64;
    LAS float* bt = (LAS float*)(wl + VT_B);
    for (int i = lane; i < 257; i += 64) { int j = i - 64; j = j < 0 ? 0 : (j > 128 ? 128 : j); bt[i] = BT[(P_ * 8 + h) * 129 + j]; }
    const int btb = 128 * 4;
    const int bvar = btb + 4 * (4 * hi - r32);
    bf16x8 qf[2][4];
    const bf16_t* rowb = DIL + ((size_t)(b * 8 + h) * SEQ + (size_t)(64 * nb) * dil + r) * 64;
    constexpr size_t KOFF = pg8::DPLANE, VOFF = 2 * pg8::DPLANE;
#pragma unroll
    for (int qh = 0; qh < 2; ++qh)
#pragma unroll
        for (int d0 = 0; d0 < 4; ++d0) qf[qh][d0] = *(const bf16x8*)(rowb + (size_t)(32 * qh + r32) * rstride + hi * 8 + d0 * 16);
    f32x16 o[2][2];
#pragma unroll
    for (int a = 0; a < 2; ++a)
#pragma unroll
        for (int c = 0; c < 2; ++c)
#pragma unroll
            for (int i = 0; i < 16; ++i) o[a][c][i] = 0.f;
    float m_run[2] = {-1e30f, -1e30f}, l_run[2] = {0.f, 0.f};
    const int voff = (4 * hi + ((lane & 15) >> 2)) * VP + (16 * ((lane >> 4) & 1) + 4 * (lane & 3)) * 2;
    LDS_WAIT();
    dil_block<0>(wl, rowb + KOFF + hi * 8, rowb + VOFF, rstride, qf, o, m_run, l_run, bvar, voff, lane, r32, hi, btb);
    if (nb > 0) dil_block<-1>(wl, rowb - 64 * rstride + KOFF + hi * 8, rowb - 64 * rstride + VOFF, rstride, qf, o, m_run, l_run, bvar, voff, lane, r32, hi, btb);
    if (nb + 1 < nblk) dil_block<1>(wl, rowb + 64 * rstride + KOFF + hi * 8, rowb + 64 * rstride + VOFF, rstride, qf, o, m_run, l_run, bvar, voff, lane, r32, hi, btb);
    float lp[2]; u32x2 pv[2][8];
    if (!first) {
#pragma unroll
        for (int qh = 0; qh < 2; ++qh) { const size_t srow = (size_t)(b * 8 + h) * SEQ + (size_t)(64 * nb + 32 * qh + r32) * dil + r; lp[qh] = LSE[srow];
            const bf16_t* sp = ST + srow * 64 + 4 * hi;
#pragma unroll
            for (int e = 0; e < 8; ++e) pv[qh][e] = *(const u32x2*)(sp + 32 * (e >> 2) + 8 * (e & 3)); }
    }
#pragma unroll
    for (int qh = 0; qh < 2; ++qh) {
        const size_t spos = (size_t)(64 * nb + 32 * qh + r32) * dil + r; const size_t srow = (size_t)(b * 8 + h) * SEQ + spos;
        const float lt = l_run[qh] + __shfl_xor(l_run[qh], 32); const float inv = 1.0f / lt; const float lse2 = m_run[qh] + __builtin_amdgcn_logf(lt);
        float a_prev = 0.f, a_cur = inv, lse_new = lse2;
        if (!first) { const float M = fmaxf(lp[qh], lse2); const float wp = __builtin_amdgcn_exp2f(lp[qh] - M), wc = __builtin_amdgcn_exp2f(lse2 - M); const float den = wp + wc;
            a_prev = wp / den; a_cur = wc / den * inv; lse_new = M + __builtin_amdgcn_logf(den); }
        bf16_t* yp = last ? Y + (tok0 + spos) * 1024 + 512 + h * 64 + 4 * hi : ST + srow * 64 + 4 * hi;
#pragma unroll
        for (int e = 0; e < 8; ++e) { const int blk = e >> 2, g = e & 3;
            float v0 = o[qh][blk][4 * g] * a_cur, v1 = o[qh][blk][4 * g + 1] * a_cur, v2 = o[qh][blk][4 * g + 2] * a_cur, v3 = o[qh][blk][4 * g + 3] * a_cur;
            if (!first) { v0 += a_prev * bf_lo(pv[qh][e].x); v1 += a_prev * bf_hi(pv[qh][e].x); v2 += a_prev * bf_lo(pv[qh][e].y); v3 += a_prev * bf_hi(pv[qh][e].y); }
            u32x2 w; w.x = cvt_pk_bf16(v0, v1); w.y = cvt_pk_bf16(v2, v3); *(u32x2*)(yp + 32 * blk + 8 * g) = w; }
        if (!last && hi == 0) LSE[srow] = lse_new;
    }
}
__device__ __forceinline__ void dil_unit(LAS unsigned char* lds, const bf16_t* DIL, bf16_t* Y, bf16_t* ST, float* LSE, const float* BT, int b, int h, int c) {
    const int wid = __builtin_amdgcn_readfirstlane(otid() >> 6);
    LAS unsigned char* wl = lds + wid * DW_BYTES;
    for (int j = 0; j < 2; ++j) { const int wu = 2 * wid + j; dil_wave_unit<0>(wl, DIL, Y, ST, LSE, BT, b, h, 0, c * 16 + wu); }
    __syncthreads();
    for (int j = 0; j < 2; ++j) { const int wu = 2 * wid + j; dil_wave_unit<1>(wl, DIL, Y, ST, LSE, BT, b, h, wu >> 2, c * 4 + (wu & 3)); }
    __syncthreads();
    for (int j = 0; j < 2; ++j) { const int wu = 2 * wid + j; dil_wave_unit<2>(wl, DIL, Y, ST, LSE, BT, b, h, wu, c); }
    __syncthreads();
}

typedef __attribute__((address_space(1))) unsigned gu32;
#define XB_TMO      128
#define XB_XCNT(j)  (256  + 64 * (j))
#define XB_XSUB(j)  (1280 + 64 * (j))
#define XB_XGEN(j)  (2304 + 64 * (j))
#define XB_TOP      3328
#define XB_TOPGEN   3392
#define XCD_BAR_WORDS 3456
#define XB_SPIN_CAP (1u << 18)

__device__ __forceinline__ unsigned xb_ld(unsigned* p)              { return __hip_atomic_load(p, __ATOMIC_RELAXED, __HIP_MEMORY_SCOPE_AGENT); }
__device__ __forceinline__ unsigned xb_add(unsigned* p, unsigned v) { return __hip_atomic_fetch_add(p, v, __ATOMIC_RELAXED, __HIP_MEMORY_SCOPE_AGENT); }
__device__ __forceinline__ unsigned xb_xcc_id() { return (unsigned)__builtin_amdgcn_s_getreg((3 << 11) | 20) & 0xFu; }
#define XB_SPIN(cond, bar) do { unsigned _sp = 0; while (cond) { __builtin_amdgcn_s_sleep(1); \
    if ((++_sp & 255u) == 0u) { if (xb_ld(&(bar)[XB_TMO])) break; if (_sp > XB_SPIN_CAP) { atomicAdd(&(bar)[XB_TMO], 1u); break; } } } } while (0)

struct XcdBarrier {
    unsigned* bar; unsigned x;
    volatile LAS unsigned* st;
};

__device__ __forceinline__ XcdBarrier xcd_barrier_post(unsigned* bar, volatile LAS unsigned* st) {
    XcdBarrier b; b.bar = bar; b.x = xb_xcc_id(); b.st = st;
    if (threadIdx.x == 0) (void)xb_add(&bar[XB_XCNT(b.x)], 1u);
    return b;
}
__device__ __forceinline__ void xcd_barrier_complete(unsigned* bar, unsigned x, unsigned& nloc, unsigned& nx) {
    const unsigned G = gridDim.x * gridDim.y * gridDim.z;
    unsigned sum, cnt, mine, sp = 0u;
    for (;;) {
        sum = 0u; cnt = 0u; mine = 0u;
#pragma unroll
        for (unsigned j = 0; j < 16; ++j) { const unsigned c = xb_ld(&bar[XB_XCNT(j)]); sum += c; cnt += (c > 0u) ? 1u : 0u; mine = (j == x) ? c : mine; }
        if (sum == G) break;
        __builtin_amdgcn_s_sleep(1);
        if ((++sp & 255u) == 0u) { if (xb_ld(&bar[XB_TMO])) break; if (sp > XB_SPIN_CAP) { atomicAdd(&bar[XB_TMO], 1u); break; } }
    }
    nloc = mine > 0u ? mine : 1u; nx = cnt > 0u ? cnt : 1u;
}

__device__ __forceinline__ void xcd_barrier(const XcdBarrier& b) {
    asm volatile("s_waitcnt vmcnt(0)" ::: "memory");
    __syncthreads();
    if (threadIdx.x == 0) {
        unsigned* bar = b.bar;
        __builtin_amdgcn_s_waitcnt(0);
        unsigned nloc = b.st[0], nx = b.st[1];
        if (nloc == 0u) { xcd_barrier_complete(bar, b.x, nloc, nx); b.st[0] = nloc; b.st[1] = nx; }
        const unsigned old = xb_add(&bar[XB_XSUB(b.x)], 1u);
        const unsigned gen = old / nloc;
        if (old + 1u == (gen + 1u) * nloc) {
            __builtin_amdgcn_fence(__ATOMIC_RELEASE, "agent");
            asm volatile("s_waitcnt vmcnt(0)" ::: "memory");
            const unsigned og = xb_add(&bar[XB_TOP], 1u);
            const unsigned tg = og / nx;
            if (og + 1u == (tg + 1u) * nx) xb_add(&bar[XB_TOPGEN], 1u);
            else XB_SPIN(xb_ld(&bar[XB_TOPGEN]) == tg, bar);
            __builtin_amdgcn_fence(__ATOMIC_ACQUIRE, "agent");
            xb_add(&bar[XB_XGEN(b.x)], 1u);
            asm volatile("s_waitcnt vmcnt(0)" ::: "memory");
        } else {
            XB_SPIN(xb_ld(&bar[XB_XGEN(b.x)]) == gen, bar);
            __builtin_amdgcn_fence(__ATOMIC_ACQUIRE, "agent");
            asm volatile("s_waitcnt vmcnt(0)" ::: "memory");
        }
    }
    __syncthreads();
}

constexpr int NPHASE = 2 + DEPTH * 7;
__device__ __forceinline__ unsigned char* opaque_ptr(unsigned char* p) { asm volatile("" : "+s"(p)); return p; }
#define GEMM(EpiT, Ev, Ap, Bp, Nn, Kk, Ld) do { pg8::Gemm g_{(Ap), (Bp), NTOK, (Nn), (Kk), (Ld), 1 << 30, 0}; pg8::StaticOrder S_; S_.init(NTOK, (Nn), G, obid()); \
        pg8::gemm_phase<EpiT, pg8::StaticOrder, true, true>(lds, g_, S_, (Ev)); } while (0)
#define BF(off) ((bf16_t*)(unsigned char*)(ws + (off)))
#define FP(off) ((float*)(unsigned char*)(ws + (off)))
#define WB(l_, off) ((bf16_t*)(unsigned char*)(ws + WS_W + (size_t)((l_) & 1) * WS_WSTRIDE + (off)))
__global__ void __launch_bounds__(NTHR, 2) mega_fwd(Params P0) {
    extern __shared__ __attribute__((aligned(16))) unsigned char lds_raw[];
    LAS unsigned char* lds = (LAS unsigned char*)lds_raw;
    cg::grid_group grid = cg::this_grid();
    { volatile LAS unsigned* misc = (volatile LAS unsigned*)(lds + RING_BYTES + 320); if (otid() < 32) misc[otid()] = 0u; }
    __syncthreads();
    XcdBarrier xbar = xcd_barrier_post((unsigned*)(P0.ws + WS_CTL) + 1024, (volatile LAS unsigned*)(lds + RING_BYTES + 320) + 8);
    { volatile LAS unsigned* misc = (volatile LAS unsigned*)(lds + RING_BYTES + 320);
      if (otid() == 0) { const unsigned x = xb_xcc_id(); misc[16] = xb_add((unsigned*)(P0.ws + WS_CTL) + 8192 + 64 * x, 1u); misc[17] = x; } }
    __syncthreads();
    const int ph_lo = P0.ph_lo, ph_hi = P0.ph_hi;
    for (int ph = ph_lo; ph < ph_hi; ++ph) {
        int G_ = (int)gridDim.x; asm volatile("" : "+s"(G_)); const int G = G_;
        typedef const __attribute__((address_space(4))) Params* kparams_t;
        kparams_t kp_ = (kparams_t)__builtin_amdgcn_kernarg_segment_ptr(); asm volatile("" : "+s"(kp_));
        const Params& P = *(const Params*)kp_;
        __attribute__((address_space(1))) unsigned char* ws = (__attribute__((address_space(1))) unsigned char*)opaque_ptr(P.ws);
        const int l = ph > 1 ? (ph - 2) / 7 : 0, kk_ = ph > 1 ? (ph - 2) % 7 + 2 : ph; const int k = kk_ >= 4 ? kk_ + 1 : kk_;
        const size_t modl = (size_t)l * 16 * 6144;
        switch (k) {
        case 0: {
            phase0(P, lds, G);
            float* SSQ = FP(WS_SSQ);
            float* SKR = FP(WS_SSQKR);
            for (int i = obid() * NTHR + otid(); i < 2 * NTOK; i += G * NTHR) { SSQ[i] = 0.f; if (i < NTOK) SKR[i] = 0.f; }
            __syncthreads();
            conv_weights(P, 0, (unsigned char*)(ws + WS_W), lds, G);
        } break;
        case 1: {
            bias_phase(P, lds, G);
            prepass_phase(P.x, P.norm1_g, FP(WS_MOD), 1024, BF(WS_H), FP(WS_SSQ) + 2 * NTOK, G);
        } break;
        case 2: {
            pg8::EpiIn E{BF(WS_PA), BF(WS_DIL), BF(WS_GATES), FP(WS_SSQ), FP(WS_SSQ) + NTOK, FP(WS_SSQKR), P.q_norm_b + l * 64, P.k_norm_b + l * 64, FP(WS_SSQ) + 2 * NTOK, FP(WS_BW1) + (size_t)l * 16 * 4096};
            GEMM(pg8::EpiIn, E, BF(WS_H), WB(l, W_IN), NIN, 1024, 1024);
        } break;
        case 3: {
            pg8::EpiRowScale2 E{(unsigned char*)ws, P.k_norm_a + l * 96};
            { pg8::Gemm g_{BF(WS_PA), WB(l, W_Q), NTOK, 1792, 256, 512, 3, 256}; pg8::StaticOrder S_; S_.init(NTOK, 1792, G, obid()); pg8::gemm_phase<pg8::EpiRowScale2, pg8::StaticOrder, true, true>(lds, g_, S_, E); }
        } break;
        case 5: {
            { float* SSQ = FP(WS_SSQ); float* SKR = FP(WS_SSQKR); for (int i = obid() * NTHR + otid(); i < 4 * NTOK; i += G * NTHR) { SSQ[i] = 0.f; if (i < NTOK) SKR[i] = 0.f; } }
            if (l + 1 < DEPTH) { conv_weights(P, l + 1, (unsigned char*)(ws + WS_W + (size_t)((l + 1) & 1) * WS_WSTRIDE), lds, G); __syncthreads(); }
            bf16_t* Y = BF(WS_KVRAW);
            if (G == 256) { int xcd = obid() & 7, slot = obid() >> 3;
                { const unsigned* tk = (const unsigned*)(ws + WS_CTL) + 8192; bool even = true;
#pragma unroll
                  for (int x = 0; x < 8; ++x) even = even && (__hip_atomic_load(tk + 64 * x, __ATOMIC_RELAXED, __HIP_MEMORY_SCOPE_AGENT) == 32u);
                  if (even) { volatile LAS unsigned* misc = (volatile LAS unsigned*)(lds + RING_BYTES + 320); slot = (int)misc[16]; xcd = (int)misc[17]; } }
                slot = __builtin_amdgcn_readfirstlane(slot); xcd = __builtin_amdgcn_readfirstlane(xcd);
                for (int i = 0; i < 8; ++i) { const int bh = ((i * 2 + (slot >> 4)) << 3) + xcd; mla_unit(lds, BF(WS_H), BF(WS_K), BF(WS_V), Y, P.q_norm_a + l * 96, FP(WS_ROPE), bh >> 3, bh & 7, slot & 15); }
            } else { for (int u = obid(); u < NB * NH * 16; u += G) mla_unit(lds, BF(WS_H), BF(WS_K), BF(WS_V), Y, P.q_norm_a + l * 96, FP(WS_ROPE), u >> 7, (u >> 4) & 7, u & 15); }
            __syncthreads();
            for (int u = obid(); u < NB * NH * 4; u += G) dil_unit(lds, BF(WS_DIL), Y, BF(WS_PA), FP(WS_LSE), FP(WS_BT), u >> 5, (u >> 2) & 7, u & 3);
        } break;
        case 6: {
            pg8::EpiGate2 E{BF(WS_H), BF(WS_GATES)}; GEMM(pg8::EpiGate2, E, BF(WS_KVRAW), WB(l, W_A), 1024, 1024, 1024);
        } break;
        case 7: {
            pg8::EpiResid E{(const __attribute__((address_space(1))) float*)(l == 0 ? P.x : P.out), (__attribute__((address_space(1))) float*)P.out, FP(WS_MOD) + modl + 2048, BF(WS_KVRAW), P.norm2_g + l * DM, FP(WS_MOD) + modl + 4096, FP(WS_SSQ) + 3 * NTOK};
            GEMM(pg8::EpiResid, E, BF(WS_H), WB(l, W_O), 1024, 1024, 1024);
        } break;
        case 8: {
            pg8::EpiSwiGLU E{BF(WS_HID), FP(WS_SSQ) + 3 * NTOK, FP(WS_BW2) + (size_t)l * 16 * 5632}; GEMM(pg8::EpiSwiGLU, E, BF(WS_KVRAW), WB(l, W_1), 5632, 1024, 1024);
        } break;
        default: {
            const bool nxt = l + 1 < DEPTH; const size_t modn = (size_t)(l + 1) * 16 * 6144;
            pg8::EpiResid E{(const __attribute__((address_space(1))) float*)P.out, (__attribute__((address_space(1))) float*)P.out, FP(WS_MOD) + modl + 5120, nxt ? BF(WS_H) : (bf16_t*)nullptr, P.norm1_g + (nxt ? (l + 1) * DM : 0), FP(WS_MOD) + (nxt ? modn + 1024 : 0), FP(WS_SSQ) + 2 * NTOK};
            GEMM(pg8::EpiResid, E, BF(WS_HID), WB(l, W_2), 1024, FFH, FFH);
        } break;
        }
        if (ph + 1 < ph_hi) { if (ph == ph_lo) grid.sync(); else xcd_barrier(xbar); }
    }
}

extern "C" void kernel_launch(void* const* d_in, const int* in_sizes, int n_in, void* d_out, int out_size, void* d_ws, size_t ws_size, hipStream_t stream) {
    static int grid = 0;
    if (grid == 0) {
        if (n_in != 23 || ws_size < WS_END) { fprintf(stderr, "kernel_launch: unexpected n_in %d / ws_size %zu\n", n_in, ws_size); grid = -1; return; }
        int dev = 0, cus = 0, per_cu = 0;
        (void)hipGetDevice(&dev); (void)hipDeviceGetAttribute(&cus, hipDeviceAttributeMultiprocessorCount, dev);
        if (hipFuncSetAttribute((const void*)mega_fwd, hipFuncAttributeMaxDynamicSharedMemorySize, LDS_BYTES) != hipSuccess) { fprintf(stderr, "kernel_launch: hipFuncSetAttribute failed\n"); grid = -1; return; }
        if (hipOccupancyMaxActiveBlocksPerMultiprocessor(&per_cu, (const void*)mega_fwd, NTHR, LDS_BYTES) != hipSuccess || per_cu < 1) { fprintf(stderr, "kernel_launch: occupancy query gave %d\n", per_cu); per_cu = 1; }
        (void)hipGetLastError();
        grid = cus * per_cu;
    }
    if (grid < 0) return;
    Params p{};
    const float** fp = (const float**)&p.x;
    p.x = (const float*)d_in[0]; p.c = (const float*)d_in[1]; p.pos = (const int*)d_in[2]; p.rel_bias = (const float*)d_in[3]; p.norm1_g = (const float*)d_in[4]; p.norm2_g = (const float*)d_in[5];
    p.ada_w = (const float*)d_in[6]; p.ada_b = (const float*)d_in[7]; p.w_in = (const float*)d_in[8]; p.q_a_norm = (const float*)d_in[9]; p.w_q_b = (const float*)d_in[10]; p.kv_a_norm = (const float*)d_in[11];
    p.w_kv_b = (const float*)d_in[12]; p.q_norm_a = (const float*)d_in[13]; p.k_norm_a = (const float*)d_in[14]; p.q_norm_b = (const float*)d_in[15]; p.k_norm_b = (const float*)d_in[16];
    p.w_branch_a = (const float*)d_in[17]; p.w_branch_b = (const float*)d_in[18]; p.w_out = (const float*)d_in[19]; p.w_ffn_gate = (const float*)d_in[20]; p.w_ffn_up = (const float*)d_in[21]; p.w_ffn_down = (const float*)d_in[22];
    (void)fp;
    p.out = (float*)d_out; p.ws = (unsigned char*)d_ws;
    for (int i = 0; i < 16; ++i) p.inv_freq[i] = (float)pow(10000.0, -(double)i / 16.0);
    p.ph_lo = 0; p.ph_hi = NPHASE;
    if (hipMemsetAsync((char*)d_ws + WS_CTL, 0, CTL_BYTES, stream) != hipSuccess) { fprintf(stderr, "kernel_launch: memset failed\n"); return; }
    void* args[] = {&p};
    hipError_t e = hipLaunchCooperativeKernel((const void*)mega_fwd, dim3(grid), dim3(NTHR), args, LDS_BYTES, stream);
    if (e != hipSuccess) fprintf(stderr, "kernel_launch: cooperative launch failed: %s (grid %d)\n", hipGetErrorString(e), grid);
}
```

```cpp
#include <hip/hip_runtime.h>
#include <hip/hip_cooperative_groups.h>
#include <cstdio>
#include <cstdint>
namespace cg = cooperative_groups;
__device__ __forceinline__ int otid() { int t = (int)threadIdx.x; asm volatile("" : "+v"(t)); return t; }
__device__ __forceinline__ int obid() { int b = (int)blockIdx.x; asm volatile("" : "+s"(b)); return b; }

#include <cmath>
namespace pg8 {
#define PG8_LAS __attribute__((address_space(3)))
typedef unsigned short bf16_t;
typedef short bf16x8 __attribute__((ext_vector_type(8)));
typedef float f32x4 __attribute__((ext_vector_type(4)));
typedef unsigned u32x4 __attribute__((ext_vector_type(4)));
constexpr int BM = 256, BK = 64, HALF = 128, HTB = HALF * BK * 2  , STAGE_BYTES = 8 * HTB, NXCD = 8, WGM = 8;

__host__ __device__ __forceinline__ int lds_byte(int r, int c) { const int st = (r >> 4) * 2 + (c >> 5), rr = r & 15, cc = c & 31, ob = rr * 64 + cc * 2; return st * 1024 + (ob ^ (((ob >> 9) & 1) << 5)); }
__host__ __device__ __forceinline__ void stage_rc(int b, int& R, int& C) { const int st = b / 1024, sb = b % 1024, swz = sb ^ (((sb >> 9) & 1) << 5); R = (st >> 1) * 16 + swz / 64; C = (st & 1) * 32 + (swz % 64) / 2; }
__host__ __device__ __forceinline__ int perm32(int rho) { const int n = rho >> 4, i = rho & 15; return 8 * (i >> 2) + 4 * n + (i & 3); }

struct Unit { int pm, pn; };
struct Gemm { const bf16_t* A; const bf16_t* Bt; int M, N, K, lda, asplit, aoff2; };

struct StaticOrder {
    int nM, nN, nwg, G, c;
    __host__ __device__ void init(int M, int N, int G_, int c_) { nM = M / BM; nN = N / BM; nwg = nM * nN; G = G_; c = c_; }
    __host__ __device__ bool next(int i, Unit& u) const {
        const long L = (long)i * G + c; if (L >= nwg) return false;
        int wgid = (int)L; { const int q = nwg / NXCD, r = nwg % NXCD, xcd = wgid % NXCD, off = wgid / NXCD; wgid = (xcd < r ? xcd * (q + 1) : r * (q + 1) + (xcd - r) * q) + off; }
        const int nig = WGM * nN, gid = wgid / nig, fm = gid * WGM, gsz = (nM - fm) < WGM ? (nM - fm) : WGM;
        u.pm = fm + ((wgid % nig) % gsz); u.pn = (wgid % nig) / gsz; return true;
    }
    __device__ __forceinline__ void a_ready(const Unit&) const {}
    __device__ __forceinline__ void done(const Unit&) const {}
};


__device__ __forceinline__ unsigned cvt_pk_bf16(float lo, float hi) { unsigned r; asm volatile("v_cvt_pk_bf16_f32 %0, %1, %2" : "=v"(r) : "v"(lo), "v"(hi)); return r; }
typedef unsigned u32x2 __attribute__((ext_vector_type(2)));
__device__ __forceinline__ float bf_lo(unsigned w) { return __builtin_bit_cast(float, w << 16); }
__device__ __forceinline__ float bf_hi(unsigned w) { return __builtin_bit_cast(float, w & 0xffff0000u); }
__device__ __forceinline__ float sigmoidf_(float x) { return 1.0f / (1.0f + __builtin_amdgcn_exp2f(-1.4426950408889634f * x)); }

constexpr float RMS_EPS = 1e-6f;
constexpr size_t DPLANE = (size_t)65536 * 512;
constexpr float LOG2E = 1.4426950408889634f;
constexpr float QSCALE_B = 0.125f * 1.4426950408889634f;
constexpr float QSCALE_A = 0.10206207261596575f * 1.4426950408889634f;

struct EpiIn {
    static constexpr bool PERM = true, AFTER_DRAIN = false, MIDHOOK = false;
    bf16_t* PA; bf16_t* DIL; bf16_t* GATES; float* ssq_q; float* ssq_kv; float* ssq_kr; const float* qn; const float* kn; const float* ssq1; const float* bw;
    __device__ __forceinline__ void operator()(const f32x4 (&acc_)[2][2][4][2], const Unit& u, int wr, int wc, int fr, int fq) const {
        { const int ln_ = otid() & 63; fr = ln_ & 15; fq = ln_ >> 4; }
        const int pn = u.pn; const size_t rowb = (size_t)u.pm * BM + wr * 64 + fr;
        f32x4 bv[2][2]; float r8[2][4];
        { const float* bwp = bw + (size_t)(u.pm >> 4) * 4096 + pn * BM + wc * 32 + fq * 8;
#pragma unroll
          for (int bj = 0; bj < 2; ++bj)
#pragma unroll
              for (int n = 0; n < 2; ++n) bv[bj][n] = *(const f32x4*)(bwp + bj * HALF + n * 4);
#pragma unroll
          for (int ai = 0; ai < 2; ++ai)
#pragma unroll
              for (int m = 0; m < 4; ++m) r8[ai][m] = __builtin_amdgcn_rsqf(ssq1[rowb + ai * HALF + m * 16] * (1.0f / 1024.0f) + RMS_EPS); }
#define EPIIN_VAL(ai, bj, m, n) (acc_[ai][bj][m][n] * r8[ai][m] + bv[bj][n])
#define EPIIN_PACK(w, a, b) do { (w).x = cvt_pk_bf16((a)[0], (a)[1]); (w).y = cvt_pk_bf16((a)[2], (a)[3]); (w).z = cvt_pk_bf16((b)[0], (b)[1]); (w).w = cvt_pk_bf16((b)[2], (b)[3]); } while (0)
        if (pn < 2) {
            float* sq = pn == 0 ? ssq_q : ssq_kv;
#pragma unroll
            for (int ai = 0; ai < 2; ++ai)
#pragma unroll
                for (int m = 0; m < 4; ++m) { const size_t row = rowb + ai * HALF + m * 16; float s = 0.f, s2 = 0.f;
#pragma unroll
                    for (int bj = 0; bj < 2; ++bj) { const f32x4 a = EPIIN_VAL(ai, bj, m, 0), b = EPIIN_VAL(ai, bj, m, 1);
                        u32x4 w; EPIIN_PACK(w, a, b);
                        *(u32x4*)(PA + row * 512 + pn * 256 + bj * HALF + wc * 32 + fq * 8) = w;
                        const float q = ((a[0] * a[0] + a[1] * a[1]) + (a[2] * a[2] + a[3] * a[3])) + ((b[0] * b[0] + b[1] * b[1]) + (b[2] * b[2] + b[3] * b[3]));
                        if (pn == 0 || bj == 0) s += q; else s2 += q; }
                    s += __shfl_xor(s, 16); s += __shfl_xor(s, 32);
                    if (fq == 0) atomicAdd(sq + row, s);
                    if (pn == 1 && wc == 0) { s2 += __shfl_xor(s2, 16); s2 += __shfl_xor(s2, 32); if (fq == 0) atomicAdd(ssq_kr + row, s2); } }
        } else if (pn < 6) {
            const int sec = (pn - 2) >> 1, head = 4 * ((pn - 2) & 1) + wc; const float* gp = sec == 0 ? qn : kn; const float gs = sec == 0 ? QSCALE_B : 1.0f;
            f32x4 gv[2][2];
#pragma unroll
            for (int bj = 0; bj < 2; ++bj)
#pragma unroll
                for (int n = 0; n < 2; ++n) gv[bj][n] = *(const f32x4*)(gp + 32 * bj + 8 * fq + 4 * n) * gs;
#pragma unroll
            for (int ai = 0; ai < 2; ++ai)
#pragma unroll
                for (int m = 0; m < 4; ++m) { const size_t row = rowb + ai * HALF + m * 16; float s = 0.f;
#pragma unroll
                    for (int bj = 0; bj < 2; ++bj)
#pragma unroll
                        for (int n = 0; n < 2; ++n) { const f32x4 v = EPIIN_VAL(ai, bj, m, n); s += (v[0] * v[0] + v[1] * v[1]) + (v[2] * v[2] + v[3] * v[3]); }
                    s += __shfl_xor(s, 16); s += __shfl_xor(s, 32);
                    const float r = __builtin_amdgcn_rsqf(s * (1.0f / 64.0f) + RMS_EPS);
#pragma unroll
                    for (int bj = 0; bj < 2; ++bj) { const f32x4 a = EPIIN_VAL(ai, bj, m, 0) * r * gv[bj][0], b = EPIIN_VAL(ai, bj, m, 1) * r * gv[bj][1];
                        u32x4 w; EPIIN_PACK(w, a, b);
                        *(u32x4*)(DIL + (size_t)sec * DPLANE + ((((row >> 12) * 8 + head) << 12) + (row & 4095)) * 64 + 32 * bj + 8 * fq) = w; } }
        } else if (pn < 8) {
#pragma unroll
            for (int ai = 0; ai < 2; ++ai)
#pragma unroll
                for (int m = 0; m < 4; ++m) { const size_t row = rowb + ai * HALF + m * 16;
#pragma unroll
                    for (int bj = 0; bj < 2; ++bj) { const f32x4 a = EPIIN_VAL(ai, bj, m, 0), b = EPIIN_VAL(ai, bj, m, 1);
                        u32x4 w; EPIIN_PACK(w, a, b);
                        *(u32x4*)(DIL + 2 * DPLANE + ((((row >> 12) * 8 + (pn - 6) * 4 + 2 * bj + (wc >> 1)) << 12) + (row & 4095)) * 64 + 32 * (wc & 1) + fq * 8) = w; } }
        } else {
#pragma unroll
            for (int ai = 0; ai < 2; ++ai)
#pragma unroll
                for (int m = 0; m < 4; ++m) { const size_t row = rowb + ai * HALF + m * 16;
#pragma unroll
                    for (int bj = 0; bj < 2; ++bj) { f32x4 a = EPIIN_VAL(ai, bj, m, 0), b = EPIIN_VAL(ai, bj, m, 1);
#pragma unroll
                        for (int i = 0; i < 4; ++i) { a[i] = sigmoidf_(a[i]); b[i] = sigmoidf_(b[i]); }
                        u32x4 w; EPIIN_PACK(w, a, b);
                        *(u32x4*)(GATES + row * 2048 + (pn - 8) * 256 + bj * HALF + wc * 32 + fq * 8) = w; } }
        }
    }
};
#undef EPIIN_PACK
#undef EPIIN_VAL
struct EpiRowScale2 {
    static constexpr bool PERM = true, AFTER_DRAIN = false, MIDHOOK = false;
    unsigned char* ws; const float* kg;
    static constexpr size_t O_Q = 0, O_PA = 128u << 20, O_K = 768u << 20, O_V = 864u << 20, O_ROPE = 990u << 20, O_SSQ = 998u << 20, O_SSQKR = (1001u << 20) + 65536;
    __device__ __forceinline__ void operator()(const f32x4 (&acc)[2][2][4][2], const Unit& u, int wr, int wc, int fr, int fq) const {
        { const int ln_ = otid() & 63; fr = ln_ & 15; fq = ln_ >> 4; }
        bf16_t* Oq = (bf16_t*)(ws + O_Q); bf16_t* Kp = (bf16_t*)(ws + O_K); bf16_t* Vp = (bf16_t*)(ws + O_V); const bf16_t* PA = (const bf16_t*)(ws + O_PA); const float* ROPE = (const float*)(ws + O_ROPE);
        const float* ssq_q = (const float*)(ws + O_SSQ); const float* ssq_kv = ssq_q + 65536; const float* ssq_kr = (const float*)(ws + O_SSQKR);
        const size_t rowb = (size_t)u.pm * BM + wr * 64 + fr;
        if (u.pn < 3) {
            const int col0 = u.pn * BM + wc * 32 + 8 * fq;
#pragma unroll
            for (int ai = 0; ai < 2; ++ai)
#pragma unroll
                for (int m = 0; m < 4; ++m) { const size_t row = rowb + ai * HALF + m * 16; const float r = __builtin_amdgcn_rsqf(ssq_q[row] * (1.0f / 256.0f) + RMS_EPS);
#pragma unroll
                    for (int bj = 0; bj < 2; ++bj) { const f32x4 v0 = acc[ai][bj][m][0] * r, v1 = acc[ai][bj][m][1] * r;
                        u32x4 w; w.x = cvt_pk_bf16(v0[0], v0[1]); w.y = cvt_pk_bf16(v0[2], v0[3]); w.z = cvt_pk_bf16(v1[0], v1[1]); w.w = cvt_pk_bf16(v1[2], v1[3]);
                        *(u32x4*)(Oq + row * 768 + col0 + bj * HALF) = w; } }
        } else {
            const int head = (u.pn - 3) * 2 + (wc & 1); float rh8[2][4];
#pragma unroll
            for (int ai = 0; ai < 2; ++ai)
#pragma unroll
                for (int m = 0; m < 4; ++m) { const size_t row = rowb + ai * HALF + m * 16; const float r = __builtin_amdgcn_rsqf(ssq_kv[row] * (1.0f / 128.0f) + RMS_EPS);
                    const size_t hrow = ((((row >> 12) * 8 + head) << 12) + (row & 4095));
                    if (wc >= 2) {
#pragma unroll
                        for (int bj = 0; bj < 2; ++bj) { const f32x4 a = acc[ai][bj][m][0] * r, b = acc[ai][bj][m][1] * r;
                            u32x4 w; w.x = cvt_pk_bf16(a[0], a[1]); w.y = cvt_pk_bf16(a[2], a[3]); w.z = cvt_pk_bf16(b[0], b[1]); w.w = cvt_pk_bf16(b[2], b[3]);
                            *(u32x4*)(Vp + hrow * 64 + 32 * bj + 8 * fq) = w; }
                    } else {
                        float s = 0.f;
#pragma unroll
                        for (int bj = 0; bj < 2; ++bj) { const f32x4 a = acc[ai][bj][m][0], b = acc[ai][bj][m][1]; s += ((a[0] * a[0] + a[1] * a[1]) + (a[2] * a[2] + a[3] * a[3])) + ((b[0] * b[0] + b[1] * b[1]) + (b[2] * b[2] + b[3] * b[3])); }
                        s += __shfl_xor(s, 16); s += __shfl_xor(s, 32);
                        const float rh = __builtin_amdgcn_rsqf((s * r * r + ssq_kr[row]) * (1.0f / 96.0f) + RMS_EPS); const float rr = r * rh;
#pragma unroll
                        for (int bj = 0; bj < 2; ++bj) { const f32x4 a = acc[ai][bj][m][0] * rr * *(const f32x4*)(kg + 32 * bj + 8 * fq), b = acc[ai][bj][m][1] * rr * *(const f32x4*)(kg + 32 * bj + 8 * fq + 4);
                            u32x4 w; w.x = cvt_pk_bf16(a[0], a[1]); w.y = cvt_pk_bf16(a[2], a[3]); w.z = cvt_pk_bf16(b[0], b[1]); w.w = cvt_pk_bf16(b[2], b[3]);
                            *(u32x4*)(Kp + hrow * 96 + 32 * bj + 8 * fq) = w; }
                        rh8[ai][m] = rh;
                    }
                    asm volatile("" ::: "memory"); }
            if (wc < 2) {
#pragma unroll
                for (int ai = 0; ai < 2; ++ai)
#pragma unroll
                    for (int m = 0; m < 4; ++m) { const size_t row = rowb + ai * HALF + m * 16; const size_t hrow = ((((row >> 12) * 8 + head) << 12) + (row & 4095)); const float rh = rh8[ai][m];
                        const bf16_t* krp = PA + row * 512 + 384; const float* rp = ROPE + row * 32;
#pragma unroll
                        for (int e = 0; e < 2; ++e) { const int i0 = 4 * fq + 2 * e;
                            const unsigned xa = *(const unsigned*)(krp + i0), xb = *(const unsigned*)(krp + 16 + i0);
                            const float c0 = rp[i0], c1 = rp[i0 + 1], s0 = rp[16 + i0], s1 = rp[16 + i0 + 1];
                            const float a0 = bf_lo(xa) * rh * kg[64 + i0], a1 = bf_hi(xa) * rh * kg[64 + i0 + 1], b0 = bf_lo(xb) * rh * kg[80 + i0], b1 = bf_hi(xb) * rh * kg[80 + i0 + 1];
                            *(unsigned*)(Kp + hrow * 96 + 64 + i0) = cvt_pk_bf16(a0 * c0 - b0 * s0, a1 * c1 - b1 * s1);
                            *(unsigned*)(Kp + hrow * 96 + 80 + i0) = cvt_pk_bf16(b0 * c0 + a0 * s0, b1 * c1 + a1 * s1); }
                        asm volatile("" ::: "memory"); }
            }
        }
    }
};
struct EpiRowScale {
    static constexpr bool PERM = true, AFTER_DRAIN = false, MIDHOOK = false;
    bf16_t* O; int ldc; const float* ssq; float invk;
    __device__ __forceinline__ void operator()(const f32x4 (&acc)[2][2][4][2], const Unit& u, int wr, int wc, int fr, int fq) const {
        { const int ln_ = otid() & 63; fr = ln_ & 15; fq = ln_ >> 4; }
        const size_t rowb = (size_t)u.pm * BM + wr * 64 + fr; const int col0 = u.pn * BM + wc * 32 + 8 * fq;
#pragma unroll
        for (int ai = 0; ai < 2; ++ai)
#pragma unroll
            for (int m = 0; m < 4; ++m) { const size_t row = rowb + ai * HALF + m * 16; const float r = __builtin_amdgcn_rsqf(ssq[row] * invk + RMS_EPS);
#pragma unroll
                for (int bj = 0; bj < 2; ++bj) { const f32x4 v0 = acc[ai][bj][m][0] * r, v1 = acc[ai][bj][m][1] * r;
                    u32x4 w; w.x = cvt_pk_bf16(v0[0], v0[1]); w.y = cvt_pk_bf16(v0[2], v0[3]); w.z = cvt_pk_bf16(v1[0], v1[1]); w.w = cvt_pk_bf16(v1[2], v1[3]);
                    *(u32x4*)(O + row * ldc + col0 + bj * HALF) = w; } }
    }
};
struct EpiGate2 {
    static constexpr bool PERM = true, AFTER_DRAIN = false, MIDHOOK = true;
    bf16_t* O; const bf16_t* SIG;
    __device__ __forceinline__ void mid(f32x4 (&acc)[2][2][4][2], const Unit& u, int wr, int wc) const {
        const int ln_ = otid() & 63, fr = ln_ & 15, fq = ln_ >> 4;
        const size_t rowb = (size_t)u.pm * BM + wr * 64 + fr; const int col0 = u.pn * BM + wc * 32 + 8 * fq;
#pragma unroll
        for (int ai = 0; ai < 2; ++ai)
#pragma unroll
            for (int m = 0; m < 4; ++m) { const bf16_t* sp = SIG + (rowb + ai * HALF + m * 16) * 2048 + col0;
#pragma unroll
                for (int bj = 0; bj < 2; ++bj) { const u32x4 sa = *(const u32x4*)(sp + bj * HALF), sb = *(const u32x4*)(sp + 1024 + bj * HALF);
                    f32x4& v0 = acc[ai][bj][m][0]; f32x4& v1 = acc[ai][bj][m][1];
                    v0[0] *= bf_lo(sa.x) * __builtin_amdgcn_rcpf(1e-30f + bf_lo(sb.x)); v0[1] *= bf_hi(sa.x) * __builtin_amdgcn_rcpf(1e-30f + bf_hi(sb.x));
                    v0[2] *= bf_lo(sa.y) * __builtin_amdgcn_rcpf(1e-30f + bf_lo(sb.y)); v0[3] *= bf_hi(sa.y) * __builtin_amdgcn_rcpf(1e-30f + bf_hi(sb.y));
                    v1[0] *= bf_lo(sa.z) * __builtin_amdgcn_rcpf(1e-30f + bf_lo(sb.z)); v1[1] *= bf_hi(sa.z) * __builtin_amdgcn_rcpf(1e-30f + bf_hi(sb.z));
                    v1[2] *= bf_lo(sa.w) * __builtin_amdgcn_rcpf(1e-30f + bf_lo(sb.w)); v1[3] *= bf_hi(sa.w) * __builtin_amdgcn_rcpf(1e-30f + bf_hi(sb.w)); }
                asm volatile("" ::: "memory"); }
    }
    __device__ __forceinline__ void operator()(const f32x4 (&acc)[2][2][4][2], const Unit& u, int wr, int wc, int fr, int fq) const {
        { const int ln_ = otid() & 63; fr = ln_ & 15; fq = ln_ >> 4; }
        const size_t rowb = (size_t)u.pm * BM + wr * 64 + fr; const int col0 = u.pn * BM + wc * 32 + 8 * fq;
#pragma unroll
        for (int ai = 0; ai < 2; ++ai)
#pragma unroll
            for (int m = 0; m < 4; ++m) { const size_t row = rowb + ai * HALF + m * 16;
#pragma unroll
                for (int bj = 0; bj < 2; ++bj) { const u32x4 sg = *(const u32x4*)(SIG + row * 2048 + 1024 + col0 + bj * HALF);
                    f32x4 v0 = acc[ai][bj][m][0], v1 = acc[ai][bj][m][1];
                    v0[0] *= bf_lo(sg.x); v0[1] *= bf_hi(sg.x); v0[2] *= bf_lo(sg.y); v0[3] *= bf_hi(sg.y);
                    v1[0] *= bf_lo(sg.z); v1[1] *= bf_hi(sg.z); v1[2] *= bf_lo(sg.w); v1[3] *= bf_hi(sg.w);
                    u32x4 w; w.x = cvt_pk_bf16(v0[0], v0[1]); w.y = cvt_pk_bf16(v0[2], v0[3]); w.z = cvt_pk_bf16(v1[0], v1[1]); w.w = cvt_pk_bf16(v1[2], v1[3]);
                    *(u32x4*)(O + row * 1024 + col0 + bj * HALF) = w; } }
    }
};
struct EpiResid {
    static constexpr bool PERM = false, AFTER_DRAIN = false, MIDHOOK = false;
    const __attribute__((address_space(1))) float* xin; __attribute__((address_space(1))) float* out; const float* gmod;
    bf16_t* XG; const float* gnorm; const float* scmod; float* ssq;
    __device__ __forceinline__ void operator()(const f32x4 (&acc)[2][2][4][2], const Unit& u, int wr, int wc, int fr, int fq) const {
        { const int ln_ = otid() & 63; fr = ln_ & 15; fq = ln_ >> 4; }
        const size_t rowb = (size_t)u.pm * BM + wr * 64 + fr; const int col0 = u.pn * BM + wc * 32 + 4 * fq; const float* gb = gmod + (size_t)(u.pm >> 4) * 6144;
        f32x4 gv[2][2], Gv[2][2];
#pragma unroll
        for (int bj = 0; bj < 2; ++bj)
#pragma unroll
            for (int n = 0; n < 2; ++n) { gv[bj][n] = *(const f32x4*)(gb + col0 + bj * HALF + n * 16);
                if (XG) Gv[bj][n] = *(const f32x4*)(gnorm + col0 + bj * HALF + n * 16) * (1.0f + *(const f32x4*)(scmod + (size_t)(u.pm >> 4) * 6144 + col0 + bj * HALF + n * 16)); }
#pragma unroll
        for (int ai = 0; ai < 2; ++ai)
#pragma unroll
            for (int m = 0; m < 4; ++m) { const size_t row = rowb + ai * HALF + m * 16; const size_t off = row * 1024 + col0; float s = 0.f;
#pragma unroll
                for (int bj = 0; bj < 2; ++bj)
#pragma unroll
                    for (int n = 0; n < 2; ++n) { const f32x4 xv = *(const __attribute__((address_space(1))) f32x4*)(xin + off + bj * HALF + n * 16);
                        const f32x4 xn = xv + gv[bj][n] * acc[ai][bj][m][n];
                        *(__attribute__((address_space(1))) f32x4*)(out + off + bj * HALF + n * 16) = xn;
                        if (XG) { s += (xn[0] * xn[0] + xn[1] * xn[1]) + (xn[2] * xn[2] + xn[3] * xn[3]); const f32x4 t = xn * Gv[bj][n];
                            u32x2 w; w.x = cvt_pk_bf16(t[0], t[1]); w.y = cvt_pk_bf16(t[2], t[3]); *(u32x2*)(XG + off + bj * HALF + n * 16) = w; } }
                if (XG) { s += __shfl_xor(s, 16); s += __shfl_xor(s, 32); if (fq == 0) atomicAdd(ssq + row, s); } }
    }
};
struct EpiSwiGLU {
    static constexpr bool PERM = true, AFTER_DRAIN = false, MIDHOOK = false;
    bf16_t* O; const float* ssq2; const float* bw;
    __device__ __forceinline__ void operator()(const f32x4 (&acc)[2][2][4][2], const Unit& u, int wr, int wc, int fr, int fq) const {
        { const int ln_ = otid() & 63; fr = ln_ & 15; fq = ln_ >> 4; }
        const size_t rowb = (size_t)u.pm * BM + wr * 64 + fr; const int col0 = u.pn * HALF + wc * 32 + 8 * fq;
        const float* bwp = bw + (size_t)(u.pm >> 4) * 5632 + u.pn * BM + wc * 32 + 8 * fq;
        const f32x4 bg0 = *(const f32x4*)bwp, bg1 = *(const f32x4*)(bwp + 4), bu0 = *(const f32x4*)(bwp + HALF), bu1 = *(const f32x4*)(bwp + HALF + 4);
#pragma unroll
        for (int ai = 0; ai < 2; ++ai)
#pragma unroll
            for (int m = 0; m < 4; ++m) { const size_t row = rowb + ai * HALF + m * 16; const float r = __builtin_amdgcn_rsqf(ssq2[row] * (1.0f / 1024.0f) + RMS_EPS);
                f32x4 g0 = acc[ai][0][m][0] * r + bg0, g1 = acc[ai][0][m][1] * r + bg1; const f32x4 u0 = acc[ai][1][m][0] * r + bu0, u1 = acc[ai][1][m][1] * r + bu1;
#pragma unroll
                for (int i = 0; i < 4; ++i) { g0[i] = g0[i] * sigmoidf_(g0[i]) * u0[i]; g1[i] = g1[i] * sigmoidf_(g1[i]) * u1[i]; }
                u32x4 w; w.x = cvt_pk_bf16(g0[0], g0[1]); w.y = cvt_pk_bf16(g0[2], g0[3]); w.z = cvt_pk_bf16(g1[0], g1[1]); w.w = cvt_pk_bf16(g1[2], g1[3]);
                *(u32x4*)(O + row * 2816 + col0) = w; }
    }
};

template <class Epi, class Sched, bool ALIGN_EPI = false, bool SP2 = false>
__device__ __forceinline__ void gemm_phase(PG8_LAS unsigned char* lds, const Gemm g, const Sched& S, const Epi& E) {
    const int tid = otid(), wid = __builtin_amdgcn_readfirstlane(tid >> 6), lane = tid & 63, wr = wid >> 2, wc = wid & 3, fr = lane & 15, fq = lane >> 4;
    const int K = g.K, lda = g.lda, nt = K / BK;
    unsigned voffA[2], voffB[2];
#pragma unroll
    for (int i = 0; i < 2; ++i) { int R, C; stage_rc(tid * 16 + i * 8192, R, C); const int Rb = Epi::PERM ? ((R & ~31) + perm32(R & 31)) : R;
        voffA[i] = (unsigned)(R * lda + C) * 2u; voffB[i] = (unsigned)(Rb * K + C) * 2u; }
    const size_t kstep = (size_t)(BK * 2);
    const size_t hstepB = (size_t)HALF * K * 2, hstepA = (size_t)HALF * lda * 2;
    const size_t tstepB = 2 * hstepB, tstepA = 2 * hstepA;
    const unsigned ldsw = (unsigned)wid * 1024u;
    const int aoff = lds_byte(wr * 64 + fr, fq * 8), boff = lds_byte(wc * 32 + fr, fq * 8);
#define PG8_SA(b, h) (((b) * 2 + (h)) * HTB)
#define PG8_SB(b, h) ((4 + (b) * 2 + (h)) * HTB)
#define PG8_STAGE(bufoff, gbase, voff) do { _Pragma("unroll") for (int _i = 0; _i < 2; ++_i) \
        __builtin_amdgcn_global_load_lds((const unsigned*)((const char*)(gbase) + (voff)[_i]), (PG8_LAS unsigned*)(lds + (bufoff) + ldsw + _i * 8192), 16, 0, 0); } while (0)
#define PG8_LDA(dst, b, h) do { _Pragma("unroll") for (int m = 0; m < 4; ++m) _Pragma("unroll") for (int k = 0; k < 2; ++k) dst[m][k] = *(const PG8_LAS bf16x8*)(lds + PG8_SA(b, h) + aoff + m * 2048 + k * 1024); } while (0)
#define PG8_LDB(dst, b, h) do { _Pragma("unroll") for (int n = 0; n < 2; ++n) _Pragma("unroll") for (int k = 0; k < 2; ++k) dst[n][k] = *(const PG8_LAS bf16x8*)(lds + PG8_SB(b, h) + boff + n * 2048 + k * 1024); } while (0)
#define PG8_MMA(ai, bj, At, Bt) do { __builtin_amdgcn_s_setprio(1); _Pragma("unroll") for (int m = 0; m < 4; ++m) _Pragma("unroll") for (int n = 0; n < 2; ++n) _Pragma("unroll") for (int k = 0; k < 2; ++k) \
        acc[ai][bj][m][n] = __builtin_amdgcn_mfma_f32_16x16x32_bf16(Bt[n][k], At[m][k], acc[ai][bj][m][n], 0, 0, 0); __builtin_amdgcn_s_setprio(0); } while (0)
#define PG8_WAIT_V(n) asm volatile("s_waitcnt vmcnt(" #n ")" ::: "memory")
#define PG8_WAIT_L(n) asm volatile("s_waitcnt lgkmcnt(" #n ")" ::: "memory")
#define PG8_BAR __builtin_amdgcn_s_barrier()
#define PG8_SCHED __builtin_amdgcn_sched_barrier(0)
    Unit cur, nxt; int ui = 0;
    if (!S.next(0, cur)) return;
    f32x4 acc[2][2][4][2];
#pragma unroll
    for (int a = 0; a < 2; ++a)
#pragma unroll
        for (int b = 0; b < 2; ++b)
#pragma unroll
            for (int m = 0; m < 4; ++m)
#pragma unroll
                for (int n = 0; n < 2; ++n) acc[a][b][m][n] = (f32x4){0.f, 0.f, 0.f, 0.f};
    bf16x8 At[4][2], B0[2][2], B1[2][2];
    const char* cA = (const char*)g.A + (size_t)cur.pm * tstepA + (cur.pn >= g.asplit ? (size_t)g.aoff2 * 2 : 0); const char* cB = (const char*)g.Bt + (size_t)cur.pn * tstepB;
    S.a_ready(cur);
    if constexpr (SP2) {
        PG8_STAGE(PG8_SB(0, 0), cB, voffB); PG8_STAGE(PG8_SB(0, 1), cB + hstepB, voffB); PG8_STAGE(PG8_SA(0, 0), cA, voffA); PG8_STAGE(PG8_SA(0, 1), cA + hstepA, voffA);
        if (wr == 1) PG8_BAR;
        PG8_WAIT_V(2); PG8_BAR;
        PG8_STAGE(PG8_SB(1, 0), cB + kstep, voffB); PG8_STAGE(PG8_SA(1, 0), cA + kstep, voffA); PG8_STAGE(PG8_SB(1, 1), cB + hstepB + kstep, voffB);
        PG8_WAIT_V(6); PG8_BAR;
    } else {
        PG8_STAGE(PG8_SB(0, 0), cB, voffB); PG8_STAGE(PG8_SA(0, 0), cA, voffA); PG8_STAGE(PG8_SB(0, 1), cB + hstepB, voffB); PG8_STAGE(PG8_SA(0, 1), cA + hstepA, voffA);
        if (wr == 1) PG8_BAR;
        PG8_WAIT_V(4); PG8_BAR;
        PG8_STAGE(PG8_SB(1, 0), cB + kstep, voffB); PG8_STAGE(PG8_SA(1, 0), cA + kstep, voffA); PG8_STAGE(PG8_SB(1, 1), cB + hstepB + kstep, voffB);
        PG8_WAIT_V(6); PG8_BAR;
    }
    for (;;) {
        const bool has_next = S.next(ui + 1, nxt);
        const char* nA = has_next ? (const char*)g.A + (size_t)nxt.pm * tstepA + (nxt.pn >= g.asplit ? (size_t)g.aoff2 * 2 : 0) : cA; const char* nB = has_next ? (const char*)g.Bt + (size_t)nxt.pn * tstepB : cB;
        for (int t = 0; t < nt; t += 2) {
            const bool last = (t == nt - 2);
            if constexpr (Epi::MIDHOOK) { if (t == (nt >> 1)) E.mid(acc, cur, wr, wc); }
            const char* a1 = cA + (size_t)(t + 1) * kstep;
            const char* a2 = last ? nA : cA + (size_t)(t + 2) * kstep; const char* b2 = last ? nB : cB + (size_t)(t + 2) * kstep;
            const char* a3 = a2 + kstep; const char* b3 = b2 + kstep;
            if (last && has_next) S.a_ready(nxt);
            if constexpr (SP2) {
            PG8_LDB(B0, 0, 0); PG8_LDB(B1, 0, 1); PG8_SCHED; PG8_LDA(At, 0, 0); PG8_STAGE(PG8_SA(1, 1), a1 + hstepA, voffA);
            PG8_WAIT_V(8); PG8_WAIT_L(0); PG8_BAR; PG8_MMA(0, 0, At, B0); PG8_MMA(0, 1, At, B1); PG8_BAR; PG8_SCHED;
            PG8_LDA(At, 0, 1); PG8_STAGE(PG8_SB(0, 0), b2, voffB); PG8_STAGE(PG8_SB(0, 1), b2 + hstepB, voffB); PG8_STAGE(PG8_SA(0, 0), a2, voffA);
            PG8_WAIT_V(8); PG8_WAIT_L(0); PG8_BAR; PG8_MMA(1, 0, At, B0); PG8_MMA(1, 1, At, B1); PG8_BAR; PG8_SCHED;
            PG8_LDB(B0, 1, 0); PG8_LDB(B1, 1, 1); PG8_SCHED; PG8_LDA(At, 1, 0); PG8_STAGE(PG8_SA(0, 1), a2 + hstepA, voffA);
            PG8_WAIT_V(8); PG8_WAIT_L(0); PG8_BAR; PG8_MMA(0, 0, At, B0); PG8_MMA(0, 1, At, B1); PG8_BAR; PG8_SCHED;
            PG8_LDA(At, 1, 1); PG8_STAGE(PG8_SB(1, 0), b3, voffB); PG8_STAGE(PG8_SB(1, 1), b3 + hstepB, voffB); PG8_STAGE(PG8_SA(1, 0), a3, voffA);
            PG8_WAIT_V(8); PG8_WAIT_L(0); PG8_BAR; PG8_MMA(1, 0, At, B0); PG8_MMA(1, 1, At, B1); PG8_BAR; PG8_SCHED;
            } else {
            PG8_LDB(B0, 0, 0); PG8_SCHED; PG8_LDA(At, 0, 0); PG8_STAGE(PG8_SA(1, 1), a1 + hstepA, voffA);
            PG8_WAIT_L(8); PG8_BAR; PG8_WAIT_L(0); PG8_MMA(0, 0, At, B0); PG8_BAR; PG8_SCHED;
            PG8_LDB(B1, 0, 1); PG8_STAGE(PG8_SB(0, 0), b2, voffB);
            PG8_BAR; PG8_WAIT_L(0); PG8_MMA(0, 1, At, B1); PG8_BAR;
            PG8_LDA(At, 0, 1); PG8_STAGE(PG8_SA(0, 0), a2, voffA);
            PG8_BAR; PG8_WAIT_L(0); PG8_MMA(1, 0, At, B0); PG8_BAR; PG8_SCHED;
            PG8_STAGE(PG8_SB(0, 1), b2 + hstepB, voffB);
            PG8_WAIT_V(6); PG8_BAR; PG8_MMA(1, 1, At, B1); PG8_BAR;
            PG8_LDB(B0, 1, 0); PG8_SCHED; PG8_LDA(At, 1, 0); PG8_STAGE(PG8_SA(0, 1), a2 + hstepA, voffA);
            PG8_WAIT_L(8); PG8_BAR; PG8_WAIT_L(0); PG8_MMA(0, 0, At, B0); PG8_BAR; PG8_SCHED;
            PG8_LDB(B1, 1, 1); PG8_STAGE(PG8_SB(1, 0), b3, voffB);
            PG8_BAR; PG8_WAIT_L(0); PG8_MMA(0, 1, At, B1); PG8_BAR;
            PG8_LDA(At, 1, 1); PG8_STAGE(PG8_SA(1, 0), a3, voffA);
            PG8_BAR; PG8_WAIT_L(0); PG8_MMA(1, 0, At, B0); PG8_BAR; PG8_SCHED;
            PG8_STAGE(PG8_SB(1, 1), b3 + hstepB, voffB);
            PG8_WAIT_V(6); PG8_BAR; PG8_MMA(1, 1, At, B1); PG8_BAR;
            }
        }
        if constexpr (ALIGN_EPI) { if (wr == 0) PG8_BAR; }
        if constexpr (!Epi::AFTER_DRAIN) { E(acc, cur, wr, wc, fr, fq); S.done(cur); }
        if (!has_next) break;
#pragma unroll
        for (int a = 0; a < 2; ++a)
#pragma unroll
            for (int b = 0; b < 2; ++b)
#pragma unroll
                for (int m = 0; m < 4; ++m)
#pragma unroll
                    for (int n = 0; n < 2; ++n) acc[a][b][m][n] = (f32x4){0.f, 0.f, 0.f, 0.f};
        cur = nxt; cA = nA; cB = nB; ++ui;
        if constexpr (ALIGN_EPI) { if (wr == 1) PG8_BAR; }
    }
    PG8_WAIT_V(0);
    if constexpr (!ALIGN_EPI) { if (wr == 0) PG8_BAR; }
    PG8_BAR;
    if constexpr (Epi::AFTER_DRAIN) { E.fused(acc, cur, wr, wc, fr, fq, lds, wid, lane); S.done(cur); }
#undef PG8_SA
#undef PG8_SB
#undef PG8_STAGE
#undef PG8_LDA
#undef PG8_LDB
#undef PG8_MMA
#undef PG8_WAIT_V
#undef PG8_WAIT_L
#undef PG8_BAR
#undef PG8_SCHED
}
}

constexpr int NB = 16, SEQ = 4096, DM = 1024, DEPTH = 4, NTOK = NB * SEQ, NH = 8, FFH = 2816, NIN = 4096, INC = 4000;
constexpr int NWAVES = 8, NTHR = 512;
constexpr int LDS_BYTES = 147456, RING_BYTES = 131072;
constexpr size_t MiB = 1u << 20;
constexpr size_t WS_H = 0;
constexpr size_t WS_PA = 128 * MiB;
constexpr size_t WS_DIL = 192 * MiB;
constexpr size_t WS_GATES = 384 * MiB;
constexpr size_t WS_HID = 128 * MiB;
constexpr size_t WS_KVRAW = 640 * MiB;
constexpr size_t WS_K = 768 * MiB;
constexpr size_t WS_V = 864 * MiB;
constexpr size_t WS_W = 928 * MiB, WS_WSTRIDE = 30 * MiB;
constexpr size_t W_IN = 0, W_Q = W_IN + (size_t)NIN * 1024 * 2, W_KV = W_Q + 768 * 256 * 2, W_A = W_KV + 1024 * 256 * 2, W_B = W_A + 1024 * 512 * 2,
                 W_O = W_B + 1024 * 512 * 2, W_1 = W_O + 1024 * 1024 * 2, W_2 = W_1 + (size_t)5632 * 1024 * 2, W_END = W_2 + (size_t)1024 * 2816 * 2;
constexpr size_t WS_MOD = 988 * MiB;
constexpr size_t WS_ROPE = 990 * MiB;
constexpr size_t WS_SSQ = 998 * MiB;
constexpr size_t WS_LSE = 999 * MiB;
constexpr size_t WS_BT = 1001 * MiB;
constexpr size_t WS_SSQKR = 1001 * MiB + 65536;
constexpr size_t WS_BW1 = 1002 * MiB;
constexpr size_t WS_BW2 = 1003 * MiB;
constexpr size_t WS_CTL = 1005 * MiB, CTL_BYTES = 65536;
constexpr size_t WS_END = 1006 * MiB;
static_assert(W_END <= WS_WSTRIDE && WS_W + 2 * WS_WSTRIDE <= WS_MOD, "weights fit");
static_assert(pg8::EpiRowScale2::O_Q == WS_H && pg8::EpiRowScale2::O_PA == WS_PA && pg8::EpiRowScale2::O_K == WS_K && pg8::EpiRowScale2::O_V == WS_V && pg8::EpiRowScale2::O_ROPE == WS_ROPE && pg8::EpiRowScale2::O_SSQ == WS_SSQ && pg8::EpiRowScale2::O_SSQKR == WS_SSQKR, "EpiRowScale2 offsets");
static_assert(WS_HID + (size_t)NTOK * FFH * 2 <= WS_KVRAW, "hid overlay");

#define LAS __attribute__((address_space(3)))
typedef unsigned short bf16_t;
typedef short bf16x8 __attribute__((ext_vector_type(8)));
typedef short s16x4 __attribute__((ext_vector_type(4)));
typedef float f32x4 __attribute__((ext_vector_type(4)));
typedef float f32x16 __attribute__((ext_vector_type(16)));
typedef unsigned u32x4 __attribute__((ext_vector_type(4)));
typedef unsigned u32x2 __attribute__((ext_vector_type(2)));
using pg8::cvt_pk_bf16; using pg8::bf_lo; using pg8::bf_hi;

struct Params {
    const float *x, *c; const int* pos; const float *rel_bias, *norm1_g, *norm2_g, *ada_w, *ada_b, *w_in, *q_a_norm, *w_q_b, *kv_a_norm, *w_kv_b, *q_norm_a, *k_norm_a, *q_norm_b, *k_norm_b,
        *w_branch_a, *w_branch_b, *w_out, *w_ffn_gate, *w_ffn_up, *w_ffn_down;
    float* out; unsigned char* ws;
    float inv_freq[16];
    int ph_lo, ph_hi;
};

__device__ __forceinline__ float wave_sum(float v) {
#pragma unroll
    for (int o = 1; o < 64; o <<= 1) v += __shfl_xor(v, o);
    return v;
}
#define LDS_WAIT() asm volatile("s_waitcnt lgkmcnt(0)" ::: "memory")

__device__ __forceinline__ void phase0(const Params& P, LAS unsigned char* lds, int G) {
    const int tid = otid(), lane = tid & 63, wid = __builtin_amdgcn_readfirstlane(tid >> 6);
    float* MOD = (float*)(P.ws + WS_MOD); float* ROPE = (float*)(P.ws + WS_ROPE); float* BT = (float*)(P.ws + WS_BT);
    const int gtid = obid() * NTHR + tid, nthr = G * NTHR;
    for (int idx = gtid; idx < NTOK * 16; idx += nthr) { const int t = idx >> 4, i = idx & 15;
        const float ang = (float)P.pos[t] * P.inv_freq[i];
        double rev = (double)ang * 0.15915494309189535; rev -= __builtin_rint(rev); const float f = (float)rev;
        ROPE[t * 32 + i] = __builtin_amdgcn_cosf(f); ROPE[t * 32 + 16 + i] = __builtin_amdgcn_sinf(f); }
    for (int idx = gtid; idx < 3 * 8 * 129; idx += nthr) { const int j = idx % 129, h = (idx / 129) & 7, p = idx / (129 * 8);
        const int dil = p == 0 ? 1 : (p == 1 ? 4 : 16); const int rp = (j - 64) * dil; const int n = rp < 0 ? -rp : rp; int bk = rp > 0 ? 16 : 0;
        if (n < 8) bk += n; else { const float nf = (float)n; int lg = 8 + (int)(__logf(nf * 0.125f) / 4.852030263919617f * 8.0f); bk += lg < 15 ? lg : 15; }
        BT[idx] = P.rel_bias[bk * 8 + h] * pg8::LOG2E; }
    LAS float* sC = (LAS float*)lds;
    LAS float* red = (LAS float*)(lds + 65536);
    for (int i = tid; i < 16 * 1024; i += NTHR) { const float v = P.c[i]; sC[i] = v / (1.0f + __expf(-v)); }
    __syncthreads();
    for (int it = obid(); it < 4 * 96; it += G) { const int l = it / 96, cb = it % 96; const int col = cb * 64 + lane;
        float a[16];
#pragma unroll
        for (int b = 0; b < 16; ++b) a[b] = 0.f;
        const float* wp = P.ada_w + ((size_t)l * 1024 + wid * 128) * 6144 + col;
#pragma unroll 16
        for (int k = 0; k < 128; ++k) { const float w = wp[(size_t)k * 6144];
#pragma unroll
            for (int b = 0; b < 16; ++b) a[b] += sC[b * 1024 + wid * 128 + k] * w; }
#pragma unroll
        for (int b = 0; b < 16; ++b) red[(wid * 16 + b) * 64 + lane] = a[b];
        __syncthreads();
        for (int o = tid; o < 1024; o += NTHR) { const int b = o >> 6, ln = o & 63; float s = 0.f;
#pragma unroll
            for (int w = 0; w < 8; ++w) s += red[(w * 16 + b) * 64 + ln];
            MOD[((size_t)l * 16 + b) * 6144 + cb * 64 + ln] = s + P.ada_b[l * 6144 + cb * 64 + ln]; }
        __syncthreads();
    }
}

__device__ __forceinline__ void tr_item(const float* W, int Nsrc, int k0, int j0, const float* kscale, bf16_t* WT, int Kdst, int R0, LAS float* scr, int lane) {
    if (j0 >= 0) {
#pragma unroll 8
        for (int i = 0; i < 32; ++i) { const int kk = 2 * i + (lane >> 5); float v = W[(size_t)(k0 + kk) * Nsrc + j0 + (lane & 31)]; if (kscale) v *= kscale[k0 + kk]; scr[kk * 33 + (lane & 31)] = v; }
    } else {
#pragma unroll 8
        for (int i = 0; i < 32; ++i) { const int kk = 2 * i + (lane >> 5); scr[kk * 33 + (lane & 31)] = 0.f; }
    }
    LDS_WAIT();
    const int c = lane & 7;
#pragma unroll
    for (int j = 0; j < 4; ++j) { const int n = (lane >> 3) + 8 * j; const LAS float* s = scr + (8 * c) * 33 + n;
        u32x4 o; o.x = cvt_pk_bf16(s[0 * 33], s[1 * 33]); o.y = cvt_pk_bf16(s[2 * 33], s[3 * 33]); o.z = cvt_pk_bf16(s[4 * 33], s[5 * 33]); o.w = cvt_pk_bf16(s[6 * 33], s[7 * 33]);
        *(u32x4*)(WT + (size_t)(R0 + n) * Kdst + k0 + 8 * c) = o; }
    LDS_WAIT();
}
__device__ __forceinline__ int win_src_col(int R0) {
    const int pn = R0 >> 8, rho = R0 & 255;
    if (pn == 0) return rho;
    if (pn == 1) return rho < 160 ? 256 + rho : -1;
    if (pn < 6) { const int wc = (rho >> 5) & 3, dd = 32 * (rho >> 7); const int sec = (pn - 2) >> 1, head = 4 * ((pn - 2) & 1) + wc; return 416 + sec * 512 + head * 64 + dd; }
    if (pn < 8) return 416 + 1024 + (R0 - 1536);
    return 1952 + (R0 - 2048);
}
__device__ __forceinline__ void conv_weights(const Params& P, int l, unsigned char* wb, LAS unsigned char* lds, int G) {
    const int tid = otid(), lane = tid & 63, wid = __builtin_amdgcn_readfirstlane(tid >> 6);
    LAS float* scr = (LAS float*)(lds + wid * 16384);
    constexpr int I_IN = 16 * 128, I_Q = 4 * 24, I_KV = 4 * 32, I_A = 8 * 32, I_B = 8 * 32, I_O = 16 * 32, I_1 = 16 * 176, I_2 = 44 * 32;
    constexpr int NIT = I_IN + I_Q + I_KV + I_A + I_B + I_O + I_1 + I_2;
    for (int it = obid() * NWAVES + wid; it < NIT; it += G * NWAVES) {
        int r = it;
        if (r < I_IN) { const int kb = r / 128, rb = r % 128; tr_item(P.w_in + (size_t)l * 1024 * INC, INC, kb * 64, win_src_col(rb * 32), nullptr, (bf16_t*)(wb + W_IN), 1024, rb * 32, scr, lane); continue; } r -= I_IN;
        if (r < I_Q) { const int kb = r / 24, rb = r % 24; tr_item(P.w_q_b + (size_t)l * 256 * 768, 768, kb * 64, rb * 32, P.q_a_norm + l * 256, (bf16_t*)(wb + W_Q), 256, rb * 32, scr, lane); continue; } r -= I_Q;
        if (r < I_KV) { const int kb = r / 32, rb = r % 32; const int R0 = rb * 32, pnl = R0 >> 8, rho = R0 & 255, wcq = (rho >> 5) & 3;
            const int jsrc = (pnl * 2 + (wcq & 1)) * 128 + (wcq >= 2 ? 64 : 0) + 32 * (rho >> 7);
            tr_item(P.w_kv_b + (size_t)l * 128 * 1024, 1024, kb * 64, kb < 2 ? jsrc : -1, P.kv_a_norm + l * 128, (bf16_t*)(wb + W_KV), 256, R0, scr, lane); continue; } r -= I_KV;
        if (r < I_A) { const int kb = r / 32, rb = r % 32; tr_item(P.w_branch_a + (size_t)l * 512 * 1024, 1024, kb * 64, rb * 32, nullptr, (bf16_t*)(wb + W_A), 1024, rb * 32, scr, lane); continue; } r -= I_A;
        if (r < I_B) { const int kb = r / 32, rb = r % 32; tr_item(P.w_branch_b + (size_t)l * 512 * 1024, 1024, kb * 64, rb * 32, nullptr, (bf16_t*)(wb + W_A) + 512, 1024, rb * 32, scr, lane); continue; } r -= I_B;
        if (r < I_O) { const int kb = r / 32, rb = r % 32; tr_item(P.w_out + (size_t)l * 1024 * 1024, 1024, kb * 64, rb * 32, nullptr, (bf16_t*)(wb + W_O), 1024, rb * 32, scr, lane); continue; } r -= I_O;
        if (r < I_1) { const int kb = r / 176, rb = r % 176; const int R0 = rb * 32, pn = R0 >> 8, rho = R0 & 255;
            const float* src = (rho < 128 ? P.w_ffn_gate : P.w_ffn_up) + (size_t)l * 1024 * FFH;
            tr_item(src, FFH, kb * 64, pn * 128 + (rho & 127), nullptr, (bf16_t*)(wb + W_1), 1024, R0, scr, lane); continue; } r -= I_1;
        { const int kb = r / 32, rb = r % 32; tr_item(P.w_ffn_down + (size_t)l * FFH * 1024, 1024, kb * 64, rb * 32, nullptr, (bf16_t*)(wb + W_2), FFH, rb * 32, scr, lane); }
    }
}

__device__ __forceinline__ void norm_phase(const float* xin, const float* g, const float* mod  , int sh_off, int sc_off, bf16_t* H, int G) {
    const int tid = otid(), lane = tid & 63, wid = __builtin_amdgcn_readfirstlane(tid >> 6);
    for (int m = obid() * NWAVES + wid; m < NTOK; m += G * NWAVES) {
        const f32x4* xr = (const f32x4*)(xin + (size_t)m * DM) + lane; f32x4 v[4]; float s = 0.f;
#pragma unroll
        for (int j = 0; j < 4; ++j) { v[j] = xr[64 * j]; s += (v[j][0] * v[j][0] + v[j][1] * v[j][1]) + (v[j][2] * v[j][2] + v[j][3] * v[j][3]); }
        const float r = __builtin_amdgcn_rsqf(wave_sum(s) * (1.0f / DM) + pg8::RMS_EPS);
        const float* mb = mod + (size_t)(m >> 12) * 6144;
#pragma unroll
        for (int j = 0; j < 4; ++j) { const int col = 4 * lane + 256 * j;
            const f32x4 gv = *(const f32x4*)(g + col), sc = *(const f32x4*)(mb + sc_off + col), sh = *(const f32x4*)(mb + sh_off + col);
            const f32x4 o = (v[j] * r) * gv * (1.0f + sc) + sh;
            u32x2 w; w.x = cvt_pk_bf16(o[0], o[1]); w.y = cvt_pk_bf16(o[2], o[3]);
            *(u32x2*)(H + (size_t)m * DM + col) = w; }
    }
}

__device__ __forceinline__ void prepass_phase(const float* xin, const float* g, const float* mod  , int sc_off, bf16_t* XG, float* ssq, int G) {
    const int tid = otid(), lane = tid & 63, wid = __builtin_amdgcn_readfirstlane(tid >> 6);
    for (int m = obid() * NWAVES + wid; m < NTOK; m += G * NWAVES) {
        const f32x4* xr = (const f32x4*)(xin + (size_t)m * DM) + lane; float s = 0.f;
        const float* mb = mod + (size_t)(m >> 12) * 6144;
#pragma unroll
        for (int j = 0; j < 4; ++j) { const f32x4 v = xr[64 * j]; s += (v[0] * v[0] + v[1] * v[1]) + (v[2] * v[2] + v[3] * v[3]); const int col = 4 * lane + 256 * j;
            const f32x4 o = v * *(const f32x4*)(g + col) * (1.0f + *(const f32x4*)(mb + sc_off + col));
            u32x2 w; w.x = cvt_pk_bf16(o[0], o[1]); w.y = cvt_pk_bf16(o[2], o[3]);
            *(u32x2*)(XG + (size_t)m * DM + col) = w; }
        s = wave_sum(s);
        if (lane == 0) ssq[m] = s;
    }
}
__device__ __forceinline__ void bias_phase(const Params& P, LAS unsigned char* lds, int G) {
    const int tid = otid(), lane = tid & 63, wid = __builtin_amdgcn_readfirstlane(tid >> 6);
    const float* MOD = (const float*)(P.ws + WS_MOD); float* BW1 = (float*)(P.ws + WS_BW1); float* BW2 = (float*)(P.ws + WS_BW2);
    LAS float* sC = (LAS float*)lds;
    LAS float* red = (LAS float*)(lds + 65536);
    for (int it = obid(); it < 4 * 152; it += G) { const int l = it / 152, blk = it % 152; const bool ffn = blk >= 64; const int R0 = (ffn ? blk - 64 : blk) * 64;
        __syncthreads();
        for (int i = tid; i < 16 * 1024; i += NTHR) sC[i] = MOD[((size_t)l * 16 + (i >> 10)) * 6144 + (ffn ? 3072 : 0) + (i & 1023)];
        __syncthreads();
        const int R = R0 + lane; const float* wsrc; int j; size_t ncol;
        if (!ffn) { const int jb = win_src_col(R & ~31); j = jb < 0 ? -1 : jb + (R & 31); wsrc = P.w_in + (size_t)l * 1024 * INC; ncol = INC; }
        else { const int pn = R >> 8, rho = R & 255; j = pn * 128 + (rho & 127); wsrc = (rho < 128 ? P.w_ffn_gate : P.w_ffn_up) + (size_t)l * 1024 * FFH; ncol = FFH; }
        float a[16];
#pragma unroll
        for (int b = 0; b < 16; ++b) a[b] = 0.f;
        if (j >= 0) { const float* wp = wsrc + (size_t)(wid * 128) * ncol + j;
#pragma unroll 16
            for (int k = 0; k < 128; ++k) { const float w = wp[(size_t)k * ncol];
#pragma unroll
                for (int b = 0; b < 16; ++b) a[b] += sC[b * 1024 + wid * 128 + k] * w; } }
#pragma unroll
        for (int b = 0; b < 16; ++b) red[(wid * 16 + b) * 64 + lane] = a[b];
        __syncthreads();
        for (int o = tid; o < 1024; o += NTHR) { const int b = o >> 6, ln = o & 63; float s = 0.f;
#pragma unroll
            for (int w = 0; w < 8; ++w) s += red[(w * 16 + b) * 64 + ln];
            if (!ffn) BW1[((size_t)l * 16 + b) * 4096 + R0 + ln] = s; else BW2[((size_t)l * 16 + b) * 5632 + R0 + ln] = s; }
    }
    __syncthreads();
}

__device__ __forceinline__ void unpack8(const u32x4 w, float* f) { f[0] = bf_lo(w.x); f[1] = bf_hi(w.x); f[2] = bf_lo(w.y); f[3] = bf_hi(w.y); f[4] = bf_lo(w.z); f[5] = bf_hi(w.z); f[6] = bf_lo(w.w); f[7] = bf_hi(w.w); }
__device__ __forceinline__ u32x4 pack8(const float* f) { u32x4 w; w.x = cvt_pk_bf16(f[0], f[1]); w.y = cvt_pk_bf16(f[2], f[3]); w.z = cvt_pk_bf16(f[4], f[5]); w.w = cvt_pk_bf16(f[6], f[7]); return w; }
__device__ __forceinline__ float ssq8(const u32x4 w) { float f[8]; unpack8(w, f); return ((f[0] * f[0] + f[1] * f[1]) + (f[2] * f[2] + f[3] * f[3])) + ((f[4] * f[4] + f[5] * f[5]) + (f[6] * f[6] + f[7] * f[7])); }
__device__ __forceinline__ void head_norm_rope(const bf16_t* src_nope, const bf16_t* src_rope, bf16_t* dst, const float* gain, const float* rope, float oscale) {
    float s = 0.f;
#pragma unroll
    for (int c = 0; c < 8; ++c) s += ssq8(*(const u32x4*)(src_nope + 8 * c));
#pragma unroll
    for (int c = 0; c < 4; ++c) s += ssq8(*(const u32x4*)(src_rope + 8 * c));
    const float r = __builtin_amdgcn_rsqf(s * (1.0f / 96.0f) + pg8::RMS_EPS);
    asm volatile("" ::: "memory");
#pragma unroll
    for (int c = 0; c < 8; ++c) { float f[8]; unpack8(*(const u32x4*)(src_nope + 8 * c), f);
#pragma unroll
        for (int i = 0; i < 8; ++i) f[i] = f[i] * r * gain[8 * c + i] * oscale;
        *(u32x4*)(dst + 8 * c) = pack8(f); asm volatile("" ::: "memory"); }
    float x[32];
#pragma unroll
    for (int c = 0; c < 4; ++c) unpack8(*(const u32x4*)(src_rope + 8 * c), x + 8 * c);
#pragma unroll
    for (int i = 0; i < 32; ++i) x[i] = x[i] * r * gain[64 + i];
#pragma unroll
    for (int i = 0; i < 16; ++i) { const float cs = rope[i], sn = rope[16 + i]; const float x1 = x[i], x2 = x[16 + i]; x[i] = (x1 * cs - x2 * sn) * oscale; x[16 + i] = (x2 * cs + x1 * sn) * oscale; }
#pragma unroll
    for (int c = 0; c < 4; ++c) *(u32x4*)(dst + 64 + 8 * c) = pack8(x + 8 * c);
    asm volatile("" ::: "memory");
}
__device__ __forceinline__ void prep_phase(const Params& P, int l, int G) {
    const bf16_t* KVRAW = (const bf16_t*)(P.ws + WS_KVRAW); const bf16_t* PA = (const bf16_t*)(P.ws + WS_PA);
    bf16_t* K = (bf16_t*)(P.ws + WS_K); const float* ROPE = (const float*)(P.ws + WS_ROPE);
    const float* kg = P.k_norm_a + l * 96;
    for (int idx = obid() * NTHR + otid(); idx < NTOK * NH; idx += G * NTHR) { const int t = idx >> 3, h = idx & 7;
        const float* rp = ROPE + (size_t)t * 32;
        const bf16_t* kp = KVRAW + (size_t)t * 1024 + h * 128;
        const size_t hrow = ((size_t)((t >> 12) * 8 + h) << 12) + (t & 4095);
        head_norm_rope(kp, PA + (size_t)t * 512 + 384, K + hrow * 96, kg, rp, 1.0f);
    }
}
typedef short v4i16_t __attribute__((ext_vector_type(4)));
__device__ __forceinline__ s16x4 vtr(const LAS unsigned char* p) { return __builtin_bit_cast(s16x4, __builtin_amdgcn_ds_read_tr16_b64_v4i16((LAS v4i16_t*)p)); }
__device__ __forceinline__ bf16x8 cat8(s16x4 a, s16x4 b) { return (bf16x8){a[0], a[1], a[2], a[3], b[0], b[1], b[2], b[3]}; }
__device__ __forceinline__ bf16x8 packp(const f32x16& p, int o) {
    u32x4 w; w.x = cvt_pk_bf16(p[o + 0], p[o + 1]); w.y = cvt_pk_bf16(p[o + 2], p[o + 3]); w.z = cvt_pk_bf16(p[o + 4], p[o + 5]); w.w = cvt_pk_bf16(p[o + 6], p[o + 7]);
    return __builtin_bit_cast(bf16x8, w);
}
__device__ __forceinline__ float max16(const f32x16& p) {
    float a = fmaxf(fmaxf(p[0], p[1]), fmaxf(p[2], p[3])), b = fmaxf(fmaxf(p[4], p[5]), fmaxf(p[6], p[7]));
    float c = fmaxf(fmaxf(p[8], p[9]), fmaxf(p[10], p[11])), d = fmaxf(fmaxf(p[12], p[13]), fmaxf(p[14], p[15]));
    return fmaxf(fmaxf(a, b), fmaxf(c, d));
}
#define MFMA32(a, b, c) __builtin_amdgcn_mfma_f32_32x32x16_bf16((a), (b), (c), 0, 0, 0)
constexpr int KP = 208, VP = 192;
constexpr int KT_B = 64 * KP, VT_B = 64 * VP;
constexpr int MLA_K0 = 0, MLA_V0 = 2 * KT_B;

constexpr float MLA_THR = 8.0f;
__device__ __forceinline__ float max3f(float a, float b, float c) { float r; asm("v_max3_f32 %0, %1, %2, %3" : "=v"(r) : "v"(a), "v"(b), "v"(c)); return r; }
__device__ __forceinline__ float rowmax32(const f32x16& a, const f32x16& b) {
    float x = max3f(a[0], a[1], a[2]), y = max3f(b[0], b[1], b[2]);
    x = max3f(x, a[3], a[4]); y = max3f(y, b[3], b[4]); x = max3f(x, a[5], a[6]); y = max3f(y, b[5], b[6]); x = max3f(x, a[7], a[8]); y = max3f(y, b[7], b[8]);
    x = max3f(x, a[9], a[10]); y = max3f(y, b[9], b[10]); x = max3f(x, a[11], a[12]); y = max3f(y, b[11], b[12]); x = max3f(x, a[13], a[14]); y = max3f(y, b[13], b[14]);
    x = max3f(x, a[15], b[15]); x = max3f(x, y, y);
    return max3f(x, __shfl_xor(x, 32), x);
}
#define SBAR0() __builtin_amdgcn_sched_barrier(0)
__device__ __forceinline__ void mla_unit(LAS unsigned char* lds, const bf16_t* Q, const bf16_t* K, const bf16_t* V, bf16_t* Y, const float* qgain, const float* ROPE, int b, int h, int qb) {
    const int tid = otid(), lane = tid & 63, wid = __builtin_amdgcn_readfirstlane(tid >> 6), r32 = lane & 31, hi = lane >> 5;
    const size_t tok0 = (size_t)b * SEQ; const size_t qrow = tok0 + qb * 256 + wid * 32 + r32;
    bf16x8 qf[6];
    {
        const bf16_t* qp = Q + qrow * 768 + h * 96 + hi * 8; float f[6][8]; float s = 0.f;
#pragma unroll
        for (int d0 = 0; d0 < 6; ++d0) { unpack8(*(const u32x4*)(qp + d0 * 16), f[d0]);
#pragma unroll
            for (int i = 0; i < 8; ++i) s += f[d0][i] * f[d0][i]; }
        s += __shfl_xor(s, 32);
        const float r = __builtin_amdgcn_rsqf(s * (1.0f / 96.0f) + pg8::RMS_EPS);
#pragma unroll
        for (int d0 = 0; d0 < 6; ++d0)
#pragma unroll
            for (int i = 0; i < 8; ++i) f[d0][i] = f[d0][i] * r * qgain[d0 * 16 + hi * 8 + i];
        const float* rp = ROPE + qrow * 32 + hi * 8;
#pragma unroll
        for (int i = 0; i < 8; ++i) { const float cs = rp[i], sn = rp[16 + i]; const float x1 = f[4][i], x2 = f[5][i]; f[4][i] = x1 * cs - x2 * sn; f[5][i] = x2 * cs + x1 * sn; }
#pragma unroll
        for (int d0 = 0; d0 < 6; ++d0) {
#pragma unroll
            for (int i = 0; i < 8; ++i) f[d0][i] *= pg8::QSCALE_A;
            qf[d0] = __builtin_bit_cast(bf16x8, pack8(f[d0])); }
    }
    const int kr0 = tid / 12, kc0 = tid % 12, kr1 = (512 + tid) / 12, kc1 = (512 + tid) % 12, vr = tid >> 3, vc = tid & 7;
    const size_t hrow0 = (size_t)(b * 8 + h) * SEQ;
    const bf16_t* kg0 = K + (hrow0 + kr0) * 96 + kc0 * 8; const bf16_t* kg1 = K + (hrow0 + kr1) * 96 + kc1 * 8;
    const bf16_t* vg = V + (hrow0 + vr) * 64 + vc * 8;
    const int kl0 = kr0 * KP + kc0 * 16, kl1 = kr1 * KP + kc1 * 16, vl = vr * VP + vc * 16;
    const bool has1 = tid < 256;
    u32x4 ka0, kb0, ka1, kb1, vv0, vv1;
    ka0 = *(const u32x4*)kg0; if (has1) kb0 = *(const u32x4*)kg1; vv0 = *(const u32x4*)vg;
    ka1 = *(const u32x4*)(kg0 + (size_t)64 * 96); if (has1) kb1 = *(const u32x4*)(kg1 + (size_t)64 * 96);
    *(LAS u32x4*)(lds + MLA_K0 + kl0) = ka0; if (has1) *(LAS u32x4*)(lds + MLA_K0 + kl1) = kb0; *(LAS u32x4*)(lds + MLA_V0 + vl) = vv0;
    *(LAS u32x4*)(lds + MLA_K0 + KT_B + kl0) = ka1; if (has1) *(LAS u32x4*)(lds + MLA_K0 + KT_B + kl1) = kb1;
    ka0 = *(const u32x4*)(kg0 + (size_t)128 * 96); if (has1) kb0 = *(const u32x4*)(kg1 + (size_t)128 * 96); vv1 = *(const u32x4*)(vg + (size_t)64 * 64);
    __syncthreads();
    f32x16 o0, o1, negm;
#pragma unroll
    for (int i = 0; i < 16; ++i) { o0[i] = 0.f; o1[i] = 0.f; negm[i] = 0.f; }
    const int koff = r32 * KP + hi * 16;
    const int voff = (4 * hi + ((lane & 15) >> 2)) * VP + (16 * ((lane >> 4) & 1) + 4 * (lane & 3)) * 2;
    f32x16 p0, p1, n0, n1;
    { const LAS unsigned char* kb_ = lds + MLA_K0 + koff; p0 = negm; p1 = negm;
#pragma unroll
      for (int d0 = 0; d0 < 6; ++d0) { const bf16x8 a0 = *(const LAS bf16x8*)(kb_ + d0 * 32), a1 = *(const LAS bf16x8*)(kb_ + 32 * KP + d0 * 32); p0 = MFMA32(a0, qf[d0], p0); p1 = MFMA32(a1, qf[d0], p1); } }
    float m_ref, l_run = 0.f;
    { const float mx = rowmax32(p0, p1); m_ref = mx;
#pragma unroll
      for (int i = 0; i < 16; ++i) { p0[i] -= mx; p1[i] -= mx; negm[i] = -mx; } }
#define MLA_STEP(C0, C1, X0, X1, T, KAI, KBI, VVI, KAW, KBW, VVW) do { const int t_ = (T); const int cur = t_ & 1; \
        if (t_ + 3 < 64) { const size_t go = (size_t)(t_ + 3) * 64; KAI = *(const u32x4*)(kg0 + go * 96); if (has1) KBI = *(const u32x4*)(kg1 + go * 96); } \
        if (t_ + 2 < 64) { const size_t go = (size_t)(t_ + 2) * 64; VVI = *(const u32x4*)(vg + go * 64); } \
        bf16x8 kfr[12]; { const LAS unsigned char* kn = lds + MLA_K0 + (cur ^ 1) * KT_B + koff; \
            _Pragma("unroll") for (int d0 = 0; d0 < 6; ++d0) { kfr[2 * d0] = *(const LAS bf16x8*)(kn + d0 * 32); kfr[2 * d0 + 1] = *(const LAS bf16x8*)(kn + 32 * KP + d0 * 32); } } \
        SBAR0(); \
        const float mx = rowmax32(C0, C1); \
        if (__builtin_amdgcn_ballot_w64(mx > MLA_THR) != 0ull) { const float d = fmaxf(mx, 0.f); const float sc = __builtin_amdgcn_exp2f(-d); m_ref += d; l_run *= sc; \
            _Pragma("unroll") for (int i = 0; i < 16; ++i) { C0[i] -= d; C1[i] -= d; o0[i] *= sc; o1[i] *= sc; negm[i] = -m_ref; } } \
        SBAR0(); \
        X0 = negm; X1 = negm; \
        _Pragma("unroll") for (int d0 = 0; d0 < 6; ++d0) { X0 = MFMA32(kfr[2 * d0], qf[d0], X0); X1 = MFMA32(kfr[2 * d0 + 1], qf[d0], X1); } \
        SBAR0(); \
        float ls = 0.f; \
        _Pragma("unroll") for (int i = 0; i < 16; ++i) { C0[i] = __builtin_amdgcn_exp2f(C0[i]); C1[i] = __builtin_amdgcn_exp2f(C1[i]); ls += C0[i] + C1[i]; } \
        l_run += ls; \
        bf16x8 pb[4]; pb[0] = packp(C0, 0); pb[1] = packp(C0, 8); pb[2] = packp(C1, 0); pb[3] = packp(C1, 8); \
        const LAS unsigned char* vb_ = lds + MLA_V0 + cur * VT_B + voff; \
        _Pragma("unroll") for (int j = 0; j < 4; ++j) { const LAS unsigned char* vj = vb_ + 16 * j * VP; \
            const bf16x8 a0 = cat8(vtr(vj), vtr(vj + 8 * VP)); const bf16x8 a1 = cat8(vtr(vj + 64), vtr(vj + 8 * VP + 64)); \
            o0 = MFMA32(a0, pb[j], o0); o1 = MFMA32(a1, pb[j], o1); } \
        if (t_ + 2 < 64) { *(LAS u32x4*)(lds + MLA_K0 + cur * KT_B + kl0) = KAW; if (has1) *(LAS u32x4*)(lds + MLA_K0 + cur * KT_B + kl1) = KBW; } \
        if (t_ + 1 < 64) *(LAS u32x4*)(lds + MLA_V0 + (cur ^ 1) * VT_B + vl) = VVW; \
        __syncthreads(); } while (0)
    if (wid >= 4) __builtin_amdgcn_s_setprio(1);
    for (int t = 0; t < 64; t += 2) { MLA_STEP(p0, p1, n0, n1, t, ka1, kb1, vv0, ka0, kb0, vv1); MLA_STEP(n0, n1, p0, p1, t + 1, ka0, kb0, vv1, ka1, kb1, vv0); }
    __builtin_amdgcn_s_setprio(0);
#undef MLA_STEP
    const float lt = l_run + __shfl_xor(l_run, 32); const float inv = 1.0f / lt;
    bf16_t* yp = Y + qrow * 1024 + h * 64 + 4 * hi;
#pragma unroll
    for (int g = 0; g < 4; ++g) {
        u32x2 w0; w0.x = cvt_pk_bf16(o0[4 * g] * inv, o0[4 * g + 1] * inv); w0.y = cvt_pk_bf16(o0[4 * g + 2] * inv, o0[4 * g + 3] * inv); *(u32x2*)(yp + 8 * g) = w0;
        u32x2 w1; w1.x = cvt_pk_bf16(o1[4 * g] * inv, o1[4 * g + 1] * inv); w1.y = cvt_pk_bf16(o1[4 * g + 2] * inv, o1[4 * g + 3] * inv); *(u32x2*)(yp + 32 + 8 * g) = w1; }
}

constexpr int DW_BYTES = 13440;
template <int DELTA>
__device__ __forceinline__ void dil_block(LAS unsigned char* wl, const bf16_t* kbase  , const bf16_t* vbase, size_t rstride  ,
                                          const bf16x8 (&qf)[2][4], f32x16 (&o)[2][2], float (&m_run)[2], float (&l_run)[2], int bvar, int voff, int lane, int r32, int hi, int btb) {
    u32x4 vv[8]; bf16x8 kf[2][4];
#pragma unroll
    for (int i = 0; i < 8; ++i) { const int idx = lane + 64 * i, row = idx >> 3, ch = idx & 7; vv[i] = *(const u32x4*)(vbase + (size_t)row * rstride + ch * 8); }
#pragma unroll
    for (int kvh = 0; kvh < 2; ++kvh)
#pragma unroll
        for (int d0 = 0; d0 < 4; ++d0) kf[kvh][d0] = *(const bf16x8*)(kbase + (size_t)(32 * kvh + r32) * rstride + d0 * 16);
    SBAR0();
#pragma unroll
    for (int i = 0; i < 8; ++i) { const int idx = lane + 64 * i, row = idx >> 3, ch = idx & 7; *(LAS u32x4*)(wl + row * VP + ch * 16) = vv[i]; }
    bf16x8 pb[2][4];
#pragma unroll
    for (int qh = 0; qh < 2; ++qh) {
        f32x16 s[2]; float mx = -1e30f;
#pragma unroll
        for (int kvh = 0; kvh < 2; ++kvh) {
            constexpr int dummy = 0; (void)dummy;
            const int toff = 64 * DELTA + 32 * (kvh - qh);
            if (toff > 64 || toff < -64) continue;
#pragma unroll
            for (int i = 0; i < 16; ++i) s[kvh][i] = 0.f;
#pragma unroll
            for (int d0 = 0; d0 < 4; ++d0) s[kvh] = MFMA32(kf[kvh][d0], qf[qh][d0], s[kvh]);
#pragma unroll
            for (int rr = 0; rr < 16; ++rr) { const int c4 = 4 * ((rr & 3) + 8 * (rr >> 2)); const float bias = *(const LAS float*)(wl + bvar + (VT_B + c4 + toff * 4));
                float v = s[kvh][rr] + bias;
                if (toff == 64) v = (bvar <= btb - c4) ? v : -1e30f;
                if (toff == -64) v = (bvar >= btb - c4) ? v : -1e30f;
                s[kvh][rr] = v; mx = fmaxf(mx, v); }
        }
        mx = fmaxf(mx, __shfl_xor(mx, 32));
        const float m_new = fmaxf(m_run[qh], mx); const float alpha = __builtin_amdgcn_exp2f(m_run[qh] - m_new); m_run[qh] = m_new;
        float ls = 0.f;
#pragma unroll
        for (int kvh = 0; kvh < 2; ++kvh) { const int toff = 64 * DELTA + 32 * (kvh - qh);
            if (toff > 64 || toff < -64) continue;
#pragma unroll
            for (int rr = 0; rr < 16; ++rr) { const float e = __builtin_amdgcn_exp2f(s[kvh][rr] - m_new); s[kvh][rr] = e; ls += e; }
            pb[qh][2 * kvh] = packp(s[kvh], 0); pb[qh][2 * kvh + 1] = packp(s[kvh], 8); }
        l_run[qh] = l_run[qh] * alpha + ls;
#pragma unroll
        for (int i = 0; i < 16; ++i) { o[qh][0][i] *= alpha; o[qh][1][i] *= alpha; }
    }
    LDS_WAIT();
#pragma unroll
    for (int j = 0; j < 4; ++j) { const LAS unsigned char* vj = wl + voff + 16 * j * VP;
        const bf16x8 a0 = cat8(vtr(vj), vtr(vj + 8 * VP)); const bf16x8 a1 = cat8(vtr(vj + 64), vtr(vj + 8 * VP + 64));
#pragma unroll
        for (int qh = 0; qh < 2; ++qh) { const int toff = 64 * DELTA + 32 * ((j >> 1) - qh);
            if (toff > 64 || toff < -64) continue;
            o[qh][0] = MFMA32(a0, pb[qh][j], o[qh][0]); o[qh][1] = MFMA32(a1, pb[qh][j], o[qh][1]); } }
    LDS_WAIT();
}
template <int P_>
__device__ __forceinline__ void dil_wave_unit(LAS unsigned char* wl, const bf16_t* DIL, bf16_t* Y, bf16_t* ST, float* LSE, const float* BT, int b, int h, int r, int nb) {
    constexpr int dil = P_ == 0 ? 1 : (P_ == 1 ? 4 : 16), nblk = 64 / dil; constexpr bool first = P_ == 0, last = P_ == 2;
    const int lane = otid() & 63, r32 = lane & 31, hi = lane >> 5;
    const size_t tok0 = (size_t)b * SEQ; const size_t rstride = (size_t)dil * 64;
    LAS float* bt = (LAS float*)(wl + VT_B);
    for (int i = lane; i < 257; i += 64) { int j = i - 64; j = j < 0 ? 0 : (j > 128 ? 128 : j); bt[i] = BT[(P_ * 8 + h) * 129 + j]; }
    const int btb = 128 * 4;
    const int bvar = btb + 4 * (4 * hi - r32);
    bf16x8 qf[2][4];
    const bf16_t* rowb = DIL + ((size_t)(b * 8 + h) * SEQ + (size_t)(64 * nb) * dil + r) * 64;
    constexpr size_t KOFF = pg8::DPLANE, VOFF = 2 * pg8::DPLANE;
#pragma unroll
    for (int qh = 0; qh < 2; ++qh)
#pragma unroll
        for (int d0 = 0; d0 < 4; ++d0) qf[qh][d0] = *(const bf16x8*)(rowb + (size_t)(32 * qh + r32) * rstride + hi * 8 + d0 * 16);
    f32x16 o[2][2];
#pragma unroll
    for (int a = 0; a < 2; ++a)
#pragma unroll
        for (int c = 0; c < 2; ++c)
#pragma unroll
            for (int i = 0; i < 16; ++i) o[a][c][i] = 0.f;
    float m_run[2] = {-1e30f, -1e30f}, l_run[2] = {0.f, 0.f};
    const int voff = (4 * hi + ((lane & 15) >> 2)) * VP + (16 * ((lane >> 4) & 1) + 4 * (lane & 3)) * 2;
    LDS_WAIT();
    dil_block<0>(wl, rowb + KOFF + hi * 8, rowb + VOFF, rstride, qf, o, m_run, l_run, bvar, voff, lane, r32, hi, btb);
    if (nb > 0) dil_block<-1>(wl, rowb - 64 * rstride + KOFF + hi * 8, rowb - 64 * rstride + VOFF, rstride, qf, o, m_run, l_run, bvar, voff, lane, r32, hi, btb);
    if (nb + 1 < nblk) dil_block<1>(wl, rowb + 64 * rstride + KOFF + hi * 8, rowb + 64 * rstride + VOFF, rstride, qf, o, m_run, l_run, bvar, voff, lane, r32, hi, btb);
    float lp[2]; u32x2 pv[2][8];
    if (!first) {
#pragma unroll
        for (int qh = 0; qh < 2; ++qh) { const size_t srow = (size_t)(b * 8 + h) * SEQ + (size_t)(64 * nb + 32 * qh + r32) * dil + r; lp[qh] = LSE[srow];
            const bf16_t* sp = ST + srow * 64 + 4 * hi;
#pragma unroll
            for (int e = 0; e < 8; ++e) pv[qh][e] = *(const u32x2*)(sp + 32 * (e >> 2) + 8 * (e & 3)); }
    }
#pragma unroll
    for (int qh = 0; qh < 2; ++qh) {
        const size_t spos = (size_t)(64 * nb + 32 * qh + r32) * dil + r; const size_t srow = (size_t)(b * 8 + h) * SEQ + spos;
        const float lt = l_run[qh] + __shfl_xor(l_run[qh], 32); const float inv = 1.0f / lt; const float lse2 = m_run[qh] + __builtin_amdgcn_logf(lt);
        float a_prev = 0.f, a_cur = inv, lse_new = lse2;
        if (!first) { const float M = fmaxf(lp[qh], lse2); const float wp = __builtin_amdgcn_exp2f(lp[qh] - M), wc = __builtin_amdgcn_exp2f(lse2 - M); const float den = wp + wc;
            a_prev = wp / den; a_cur = wc / den * inv; lse_new = M + __builtin_amdgcn_logf(den); }
        bf16_t* yp = last ? Y + (tok0 + spos) * 1024 + 512 + h * 64 + 4 * hi : ST + srow * 64 + 4 * hi;
#pragma unroll
        for (int e = 0; e < 8; ++e) { const int blk = e >> 2, g = e & 3;
            float v0 = o[qh][blk][4 * g] * a_cur, v1 = o[qh][blk][4 * g + 1] * a_cur, v2 = o[qh][blk][4 * g + 2] * a_cur, v3 = o[qh][blk][4 * g + 3] * a_cur;
            if (!first) { v0 += a_prev * bf_lo(pv[qh][e].x); v1 += a_prev * bf_hi(pv[qh][e].x); v2 += a_prev * bf_lo(pv[qh][e].y); v3 += a_prev * bf_hi(pv[qh][e].y); }
            u32x2 w; w.x = cvt_pk_bf16(v0, v1); w.y = cvt_pk_bf16(v2, v3); *(u32x2*)(yp + 32 * blk + 8 * g) = w; }
        if (!last && hi == 0) LSE[srow] = lse_new;
    }
}
__device__ __forceinline__ void dil_unit(LAS unsigned char* lds, const bf16_t* DIL, bf16_t* Y, bf16_t* ST, float* LSE, const float* BT, int b, int h, int c) {
    const int wid = __builtin_amdgcn_readfirstlane(otid() >> 6);
    LAS unsigned char* wl = lds + wid * DW_BYTES;
    for (int j = 0; j < 2; ++j) { const int wu = 2 * wid + j; dil_wave_unit<0>(wl, DIL, Y, ST, LSE, BT, b, h, 0, c * 16 + wu); }
    __syncthreads();
    for (int j = 0; j < 2; ++j) { const int wu = 2 * wid + j; dil_wave_unit<1>(wl, DIL, Y, ST, LSE, BT, b, h, wu >> 2, c * 4 + (wu & 3)); }
    __syncthreads();
    for (int j = 0; j < 2; ++j) { const int wu = 2 * wid + j; dil_wave_unit<2>(wl, DIL, Y, ST, LSE, BT, b, h, wu, c); }
    __syncthreads();
}

typedef __attribute__((address_space(1))) unsigned gu32;
#define XB_TMO      128
#define XB_XCNT(j)  (256  + 64 * (j))
#define XB_XSUB(j)  (1280 + 64 * (j))
#define XB_XGEN(j)  (2304 + 64 * (j))
#define XB_TOP      3328
#define XB_TOPGEN   3392
#define XCD_BAR_WORDS 3456
#define XB_SPIN_CAP (1u << 18)

__device__ __forceinline__ unsigned xb_ld(unsigned* p)              { return __hip_atomic_load(p, __ATOMIC_RELAXED, __HIP_MEMORY_SCOPE_AGENT); }
__device__ __forceinline__ unsigned xb_add(unsigned* p, unsigned v) { return __hip_atomic_fetch_add(p, v, __ATOMIC_RELAXED, __HIP_MEMORY_SCOPE_AGENT); }
__device__ __forceinline__ unsigned xb_xcc_id() { return (unsigned)__builtin_amdgcn_s_getreg((3 << 11) | 20) & 0xFu; }
#define XB_SPIN(cond, bar) do { unsigned _sp = 0; while (cond) { __builtin_amdgcn_s_sleep(1); \
    if ((++_sp & 255u) == 0u) { if (xb_ld(&(bar)[XB_TMO])) break; if (_sp > XB_SPIN_CAP) { atomicAdd(&(bar)[XB_TMO], 1u); break; } } } } while (0)

struct XcdBarrier {
    unsigned* bar; unsigned x;
    volatile LAS unsigned* st;
};

__device__ __forceinline__ XcdBarrier xcd_barrier_post(unsigned* bar, volatile LAS unsigned* st) {
    XcdBarrier b; b.bar = bar; b.x = xb_xcc_id(); b.st = st;
    if (threadIdx.x == 0) (void)xb_add(&bar[XB_XCNT(b.x)], 1u);
    return b;
}
__device__ __forceinline__ void xcd_barrier_complete(unsigned* bar, unsigned x, unsigned& nloc, unsigned& nx) {
    const unsigned G = gridDim.x * gridDim.y * gridDim.z;
    unsigned sum, cnt, mine, sp = 0u;
    for (;;) {
        sum = 0u; cnt = 0u; mine = 0u;
#pragma unroll
        for (unsigned j = 0; j < 16; ++j) { const unsigned c = xb_ld(&bar[XB_XCNT(j)]); sum += c; cnt += (c > 0u) ? 1u : 0u; mine = (j == x) ? c : mine; }
        if (sum == G) break;
        __builtin_amdgcn_s_sleep(1);
        if ((++sp & 255u) == 0u) { if (xb_ld(&bar[XB_TMO])) break; if (sp > XB_SPIN_CAP) { atomicAdd(&bar[XB_TMO], 1u); break; } }
    }
    nloc = mine > 0u ? mine : 1u; nx = cnt > 0u ? cnt : 1u;
}

__device__ __forceinline__ void xcd_barrier(const XcdBarrier& b) {
    asm volatile("s_waitcnt vmcnt(0)" ::: "memory");
    __syncthreads();
    if (threadIdx.x == 0) {
        unsigned* bar = b.bar;
        __builtin_amdgcn_s_waitcnt(0);
        unsigned nloc = b.st[0], nx = b.st[1];
        if (nloc == 0u) { xcd_barrier_complete(bar, b.x, nloc, nx); b.st[0] = nloc; b.st[1] = nx; }
        const unsigned old = xb_add(&bar[XB_XSUB(b.x)], 1u);
        const unsigned gen = old / nloc;
        if (old + 1u == (gen + 1u) * nloc) {
            __builtin_amdgcn_fence(__ATOMIC_RELEASE, "agent");
            asm volatile("s_waitcnt vmcnt(0)" ::: "memory");
            const unsigned og = xb_add(&bar[XB_TOP], 1u);
            const unsigned tg = og / nx;
            if (og + 1u == (tg + 1u) * nx) xb_add(&bar[XB_TOPGEN], 1u);
            else XB_SPIN(xb_ld(&bar[XB_TOPGEN]) == tg, bar);
            __builtin_amdgcn_fence(__ATOMIC_ACQUIRE, "agent");
            xb_add(&bar[XB_XGEN(b.x)], 1u);
            asm volatile("s_waitcnt vmcnt(0)" ::: "memory");
        } else {
            XB_SPIN(xb_ld(&bar[XB_XGEN(b.x)]) == gen, bar);
            __builtin_amdgcn_fence(__ATOMIC_ACQUIRE, "agent");
            asm volatile("s_waitcnt vmcnt(0)" ::: "memory");
        }
    }
    __syncthreads();
}

constexpr int NPHASE = 2 + DEPTH * 7;
__device__ __forceinline__ unsigned char* opaque_ptr(unsigned char* p) { asm volatile("" : "+s"(p)); return p; }
#define GEMM(EpiT, Ev, Ap, Bp, Nn, Kk, Ld) do { pg8::Gemm g_{(Ap), (Bp), NTOK, (Nn), (Kk), (Ld), 1 << 30, 0}; pg8::StaticOrder S_; S_.init(NTOK, (Nn), G, obid()); \
        pg8::gemm_phase<EpiT, pg8::StaticOrder, true, true>(lds, g_, S_, (Ev)); } while (0)
#define BF(off) ((bf16_t*)(unsigned char*)(ws + (off)))
#define FP(off) ((float*)(unsigned char*)(ws + (off)))
#define WB(l_, off) ((bf16_t*)(unsigned char*)(ws + WS_W + (size_t)((l_) & 1) * WS_WSTRIDE + (off)))
__global__ void __launch_bounds__(NTHR, 2) mega_fwd(Params P0) {
    extern __shared__ __attribute__((aligned(16))) unsigned char lds_raw[];
    LAS unsigned char* lds = (LAS unsigned char*)lds_raw;
    cg::grid_group grid = cg::this_grid();
    { volatile LAS unsigned* misc = (volatile LAS unsigned*)(lds + RING_BYTES + 320); if (otid() < 32) misc[otid()] = 0u; }
    __syncthreads();
    XcdBarrier xbar = xcd_barrier_post((unsigned*)(P0.ws + WS_CTL) + 1024, (volatile LAS unsigned*)(lds + RING_BYTES + 320) + 8);
    { volatile LAS unsigned* misc = (volatile LAS unsigned*)(lds + RING_BYTES + 320);
      if (otid() == 0) { const unsigned x = xb_xcc_id(); misc[16] = xb_add((unsigned*)(P0.ws + WS_CTL) + 8192 + 64 * x, 1u); misc[17] = x; } }
    __syncthreads();
    const int ph_lo = P0.ph_lo, ph_hi = P0.ph_hi;
    for (int ph = ph_lo; ph < ph_hi; ++ph) {
        int G_ = (int)gridDim.x; asm volatile("" : "+s"(G_)); const int G = G_;
        typedef const __attribute__((address_space(4))) Params* kparams_t;
        kparams_t kp_ = (kparams_t)__builtin_amdgcn_kernarg_segment_ptr(); asm volatile("" : "+s"(kp_));
        const Params& P = *(const Params*)kp_;
        __attribute__((address_space(1))) unsigned char* ws = (__attribute__((address_space(1))) unsigned char*)opaque_ptr(P.ws);
        const int l = ph > 1 ? (ph - 2) / 7 : 0, kk_ = ph > 1 ? (ph - 2) % 7 + 2 : ph; const int k = kk_ >= 4 ? kk_ + 1 : kk_;
        const size_t modl = (size_t)l * 16 * 6144;
        switch (k) {
        case 0: {
            phase0(P, lds, G);
            float* SSQ = FP(WS_SSQ);
            float* SKR = FP(WS_SSQKR);
            for (int i = obid() * NTHR + otid(); i < 2 * NTOK; i += G * NTHR) { SSQ[i] = 0.f; if (i < NTOK) SKR[i] = 0.f; }
            __syncthreads();
            conv_weights(P, 0, (unsigned char*)(ws + WS_W), lds, G);
        } break;
        case 1: {
            bias_phase(P, lds, G);
            prepass_phase(P.x, P.norm1_g, FP(WS_MOD), 1024, BF(WS_H), FP(WS_SSQ) + 2 * NTOK, G);
        } break;
        case 2: {
            pg8::EpiIn E{BF(WS_PA), BF(WS_DIL), BF(WS_GATES), FP(WS_SSQ), FP(WS_SSQ) + NTOK, FP(WS_SSQKR), P.q_norm_b + l * 64, P.k_norm_b + l * 64, FP(WS_SSQ) + 2 * NTOK, FP(WS_BW1) + (size_t)l * 16 * 4096};
            GEMM(pg8::EpiIn, E, BF(WS_H), WB(l, W_IN), NIN, 1024, 1024);
        } break;
        case 3: {
            pg8::EpiRowScale2 E{(unsigned char*)ws, P.k_norm_a + l * 96};
            { pg8::Gemm g_{BF(WS_PA), WB(l, W_Q), NTOK, 1792, 256, 512, 3, 256}; pg8::StaticOrder S_; S_.init(NTOK, 1792, G, obid()); pg8::gemm_phase<pg8::EpiRowScale2, pg8::StaticOrder, true, true>(lds, g_, S_, E); }
        } break;
        case 5: {
            { float* SSQ = FP(WS_SSQ); float* SKR = FP(WS_SSQKR); for (int i = obid() * NTHR + otid(); i < 4 * NTOK; i += G * NTHR) { SSQ[i] = 0.f; if (i < NTOK) SKR[i] = 0.f; } }
            if (l + 1 < DEPTH) { conv_weights(P, l + 1, (unsigned char*)(ws + WS_W + (size_t)((l + 1) & 1) * WS_WSTRIDE), lds, G); __syncthreads(); }
            bf16_t* Y = BF(WS_KVRAW);
            if (G == 256) { int xcd = obid() & 7, slot = obid() >> 3;
                { const unsigned* tk = (const unsigned*)(ws + WS_CTL) + 8192; bool even = true;
#pragma unroll
                  for (int x = 0; x < 8; ++x) even = even && (__hip_atomic_load(tk + 64 * x, __ATOMIC_RELAXED, __HIP_MEMORY_SCOPE_AGENT) == 32u);
                  if (even) { volatile LAS unsigned* misc = (volatile LAS unsigned*)(lds + RING_BYTES + 320); slot = (int)misc[16]; xcd = (int)misc[17]; } }
                slot = __builtin_amdgcn_readfirstlane(slot); xcd = __builtin_amdgcn_readfirstlane(xcd);
                for (int i = 0; i < 8; ++i) { const int bh = ((i * 2 + (slot >> 4)) << 3) + xcd; mla_unit(lds, BF(WS_H), BF(WS_K), BF(WS_V), Y, P.q_norm_a + l * 96, FP(WS_ROPE), bh >> 3, bh & 7, slot & 15); }
            } else { for (int u = obid(); u < NB * NH * 16; u += G) mla_unit(lds, BF(WS_H), BF(WS_K), BF(WS_V), Y, P.q_norm_a + l * 96, FP(WS_ROPE), u >> 7, (u >> 4) & 7, u & 15); }
            __syncthreads();
            for (int u = obid(); u < NB * NH * 4; u += G) dil_unit(lds, BF(WS_DIL), Y, BF(WS_PA), FP(WS_LSE), FP(WS_BT), u >> 5, (u >> 2) & 7, u & 3);
        } break;
        case 6: {
            pg8::EpiGate2 E{BF(WS_H), BF(WS_GATES)}; GEMM(pg8::EpiGate2, E, BF(WS_KVRAW), WB(l, W_A), 1024, 1024, 1024);
        } break;
        case 7: {
            pg8::EpiResid E{(const __attribute__((address_space(1))) float*)(l == 0 ? P.x : P.out), (__attribute__((address_space(1))) float*)P.out, FP(WS_MOD) + modl + 2048, BF(WS_KVRAW), P.norm2_g + l * DM, FP(WS_MOD) + modl + 4096, FP(WS_SSQ) + 3 * NTOK};
            GEMM(pg8::EpiResid, E, BF(WS_H), WB(l, W_O), 1024, 1024, 1024);
        } break;
        case 8: {
            pg8::EpiSwiGLU E{BF(WS_HID), FP(WS_SSQ) + 3 * NTOK, FP(WS_BW2) + (size_t)l * 16 * 5632}; GEMM(pg8::EpiSwiGLU, E, BF(WS_KVRAW), WB(l, W_1), 5632, 1024, 1024);
        } break;
        default: {
            const bool nxt = l + 1 < DEPTH; const size_t modn = (size_t)(l + 1) * 16 * 6144;
            pg8::EpiResid E{(const __attribute__((address_space(1))) float*)P.out, (__attribute__((address_space(1))) float*)P.out, FP(WS_MOD) + modl + 5120, nxt ? BF(WS_H) : (bf16_t*)nullptr, P.norm1_g + (nxt ? (l + 1) * DM : 0), FP(WS_MOD) + (nxt ? modn + 1024 : 0), FP(WS_SSQ) + 2 * NTOK};
            GEMM(pg8::EpiResid, E, BF(WS_HID), WB(l, W_2), 1024, FFH, FFH);
        } break;
        }
        if (ph + 1 < ph_hi) { if (ph == ph_lo) grid.sync(); else xcd_barrier(xbar); }
    }
}

extern "C" void kernel_launch(void* const* d_in, const int* in_sizes, int n_in, void* d_out, int out_size, void* d_ws, size_t ws_size, hipStream_t stream) {
    static int grid = 0;
    if (grid == 0) {
        if (n_in != 23 || ws_size < WS_END) { fprintf(stderr, "kernel_launch: unexpected n_in %d / ws_size %zu\n", n_in, ws_size); grid = -1; return; }
        int dev = 0, cus = 0, per_cu = 0;
        (void)hipGetDevice(&dev); (void)hipDeviceGetAttribute(&cus, hipDeviceAttributeMultiprocessorCount, dev);
        if (hipFuncSetAttribute((const void*)mega_fwd, hipFuncAttributeMaxDynamicSharedMemorySize, LDS_BYTES) != hipSuccess) { fprintf(stderr, "kernel_launch: hipFuncSetAttribute failed\n"); grid = -1; return; }
        if (hipOccupancyMaxActiveBlocksPerMultiprocessor(&per_cu, (const void*)mega_fwd, NTHR, LDS_BYTES) != hipSuccess || per_cu < 1) { fprintf(stderr, "kernel_launch: occupancy query gave %d\n", per_cu); per_cu = 1; }
        (void)hipGetLastError();
        grid = cus * per_cu;
    }
    if (grid < 0) return;
    Params p{};
    const float** fp = (const float**)&p.x;
    p.x = (const float*)d_in[0]; p.c = (const float*)d_in[1]; p.pos = (const int*)d_in[2]; p.rel_bias = (const float*)d_in[3]; p.norm1_g = (const float*)d_in[4]; p.norm2_g = (const float*)d_in[5];
    p.ada_w = (const float*)d_in[6]; p.ada_b = (const float*)d_in[7]; p.w_in = (const float*)d_in[8]; p.q_a_norm = (const float*)d_in[9]; p.w_q_b = (const float*)d_in[10]; p.kv_a_norm = (const float*)d_in[11];
    p.w_kv_b = (const float*)d_in[12]; p.q_norm_a = (const float*)d_in[13]; p.k_norm_a = (const float*)d_in[14]; p.q_norm_b = (const float*)d_in[15]; p.k_norm_b = (const float*)d_in[16];
    p.w_branch_a = (const float*)d_in[17]; p.w_branch_b = (const float*)d_in[18]; p.w_out = (const float*)d_in[19]; p.w_ffn_gate = (const float*)d_in[20]; p.w_ffn_up = (const float*)d_in[21]; p.w_ffn_down = (const float*)d_in[22];
    (void)fp;
    p.out = (float*)d_out; p.ws = (unsigned char*)d_ws;
    for (int i = 0; i < 16; ++i) p.inv_freq[i] = (float)pow(10000.0, -(double)i / 16.0);
    p.ph_lo = 0; p.ph_hi = NPHASE;
    if (hipMemsetAsync((char*)d_ws + WS_CTL, 0, CTL_BYTES, stream) != hipSuccess) { fprintf(stderr, "kernel_launch: memset failed\n"); return; }
    void* args[] = {&p};
    hipError_t e = hipLaunchCooperativeKernel((const void*)mega_fwd, dim3(grid), dim3(NTHR), args, LDS_BYTES, stream);
    if (e != hipSuccess) fprintf(stderr, "kernel_launch: cooperative launch failed: %s (grid %d)\n", hipGetErrorString(e), grid);
}
```

```cpp
#include <hip/hip_runtime.h>
#include <hip/hip_cooperative_groups.h>
#include <cstdio>
#include <cstdint>
namespace cg = cooperative_groups;
__device__ __forceinline__ int otid() { int t = (int)threadIdx.x; asm volatile("" : "+v"(t)); return t; }
__device__ __forceinline__ int obid() { int b = (int)blockIdx.x; asm volatile("" : "+s"(b)); return b; }

#include <cmath>
namespace pg8 {
#define PG8_LAS __attribute__((address_space(3)))
typedef unsigned short bf16_t;
typedef short bf16x8 __attribute__((ext_vector_type(8)));
typedef float f32x4 __attribute__((ext_vector_type(4)));
typedef unsigned u32x4 __attribute__((ext_vector_type(4)));
constexpr int BM = 256, BK = 64, HALF = 128, HTB = HALF * BK * 2  , STAGE_BYTES = 8 * HTB, NXCD = 8, WGM = 8;

__host__ __device__ __forceinline__ int lds_byte(int r, int c) { const int st = (r >> 4) * 2 + (c >> 5), rr = r & 15, cc = c & 31, ob = rr * 64 + cc * 2; return st * 1024 + (ob ^ (((ob >> 9) & 1) << 5)); }
__host__ __device__ __forceinline__ void stage_rc(int b, int& R, int& C) { const int st = b / 1024, sb = b % 1024, swz = sb ^ (((sb >> 9) & 1) << 5); R = (st >> 1) * 16 + swz / 64; C = (st & 1) * 32 + (swz % 64) / 2; }
__host__ __device__ __forceinline__ int perm32(int rho) { const int n = rho >> 4, i = rho & 15; return 8 * (i >> 2) + 4 * n + (i & 3); }

struct Unit { int pm, pn; };
struct Gemm { const bf16_t* A; const bf16_t* Bt; int M, N, K, lda, asplit, aoff2; };

struct StaticOrder {
    int nM, nN, nwg, G, c;
    __host__ __device__ void init(int M, int N, int G_, int c_) { nM = M / BM; nN = N / BM; nwg = nM * nN; G = G_; c = c_; }
    __host__ __device__ bool next(int i, Unit& u) const {
        const long L = (long)i * G + c; if (L >= nwg) return false;
        int wgid = (int)L; { const int q = nwg / NXCD, r = nwg % NXCD, xcd = wgid % NXCD, off = wgid / NXCD; wgid = (xcd < r ? xcd * (q + 1) : r * (q + 1) + (xcd - r) * q) + off; }
        const int nig = WGM * nN, gid = wgid / nig, fm = gid * WGM, gsz = (nM - fm) < WGM ? (nM - fm) : WGM;
        u.pm = fm + ((wgid % nig) % gsz); u.pn = (wgid % nig) / gsz; return true;
    }
    __device__ __forceinline__ void a_ready(const Unit&) const {}
    __device__ __forceinline__ void done(const Unit&) const {}
};


__device__ __forceinline__ unsigned cvt_pk_bf16(float lo, float hi) { unsigned r; asm volatile("v_cvt_pk_bf16_f32 %0, %1, %2" : "=v"(r) : "v"(lo), "v"(hi)); return r; }
typedef unsigned u32x2 __attribute__((ext_vector_type(2)));
__device__ __forceinline__ float bf_lo(unsigned w) { return __builtin_bit_cast(float, w << 16); }
__device__ __forceinline__ float bf_hi(unsigned w) { return __builtin_bit_cast(float, w & 0xffff0000u); }
__device__ __forceinline__ float sigmoidf_(float x) { return 1.0f / (1.0f + __builtin_amdgcn_exp2f(-1.4426950408889634f * x)); }

constexpr float RMS_EPS = 1e-6f;
constexpr size_t DPLANE = (size_t)65536 * 512;
constexpr float LOG2E = 1.4426950408889634f;
constexpr float QSCALE_B = 0.125f * 1.4426950408889634f;
constexpr float QSCALE_A = 0.10206207261596575f * 1.4426950408889634f;

struct EpiIn {
    static constexpr bool PERM = true, AFTER_DRAIN = false, MIDHOOK = false;
    bf16_t* PA; bf16_t* DIL; bf16_t* GATES; float* ssq_q; float* ssq_kv; float* ssq_kr; const float* qn; const float* kn; const float* ssq1; const float* bw;
    __device__ __forceinline__ void operator()(const f32x4 (&acc_)[2][2][4][2], const Unit& u, int wr, int wc, int fr, int fq) const {
        { const int ln_ = otid() & 63; fr = ln_ & 15; fq = ln_ >> 4; }
        const int pn = u.pn; const size_t rowb = (size_t)u.pm * BM + wr * 64 + fr;
        f32x4 bv[2][2]; float r8[2][4];
        { const float* bwp = bw + (size_t)(u.pm >> 4) * 4096 + pn * BM + wc * 32 + fq * 8;
#pragma unroll
          for (int bj = 0; bj < 2; ++bj)
#pragma unroll
              for (int n = 0; n < 2; ++n) bv[bj][n] = *(const f32x4*)(bwp + bj * HALF + n * 4);
#pragma unroll
          for (int ai = 0; ai < 2; ++ai)
#pragma unroll
              for (int m = 0; m < 4; ++m) r8[ai][m] = __builtin_amdgcn_rsqf(ssq1[rowb + ai * HALF + m * 16] * (1.0f / 1024.0f) + RMS_EPS); }
#define EPIIN_VAL(ai, bj, m, n) (acc_[ai][bj][m][n] * r8[ai][m] + bv[bj][n])
#define EPIIN_PACK(w, a, b) do { (w).x = cvt_pk_bf16((a)[0], (a)[1]); (w).y = cvt_pk_bf16((a)[2], (a)[3]); (w).z = cvt_pk_bf16((b)[0], (b)[1]); (w).w = cvt_pk_bf16((b)[2], (b)[3]); } while (0)
        if (pn < 2) {
            float* sq = pn == 0 ? ssq_q : ssq_kv;
#pragma unroll
            for (int ai = 0; ai < 2; ++ai)
#pragma unroll
                for (int m = 0; m < 4; ++m) { const size_t row = rowb + ai * HALF + m * 16; float s = 0.f, s2 = 0.f;
#pragma unroll
                    for (int bj = 0; bj < 2; ++bj) { const f32x4 a = EPIIN_VAL(ai, bj, m, 0), b = EPIIN_VAL(ai, bj, m, 1);
                        u32x4 w; EPIIN_PACK(w, a, b);
                        *(u32x4*)(PA + row * 512 + pn * 256 + bj * HALF + wc * 32 + fq * 8) = w;
                        const float q = ((a[0] * a[0] + a[1] * a[1]) + (a[2] * a[2] + a[3] * a[3])) + ((b[0] * b[0] + b[1] * b[1]) + (b[2] * b[2] + b[3] * b[3]));
                        if (pn == 0 || bj == 0) s += q; else s2 += q; }
                    s += __shfl_xor(s, 16); s += __shfl_xor(s, 32);
                    if (fq == 0) atomicAdd(sq + row, s);
                    if (pn == 1 && wc == 0) { s2 += __shfl_xor(s2, 16); s2 += __shfl_xor(s2, 32); if (fq == 0) atomicAdd(ssq_kr + row, s2); } }
        } else if (pn < 6) {
            const int sec = (pn - 2) >> 1, head = 4 * ((pn - 2) & 1) + wc; const float* gp = sec == 0 ? qn : kn; const float gs = sec == 0 ? QSCALE_B : 1.0f;
            f32x4 gv[2][2];
#pragma unroll
            for (int bj = 0; bj < 2; ++bj)
#pragma unroll
                for (int n = 0; n < 2; ++n) gv[bj][n] = *(const f32x4*)(gp + 32 * bj + 8 * fq + 4 * n) * gs;
#pragma unroll
            for (int ai = 0; ai < 2; ++ai)
#pragma unroll
                for (int m = 0; m < 4; ++m) { const size_t row = rowb + ai * HALF + m * 16; float s = 0.f;
#pragma unroll
                    for (int bj = 0; bj < 2; ++bj)
#pragma unroll
                        for (int n = 0; n < 2; ++n) { const f32x4 v = EPIIN_VAL(ai, bj, m, n); s += (v[0] * v[0] + v[1] * v[1]) + (v[2] * v[2] + v[3] * v[3]); }
                    s += __shfl_xor(s, 16); s += __shfl_xor(s, 32);
                    const float r = __builtin_amdgcn_rsqf(s * (1.0f / 64.0f) + RMS_EPS);
#pragma unroll
                    for (int bj = 0; bj < 2; ++bj) { const f32x4 a = EPIIN_VAL(ai, bj, m, 0) * r * gv[bj][0], b = EPIIN_VAL(ai, bj, m, 1) * r * gv[bj][1];
                        u32x4 w; EPIIN_PACK(w, a, b);
                        *(u32x4*)(DIL + (size_t)sec * DPLANE + ((((row >> 12) * 8 + head) << 12) + (row & 4095)) * 64 + 32 * bj + 8 * fq) = w; } }
        } else if (pn < 8) {
#pragma unroll
            for (int ai = 0; ai < 2; ++ai)
#pragma unroll
                for (int m = 0; m < 4; ++m) { const size_t row = rowb + ai * HALF + m * 16;
#pragma unroll
                    for (int bj = 0; bj < 2; ++bj) { const f32x4 a = EPIIN_VAL(ai, bj, m, 0), b = EPIIN_VAL(ai, bj, m, 1);
                        u32x4 w; EPIIN_PACK(w, a, b);
                        *(u32x4*)(DIL + 2 * DPLANE + ((((row >> 12) * 8 + (pn - 6) * 4 + 2 * bj + (wc >> 1)) << 12) + (row & 4095)) * 64 + 32 * (wc & 1) + fq * 8) = w; } }
        } else {
#pragma unroll
            for (int ai = 0; ai < 2; ++ai)
#pragma unroll
                for (int m = 0; m < 4; ++m) { const size_t row = rowb + ai * HALF + m * 16;
#pragma unroll
                    for (int bj = 0; bj < 2; ++bj) { f32x4 a = EPIIN_VAL(ai, bj, m, 0), b = EPIIN_VAL(ai, bj, m, 1);
#pragma unroll
                        for (int i = 0; i < 4; ++i) { a[i] = sigmoidf_(a[i]); b[i] = sigmoidf_(b[i]); }
                        u32x4 w; EPIIN_PACK(w, a, b);
                        *(u32x4*)(GATES + row * 2048 + (pn - 8) * 256 + bj * HALF + wc * 32 + fq * 8) = w; } }
        }
    }
};
#undef EPIIN_PACK
#undef EPIIN_VAL
struct EpiRowScale2 {
    static constexpr bool PERM = true, AFTER_DRAIN = false, MIDHOOK = false;
    unsigned char* ws; const float* kg;
    static constexpr size_t O_Q = 0, O_PA = 128u << 20, O_K = 768u << 20, O_V = 864u << 20, O_ROPE = 990u << 20, O_SSQ = 998u << 20, O_SSQKR = (1001u << 20) + 65536;
    __device__ __forceinline__ void operator()(const f32x4 (&acc)[2][2][4][2], const Unit& u, int wr, int wc, int fr, int fq) const {
        { const int ln_ = otid() & 63; fr = ln_ & 15; fq = ln_ >> 4; }
        bf16_t* Oq = (bf16_t*)(ws + O_Q); bf16_t* Kp = (bf16_t*)(ws + O_K); bf16_t* Vp = (bf16_t*)(ws + O_V); const bf16_t* PA = (const bf16_t*)(ws + O_PA); const float* ROPE = (const float*)(ws + O_ROPE);
        const float* ssq_q = (const float*)(ws + O_SSQ); const float* ssq_kv = ssq_q + 65536; const float* ssq_kr = (const float*)(ws + O_SSQKR);
        const size_t rowb = (size_t)u.pm * BM + wr * 64 + fr;
        if (u.pn < 3) {
            const int col0 = u.pn * BM + wc * 32 + 8 * fq;
#pragma unroll
            for (int ai = 0; ai < 2; ++ai)
#pragma unroll
                for (int m = 0; m < 4; ++m) { const size_t row = rowb + ai * HALF + m * 16; const float r = __builtin_amdgcn_rsqf(ssq_q[row] * (1.0f / 256.0f) + RMS_EPS);
#pragma unroll
                    for (int bj = 0; bj < 2; ++bj) { const f32x4 v0 = acc[ai][bj][m][0] * r, v1 = acc[ai][bj][m][1] * r;
                        u32x4 w; w.x = cvt_pk_bf16(v0[0], v0[1]); w.y = cvt_pk_bf16(v0[2], v0[3]); w.z = cvt_pk_bf16(v1[0], v1[1]); w.w = cvt_pk_bf16(v1[2], v1[3]);
                        *(u32x4*)(Oq + row * 768 + col0 + bj * HALF) = w; } }
        } else {
            const int head = (u.pn - 3) * 2 + (wc & 1); float rh8[2][4];
#pragma unroll
            for (int ai = 0; ai < 2; ++ai)
#pragma unroll
                for (int m = 0; m < 4; ++m) { const size_t row = rowb + ai * HALF + m * 16; const float r = __builtin_amdgcn_rsqf(ssq_kv[row] * (1.0f / 128.0f) + RMS_EPS);
                    const size_t hrow = ((((row >> 12) * 8 + head) << 12) + (row & 4095));
                    if (wc >= 2) {
#pragma unroll
                        for (int bj = 0; bj < 2; ++bj) { const f32x4 a = acc[ai][bj][m][0] * r, b = acc[ai][bj][m][1] * r;
                            u32x4 w; w.x = cvt_pk_bf16(a[0], a[1]); w.y = cvt_pk_bf16(a[2], a[3]); w.z = cvt_pk_bf16(b[0], b[1]); w.w = cvt_pk_bf16(b[2], b[3]);
                            *(u32x4*)(Vp + hrow * 64 + 32 * bj + 8 * fq) = w; }
                    } else {
                        float s = 0.f;
#pragma unroll
                        for (int bj = 0; bj < 2; ++bj) { const f32x4 a = acc[ai][bj][m][0], b = acc[ai][bj][m][1]; s += ((a[0] * a[0] + a[1] * a[1]) + (a[2] * a[2] + a[3] * a[3])) + ((b[0] * b[0] + b[1] * b[1]) + (b[2] * b[2] + b[3] * b[3])); }
                        s += __shfl_xor(s, 16); s += __shfl_xor(s, 32);
                        const float rh = __builtin_amdgcn_rsqf((s * r * r + ssq_kr[row]) * (1.0f / 96.0f) + RMS_EPS); const float rr = r * rh;
#pragma unroll
                        for (int bj = 0; bj < 2; ++bj) { const f32x4 a = acc[ai][bj][m][0] * rr * *(const f32x4*)(kg + 32 * bj + 8 * fq), b = acc[ai][bj][m][1] * rr * *(const f32x4*)(kg + 32 * bj + 8 * fq + 4);
                            u32x4 w; w.x = cvt_pk_bf16(a[0], a[1]); w.y = cvt_pk_bf16(a[2], a[3]); w.z = cvt_pk_bf16(b[0], b[1]); w.w = cvt_pk_bf16(b[2], b[3]);
                            *(u32x4*)(Kp + hrow * 96 + 32 * bj + 8 * fq) = w; }
                        rh8[ai][m] = rh;
                    }
                    asm volatile("" ::: "memory"); }
            if (wc < 2) {
#pragma unroll
                for (int ai = 0; ai < 2; ++ai)
#pragma unroll
                    for (int m = 0; m < 4; ++m) { const size_t row = rowb + ai * HALF + m * 16; const size_t hrow = ((((row >> 12) * 8 + head) << 12) + (row & 4095)); const float rh = rh8[ai][m];
                        const bf16_t* krp = PA + row * 512 + 384; const float* rp = ROPE + row * 32;
#pragma unroll
                        for (int e = 0; e < 2; ++e) { const int i0 = 4 * fq + 2 * e;
                            const unsigned xa = *(const unsigned*)(krp + i0), xb = *(const unsigned*)(krp + 16 + i0);
                            const float c0 = rp[i0], c1 = rp[i0 + 1], s0 = rp[16 + i0], s1 = rp[16 + i0 + 1];
                            const float a0 = bf_lo(xa) * rh * kg[64 + i0], a1 = bf_hi(xa) * rh * kg[64 + i0 + 1], b0 = bf_lo(xb) * rh * kg[80 + i0], b1 = bf_hi(xb) * rh * kg[80 + i0 + 1];
                            *(unsigned*)(Kp + hrow * 96 + 64 + i0) = cvt_pk_bf16(a0 * c0 - b0 * s0, a1 * c1 - b1 * s1);
                            *(unsigned*)(Kp + hrow * 96 + 80 + i0) = cvt_pk_bf16(b0 * c0 + a0 * s0, b1 * c1 + a1 * s1); }
                        asm volatile("" ::: "memory"); }
            }
        }
    }
};
struct EpiRowScale {
    static constexpr bool PERM = true, AFTER_DRAIN = false, MIDHOOK = false;
    bf16_t* O; int ldc; const float* ssq; float invk;
    __device__ __forceinline__ void operator()(const f32x4 (&acc)[2][2][4][2], const Unit& u, int wr, int wc, int fr, int fq) const {
        { const int ln_ = otid() & 63; fr = ln_ & 15; fq = ln_ >> 4; }
        const size_t rowb = (size_t)u.pm * BM + wr * 64 + fr; const int col0 = u.pn * BM + wc * 32 + 8 * fq;
#pragma unroll
        for (int ai = 0; ai < 2; ++ai)
#pragma unroll
            for (int m = 0; m < 4; ++m) { const size_t row = rowb + ai * HALF + m * 16; const float r = __builtin_amdgcn_rsqf(ssq[row] * invk + RMS_EPS);
#pragma unroll
                for (int bj = 0; bj < 2; ++bj) { const f32x4 v0 = acc[ai][bj][m][0] * r, v1 = acc[ai][bj][m][1] * r;
                    u32x4 w; w.x = cvt_pk_bf16(v0[0], v0[1]); w.y = cvt_pk_bf16(v0[2], v0[3]); w.z = cvt_pk_bf16(v1[0], v1[1]); w.w = cvt_pk_bf16(v1[2], v1[3]);
                    *(u32x4*)(O + row * ldc + col0 + bj * HALF) = w; } }
    }
};
struct EpiGate2 {
    static constexpr bool PERM = true, AFTER_DRAIN = false, MIDHOOK = true;
    bf16_t* O; const bf16_t* SIG;
    __device__ __forceinline__ void mid(f32x4 (&acc)[2][2][4][2], const Unit& u, int wr, int wc) const {
        const int ln_ = otid() & 63, fr = ln_ & 15, fq = ln_ >> 4;
        const size_t rowb = (size_t)u.pm * BM + wr * 64 + fr; const int col0 = u.pn * BM + wc * 32 + 8 * fq;
#pragma unroll
        for (int ai = 0; ai < 2; ++ai)
#pragma unroll
            for (int m = 0; m < 4; ++m) { const bf16_t* sp = SIG + (rowb + ai * HALF + m * 16) * 2048 + col0;
#pragma unroll
                for (int bj = 0; bj < 2; ++bj) { const u32x4 sa = *(const u32x4*)(sp + bj * HALF), sb = *(const u32x4*)(sp + 1024 + bj * HALF);
                    f32x4& v0 = acc[ai][bj][m][0]; f32x4& v1 = acc[ai][bj][m][1];
                    v0[0] *= bf_lo(sa.x) * __builtin_amdgcn_rcpf(1e-30f + bf_lo(sb.x)); v0[1] *= bf_hi(sa.x) * __builtin_amdgcn_rcpf(1e-30f + bf_hi(sb.x));
                    v0[2] *= bf_lo(sa.y) * __builtin_amdgcn_rcpf(1e-30f + bf_lo(sb.y)); v0[3] *= bf_hi(sa.y) * __builtin_amdgcn_rcpf(1e-30f + bf_hi(sb.y));
                    v1[0] *= bf_lo(sa.z) * __builtin_amdgcn_rcpf(1e-30f + bf_lo(sb.z)); v1[1] *= bf_hi(sa.z) * __builtin_amdgcn_rcpf(1e-30f + bf_hi(sb.z));
                    v1[2] *= bf_lo(sa.w) * __builtin_amdgcn_rcpf(1e-30f + bf_lo(sb.w)); v1[3] *= bf_hi(sa.w) * __builtin_amdgcn_rcpf(1e-30f + bf_hi(sb.w)); }
                asm volatile("" ::: "memory"); }
    }
    __device__ __forceinline__ void operator()(const f32x4 (&acc)[2][2][4][2], const Unit& u, int wr, int wc, int fr, int fq) const {
        { const int ln_ = otid() & 63; fr = ln_ & 15; fq = ln_ >> 4; }
        const size_t rowb = (size_t)u.pm * BM + wr * 64 + fr; const int col0 = u.pn * BM + wc * 32 + 8 * fq;
#pragma unroll
        for (int ai = 0; ai < 2; ++ai)
#pragma unroll
            for (int m = 0; m < 4; ++m) { const size_t row = rowb + ai * HALF + m * 16;
#pragma unroll
                for (int bj = 0; bj < 2; ++bj) { const u32x4 sg = *(const u32x4*)(SIG + row * 2048 + 1024 + col0 + bj * HALF);
                    f32x4 v0 = acc[ai][bj][m][0], v1 = acc[ai][bj][m][1];
                    v0[0] *= bf_lo(sg.x); v0[1] *= bf_hi(sg.x); v0[2] *= bf_lo(sg.y); v0[3] *= bf_hi(sg.y);
                    v1[0] *= bf_lo(sg.z); v1[1] *= bf_hi(sg.z); v1[2] *= bf_lo(sg.w); v1[3] *= bf_hi(sg.w);
                    u32x4 w; w.x = cvt_pk_bf16(v0[0], v0[1]); w.y = cvt_pk_bf16(v0[2], v0[3]); w.z = cvt_pk_bf16(v1[0], v1[1]); w.w = cvt_pk_bf16(v1[2], v1[3]);
                    *(u32x4*)(O + row * 1024 + col0 + bj * HALF) = w; } }
    }
};
struct EpiResid {
    static constexpr bool PERM = false, AFTER_DRAIN = false, MIDHOOK = false;
    const __attribute__((address_space(1))) float* xin; __attribute__((address_space(1))) float* out; const float* gmod;
    bf16_t* XG; const float* gnorm; const float* scmod; float* ssq;
    __device__ __forceinline__ void operator()(const f32x4 (&acc)[2][2][4][2], const Unit& u, int wr, int wc, int fr, int fq) const {
        { const int ln_ = otid() & 63; fr = ln_ & 15; fq = ln_ >> 4; }
        const size_t rowb = (size_t)u.pm * BM + wr * 64 + fr; const int col0 = u.pn * BM + wc * 32 + 4 * fq; const float* gb = gmod + (size_t)(u.pm >> 4) * 6144;
        f32x4 gv[2][2], Gv[2][2];
#pragma unroll
        for (int bj = 0; bj < 2; ++bj)
#pragma unroll
            for (int n = 0; n < 2; ++n) { gv[bj][n] = *(const f32x4*)(gb + col0 + bj * HALF + n * 16);
                if (XG) Gv[bj][n] = *(const f32x4*)(gnorm + col0 + bj * HALF + n * 16) * (1.0f + *(const f32x4*)(scmod + (size_t)(u.pm >> 4) * 6144 + col0 + bj * HALF + n * 16)); }
#pragma unroll
        for (int ai = 0; ai < 2; ++ai)
#pragma unroll
            for (int m = 0; m < 4; ++m) { const size_t row = rowb + ai * HALF + m * 16; const size_t off = row * 1024 + col0; float s = 0.f;
#pragma unroll
                for (int bj = 0; bj < 2; ++bj)
#pragma unroll
                    for (int n = 0; n < 2; ++n) { const f32x4 xv = *(const __attribute__((address_space(1))) f32x4*)(xin + off + bj * HALF + n * 16);
                        const f32x4 xn = xv + gv[bj][n] * acc[ai][bj][m][n];
                        *(__attribute__((address_space(1))) f32x4*)(out + off + bj * HALF + n * 16) = xn;
                        if (XG) { s += (xn[0] * xn[0] + xn[1] * xn[1]) + (xn[2] * xn[2] + xn[3] * xn[3]); const f32x4 t = xn * Gv[bj][n];
                            u32x2 w; w.x = cvt_pk_bf16(t[0], t[1]); w.y = cvt_pk_bf16(t[2], t[3]); *(u32x2*)(XG + off + bj * HALF + n * 16) = w; } }
                if (XG) { s += __shfl_xor(s, 16); s += __shfl_xor(s, 32); if (fq == 0) atomicAdd(ssq + row, s); } }
    }
};
struct EpiSwiGLU {
    static constexpr bool PERM = true, AFTER_DRAIN = false, MIDHOOK = false;
    bf16_t* O; const float* ssq2; const float* bw;
    __device__ __forceinline__ void operator()(const f32x4 (&acc)[2][2][4][2], const Unit& u, int wr, int wc, int fr, int fq) const {
        { const int ln_ = otid() & 63; fr = ln_ & 15; fq = ln_ >> 4; }
        const size_t rowb = (size_t)u.pm * BM + wr * 64 + fr; const int col0 = u.pn * HALF + wc * 32 + 8 * fq;
        const float* bwp = bw + (size_t)(u.pm >> 4) * 5632 + u.pn * BM + wc * 32 + 8 * fq;
        const f32x4 bg0 = *(const f32x4*)bwp, bg1 = *(const f32x4*)(bwp + 4), bu0 = *(const f32x4*)(bwp + HALF), bu1 = *(const f32x4*)(bwp + HALF + 4);
#pragma unroll
        for (int ai = 0; ai < 2; ++ai)
#pragma unroll
            for (int m = 0; m < 4; ++m) { const size_t row = rowb + ai * HALF + m * 16; const float r = __builtin_amdgcn_rsqf(ssq2[row] * (1.0f / 1024.0f) + RMS_EPS);
                f32x4 g0 = acc[ai][0][m][0] * r + bg0, g1 = acc[ai][0][m][1] * r + bg1; const f32x4 u0 = acc[ai][1][m][0] * r + bu0, u1 = acc[ai][1][m][1] * r + bu1;
#pragma unroll
                for (int i = 0; i < 4; ++i) { g0[i] = g0[i] * sigmoidf_(g0[i]) * u0[i]; g1[i] = g1[i] * sigmoidf_(g1[i]) * u1[i]; }
                u32x4 w; w.x = cvt_pk_bf16(g0[0], g0[1]); w.y = cvt_pk_bf16(g0[2], g0[3]); w.z = cvt_pk_bf16(g1[0], g1[1]); w.w = cvt_pk_bf16(g1[2], g1[3]);
                *(u32x4*)(O + row * 2816 + col0) = w; }
    }
};

template <class Epi, class Sched, bool ALIGN_EPI = false, bool SP2 = false>
__device__ __forceinline__ void gemm_phase(PG8_LAS unsigned char* lds, const Gemm g, const Sched& S, const Epi& E) {
    const int tid = otid(), wid = __builtin_amdgcn_readfirstlane(tid >> 6), lane = tid & 63, wr = wid >> 2, wc = wid & 3, fr = lane & 15, fq = lane >> 4;
    const int K = g.K, lda = g.lda, nt = K / BK;
    unsigned voffA[2], voffB[2];
#pragma unroll
    for (int i = 0; i < 2; ++i) { int R, C; stage_rc(tid * 16 + i * 8192, R, C); const int Rb = Epi::PERM ? ((R & ~31) + perm32(R & 31)) : R;
        voffA[i] = (unsigned)(R * lda + C) * 2u; voffB[i] = (unsigned)(Rb * K + C) * 2u; }
    const size_t kstep = (size_t)(BK * 2);
    const size_t hstepB = (size_t)HALF * K * 2, hstepA = (size_t)HALF * lda * 2;
    const size_t tstepB = 2 * hstepB, tstepA = 2 * hstepA;
    const unsigned ldsw = (unsigned)wid * 1024u;
    const int aoff = lds_byte(wr * 64 + fr, fq * 8), boff = lds_byte(wc * 32 + fr, fq * 8);
#define PG8_SA(b, h) (((b) * 2 + (h)) * HTB)
#define PG8_SB(b, h) ((4 + (b) * 2 + (h)) * HTB)
#define PG8_STAGE(bufoff, gbase, voff) do { _Pragma("unroll") for (int _i = 0; _i < 2; ++_i) \
        __builtin_amdgcn_global_load_lds((const unsigned*)((const char*)(gbase) + (voff)[_i]), (PG8_LAS unsigned*)(lds + (bufoff) + ldsw + _i * 8192), 16, 0, 0); } while (0)
#define PG8_LDA(dst, b, h) do { _Pragma("unroll") for (int m = 0; m < 4; ++m) _Pragma("unroll") for (int k = 0; k < 2; ++k) dst[m][k] = *(const PG8_LAS bf16x8*)(lds + PG8_SA(b, h) + aoff + m * 2048 + k * 1024); } while (0)
#define PG8_LDB(dst, b, h) do { _Pragma("unroll") for (int n = 0; n < 2; ++n) _Pragma("unroll") for (int k = 0; k < 2; ++k) dst[n][k] = *(const PG8_LAS bf16x8*)(lds + PG8_SB(b, h) + boff + n * 2048 + k * 1024); } while (0)
#define PG8_MMA(ai, bj, At, Bt) do { __builtin_amdgcn_s_setprio(1); _Pragma("unroll") for (int m = 0; m < 4; ++m) _Pragma("unroll") for (int n = 0; n < 2; ++n) _Pragma("unroll") for (int k = 0; k < 2; ++k) \
        acc[ai][bj][m][n] = __builtin_amdgcn_mfma_f32_16x16x32_bf16(Bt[n][k], At[m][k], acc[ai][bj][m][n], 0, 0, 0); __builtin_amdgcn_s_setprio(0); } while (0)
#define PG8_WAIT_V(n) asm volatile("s_waitcnt vmcnt(" #n ")" ::: "memory")
#define PG8_WAIT_L(n) asm volatile("s_waitcnt lgkmcnt(" #n ")" ::: "memory")
#define PG8_BAR __builtin_amdgcn_s_barrier()
#define PG8_SCHED __builtin_amdgcn_sched_barrier(0)
    Unit cur, nxt; int ui = 0;
    if (!S.next(0, cur)) return;
    f32x4 acc[2][2][4][2];
#pragma unroll
    for (int a = 0; a < 2; ++a)
#pragma unroll
        for (int b = 0; b < 2; ++b)
#pragma unroll
            for (int m = 0; m < 4; ++m)
#pragma unroll
                for (int n = 0; n < 2; ++n) acc[a][b][m][n] = (f32x4){0.f, 0.f, 0.f, 0.f};
    bf16x8 At[4][2], B0[2][2], B1[2][2];
    const char* cA = (const char*)g.A + (size_t)cur.pm * tstepA + (cur.pn >= g.asplit ? (size_t)g.aoff2 * 2 : 0); const char* cB = (const char*)g.Bt + (size_t)cur.pn * tstepB;
    S.a_ready(cur);
    if constexpr (SP2) {
        PG8_STAGE(PG8_SB(0, 0), cB, voffB); PG8_STAGE(PG8_SB(0, 1), cB + hstepB, voffB); PG8_STAGE(PG8_SA(0, 0), cA, voffA); PG8_STAGE(PG8_SA(0, 1), cA + hstepA, voffA);
        if (wr == 1) PG8_BAR;
        PG8_WAIT_V(2); PG8_BAR;
        PG8_STAGE(PG8_SB(1, 0), cB + kstep, voffB); PG8_STAGE(PG8_SA(1, 0), cA + kstep, voffA); PG8_STAGE(PG8_SB(1, 1), cB + hstepB + kstep, voffB);
        PG8_WAIT_V(6); PG8_BAR;
    } else {
        PG8_STAGE(PG8_SB(0, 0), cB, voffB); PG8_STAGE(PG8_SA(0, 0), cA, voffA); PG8_STAGE(PG8_SB(0, 1), cB + hstepB, voffB); PG8_STAGE(PG8_SA(0, 1), cA + hstepA, voffA);
        if (wr == 1) PG8_BAR;
        PG8_WAIT_V(4); PG8_BAR;
        PG8_STAGE(PG8_SB(1, 0), cB + kstep, voffB); PG8_STAGE(PG8_SA(1, 0), cA + kstep, voffA); PG8_STAGE(PG8_SB(1, 1), cB + hstepB + kstep, voffB);
        PG8_WAIT_V(6); PG8_BAR;
    }
    for (;;) {
        const bool has_next = S.next(ui + 1, nxt);
        const char* nA = has_next ? (const char*)g.A + (size_t)nxt.pm * tstepA + (nxt.pn >= g.asplit ? (size_t)g.aoff2 * 2 : 0) : cA; const char* nB = has_next ? (const char*)g.Bt + (size_t)nxt.pn * tstepB : cB;
        for (int t = 0; t < nt; t += 2) {
            const bool last = (t == nt - 2);
            if constexpr (Epi::MIDHOOK) { if (t == (nt >> 1)) E.mid(acc, cur, wr, wc); }
            const char* a1 = cA + (size_t)(t + 1) * kstep;
            const char* a2 = last ? nA : cA + (size_t)(t + 2) * kstep; const char* b2 = last ? nB : cB + (size_t)(t + 2) * kstep;
            const char* a3 = a2 + kstep; const char* b3 = b2 + kstep;
            if (last && has_next) S.a_ready(nxt);
            if constexpr (SP2) {
            PG8_LDB(B0, 0, 0); PG8_LDB(B1, 0, 1); PG8_SCHED; PG8_LDA(At, 0, 0); PG8_STAGE(PG8_SA(1, 1), a1 + hstepA, voffA);
            PG8_WAIT_V(8); PG8_WAIT_L(0); PG8_BAR; PG8_MMA(0, 0, At, B0); PG8_MMA(0, 1, At, B1); PG8_BAR; PG8_SCHED;
            PG8_LDA(At, 0, 1); PG8_STAGE(PG8_SB(0, 0), b2, voffB); PG8_STAGE(PG8_SB(0, 1), b2 + hstepB, voffB); PG8_STAGE(PG8_SA(0, 0), a2, voffA);
            PG8_WAIT_V(8); PG8_WAIT_L(0); PG8_BAR; PG8_MMA(1, 0, At, B0); PG8_MMA(1, 1, At, B1); PG8_BAR; PG8_SCHED;
            PG8_LDB(B0, 1, 0); PG8_LDB(B1, 1, 1); PG8_SCHED; PG8_LDA(At, 1, 0); PG8_STAGE(PG8_SA(0, 1), a2 + hstepA, voffA);
            PG8_WAIT_V(8); PG8_WAIT_L(0); PG8_BAR; PG8_MMA(0, 0, At, B0); PG8_MMA(0, 1, At, B1); PG8_BAR; PG8_SCHED;
            PG8_LDA(At, 1, 1); PG8_STAGE(PG8_SB(1, 0), b3, voffB); PG8_STAGE(PG8_SB(1, 1), b3 + hstepB, voffB); PG8_STAGE(PG8_SA(1, 0), a3, voffA);
            PG8_WAIT_V(8); PG8_WAIT_L(0); PG8_BAR; PG8_MMA(1, 0, At, B0); PG8_MMA(1, 1, At, B1); PG8_BAR; PG8_SCHED;
            } else {
            PG8_LDB(B0, 0, 0); PG8_SCHED; PG8_LDA(At, 0, 0); PG8_STAGE(PG8_SA(1, 1), a1 + hstepA, voffA);
            PG8_WAIT_L(8); PG8_BAR; PG8_WAIT_L(0); PG8_MMA(0, 0, At, B0); PG8_BAR; PG8_SCHED;
            PG8_LDB(B1, 0, 1); PG8_STAGE(PG8_SB(0, 0), b2, voffB);
            PG8_BAR; PG8_WAIT_L(0); PG8_MMA(0, 1, At, B1); PG8_BAR;
            PG8_LDA(At, 0, 1); PG8_STAGE(PG8_SA(0, 0), a2, voffA);
            PG8_BAR; PG8_WAIT_L(0); PG8_MMA(1, 0, At, B0); PG8_BAR; PG8_SCHED;
            PG8_STAGE(PG8_SB(0, 1), b2 + hstepB, voffB);
            PG8_WAIT_V(6); PG8_BAR; PG8_MMA(1, 1, At, B1); PG8_BAR;
            PG8_LDB(B0, 1, 0); PG8_SCHED; PG8_LDA(At, 1, 0); PG8_STAGE(PG8_SA(0, 1), a2 + hstepA, voffA);
            PG8_WAIT_L(8); PG8_BAR; PG8_WAIT_L(0); PG8_MMA(0, 0, At, B0); PG8_BAR; PG8_SCHED;
            PG8_LDB(B1, 1, 1); PG8_STAGE(PG8_SB(1, 0), b3, voffB);
            PG8_BAR; PG8_WAIT_L(0); PG8_MMA(0, 1, At, B1); PG8_BAR;
            PG8_LDA(At, 1, 1); PG8_STAGE(PG8_SA(1, 0), a3, voffA);
            PG8_BAR; PG8_WAIT_L(0); PG8_MMA(1, 0, At, B0); PG8_BAR; PG8_SCHED;
            PG8_STAGE(PG8_SB(1, 1), b3 + hstepB, voffB);
            PG8_WAIT_V(6); PG8_BAR; PG8_MMA(1, 1, At, B1); PG8_BAR;
            }
        }
        if constexpr (ALIGN_EPI) { if (wr == 0) PG8_BAR; }
        if constexpr (!Epi::AFTER_DRAIN) { E(acc, cur, wr, wc, fr, fq); S.done(cur); }
        if (!has_next) break;
#pragma unroll
        for (int a = 0; a < 2; ++a)
#pragma unroll
            for (int b = 0; b < 2; ++b)
#pragma unroll
                for (int m = 0; m < 4; ++m)
#pragma unroll
                    for (int n = 0; n < 2; ++n) acc[a][b][m][n] = (f32x4){0.f, 0.f, 0.f, 0.f};
        cur = nxt; cA = nA; cB = nB; ++ui;
        if constexpr (ALIGN_EPI) { if (wr == 1) PG8_BAR; }
    }
    PG8_WAIT_V(0);
    if constexpr (!ALIGN_EPI) { if (wr == 0) PG8_BAR; }
    PG8_BAR;
    if constexpr (Epi::AFTER_DRAIN) { E.fused(acc, cur, wr, wc, fr, fq, lds, wid, lane); S.done(cur); }
#undef PG8_SA
#undef PG8_SB
#undef PG8_STAGE
#undef PG8_LDA
#undef PG8_LDB
#undef PG8_MMA
#undef PG8_WAIT_V
#undef PG8_WAIT_L
#undef PG8_BAR
#undef PG8_SCHED
}
}

constexpr int NB = 16, SEQ = 4096, DM = 1024, DEPTH = 4, NTOK = NB * SEQ, NH = 8, FFH = 2816, NIN = 4096, INC = 4000;
constexpr int NWAVES = 8, NTHR = 512;
constexpr int LDS_BYTES = 147456, RING_BYTES = 131072;
constexpr size_t MiB = 1u << 20;
constexpr size_t WS_H = 0;
constexpr size_t WS_PA = 128 * MiB;
constexpr size_t WS_DIL = 192 * MiB;
constexpr size_t WS_GATES = 384 * MiB;
constexpr size_t WS_HID = 128 * MiB;
constexpr size_t WS_KVRAW = 640 * MiB;
constexpr size_t WS_K = 768 * MiB;
constexpr size_t WS_V = 864 * MiB;
constexpr size_t WS_W = 928 * MiB, WS_WSTRIDE = 30 * MiB;
constexpr size_t W_IN = 0, W_Q = W_IN + (size_t)NIN * 1024 * 2, W_KV = W_Q + 768 * 256 * 2, W_A = W_KV + 1024 * 256 * 2, W_B = W_A + 1024 * 512 * 2,
                 W_O = W_B + 1024 * 512 * 2, W_1 = W_O + 1024 * 1024 * 2, W_2 = W_1 + (size_t)5632 * 1024 * 2, W_END = W_2 + (size_t)1024 * 2816 * 2;
constexpr size_t WS_MOD = 988 * MiB;
constexpr size_t WS_ROPE = 990 * MiB;
constexpr size_t WS_SSQ = 998 * MiB;
constexpr size_t WS_LSE = 999 * MiB;
constexpr size_t WS_BT = 1001 * MiB;
constexpr size_t WS_SSQKR = 1001 * MiB + 65536;
constexpr size_t WS_BW1 = 1002 * MiB;
constexpr size_t WS_BW2 = 1003 * MiB;
constexpr size_t WS_CTL = 1005 * MiB, CTL_BYTES = 65536;
constexpr size_t WS_END = 1006 * MiB;
static_assert(W_END <= WS_WSTRIDE && WS_W + 2 * WS_WSTRIDE <= WS_MOD, "weights fit");
static_assert(pg8::EpiRowScale2::O_Q == WS_H && pg8::EpiRowScale2::O_PA == WS_PA && pg8::EpiRowScale2::O_K == WS_K && pg8::EpiRowScale2::O_V == WS_V && pg8::EpiRowScale2::O_ROPE == WS_ROPE && pg8::EpiRowScale2::O_SSQ == WS_SSQ && pg8::EpiRowScale2::O_SSQKR == WS_SSQKR, "EpiRowScale2 offsets");
static_assert(WS_HID + (size_t)NTOK * FFH * 2 <= WS_KVRAW, "hid overlay");

#define LAS __attribute__((address_space(3)))
typedef unsigned short bf16_t;
typedef short bf16x8 __attribute__((ext_vector_type(8)));
typedef short s16x4 __attribute__((ext_vector_type(4)));
typedef float f32x4 __attribute__((ext_vector_type(4)));
typedef float f32x16 __attribute__((ext_vector_type(16)));
typedef unsigned u32x4 __attribute__((ext_vector_type(4)));
typedef unsigned u32x2 __attribute__((ext_vector_type(2)));
using pg8::cvt_pk_bf16; using pg8::bf_lo; using pg8::bf_hi;

struct Params {
    const float *x, *c; const int* pos; const float *rel_bias, *norm1_g, *norm2_g, *ada_w, *ada_b, *w_in, *q_a_norm, *w_q_b, *kv_a_norm, *w_kv_b, *q_norm_a, *k_norm_a, *q_norm_b, *k_norm_b,
        *w_branch_a, *w_branch_b, *w_out, *w_ffn_gate, *w_ffn_up, *w_ffn_down;
    float* out; unsigned char* ws;
    float inv_freq[16];
    int ph_lo, ph_hi;
};

__device__ __forceinline__ float wave_sum(float v) {
#pragma unroll
    for (int o = 1; o < 64; o <<= 1) v += __shfl_xor(v, o);
    return v;
}
#define LDS_WAIT() asm volatile("s_waitcnt lgkmcnt(0)" ::: "memory")

__device__ __forceinline__ void phase0(const Params& P, LAS unsigned char* lds, int G) {
    const int tid = otid(), lane = tid & 63, wid = __builtin_amdgcn_readfirstlane(tid >> 6);
    float* MOD = (float*)(P.ws + WS_MOD); float* ROPE = (float*)(P.ws + WS_ROPE); float* BT = (float*)(P.ws + WS_BT);
    const int gtid = obid() * NTHR + tid, nthr = G * NTHR;
    for (int idx = gtid; idx < NTOK * 16; idx += nthr) { const int t = idx >> 4, i = idx & 15;
        const float ang = (float)P.pos[t] * P.inv_freq[i];
        double rev = (double)ang * 0.15915494309189535; rev -= __builtin_rint(rev); const float f = (float)rev;
        ROPE[t * 32 + i] = __builtin_amdgcn_cosf(f); ROPE[t * 32 + 16 + i] = __builtin_amdgcn_sinf(f); }
    for (int idx = gtid; idx < 3 * 8 * 129; idx += nthr) { const int j = idx % 129, h = (idx / 129) & 7, p = idx / (129 * 8);
        const int dil = p == 0 ? 1 : (p == 1 ? 4 : 16); const int rp = (j - 64) * dil; const int n = rp < 0 ? -rp : rp; int bk = rp > 0 ? 16 : 0;
        if (n < 8) bk += n; else { const float nf = (float)n; int lg = 8 + (int)(__logf(nf * 0.125f) / 4.852030263919617f * 8.0f); bk += lg < 15 ? lg : 15; }
        BT[idx] = P.rel_bias[bk * 8 + h] * pg8::LOG2E; }
    LAS float* sC = (LAS float*)lds;
    LAS float* red = (LAS float*)(lds + 65536);
    for (int i = tid; i < 16 * 1024; i += NTHR) { const float v = P.c[i]; sC[i] = v / (1.0f + __expf(-v)); }
    __syncthreads();
    for (int it = obid(); it < 4 * 96; it += G) { const int l = it / 96, cb = it % 96; const int col = cb * 64 + lane;
        float a[16];
#pragma unroll
        for (int b = 0; b < 16; ++b) a[b] = 0.f;
        const float* wp = P.ada_w + ((size_t)l * 1024 + wid * 128) * 6144 + col;
#pragma unroll 16
        for (int k = 0; k < 128; ++k) { const float w = wp[(size_t)k * 6144];
#pragma unroll
            for (int b = 0; b < 16; ++b) a[b] += sC[b * 1024 + wid * 128 + k] * w; }
#pragma unroll
        for (int b = 0; b < 16; ++b) red[(wid * 16 + b) * 64 + lane] = a[b];
        __syncthreads();
        for (int o = tid; o < 1024; o += NTHR) { const int b = o >> 6, ln = o & 63; float s = 0.f;
#pragma unroll
            for (int w = 0; w < 8; ++w) s += red[(w * 16 + b) * 64 + ln];
            MOD[((size_t)l * 16 + b) * 6144 + cb * 64 + ln] = s + P.ada_b[l * 6144 + cb * 64 + ln]; }
        __syncthreads();
    }
}

__device__ __forceinline__ void tr_item(const float* W, int Nsrc, int k0, int j0, const float* kscale, bf16_t* WT, int Kdst, int R0, LAS float* scr, int lane) {
    if (j0 >= 0) {
#pragma unroll 8
        for (int i = 0; i < 32; ++i) { const int kk = 2 * i + (lane >> 5); float v = W[(size_t)(k0 + kk) * Nsrc + j0 + (lane & 31)]; if (kscale) v *= kscale[k0 + kk]; scr[kk * 33 + (lane & 31)] = v; }
    } else {
#pragma unroll 8
        for (int i = 0; i < 32; ++i) { const int kk = 2 * i + (lane >> 5); scr[kk * 33 + (lane & 31)] = 0.f; }
    }
    LDS_WAIT();
    const int c = lane & 7;
#pragma unroll
    for (int j = 0; j < 4; ++j) { const int n = (lane >> 3) + 8 * j; const LAS float* s = scr + (8 * c) * 33 + n;
        u32x4 o; o.x = cvt_pk_bf16(s[0 * 33], s[1 * 33]); o.y = cvt_pk_bf16(s[2 * 33], s[3 * 33]); o.z = cvt_pk_bf16(s[4 * 33], s[5 * 33]); o.w = cvt_pk_bf16(s[6 * 33], s[7 * 33]);
        *(u32x4*)(WT + (size_t)(R0 + n) * Kdst + k0 + 8 * c) = o; }
    LDS_WAIT();
}
__device__ __forceinline__ int win_src_col(int R0) {
    const int pn = R0 >> 8, rho = R0 & 255;
    if (pn == 0) return rho;
    if (pn == 1) return rho < 160 ? 256 + rho : -1;
    if (pn < 6) { const int wc = (rho >> 5) & 3, dd = 32 * (rho >> 7); const int sec = (pn - 2) >> 1, head = 4 * ((pn - 2) & 1) + wc; return 416 + sec * 512 + head * 64 + dd; }
    if (pn < 8) return 416 + 1024 + (R0 - 1536);
    return 1952 + (R0 - 2048);
}
__device__ __forceinline__ void conv_weights(const Params& P, int l, unsigned char* wb, LAS unsigned char* lds, int G) {
    const int tid = otid(), lane = tid & 63, wid = __builtin_amdgcn_readfirstlane(tid >> 6);
    LAS float* scr = (LAS float*)(lds + wid * 16384);
    constexpr int I_IN = 16 * 128, I_Q = 4 * 24, I_KV = 4 * 32, I_A = 8 * 32, I_B = 8 * 32, I_O = 16 * 32, I_1 = 16 * 176, I_2 = 44 * 32;
    constexpr int NIT = I_IN + I_Q + I_KV + I_A + I_B + I_O + I_1 + I_2;
    for (int it = obid() * NWAVES + wid; it < NIT; it += G * NWAVES) {
        int r = it;
        if (r < I_IN) { const int kb = r / 128, rb = r % 128; tr_item(P.w_in + (size_t)l * 1024 * INC, INC, kb * 64, win_src_col(rb * 32), nullptr, (bf16_t*)(wb + W_IN), 1024, rb * 32, scr, lane); continue; } r -= I_IN;
        if (r < I_Q) { const int kb = r / 24, rb = r % 24; tr_item(P.w_q_b + (size_t)l * 256 * 768, 768, kb * 64, rb * 32, P.q_a_norm + l * 256, (bf16_t*)(wb + W_Q), 256, rb * 32, scr, lane); continue; } r -= I_Q;
        if (r < I_KV) { const int kb = r / 32, rb = r % 32; const int R0 = rb * 32, pnl = R0 >> 8, rho = R0 & 255, wcq = (rho >> 5) & 3;
            const int jsrc = (pnl * 2 + (wcq & 1)) * 128 + (wcq >= 2 ? 64 : 0) + 32 * (rho >> 7);
            tr_item(P.w_kv_b + (size_t)l * 128 * 1024, 1024, kb * 64, kb < 2 ? jsrc : -1, P.kv_a_norm + l * 128, (bf16_t*)(wb + W_KV), 256, R0, scr, lane); continue; } r -= I_KV;
        if (r < I_A) { const int kb = r / 32, rb = r % 32; tr_item(P.w_branch_a + (size_t)l * 512 * 1024, 1024, kb * 64, rb * 32, nullptr, (bf16_t*)(wb + W_A), 1024, rb * 32, scr, lane); continue; } r -= I_A;
        if (r < I_B) { const int kb = r / 32, rb = r % 32; tr_item(P.w_branch_b + (size_t)l * 512 * 1024, 1024, kb * 64, rb * 32, nullptr, (bf16_t*)(wb + W_A) + 512, 1024, rb * 32, scr, lane); continue; } r -= I_B;
        if (r < I_O) { const int kb = r / 32, rb = r % 32; tr_item(P.w_out + (size_t)l * 1024 * 1024, 1024, kb * 64, rb * 32, nullptr, (bf16_t*)(wb + W_O), 1024, rb * 32, scr, lane); continue; } r -= I_O;
        if (r < I_1) { const int kb = r / 176, rb = r % 176; const int R0 = rb * 32, pn = R0 >> 8, rho = R0 & 255;
            const float* src = (rho < 128 ? P.w_ffn_gate : P.w_ffn_up) + (size_t)l * 1024 * FFH;
            tr_item(src, FFH, kb * 64, pn * 128 + (rho & 127), nullptr, (bf16_t*)(wb + W_1), 1024, R0, scr, lane); continue; } r -= I_1;
        { const int kb = r / 32, rb = r % 32; tr_item(P.w_ffn_down + (size_t)l * FFH * 1024, 1024, kb * 64, rb * 32, nullptr, (bf16_t*)(wb + W_2), FFH, rb * 32, scr, lane); }
    }
}

__device__ __forceinline__ void norm_phase(const float* xin, const float* g, const float* mod  , int sh_off, int sc_off, bf16_t* H, int G) {
    const int tid = otid(), lane = tid & 63, wid = __builtin_amdgcn_readfirstlane(tid >> 6);
    for (int m = obid() * NWAVES + wid; m < NTOK; m += G * NWAVES) {
        const f32x4* xr = (const f32x4*)(xin + (size_t)m * DM) + lane; f32x4 v[4]; float s = 0.f;
#pragma unroll
        for (int j = 0; j < 4; ++j) { v[j] = xr[64 * j]; s += (v[j][0] * v[j][0] + v[j][1] * v[j][1]) + (v[j][2] * v[j][2] + v[j][3] * v[j][3]); }
        const float r = __builtin_amdgcn_rsqf(wave_sum(s) * (1.0f / DM) + pg8::RMS_EPS);
        const float* mb = mod + (size_t)(m >> 12) * 6144;
#pragma unroll
        for (int j = 0; j < 4; ++j) { const int col = 4 * lane + 256 * j;
            const f32x4 gv = *(const f32x4*)(g + col), sc = *(const f32x4*)(mb + sc_off + col), sh = *(const f32x4*)(mb + sh_off + col);
            const f32x4 o = (v[j] * r) * gv * (1.0f + sc) + sh;
            u32x2 w; w.x = cvt_pk_bf16(o[0], o[1]); w.y = cvt_pk_bf16(o[2], o[3]);
            *(u32x2*)(H + (size_t)m * DM + col) = w; }
    }
}

__device__ __forceinline__ void prepass_phase(const float* xin, const float* g, const float* mod  , int sc_off, bf16_t* XG, float* ssq, int G) {
    const int tid = otid(), lane = tid & 63, wid = __builtin_amdgcn_readfirstlane(tid >> 6);
    for (int m = obid() * NWAVES + wid; m < NTOK; m += G * NWAVES) {
        const f32x4* xr = (const f32x4*)(xin + (size_t)m * DM) + lane; float s = 0.f;
        const float* mb = mod + (size_t)(m >> 12) * 6144;
#pragma unroll
        for (int j = 0; j < 4; ++j) { const f32x4 v = xr[64 * j]; s += (v[0] * v[0] + v[1] * v[1]) + (v[2] * v[2] + v[3] * v[3]); const int col = 4 * lane + 256 * j;
            const f32x4 o = v * *(const f32x4*)(g + col) * (1.0f + *(const f32x4*)(mb + sc_off + col));
            u32x2 w; w.x = cvt_pk_bf16(o[0], o[1]); w.y = cvt_pk_bf16(o[2], o[3]);
            *(u32x2*)(XG + (size_t)m * DM + col) = w; }
        s = wave_sum(s);
        if (lane == 0) ssq[m] = s;
    }
}
__device__ __forceinline__ void bias_phase(const Params& P, LAS unsigned char* lds, int G) {
    const int tid = otid(), lane = tid & 63, wid = __builtin_amdgcn_readfirstlane(tid >> 6);
    const float* MOD = (const float*)(P.ws + WS_MOD); float* BW1 = (float*)(P.ws + WS_BW1); float* BW2 = (float*)(P.ws + WS_BW2);
    LAS float* sC = (LAS float*)lds;
    LAS float* red = (LAS float*)(lds + 65536);
    for (int it = obid(); it < 4 * 152; it += G) { const int l = it / 152, blk = it % 152; const bool ffn = blk >= 64; const int R0 = (ffn ? blk - 64 : blk) * 64;
        __syncthreads();
        for (int i = tid; i < 16 * 1024; i += NTHR) sC[i] = MOD[((size_t)l * 16 + (i >> 10)) * 6144 + (ffn ? 3072 : 0) + (i & 1023)];
        __syncthreads();
        const int R = R0 + lane; const float* wsrc; int j; size_t ncol;
        if (!ffn) { const int jb = win_src_col(R & ~31); j = jb < 0 ? -1 : jb + (R & 31); wsrc = P.w_in + (size_t)l * 1024 * INC; ncol = INC; }
        else { const int pn = R >> 8, rho = R & 255; j = pn * 128 + (rho & 127); wsrc = (rho < 128 ? P.w_ffn_gate : P.w_ffn_up) + (size_t)l * 1024 * FFH; ncol = FFH; }
        float a[16];
#pragma unroll
        for (int b = 0; b < 16; ++b) a[b] = 0.f;
        if (j >= 0) { const float* wp = wsrc + (size_t)(wid * 128) * ncol + j;
#pragma unroll 16
            for (int k = 0; k < 128; ++k) { const float w = wp[(size_t)k * ncol];
#pragma unroll
                for (int b = 0; b < 16; ++b) a[b] += sC[b * 1024 + wid * 128 + k] * w; } }
#pragma unroll
        for (int b = 0; b < 16; ++b) red[(wid * 16 + b) * 64 + lane] = a[b];
        __syncthreads();
        for (int o = tid; o < 1024; o += NTHR) { const int b = o >> 6, ln = o & 63; float s = 0.f;
#pragma unroll
            for (int w = 0; w < 8; ++w) s += red[(w * 16 + b) * 64 + ln];
            if (!ffn) BW1[((size_t)l * 16 + b) * 4096 + R0 + ln] = s; else BW2[((size_t)l * 16 + b) * 5632 + R0 + ln] = s; }
    }
    __syncthreads();
}

__device__ __forceinline__ void unpack8(const u32x4 w, float* f) { f[0] = bf_lo(w.x); f[1] = bf_hi(w.x); f[2] = bf_lo(w.y); f[3] = bf_hi(w.y); f[4] = bf_lo(w.z); f[5] = bf_hi(w.z); f[6] = bf_lo(w.w); f[7] = bf_hi(w.w); }
__device__ __forceinline__ u32x4 pack8(const float* f) { u32x4 w; w.x = cvt_pk_bf16(f[0], f[1]); w.y = cvt_pk_bf16(f[2], f[3]); w.z = cvt_pk_bf16(f[4], f[5]); w.w = cvt_pk_bf16(f[6], f[7]); return w; }
__device__ __forceinline__ float ssq8(const u32x4 w) { float f[8]; unpack8(w, f); return ((f[0] * f[0] + f[1] * f[1]) + (f[2] * f[2] + f[3] * f[3])) + ((f[4] * f[4] + f[5] * f[5]) + (f[6] * f[6] + f[7] * f[7])); }
__device__ __forceinline__ void head_norm_rope(const bf16_t* src_nope, const bf16_t* src_rope, bf16_t* dst, const float* gain, const float* rope, float oscale) {
    float s = 0.f;
#pragma unroll
    for (int c = 0; c < 8; ++c) s += ssq8(*(const u32x4*)(src_nope + 8 * c));
#pragma unroll
    for (int c = 0; c < 4; ++c) s += ssq8(*(const u32x4*)(src_rope + 8 * c));
    const float r = __builtin_amdgcn_rsqf(s * (1.0f / 96.0f) + pg8::RMS_EPS);
    asm volatile("" ::: "memory");
#pragma unroll
    for (int c = 0; c < 8; ++c) { float f[8]; unpack8(*(const u32x4*)(src_nope + 8 * c), f);
#pragma unroll
        for (int i = 0; i < 8; ++i) f[i] = f[i] * r * gain[8 * c + i] * oscale;
        *(u32x4*)(dst + 8 * c) = pack8(f); asm volatile("" ::: "memory"); }
    float x[32];
#pragma unroll
    for (int c = 0; c < 4; ++c) unpack8(*(const u32x4*)(src_rope + 8 * c), x + 8 * c);
#pragma unroll
    for (int i = 0; i < 32; ++i) x[i] = x[i] * r * gain[64 + i];
#pragma unroll
    for (int i = 0; i < 16; ++i) { const float cs = rope[i], sn = rope[16 + i]; const float x1 = x[i], x2 = x[16 + i]; x[i] = (x1 * cs - x2 * sn) * oscale; x[16 + i] = (x2 * cs + x1 * sn) * oscale; }
#pragma unroll
    for (int c = 0; c < 4; ++c) *(u32x4*)(dst + 64 + 8 * c) = pack8(x + 8 * c);
    asm volatile("" ::: "memory");
}
__device__ __forceinline__ void prep_phase(const Params& P, int l, int G) {
    const bf16_t* KVRAW = (const bf16_t*)(P.ws + WS_KVRAW); const bf16_t* PA = (const bf16_t*)(P.ws + WS_PA);
    bf16_t* K = (bf16_t*)(P.ws + WS_K); const float* ROPE = (const float*)(P.ws + WS_ROPE);
    const float* kg = P.k_norm_a + l * 96;
    for (int idx = obid() * NTHR + otid(); idx < NTOK * NH; idx += G * NTHR) { const int t = idx >> 3, h = idx & 7;
        const float* rp = ROPE + (size_t)t * 32;
        const bf16_t* kp = KVRAW + (size_t)t * 1024 + h * 128;
        const size_t hrow = ((size_t)((t >> 12) * 8 + h) << 12) + (t & 4095);
        head_norm_rope(kp, PA + (size_t)t * 512 + 384, K + hrow * 96, kg, rp, 1.0f);
    }
}
typedef short v4i16_t __attribute__((ext_vector_type(4)));
__device__ __forceinline__ s16x4 vtr(const LAS unsigned char* p) { return __builtin_bit_cast(s16x4, __builtin_amdgcn_ds_read_tr16_b64_v4i16((LAS v4i16_t*)p)); }
__device__ __forceinline__ bf16x8 cat8(s16x4 a, s16x4 b) { return (bf16x8){a[0], a[1], a[2], a[3], b[0], b[1], b[2], b[3]}; }
__device__ __forceinline__ bf16x8 packp(const f32x16& p, int o) {
    u32x4 w; w.x = cvt_pk_bf16(p[o + 0], p[o + 1]); w.y = cvt_pk_bf16(p[o + 2], p[o + 3]); w.z = cvt_pk_bf16(p[o + 4], p[o + 5]); w.w = cvt_pk_bf16(p[o + 6], p[o + 7]);
    return __builtin_bit_cast(bf16x8, w);
}
__device__ __forceinline__ float max16(const f32x16& p) {
    float a = fmaxf(fmaxf(p[0], p[1]), fmaxf(p[2], p[3])), b = fmaxf(fmaxf(p[4], p[5]), fmaxf(p[6], p[7]));
    float c = fmaxf(fmaxf(p[8], p[9]), fmaxf(p[10], p[11])), d = fmaxf(fmaxf(p[12], p[13]), fmaxf(p[14], p[15]));
    return fmaxf(fmaxf(a, b), fmaxf(c, d));
}
#define MFMA32(a, b, c) __builtin_amdgcn_mfma_f32_32x32x16_bf16((a), (b), (c), 0, 0, 0)
constexpr int KP = 208, VP = 192;
constexpr int KT_B = 64 * KP, VT_B = 64 * VP;
constexpr int MLA_K0 = 0, MLA_V0 = 2 * KT_B;

constexpr float MLA_THR = 8.0f;
__device__ __forceinline__ float max3f(float a, float b, float c) { float r; asm("v_max3_f32 %0, %1, %2, %3" : "=v"(r) : "v"(a), "v"(b), "v"(c)); return r; }
__device__ __forceinline__ float rowmax32(const f32x16& a, const f32x16& b) {
    float x = max3f(a[0], a[1], a[2]), y = max3f(b[0], b[1], b[2]);
    x = max3f(x, a[3], a[4]); y = max3f(y, b[3], b[4]); x = max3f(x, a[5], a[6]); y = max3f(y, b[5], b[6]); x = max3f(x, a[7], a[8]); y = max3f(y, b[7], b[8]);
    x = max3f(x, a[9], a[10]); y = max3f(y, b[9], b[10]); x = max3f(x, a[11], a[12]); y = max3f(y, b[11], b[12]); x = max3f(x, a[13], a[14]); y = max3f(y, b[13], b[14]);
    x = max3f(x, a[15], b[15]); x = max3f(x, y, y);
    return max3f(x, __shfl_xor(x, 32), x);
}
#define SBAR0() __builtin_amdgcn_sched_barrier(0)
__device__ __forceinline__ void mla_unit(LAS unsigned char* lds, const bf16_t* Q, const bf16_t* K, const bf16_t* V, bf16_t* Y, const float* qgain, const float* ROPE, int b, int h, int qb) {
    const int tid = otid(), lane = tid & 63, wid = __builtin_amdgcn_readfirstlane(tid >> 6), r32 = lane & 31, hi = lane >> 5;
    const size_t tok0 = (size_t)b * SEQ; const size_t qrow = tok0 + qb * 256 + wid * 32 + r32;
    const int kr0 = tid / 12, kc0 = tid % 12, kr1 = (512 + tid) / 12, kc1 = (512 + tid) % 12, vr = tid >> 3, vc = tid & 7;
    const size_t hrow0 = (size_t)(b * 8 + h) * SEQ;
    const bf16_t* kg0 = K + (hrow0 + kr0) * 96 + kc0 * 8; const bf16_t* kg1 = K + (hrow0 + kr1) * 96 + kc1 * 8;
    const bf16_t* vg = V + (hrow0 + vr) * 64 + vc * 8;
    const int kl0 = kr0 * KP + kc0 * 16, kl1 = kr1 * KP + kc1 * 16, vl = vr * VP + vc * 16;
    const bool has1 = tid < 256;
    u32x4 ka0, kb0, ka1, kb1, vv0, vv1;
    ka0 = *(const u32x4*)kg0; if (has1) kb0 = *(const u32x4*)kg1; vv0 = *(const u32x4*)vg;
    ka1 = *(const u32x4*)(kg0 + (size_t)64 * 96); if (has1) kb1 = *(const u32x4*)(kg1 + (size_t)64 * 96);
    bf16x8 qf[6];
    {
        const bf16_t* qp = Q + qrow * 768 + h * 96 + hi * 8; float f[6][8]; float s = 0.f;
#pragma unroll
        for (int d0 = 0; d0 < 6; ++d0) { unpack8(*(const u32x4*)(qp + d0 * 16), f[d0]);
#pragma unroll
            for (int i = 0; i < 8; ++i) s += f[d0][i] * f[d0][i]; }
        s += __shfl_xor(s, 32);
        const float r = __builtin_amdgcn_rsqf(s * (1.0f / 96.0f) + pg8::RMS_EPS);
#pragma unroll
        for (int d0 = 0; d0 < 6; ++d0)
#pragma unroll
            for (int i = 0; i < 8; ++i) f[d0][i] = f[d0][i] * r * qgain[d0 * 16 + hi * 8 + i];
        const float* rp = ROPE + qrow * 32 + hi * 8;
#pragma unroll
        for (int i = 0; i < 8; ++i) { const float cs = rp[i], sn = rp[16 + i]; const float x1 = f[4][i], x2 = f[5][i]; f[4][i] = x1 * cs - x2 * sn; f[5][i] = x2 * cs + x1 * sn; }
#pragma unroll
        for (int d0 = 0; d0 < 6; ++d0) {
#pragma unroll
            for (int i = 0; i < 8; ++i) f[d0][i] *= pg8::QSCALE_A;
            qf[d0] = __builtin_bit_cast(bf16x8, pack8(f[d0])); }
    }
    *(LAS u32x4*)(lds + MLA_K0 + kl0) = ka0; if (has1) *(LAS u32x4*)(lds + MLA_K0 + kl1) = kb0; *(LAS u32x4*)(lds + MLA_V0 + vl) = vv0;
    *(LAS u32x4*)(lds + MLA_K0 + KT_B + kl0) = ka1; if (has1) *(LAS u32x4*)(lds + MLA_K0 + KT_B + kl1) = kb1;
    ka0 = *(const u32x4*)(kg0 + (size_t)128 * 96); if (has1) kb0 = *(const u32x4*)(kg1 + (size_t)128 * 96); vv1 = *(const u32x4*)(vg + (size_t)64 * 64);
    __syncthreads();
    f32x16 o0, o1, negm;
#pragma unroll
    for (int i = 0; i < 16; ++i) { o0[i] = 0.f; o1[i] = 0.f; negm[i] = 0.f; }
    const int koff = r32 * KP + hi * 16;
    const int voff = (4 * hi + ((lane & 15) >> 2)) * VP + (16 * ((lane >> 4) & 1) + 4 * (lane & 3)) * 2;
    f32x16 p0, p1, n0, n1;
    { const LAS unsigned char* kb_ = lds + MLA_K0 + koff; p0 = negm; p1 = negm;
#pragma unroll
      for (int d0 = 0; d0 < 6; ++d0) { const bf16x8 a0 = *(const LAS bf16x8*)(kb_ + d0 * 32), a1 = *(const LAS bf16x8*)(kb_ + 32 * KP + d0 * 32); p0 = MFMA32(a0, qf[d0], p0); p1 = MFMA32(a1, qf[d0], p1); } }
    float m_ref, l_run = 0.f;
    { const float mx = rowmax32(p0, p1); m_ref = mx;
#pragma unroll
      for (int i = 0; i < 16; ++i) { p0[i] -= mx; p1[i] -= mx; negm[i] = -mx; } }
#define MLA_STEP(C0, C1, X0, X1, T, KAI, KBI, VVI, KAW, KBW, VVW) do { const int t_ = (T); const int cur = t_ & 1; \
        if (t_ + 3 < 64) { const size_t go = (size_t)(t_ + 3) * 64; KAI = *(const u32x4*)(kg0 + go * 96); if (has1) KBI = *(const u32x4*)(kg1 + go * 96); } \
        if (t_ + 2 < 64) { const size_t go = (size_t)(t_ + 2) * 64; VVI = *(const u32x4*)(vg + go * 64); } \
        bf16x8 kfr[12]; { const LAS unsigned char* kn = lds + MLA_K0 + (cur ^ 1) * KT_B + koff; \
            _Pragma("unroll") for (int d0 = 0; d0 < 6; ++d0) { kfr[2 * d0] = *(const LAS bf16x8*)(kn + d0 * 32); kfr[2 * d0 + 1] = *(const LAS bf16x8*)(kn + 32 * KP + d0 * 32); } } \
        SBAR0(); \
        const float mx = rowmax32(C0, C1); \
        if (__builtin_amdgcn_ballot_w64(mx > MLA_THR) != 0ull) { const float d = fmaxf(mx, 0.f); const float sc = __builtin_amdgcn_exp2f(-d); m_ref += d; l_run *= sc; \
            _Pragma("unroll") for (int i = 0; i < 16; ++i) { C0[i] -= d; C1[i] -= d; o0[i] *= sc; o1[i] *= sc; negm[i] = -m_ref; } } \
        SBAR0(); \
        X0 = negm; X1 = negm; \
        _Pragma("unroll") for (int d0 = 0; d0 < 6; ++d0) { X0 = MFMA32(kfr[2 * d0], qf[d0], X0); X1 = MFMA32(kfr[2 * d0 + 1], qf[d0], X1); } \
        SBAR0(); \
        float ls = 0.f; \
        _Pragma("unroll") for (int i = 0; i < 16; ++i) { C0[i] = __builtin_amdgcn_exp2f(C0[i]); C1[i] = __builtin_amdgcn_exp2f(C1[i]); ls += C0[i] + C1[i]; } \
        l_run += ls; \
        bf16x8 pb[4]; pb[0] = packp(C0, 0); pb[1] = packp(C0, 8); pb[2] = packp(C1, 0); pb[3] = packp(C1, 8); \
        const LAS unsigned char* vb_ = lds + MLA_V0 + cur * VT_B + voff; \
        _Pragma("unroll") for (int j = 0; j < 4; ++j) { const LAS unsigned char* vj = vb_ + 16 * j * VP; \
            const bf16x8 a0 = cat8(vtr(vj), vtr(vj + 8 * VP)); const bf16x8 a1 = cat8(vtr(vj + 64), vtr(vj + 8 * VP + 64)); \
            o0 = MFMA32(a0, pb[j], o0); o1 = MFMA32(a1, pb[j], o1); } \
        if (t_ + 2 < 64) { *(LAS u32x4*)(lds + MLA_K0 + cur * KT_B + kl0) = KAW; if (has1) *(LAS u32x4*)(lds + MLA_K0 + cur * KT_B + kl1) = KBW; } \
        if (t_ + 1 < 64) *(LAS u32x4*)(lds + MLA_V0 + (cur ^ 1) * VT_B + vl) = VVW; \
        __syncthreads(); } while (0)
    if (wid >= 4) __builtin_amdgcn_s_setprio(1);
    for (int t = 0; t < 64; t += 2) { MLA_STEP(p0, p1, n0, n1, t, ka1, kb1, vv0, ka0, kb0, vv1); MLA_STEP(n0, n1, p0, p1, t + 1, ka0, kb0, vv1, ka1, kb1, vv0); }
    __builtin_amdgcn_s_setprio(0);
#undef MLA_STEP
    const float lt = l_run + __shfl_xor(l_run, 32); const float inv = 1.0f / lt;
    bf16_t* yp = Y + qrow * 1024 + h * 64 + 4 * hi;
#pragma unroll
    for (int g = 0; g < 4; ++g) {
        u32x2 w0; w0.x = cvt_pk_bf16(o0[4 * g] * inv, o0[4 * g + 1] * inv); w0.y = cvt_pk_bf16(o0[4 * g + 2] * inv, o0[4 * g + 3] * inv); *(u32x2*)(yp + 8 * g) = w0;
        u32x2 w1; w1.x = cvt_pk_bf16(o1[4 * g] * inv, o1[4 * g + 1] * inv); w1.y = cvt_pk_bf16(o1[4 * g + 2] * inv, o1[4 * g + 3] * inv); *(u32x2*)(yp + 32 + 8 * g) = w1; }
}

constexpr int DW_BYTES = 13440;
template <int DELTA>
__device__ __forceinline__ void dil_block(LAS unsigned char* wl, const bf16_t* kbase  , const bf16_t* vbase, size_t rstride  ,
                                          const bf16x8 (&qf)[2][4], f32x16 (&o)[2][2], float (&m_run)[2], float (&l_run)[2], int bvar, int voff, int lane, int r32, int hi, int btb) {
    u32x4 vv[8]; bf16x8 kf[2][4];
#pragma unroll
    for (int i = 0; i < 8; ++i) { const int idx = lane + 64 * i, row = idx >> 3, ch = idx & 7; vv[i] = *(const u32x4*)(vbase + (size_t)row * rstride + ch * 8); }
#pragma unroll
    for (int kvh = 0; kvh < 2; ++kvh)
#pragma unroll
        for (int d0 = 0; d0 < 4; ++d0) kf[kvh][d0] = *(const bf16x8*)(kbase + (size_t)(32 * kvh + r32) * rstride + d0 * 16);
    SBAR0();
#pragma unroll
    for (int i = 0; i < 8; ++i) { const int idx = lane + 64 * i, row = idx >> 3, ch = idx & 7; *(LAS u32x4*)(wl + row * VP + ch * 16) = vv[i]; }
    bf16x8 pb[2][4];
#pragma unroll
    for (int qh = 0; qh < 2; ++qh) {
        f32x16 s[2]; float mx = -1e30f;
#pragma unroll
        for (int kvh = 0; kvh < 2; ++kvh) {
            constexpr int dummy = 0; (void)dummy;
            const int toff = 64 * DELTA + 32 * (kvh - qh);
            if (toff > 64 || toff < -64) continue;
#pragma unroll
            for (int i = 0; i < 16; ++i) s[kvh][i] = 0.f;
#pragma unroll
            for (int d0 = 0; d0 < 4; ++d0) s[kvh] = MFMA32(kf[kvh][d0], qf[qh][d0], s[kvh]);
#pragma unroll
            for (int rr = 0; rr < 16; ++rr) { const int c4 = 4 * ((rr & 3) + 8 * (rr >> 2)); const float bias = *(const LAS float*)(wl + bvar + (VT_B + c4 + toff * 4));
                float v = s[kvh][rr] + bias;
                if (toff == 64) v = (bvar <= btb - c4) ? v : -1e30f;
                if (toff == -64) v = (bvar >= btb - c4) ? v : -1e30f;
                s[kvh][rr] = v; mx = fmaxf(mx, v); }
        }
        mx = fmaxf(mx, __shfl_xor(mx, 32));
        const float m_new = fmaxf(m_run[qh], mx); const float alpha = __builtin_amdgcn_exp2f(m_run[qh] - m_new); m_run[qh] = m_new;
        float ls = 0.f;
#pragma unroll
        for (int kvh = 0; kvh < 2; ++kvh) { const int toff = 64 * DELTA + 32 * (kvh - qh);
            if (toff > 64 || toff < -64) continue;
#pragma unroll
            for (int rr = 0; rr < 16; ++rr) { const float e = __builtin_amdgcn_exp2f(s[kvh][rr] - m_new); s[kvh][rr] = e; ls += e; }
            pb[qh][2 * kvh] = packp(s[kvh], 0); pb[qh][2 * kvh + 1] = packp(s[kvh], 8); }
        l_run[qh] = l_run[qh] * alpha + ls;
#pragma unroll
        for (int i = 0; i < 16; ++i) { o[qh][0][i] *= alpha; o[qh][1][i] *= alpha; }
    }
    LDS_WAIT();
#pragma unroll
    for (int j = 0; j < 4; ++j) { const LAS unsigned char* vj = wl + voff + 16 * j * VP;
        const bf16x8 a0 = cat8(vtr(vj), vtr(vj + 8 * VP)); const bf16x8 a1 = cat8(vtr(vj + 64), vtr(vj + 8 * VP + 64));
#pragma unroll
        for (int qh = 0; qh < 2; ++qh) { const int toff = 64 * DELTA + 32 * ((j >> 1) - qh);
            if (toff > 64 || toff < -64) continue;
            o[qh][0] = MFMA32(a0, pb[qh][j], o[qh][0]); o[qh][1] = MFMA32(a1, pb[qh][j], o[qh][1]); } }
    LDS_WAIT();
}
template <int P_>
__device__ __forceinline__ void dil_wave_unit(LAS unsigned char* wl, const bf16_t* DIL, bf16_t* Y, bf16_t* ST, float* LSE, const float* BT, int b, int h, int r, int nb) {
    constexpr int dil = P_ == 0 ? 1 : (P_ == 1 ? 4 : 16), nblk = 64 / dil; constexpr bool first = P_ == 0, last = P_ == 2;
    const int lane = otid() & 63, r32 = lane & 31, hi = lane >> 5;
    const size_t tok0 = (size_t)b * SEQ; const size_t rstride = (size_t)dil * 64;
    LAS float* bt = (LAS float*)(wl + VT_B);
    for (int i = lane; i < 257; i += 64) { int j = i - 64; j = j < 0 ? 0 : (j > 128 ? 128 : j); bt[i] = BT[(P_ * 8 + h) * 129 + j]; }
    const int btb = 128 * 4;
    const int bvar = btb + 4 * (4 * hi - r32);
    bf16x8 qf[2][4];
    const bf16_t* rowb = DIL + ((size_t)(b * 8 + h) * SEQ + (size_t)(64 * nb) * dil + r) * 64;
    constexpr size_t KOFF = pg8::DPLANE, VOFF = 2 * pg8::DPLANE;
#pragma unroll
    for (int qh = 0; qh < 2; ++qh)
#pragma unroll
        for (int d0 = 0; d0 < 4; ++d0) qf[qh][d0] = *(const bf16x8*)(rowb + (size_t)(32 * qh + r32) * rstride + hi * 8 + d0 * 16);
    f32x16 o[2][2];
#pragma unroll
    for (int a = 0; a < 2; ++a)
#pragma unroll
        for (int c = 0; c < 2; ++c)
#pragma unroll
            for (int i = 0; i < 16; ++i) o[a][c][i] = 0.f;
    float m_run[2] = {-1e30f, -1e30f}, l_run[2] = {0.f, 0.f};
    const int voff = (4 * hi + ((lane & 15) >> 2)) * VP + (16 * ((lane >> 4) & 1) + 4 * (lane & 3)) * 2;
    LDS_WAIT();
    dil_block<0>(wl, rowb + KOFF + hi * 8, rowb + VOFF, rstride, qf, o, m_run, l_run, bvar, voff, lane, r32, hi, btb);
    if (nb > 0) dil_block<-1>(wl, rowb - 64 * rstride + KOFF + hi * 8, rowb - 64 * rstride + VOFF, rstride, qf, o, m_run, l_run, bvar, voff, lane, r32, hi, btb);
    if (nb + 1 < nblk) dil_block<1>(wl, rowb + 64 * rstride + KOFF + hi * 8, rowb + 64 * rstride + VOFF, rstride, qf, o, m_run, l_run, bvar, voff, lane, r32, hi, btb);
    float lp[2]; u32x2 pv[2][8];
    if (!first) {
#pragma unroll
        for (int qh = 0; qh < 2; ++qh) { const size_t srow = (size_t)(b * 8 + h) * SEQ + (size_t)(64 * nb + 32 * qh + r32) * dil + r; lp[qh] = LSE[srow];
            const bf16_t* sp = ST + srow * 64 + 4 * hi;
#pragma unroll
            for (int e = 0; e < 8; ++e) pv[qh][e] = *(const u32x2*)(sp + 32 * (e >> 2) + 8 * (e & 3)); }
    }
#pragma unroll
    for (int qh = 0; qh < 2; ++qh) {
        const size_t spos = (size_t)(64 * nb + 32 * qh + r32) * dil + r; const size_t srow = (size_t)(b * 8 + h) * SEQ + spos;
        const float lt = l_run[qh] + __shfl_xor(l_run[qh], 32); const float inv = 1.0f / lt; const float lse2 = m_run[qh] + __builtin_amdgcn_logf(lt);
        float a_prev = 0.f, a_cur = inv, lse_new = lse2;
        if (!first) { const float M = fmaxf(lp[qh], lse2); const float wp = __builtin_amdgcn_exp2f(lp[qh] - M), wc = __builtin_amdgcn_exp2f(lse2 - M); const float den = wp + wc;
            a_prev = wp / den; a_cur = wc / den * inv; lse_new = M + __builtin_amdgcn_logf(den); }
        bf16_t* yp = last ? Y + (tok0 + spos) * 1024 + 512 + h * 64 + 4 * hi : ST + srow * 64 + 4 * hi;
#pragma unroll
        for (int e = 0; e < 8; ++e) { const int blk = e >> 2, g = e & 3;
            float v0 = o[qh][blk][4 * g] * a_cur, v1 = o[qh][blk][4 * g + 1] * a_cur, v2 = o[qh][blk][4 * g + 2] * a_cur, v3 = o[qh][blk][4 * g + 3] * a_cur;
            if (!first) { v0 += a_prev * bf_lo(pv[qh][e].x); v1 += a_prev * bf_hi(pv[qh][e].x); v2 += a_prev * bf_lo(pv[qh][e].y); v3 += a_prev * bf_hi(pv[qh][e].y); }
            u32x2 w; w.x = cvt_pk_bf16(v0, v1); w.y = cvt_pk_bf16(v2, v3); *(u32x2*)(yp + 32 * blk + 8 * g) = w; }
        if (!last && hi == 0) LSE[srow] = lse_new;
    }
}
__device__ __forceinline__ void dil_unit(LAS unsigned char* lds, const bf16_t* DIL, bf16_t* Y, bf16_t* ST, float* LSE, const float* BT, int b, int h, int c) {
    const int wid = __builtin_amdgcn_readfirstlane(otid() >> 6);
    LAS unsigned char* wl = lds + wid * DW_BYTES;
    for (int j = 0; j < 2; ++j) { const int wu = 2 * wid + j; dil_wave_unit<0>(wl, DIL, Y, ST, LSE, BT, b, h, 0, c * 16 + wu); }
    __syncthreads();
    for (int j = 0; j < 2; ++j) { const int wu = 2 * wid + j; dil_wave_unit<1>(wl, DIL, Y, ST, LSE, BT, b, h, wu >> 2, c * 4 + (wu & 3)); }
    __syncthreads();
    for (int j = 0; j < 2; ++j) { const int wu = 2 * wid + j; dil_wave_unit<2>(wl, DIL, Y, ST, LSE, BT, b, h, wu, c); }
    __syncthreads();
}

typedef __attribute__((address_space(1))) unsigned gu32;
#define XB_TMO      128
#define XB_XCNT(j)  (256  + 64 * (j))
#define XB_XSUB(j)  (1280 + 64 * (j))
#define XB_XGEN(j)  (2304 + 64 * (j))
#define XB_TOP      3328
#define XB_TOPGEN   3392
#define XCD_BAR_WORDS 3456
#define XB_SPIN_CAP (1u << 18)

__device__ __forceinline__ unsigned xb_ld(unsigned* p)              { return __hip_atomic_load(p, __ATOMIC_RELAXED, __HIP_MEMORY_SCOPE_AGENT); }
__device__ __forceinline__ unsigned xb_add(unsigned* p, unsigned v) { return __hip_atomic_fetch_add(p, v, __ATOMIC_RELAXED, __HIP_MEMORY_SCOPE_AGENT); }
__device__ __forceinline__ unsigned xb_xcc_id() { return (unsigned)__builtin_amdgcn_s_getreg((3 << 11) | 20) & 0xFu; }
#define XB_SPIN(cond, bar) do { unsigned _sp = 0; while (cond) { __builtin_amdgcn_s_sleep(1); \
    if ((++_sp & 255u) == 0u) { if (xb_ld(&(bar)[XB_TMO])) break; if (_sp > XB_SPIN_CAP) { atomicAdd(&(bar)[XB_TMO], 1u); break; } } } } while (0)

struct XcdBarrier {
    unsigned* bar; unsigned x;
    volatile LAS unsigned* st;
};

__device__ __forceinline__ XcdBarrier xcd_barrier_post(unsigned* bar, volatile LAS unsigned* st) {
    XcdBarrier b; b.bar = bar; b.x = xb_xcc_id(); b.st = st;
    if (threadIdx.x == 0) (void)xb_add(&bar[XB_XCNT(b.x)], 1u);
    return b;
}
__device__ __forceinline__ void xcd_barrier_complete(unsigned* bar, unsigned x, unsigned& nloc, unsigned& nx) {
    const unsigned G = gridDim.x * gridDim.y * gridDim.z;
    unsigned sum, cnt, mine, sp = 0u;
    for (;;) {
        sum = 0u; cnt = 0u; mine = 0u;
#pragma unroll
        for (unsigned j = 0; j < 16; ++j) { const unsigned c = xb_ld(&bar[XB_XCNT(j)]); sum += c; cnt += (c > 0u) ? 1u : 0u; mine = (j == x) ? c : mine; }
        if (sum == G) break;
        __builtin_amdgcn_s_sleep(1);
        if ((++sp & 255u) == 0u) { if (xb_ld(&bar[XB_TMO])) break; if (sp > XB_SPIN_CAP) { atomicAdd(&bar[XB_TMO], 1u); break; } }
    }
    nloc = mine > 0u ? mine : 1u; nx = cnt > 0u ? cnt : 1u;
}

__device__ __forceinline__ void xcd_barrier(const XcdBarrier& b) {
    asm volatile("s_waitcnt vmcnt(0)" ::: "memory");
    __syncthreads();
    if (threadIdx.x == 0) {
        unsigned* bar = b.bar;
        __builtin_amdgcn_s_waitcnt(0);
        unsigned nloc = b.st[0], nx = b.st[1];
        if (nloc == 0u) { xcd_barrier_complete(bar, b.x, nloc, nx); b.st[0] = nloc; b.st[1] = nx; }
        const unsigned old = xb_add(&bar[XB_XSUB(b.x)], 1u);
        const unsigned gen = old / nloc;
        if (old + 1u == (gen + 1u) * nloc) {
            __builtin_amdgcn_fence(__ATOMIC_RELEASE, "agent");
            asm volatile("s_waitcnt vmcnt(0)" ::: "memory");
            const unsigned og = xb_add(&bar[XB_TOP], 1u);
            const unsigned tg = og / nx;
            if (og + 1u == (tg + 1u) * nx) xb_add(&bar[XB_TOPGEN], 1u);
            else XB_SPIN(xb_ld(&bar[XB_TOPGEN]) == tg, bar);
            __builtin_amdgcn_fence(__ATOMIC_ACQUIRE, "agent");
            xb_add(&bar[XB_XGEN(b.x)], 1u);
            asm volatile("s_waitcnt vmcnt(0)" ::: "memory");
        } else {
            XB_SPIN(xb_ld(&bar[XB_XGEN(b.x)]) == gen, bar);
            __builtin_amdgcn_fence(__ATOMIC_ACQUIRE, "agent");
            asm volatile("s_waitcnt vmcnt(0)" ::: "memory");
        }
    }
    __syncthreads();
}

constexpr int NPHASE = 2 + DEPTH * 7;
__device__ __forceinline__ unsigned char* opaque_ptr(unsigned char* p) { asm volatile("" : "+s"(p)); return p; }
#define GEMM(EpiT, Ev, Ap, Bp, Nn, Kk, Ld) do { pg8::Gemm g_{(Ap), (Bp), NTOK, (Nn), (Kk), (Ld), 1 << 30, 0}; pg8::StaticOrder S_; S_.init(NTOK, (Nn), G, obid()); \
        pg8::gemm_phase<EpiT, pg8::StaticOrder, true, true>(lds, g_, S_, (Ev)); } while (0)
#define BF(off) ((bf16_t*)(unsigned char*)(ws + (off)))
#define FP(off) ((float*)(unsigned char*)(ws + (off)))
#define WB(l_, off) ((bf16_t*)(unsigned char*)(ws + WS_W + (size_t)((l_) & 1) * WS_WSTRIDE + (off)))
__global__ void __launch_bounds__(NTHR, 2) mega_fwd(Params P0) {
    extern __shared__ __attribute__((aligned(16))) unsigned char lds_raw[];
    LAS unsigned char* lds = (LAS unsigned char*)lds_raw;
    cg::grid_group grid = cg::this_grid();
    { volatile LAS unsigned* misc = (volatile LAS unsigned*)(lds + RING_BYTES + 320); if (otid() < 32) misc[otid()] = 0u; }
    __syncthreads();
    XcdBarrier xbar = xcd_barrier_post((unsigned*)(P0.ws + WS_CTL) + 1024, (volatile LAS unsigned*)(lds + RING_BYTES + 320) + 8);
    { volatile LAS unsigned* misc = (volatile LAS unsigned*)(lds + RING_BYTES + 320);
      if (otid() == 0) { const unsigned x = xb_xcc_id(); misc[16] = xb_add((unsigned*)(P0.ws + WS_CTL) + 8192 + 64 * x, 1u); misc[17] = x; } }
    __syncthreads();
    const int ph_lo = P0.ph_lo, ph_hi = P0.ph_hi;
    for (int ph = ph_lo; ph < ph_hi; ++ph) {
        int G_ = (int)gridDim.x; asm volatile("" : "+s"(G_)); const int G = G_;
        typedef const __attribute__((address_space(4))) Params* kparams_t;
        kparams_t kp_ = (kparams_t)__builtin_amdgcn_kernarg_segment_ptr(); asm volatile("" : "+s"(kp_));
        const Params& P = *(const Params*)kp_;
        __attribute__((address_space(1))) unsigned char* ws = (__attribute__((address_space(1))) unsigned char*)opaque_ptr(P.ws);
        const int l = ph > 1 ? (ph - 2) / 7 : 0, kk_ = ph > 1 ? (ph - 2) % 7 + 2 : ph; const int k = kk_ >= 4 ? kk_ + 1 : kk_;
        const size_t modl = (size_t)l * 16 * 6144;
        switch (k) {
        case 0: {
            phase0(P, lds, G);
            float* SSQ = FP(WS_SSQ);
            float* SKR = FP(WS_SSQKR);
            for (int i = obid() * NTHR + otid(); i < 2 * NTOK; i += G * NTHR) { SSQ[i] = 0.f; if (i < NTOK) SKR[i] = 0.f; }
            __syncthreads();
            conv_weights(P, 0, (unsigned char*)(ws + WS_W), lds, G);
        } break;
        case 1: {
            bias_phase(P, lds, G);
            prepass_phase(P.x, P.norm1_g, FP(WS_MOD), 1024, BF(WS_H), FP(WS_SSQ) + 2 * NTOK, G);
        } break;
        case 2: {
            pg8::EpiIn E{BF(WS_PA), BF(WS_DIL), BF(WS_GATES), FP(WS_SSQ), FP(WS_SSQ) + NTOK, FP(WS_SSQKR), P.q_norm_b + l * 64, P.k_norm_b + l * 64, FP(WS_SSQ) + 2 * NTOK, FP(WS_BW1) + (size_t)l * 16 * 4096};
            GEMM(pg8::EpiIn, E, BF(WS_H), WB(l, W_IN), NIN, 1024, 1024);
        } break;
        case 3: {
            pg8::EpiRowScale2 E{(unsigned char*)ws, P.k_norm_a + l * 96};
            { pg8::Gemm g_{BF(WS_PA), WB(l, W_Q), NTOK, 1792, 256, 512, 3, 256}; pg8::StaticOrder S_; S_.init(NTOK, 1792, G, obid()); pg8::gemm_phase<pg8::EpiRowScale2, pg8::StaticOrder, true, true>(lds, g_, S_, E); }
        } break;
        case 5: {
            { float* SSQ = FP(WS_SSQ); float* SKR = FP(WS_SSQKR); for (int i = obid() * NTHR + otid(); i < 4 * NTOK; i += G * NTHR) { SSQ[i] = 0.f; if (i < NTOK) SKR[i] = 0.f; } }
            if (l + 1 < DEPTH) { conv_weights(P, l + 1, (unsigned char*)(ws + WS_W + (size_t)((l + 1) & 1) * WS_WSTRIDE), lds, G); __syncthreads(); }
            bf16_t* Y = BF(WS_KVRAW);
            if (G == 256) { int xcd = obid() & 7, slot = obid() >> 3;
                { const unsigned* tk = (const unsigned*)(ws + WS_CTL) + 8192; bool even = true;
#pragma unroll
                  for (int x = 0; x < 8; ++x) even = even && (__hip_atomic_load(tk + 64 * x, __ATOMIC_RELAXED, __HIP_MEMORY_SCOPE_AGENT) == 32u);
                  if (even) { volatile LAS unsigned* misc = (volatile LAS unsigned*)(lds + RING_BYTES + 320); slot = (int)misc[16]; xcd = (int)misc[17]; } }
                slot = __builtin_amdgcn_readfirstlane(slot); xcd = __builtin_amdgcn_readfirstlane(xcd);
                for (int i = 0; i < 8; ++i) { const int bh = ((i * 2 + (slot >> 4)) << 3) + xcd; mla_unit(lds, BF(WS_H), BF(WS_K), BF(WS_V), Y, P.q_norm_a + l * 96, FP(WS_ROPE), bh >> 3, bh & 7, slot & 15); }
            } else { for (int u = obid(); u < NB * NH * 16; u += G) mla_unit(lds, BF(WS_H), BF(WS_K), BF(WS_V), Y, P.q_norm_a + l * 96, FP(WS_ROPE), u >> 7, (u >> 4) & 7, u & 15); }
            __syncthreads();
            for (int u = obid(); u < NB * NH * 4; u += G) dil_unit(lds, BF(WS_DIL), Y, BF(WS_PA), FP(WS_LSE), FP(WS_BT), u >> 5, (u >> 2) & 7, u & 3);
        } break;
        case 6: {
            pg8::EpiGate2 E{BF(WS_H), BF(WS_GATES)}; GEMM(pg8::EpiGate2, E, BF(WS_KVRAW), WB(l, W_A), 1024, 1024, 1024);
        } break;
        case 7: {
            pg8::EpiResid E{(const __attribute__((address_space(1))) float*)(l == 0 ? P.x : P.out), (__attribute__((address_space(1))) float*)P.out, FP(WS_MOD) + modl + 2048, BF(WS_KVRAW), P.norm2_g + l * DM, FP(WS_MOD) + modl + 4096, FP(WS_SSQ) + 3 * NTOK};
            GEMM(pg8::EpiResid, E, BF(WS_H), WB(l, W_O), 1024, 1024, 1024);
        } break;
        case 8: {
            pg8::EpiSwiGLU E{BF(WS_HID), FP(WS_SSQ) + 3 * NTOK, FP(WS_BW2) + (size_t)l * 16 * 5632}; GEMM(pg8::EpiSwiGLU, E, BF(WS_KVRAW), WB(l, W_1), 5632, 1024, 1024);
        } break;
        default: {
            const bool nxt = l + 1 < DEPTH; const size_t modn = (size_t)(l + 1) * 16 * 6144;
            pg8::EpiResid E{(const __attribute__((address_space(1))) float*)P.out, (__attribute__((address_space(1))) float*)P.out, FP(WS_MOD) + modl + 5120, nxt ? BF(WS_H) : (bf16_t*)nullptr, P.norm1_g + (nxt ? (l + 1) * DM : 0), FP(WS_MOD) + (nxt ? modn + 1024 : 0), FP(WS_SSQ) + 2 * NTOK};
            GEMM(pg8::EpiResid, E, BF(WS_HID), WB(l, W_2), 1024, FFH, FFH);
        } break;
        }
        if (ph + 1 < ph_hi) { if (ph == ph_lo) grid.sync(); else xcd_barrier(xbar); }
    }
}

extern "C" void kernel_launch(void* const* d_in, const int* in_sizes, int n_in, void* d_out, int out_size, void* d_ws, size_t ws_size, hipStream_t stream) {
    static int grid = 0;
    if (grid == 0) {
        if (n_in != 23 || ws_size < WS_END) { fprintf(stderr, "kernel_launch: unexpected n_in %d / ws_size %zu\n", n_in, ws_size); grid = -1; return; }
        int dev = 0, cus = 0, per_cu = 0;
        (void)hipGetDevice(&dev); (void)hipDeviceGetAttribute(&cus, hipDeviceAttributeMultiprocessorCount, dev);
        if (hipFuncSetAttribute((const void*)mega_fwd, hipFuncAttributeMaxDynamicSharedMemorySize, LDS_BYTES) != hipSuccess) { fprintf(stderr, "kernel_launch: hipFuncSetAttribute failed\n"); grid = -1; return; }
        if (hipOccupancyMaxActiveBlocksPerMultiprocessor(&per_cu, (const void*)mega_fwd, NTHR, LDS_BYTES) != hipSuccess || per_cu < 1) { fprintf(stderr, "kernel_launch: occupancy query gave %d\n", per_cu); per_cu = 1; }
        (void)hipGetLastError();
        grid = cus * per_cu;
    }
    if (grid < 0) return;
    Params p{};
    const float** fp = (const float**)&p.x;
    p.x = (const float*)d_in[0]; p.c = (const float*)d_in[1]; p.pos = (const int*)d_in[2]; p.rel_bias = (const float*)d_in[3]; p.norm1_g = (const float*)d_in[4]; p.norm2_g = (const float*)d_in[5];
    p.ada_w = (const float*)d_in[6]; p.ada_b = (const float*)d_in[7]; p.w_in = (const float*)d_in[8]; p.q_a_norm = (const float*)d_in[9]; p.w_q_b = (const float*)d_in[10]; p.kv_a_norm = (const float*)d_in[11];
    p.w_kv_b = (const float*)d_in[12]; p.q_norm_a = (const float*)d_in[13]; p.k_norm_a = (const float*)d_in[14]; p.q_norm_b = (const float*)d_in[15]; p.k_norm_b = (const float*)d_in[16];
    p.w_branch_a = (const float*)d_in[17]; p.w_branch_b = (const float*)d_in[18]; p.w_out = (const float*)d_in[19]; p.w_ffn_gate = (const float*)d_in[20]; p.w_ffn_up = (const float*)d_in[21]; p.w_ffn_down = (const float*)d_in[22];
    (void)fp;
    p.out = (float*)d_out; p.ws = (unsigned char*)d_ws;
    for (int i = 0; i < 16; ++i) p.inv_freq[i] = (float)pow(10000.0, -(double)i / 16.0);
    p.ph_lo = 0; p.ph_hi = NPHASE;
    if (hipMemsetAsync((char*)d_ws + WS_CTL, 0, CTL_BYTES, stream) != hipSuccess) { fprintf(stderr, "kernel_launch: memset failed\n"); return; }
    void* args[] = {&p};
    hipError_t e = hipLaunchCooperativeKernel((const void*)mega_fwd, dim3(grid), dim3(NTHR), args, LDS_BYTES, stream);
    if (e != hipSuccess) fprintf(stderr, "kernel_launch: cooperative launch failed: %s (grid %d)\n", hipGetErrorString(e), grid);
}
```

```cpp
#include <hip/hip_runtime.h>
#include <hip/hip_cooperative_groups.h>
#include <cstdio>
#include <cstdint>
namespace cg = cooperative_groups;
__device__ __forceinline__ int otid() { int t = (int)threadIdx.x; asm volatile("" : "+v"(t)); return t; }
__device__ __forceinline__ int obid() { int b = (int)blockIdx.x; asm volatile("" : "+s"(b)); return b; }

#include <cmath>
namespace pg8 {
#define PG8_LAS __attribute__((address_space(3)))
typedef unsigned short bf16_t;
typedef short bf16x8 __attribute__((ext_vector_type(8)));
typedef float f32x4 __attribute__((ext_vector_type(4)));
typedef unsigned u32x4 __attribute__((ext_vector_type(4)));
constexpr int BM = 256, BK = 64, HALF = 128, HTB = HALF * BK * 2  , STAGE_BYTES = 8 * HTB, NXCD = 8, WGM = 8;

__host__ __device__ __forceinline__ int lds_byte(int r, int c) { const int st = (r >> 4) * 2 + (c >> 5), rr = r & 15, cc = c & 31, ob = rr * 64 + cc * 2; return st * 1024 + (ob ^ (((ob >> 9) & 1) << 5)); }
__host__ __device__ __forceinline__ void stage_rc(int b, int& R, int& C) { const int st = b / 1024, sb = b % 1024, swz = sb ^ (((sb >> 9) & 1) << 5); R = (st >> 1) * 16 + swz / 64; C = (st & 1) * 32 + (swz % 64) / 2; }
__host__ __device__ __forceinline__ int perm32(int rho) { const int n = rho >> 4, i = rho & 15; return 8 * (i >> 2) + 4 * n + (i & 3); }

struct Unit { int pm, pn; };
struct Gemm { const bf16_t* A; const bf16_t* Bt; int M, N, K, lda, asplit, aoff2; };

struct StaticOrder {
    int nM, nN, nwg, G, c;
    __host__ __device__ void init(int M, int N, int G_, int c_) { nM = M / BM; nN = N / BM; nwg = nM * nN; G = G_; c = c_; }
    __host__ __device__ bool next(int i, Unit& u) const {
        const long L = (long)i * G + c; if (L >= nwg) return false;
        int wgid = (int)L; { const int q = nwg / NXCD, r = nwg % NXCD, xcd = wgid % NXCD, off = wgid / NXCD; wgid = (xcd < r ? xcd * (q + 1) : r * (q + 1) + (xcd - r) * q) + off; }
        const int nig = WGM * nN, gid = wgid / nig, fm = gid * WGM, gsz = (nM - fm) < WGM ? (nM - fm) : WGM;
        u.pm = fm + ((wgid % nig) % gsz); u.pn = (wgid % nig) / gsz; return true;
    }
    __device__ __forceinline__ void a_ready(const Unit&) const {}
    __device__ __forceinline__ void done(const Unit&) const {}
};


__device__ __forceinline__ unsigned cvt_pk_bf16(float lo, float hi) { unsigned r; asm volatile("v_cvt_pk_bf16_f32 %0, %1, %2" : "=v"(r) : "v"(lo), "v"(hi)); return r; }
typedef unsigned u32x2 __attribute__((ext_vector_type(2)));
__device__ __forceinline__ float bf_lo(unsigned w) { return __builtin_bit_cast(float, w << 16); }
__device__ __forceinline__ float bf_hi(unsigned w) { return __builtin_bit_cast(float, w & 0xffff0000u); }
__device__ __forceinline__ float sigmoidf_(float x) { return 1.0f / (1.0f + __builtin_amdgcn_exp2f(-1.4426950408889634f * x)); }

constexpr float RMS_EPS = 1e-6f;
constexpr size_t DPLANE = (size_t)65536 * 512;
constexpr float LOG2E = 1.4426950408889634f;
constexpr float QSCALE_B = 0.125f * 1.4426950408889634f;
constexpr float QSCALE_A = 0.10206207261596575f * 1.4426950408889634f;

struct EpiIn {
    static constexpr bool PERM = true, AFTER_DRAIN = false, MIDHOOK = false;
    bf16_t* PA; bf16_t* DIL; bf16_t* GATES; float* ssq_q; float* ssq_kv; float* ssq_kr; const float* qn; const float* kn; const float* ssq1; const float* bw;
    __device__ __forceinline__ void operator()(const f32x4 (&acc_)[2][2][4][2], const Unit& u, int wr, int wc, int fr, int fq) const {
        { const int ln_ = otid() & 63; fr = ln_ & 15; fq = ln_ >> 4; }
        const int pn = u.pn; const size_t rowb = (size_t)u.pm * BM + wr * 64 + fr;
        f32x4 bv[2][2]; float r8[2][4];
        { const float* bwp = bw + (size_t)(u.pm >> 4) * 4096 + pn * BM + wc * 32 + fq * 8;
#pragma unroll
          for (int bj = 0; bj < 2; ++bj)
#pragma unroll
              for (int n = 0; n < 2; ++n) bv[bj][n] = *(const f32x4*)(bwp + bj * HALF + n * 4);
#pragma unroll
          for (int ai = 0; ai < 2; ++ai)
#pragma unroll
              for (int m = 0; m < 4; ++m) r8[ai][m] = __builtin_amdgcn_rsqf(ssq1[rowb + ai * HALF + m * 16] * (1.0f / 1024.0f) + RMS_EPS); }
#define EPIIN_VAL(ai, bj, m, n) (acc_[ai][bj][m][n] * r8[ai][m] + bv[bj][n])
#define EPIIN_PACK(w, a, b) do { (w).x = cvt_pk_bf16((a)[0], (a)[1]); (w).y = cvt_pk_bf16((a)[2], (a)[3]); (w).z = cvt_pk_bf16((b)[0], (b)[1]); (w).w = cvt_pk_bf16((b)[2], (b)[3]); } while (0)
        if (pn < 2) {
            float* sq = pn == 0 ? ssq_q : ssq_kv;
#pragma unroll
            for (int ai = 0; ai < 2; ++ai)
#pragma unroll
                for (int m = 0; m < 4; ++m) { const size_t row = rowb + ai * HALF + m * 16; float s = 0.f, s2 = 0.f;
#pragma unroll
                    for (int bj = 0; bj < 2; ++bj) { const f32x4 a = EPIIN_VAL(ai, bj, m, 0), b = EPIIN_VAL(ai, bj, m, 1);
                        u32x4 w; EPIIN_PACK(w, a, b);
                        *(u32x4*)(PA + row * 512 + pn * 256 + bj * HALF + wc * 32 + fq * 8) = w;
                        const float q = ((a[0] * a[0] + a[1] * a[1]) + (a[2] * a[2] + a[3] * a[3])) + ((b[0] * b[0] + b[1] * b[1]) + (b[2] * b[2] + b[3] * b[3]));
                        if (pn == 0 || bj == 0) s += q; else s2 += q; }
                    s += __shfl_xor(s, 16); s += __shfl_xor(s, 32);
                    if (fq == 0) atomicAdd(sq + row, s);
                    if (pn == 1 && wc == 0) { s2 += __shfl_xor(s2, 16); s2 += __shfl_xor(s2, 32); if (fq == 0) atomicAdd(ssq_kr + row, s2); } }
        } else if (pn < 6) {
            const int sec = (pn - 2) >> 1, head = 4 * ((pn - 2) & 1) + wc; const float* gp = sec == 0 ? qn : kn; const float gs = sec == 0 ? QSCALE_B : 1.0f;
            f32x4 gv[2][2];
#pragma unroll
            for (int bj = 0; bj < 2; ++bj)
#pragma unroll
                for (int n = 0; n < 2; ++n) gv[bj][n] = *(const f32x4*)(gp + 32 * bj + 8 * fq + 4 * n) * gs;
#pragma unroll
            for (int ai = 0; ai < 2; ++ai)
#pragma unroll
                for (int m = 0; m < 4; ++m) { const size_t row = rowb + ai * HALF + m * 16; float s = 0.f;
#pragma unroll
                    for (int bj = 0; bj < 2; ++bj)
#pragma unroll
                        for (int n = 0; n < 2; ++n) { const f32x4 v = EPIIN_VAL(ai, bj, m, n); s += (v[0] * v[0] + v[1] * v[1]) + (v[2] * v[2] + v[3] * v[3]); }
                    s += __shfl_xor(s, 16); s += __shfl_xor(s, 32);
                    const float r = __builtin_amdgcn_rsqf(s * (1.0f / 64.0f) + RMS_EPS);
#pragma unroll
                    for (int bj = 0; bj < 2; ++bj) { const f32x4 a = EPIIN_VAL(ai, bj, m, 0) * r * gv[bj][0], b = EPIIN_VAL(ai, bj, m, 1) * r * gv[bj][1];
                        u32x4 w; EPIIN_PACK(w, a, b);
                        *(u32x4*)(DIL + (size_t)sec * DPLANE + ((((row >> 12) * 8 + head) << 12) + (row & 4095)) * 64 + 32 * bj + 8 * fq) = w; } }
        } else if (pn < 8) {
#pragma unroll
            for (int ai = 0; ai < 2; ++ai)
#pragma unroll
                for (int m = 0; m < 4; ++m) { const size_t row = rowb + ai * HALF + m * 16;
#pragma unroll
                    for (int bj = 0; bj < 2; ++bj) { const f32x4 a = EPIIN_VAL(ai, bj, m, 0), b = EPIIN_VAL(ai, bj, m, 1);
                        u32x4 w; EPIIN_PACK(w, a, b);
                        *(u32x4*)(DIL + 2 * DPLANE + ((((row >> 12) * 8 + (pn - 6) * 4 + 2 * bj + (wc >> 1)) << 12) + (row & 4095)) * 64 + 32 * (wc & 1) + fq * 8) = w; } }
        } else {
#pragma unroll
            for (int ai = 0; ai < 2; ++ai)
#pragma unroll
                for (int m = 0; m < 4; ++m) { const size_t row = rowb + ai * HALF + m * 16;
#pragma unroll
                    for (int bj = 0; bj < 2; ++bj) { f32x4 a = EPIIN_VAL(ai, bj, m, 0), b = EPIIN_VAL(ai, bj, m, 1);
#pragma unroll
                        for (int i = 0; i < 4; ++i) { a[i] = sigmoidf_(a[i]); b[i] = sigmoidf_(b[i]); }
                        u32x4 w; EPIIN_PACK(w, a, b);
                        *(u32x4*)(GATES + row * 2048 + (pn - 8) * 256 + bj * HALF + wc * 32 + fq * 8) = w; } }
        }
    }
};
#undef EPIIN_PACK
#undef EPIIN_VAL
struct EpiRowScale2 {
    static constexpr bool PERM = true, AFTER_DRAIN = false, MIDHOOK = false;
    unsigned char* ws; const float* kg;
    static constexpr size_t O_Q = 0, O_PA = 128u << 20, O_K = 768u << 20, O_V = 864u << 20, O_ROPE = 990u << 20, O_SSQ = 998u << 20, O_SSQKR = (1001u << 20) + 65536;
    __device__ __forceinline__ void operator()(const f32x4 (&acc)[2][2][4][2], const Unit& u, int wr, int wc, int fr, int fq) const {
        { const int ln_ = otid() & 63; fr = ln_ & 15; fq = ln_ >> 4; }
        bf16_t* Oq = (bf16_t*)(ws + O_Q); bf16_t* Kp = (bf16_t*)(ws + O_K); bf16_t* Vp = (bf16_t*)(ws + O_V); const bf16_t* PA = (const bf16_t*)(ws + O_PA); const float* ROPE = (const float*)(ws + O_ROPE);
        const float* ssq_q = (const float*)(ws + O_SSQ); const float* ssq_kv = ssq_q + 65536; const float* ssq_kr = (const float*)(ws + O_SSQKR);
        const size_t rowb = (size_t)u.pm * BM + wr * 64 + fr;
        if (u.pn < 3) {
            const int col0 = u.pn * BM + wc * 32 + 8 * fq;
#pragma unroll
            for (int ai = 0; ai < 2; ++ai)
#pragma unroll
                for (int m = 0; m < 4; ++m) { const size_t row = rowb + ai * HALF + m * 16; const float r = __builtin_amdgcn_rsqf(ssq_q[row] * (1.0f / 256.0f) + RMS_EPS);
#pragma unroll
                    for (int bj = 0; bj < 2; ++bj) { const f32x4 v0 = acc[ai][bj][m][0] * r, v1 = acc[ai][bj][m][1] * r;
                        u32x4 w; w.x = cvt_pk_bf16(v0[0], v0[1]); w.y = cvt_pk_bf16(v0[2], v0[3]); w.z = cvt_pk_bf16(v1[0], v1[1]); w.w = cvt_pk_bf16(v1[2], v1[3]);
                        *(u32x4*)(Oq + row * 768 + col0 + bj * HALF) = w; } }
        } else {
            const int head = (u.pn - 3) * 2 + (wc & 1); float rh8[2][4];
#pragma unroll
            for (int ai = 0; ai < 2; ++ai)
#pragma unroll
                for (int m = 0; m < 4; ++m) { const size_t row = rowb + ai * HALF + m * 16; const float r = __builtin_amdgcn_rsqf(ssq_kv[row] * (1.0f / 128.0f) + RMS_EPS);
                    const size_t hrow = ((((row >> 12) * 8 + head) << 12) + (row & 4095));
                    if (wc >= 2) {
#pragma unroll
                        for (int bj = 0; bj < 2; ++bj) { const f32x4 a = acc[ai][bj][m][0] * r, b = acc[ai][bj][m][1] * r;
                            u32x4 w; w.x = cvt_pk_bf16(a[0], a[1]); w.y = cvt_pk_bf16(a[2], a[3]); w.z = cvt_pk_bf16(b[0], b[1]); w.w = cvt_pk_bf16(b[2], b[3]);
                            *(u32x4*)(Vp + hrow * 64 + 32 * bj + 8 * fq) = w; }
                    } else {
                        float s = 0.f;
#pragma unroll
                        for (int bj = 0; bj < 2; ++bj) { const f32x4 a = acc[ai][bj][m][0], b = acc[ai][bj][m][1]; s += ((a[0] * a[0] + a[1] * a[1]) + (a[2] * a[2] + a[3] * a[3])) + ((b[0] * b[0] + b[1] * b[1]) + (b[2] * b[2] + b[3] * b[3])); }
                        s += __shfl_xor(s, 16); s += __shfl_xor(s, 32);
                        const float rh = __builtin_amdgcn_rsqf((s * r * r + ssq_kr[row]) * (1.0f / 96.0f) + RMS_EPS); const float rr = r * rh;
#pragma unroll
                        for (int bj = 0; bj < 2; ++bj) { const f32x4 a = acc[ai][bj][m][0] * rr * *(const f32x4*)(kg + 32 * bj + 8 * fq), b = acc[ai][bj][m][1] * rr * *(const f32x4*)(kg + 32 * bj + 8 * fq + 4);
                            u32x4 w; w.x = cvt_pk_bf16(a[0], a[1]); w.y = cvt_pk_bf16(a[2], a[3]); w.z = cvt_pk_bf16(b[0], b[1]); w.w = cvt_pk_bf16(b[2], b[3]);
                            *(u32x4*)(Kp + hrow * 96 + 32 * bj + 8 * fq) = w; }
                        rh8[ai][m] = rh;
                    }
                    asm volatile("" ::: "memory"); }
            if (wc < 2) {
#pragma unroll
                for (int ai = 0; ai < 2; ++ai)
#pragma unroll
                    for (int m = 0; m < 4; ++m) { const size_t row = rowb + ai * HALF + m * 16; const size_t hrow = ((((row >> 12) * 8 + head) << 12) + (row & 4095)); const float rh = rh8[ai][m];
                        const bf16_t* krp = PA + row * 512 + 384; const float* rp = ROPE + row * 32;
#pragma unroll
                        for (int e = 0; e < 2; ++e) { const int i0 = 4 * fq + 2 * e;
                            const unsigned xa = *(const unsigned*)(krp + i0), xb = *(const unsigned*)(krp + 16 + i0);
                            const float c0 = rp[i0], c1 = rp[i0 + 1], s0 = rp[16 + i0], s1 = rp[16 + i0 + 1];
                            const float a0 = bf_lo(xa) * rh * kg[64 + i0], a1 = bf_hi(xa) * rh * kg[64 + i0 + 1], b0 = bf_lo(xb) * rh * kg[80 + i0], b1 = bf_hi(xb) * rh * kg[80 + i0 + 1];
                            *(unsigned*)(Kp + hrow * 96 + 64 + i0) = cvt_pk_bf16(a0 * c0 - b0 * s0, a1 * c1 - b1 * s1);
                            *(unsigned*)(Kp + hrow * 96 + 80 + i0) = cvt_pk_bf16(b0 * c0 + a0 * s0, b1 * c1 + a1 * s1); }
                        asm volatile("" ::: "memory"); }
            }
        }
    }
};
struct EpiRowScale {
    static constexpr bool PERM = true, AFTER_DRAIN = false, MIDHOOK = false;
    bf16_t* O; int ldc; const float* ssq; float invk;
    __device__ __forceinline__ void operator()(const f32x4 (&acc)[2][2][4][2], const Unit& u, int wr, int wc, int fr, int fq) const {
        { const int ln_ = otid() & 63; fr = ln_ & 15; fq = ln_ >> 4; }
        const size_t rowb = (size_t)u.pm * BM + wr * 64 + fr; const int col0 = u.pn * BM + wc * 32 + 8 * fq;
#pragma unroll
        for (int ai = 0; ai < 2; ++ai)
#pragma unroll
            for (int m = 0; m < 4; ++m) { const size_t row = rowb + ai * HALF + m * 16; const float r = __builtin_amdgcn_rsqf(ssq[row] * invk + RMS_EPS);
#pragma unroll
                for (int bj = 0; bj < 2; ++bj) { const f32x4 v0 = acc[ai][bj][m][0] * r, v1 = acc[ai][bj][m][1] * r;
                    u32x4 w; w.x = cvt_pk_bf16(v0[0], v0[1]); w.y = cvt_pk_bf16(v0[2], v0[3]); w.z = cvt_pk_bf16(v1[0], v1[1]); w.w = cvt_pk_bf16(v1[2], v1[3]);
                    *(u32x4*)(O + row * ldc + col0 + bj * HALF) = w; } }
    }
};
struct EpiGate2 {
    static constexpr bool PERM = true, AFTER_DRAIN = false, MIDHOOK = true;
    bf16_t* O; const bf16_t* SIG;
    __device__ __forceinline__ void mid(f32x4 (&acc)[2][2][4][2], const Unit& u, int wr, int wc) const {
        const int ln_ = otid() & 63, fr = ln_ & 15, fq = ln_ >> 4;
        const size_t rowb = (size_t)u.pm * BM + wr * 64 + fr; const int col0 = u.pn * BM + wc * 32 + 8 * fq;
#pragma unroll
        for (int ai = 0; ai < 2; ++ai)
#pragma unroll
            for (int m = 0; m < 4; ++m) { const bf16_t* sp = SIG + (rowb + ai * HALF + m * 16) * 2048 + col0;
#pragma unroll
                for (int bj = 0; bj < 2; ++bj) { const u32x4 sa = *(const u32x4*)(sp + bj * HALF), sb = *(const u32x4*)(sp + 1024 + bj * HALF);
                    f32x4& v0 = acc[ai][bj][m][0]; f32x4& v1 = acc[ai][bj][m][1];
                    v0[0] *= bf_lo(sa.x) * __builtin_amdgcn_rcpf(1e-30f + bf_lo(sb.x)); v0[1] *= bf_hi(sa.x) * __builtin_amdgcn_rcpf(1e-30f + bf_hi(sb.x));
                    v0[2] *= bf_lo(sa.y) * __builtin_amdgcn_rcpf(1e-30f + bf_lo(sb.y)); v0[3] *= bf_hi(sa.y) * __builtin_amdgcn_rcpf(1e-30f + bf_hi(sb.y));
                    v1[0] *= bf_lo(sa.z) * __builtin_amdgcn_rcpf(1e-30f + bf_lo(sb.z)); v1[1] *= bf_hi(sa.z) * __builtin_amdgcn_rcpf(1e-30f + bf_hi(sb.z));
                    v1[2] *= bf_lo(sa.w) * __builtin_amdgcn_rcpf(1e-30f + bf_lo(sb.w)); v1[3] *= bf_hi(sa.w) * __builtin_amdgcn_rcpf(1e-30f + bf_hi(sb.w)); }
                asm volatile("" ::: "memory"); }
    }
    __device__ __forceinline__ void operator()(const f32x4 (&acc)[2][2][4][2], const Unit& u, int wr, int wc, int fr, int fq) const {
        { const int ln_ = otid() & 63; fr = ln_ & 15; fq = ln_ >> 4; }
        const size_t rowb = (size_t)u.pm * BM + wr * 64 + fr; const int col0 = u.pn * BM + wc * 32 + 8 * fq;
#pragma unroll
        for (int ai = 0; ai < 2; ++ai)
#pragma unroll
            for (int m = 0; m < 4; ++m) { const size_t row = rowb + ai * HALF + m * 16;
#pragma unroll
                for (int bj = 0; bj < 2; ++bj) { const u32x4 sg = *(const u32x4*)(SIG + row * 2048 + 1024 + col0 + bj * HALF);
                    f32x4 v0 = acc[ai][bj][m][0], v1 = acc[ai][bj][m][1];
                    v0[0] *= bf_lo(sg.x); v0[1] *= bf_hi(sg.x); v0[2] *= bf_lo(sg.y); v0[3] *= bf_hi(sg.y);
                    v1[0] *= bf_lo(sg.z); v1[1] *= bf_hi(sg.z); v1[2] *= bf_lo(sg.w); v1[3] *= bf_hi(sg.w);
                    u32x4 w; w.x = cvt_pk_bf16(v0[0], v0[1]); w.y = cvt_pk_bf16(v0[2], v0[3]); w.z = cvt_pk_bf16(v1[0], v1[1]); w.w = cvt_pk_bf16(v1[2], v1[3]);
                    *(u32x4*)(O + row * 1024 + col0 + bj * HALF) = w; } }
    }
};
struct EpiResid {
    static constexpr bool PERM = false, AFTER_DRAIN = false, MIDHOOK = false;
    const __attribute__((address_space(1))) float* xin; __attribute__((address_space(1))) float* out; const float* gmod;
    bf16_t* XG; const float* gnorm; const float* scmod; float* ssq;
    __device__ __forceinline__ void operator()(const f32x4 (&acc)[2][2][4][2], const Unit& u, int wr, int wc, int fr, int fq) const {
        { const int ln_ = otid() & 63; fr = ln_ & 15; fq = ln_ >> 4; }
        const size_t rowb = (size_t)u.pm * BM + wr * 64 + fr; const int col0 = u.pn * BM + wc * 32 + 4 * fq; const float* gb = gmod + (size_t)(u.pm >> 4) * 6144;
        f32x4 gv[2][2], Gv[2][2];
#pragma unroll
        for (int bj = 0; bj < 2; ++bj)
#pragma unroll
            for (int n = 0; n < 2; ++n) { gv[bj][n] = *(const f32x4*)(gb + col0 + bj * HALF + n * 16);
                if (XG) Gv[bj][n] = *(const f32x4*)(gnorm + col0 + bj * HALF + n * 16) * (1.0f + *(const f32x4*)(scmod + (size_t)(u.pm >> 4) * 6144 + col0 + bj * HALF + n * 16)); }
#pragma unroll
        for (int ai = 0; ai < 2; ++ai)
#pragma unroll
            for (int m = 0; m < 4; ++m) { const size_t row = rowb + ai * HALF + m * 16; const size_t off = row * 1024 + col0; float s = 0.f;
#pragma unroll
                for (int bj = 0; bj < 2; ++bj) { u32x2 w[2];
#pragma unroll
                    for (int n = 0; n < 2; ++n) { const f32x4 xv = *(const __attribute__((address_space(1))) f32x4*)(xin + off + bj * HALF + n * 16);
                        const f32x4 xn = xv + gv[bj][n] * acc[ai][bj][m][n];
                        *(__attribute__((address_space(1))) f32x4*)(out + off + bj * HALF + n * 16) = xn;
                        if (XG) { s += (xn[0] * xn[0] + xn[1] * xn[1]) + (xn[2] * xn[2] + xn[3] * xn[3]); const f32x4 t = xn * Gv[bj][n];
                            w[n].x = cvt_pk_bf16(t[0], t[1]); w[n].y = cvt_pk_bf16(t[2], t[3]); } }
                    if (XG) {
                        const bool odd = (fq & 1) != 0; const u32x2 snd = odd ? w[0] : w[1]; u32x2 rcv; rcv.x = __shfl_xor(snd.x, 16); rcv.y = __shfl_xor(snd.y, 16);
                        u32x4 o4; if (odd) { o4.x = rcv.x; o4.y = rcv.y; o4.z = w[1].x; o4.w = w[1].y; } else { o4.x = w[0].x; o4.y = w[0].y; o4.z = rcv.x; o4.w = rcv.y; }
                        *(u32x4*)(XG + off + bj * HALF + (odd ? 12 : 0)) = o4; } }
                if (XG) { s += __shfl_xor(s, 16); s += __shfl_xor(s, 32); if (fq == 0) atomicAdd(ssq + row, s); } }
    }
};
struct EpiSwiGLU {
    static constexpr bool PERM = true, AFTER_DRAIN = false, MIDHOOK = false;
    bf16_t* O; const float* ssq2; const float* bw;
    __device__ __forceinline__ void operator()(const f32x4 (&acc)[2][2][4][2], const Unit& u, int wr, int wc, int fr, int fq) const {
        { const int ln_ = otid() & 63; fr = ln_ & 15; fq = ln_ >> 4; }
        const size_t rowb = (size_t)u.pm * BM + wr * 64 + fr; const int col0 = u.pn * HALF + wc * 32 + 8 * fq;
        const float* bwp = bw + (size_t)(u.pm >> 4) * 5632 + u.pn * BM + wc * 32 + 8 * fq;
        const f32x4 bg0 = *(const f32x4*)bwp, bg1 = *(const f32x4*)(bwp + 4), bu0 = *(const f32x4*)(bwp + HALF), bu1 = *(const f32x4*)(bwp + HALF + 4);
#pragma unroll
        for (int ai = 0; ai < 2; ++ai)
#pragma unroll
            for (int m = 0; m < 4; ++m) { const size_t row = rowb + ai * HALF + m * 16; const float r = __builtin_amdgcn_rsqf(ssq2[row] * (1.0f / 1024.0f) + RMS_EPS);
                f32x4 g0 = acc[ai][0][m][0] * r + bg0, g1 = acc[ai][0][m][1] * r + bg1; const f32x4 u0 = acc[ai][1][m][0] * r + bu0, u1 = acc[ai][1][m][1] * r + bu1;
#pragma unroll
                for (int i = 0; i < 4; ++i) { g0[i] = g0[i] * sigmoidf_(g0[i]) * u0[i]; g1[i] = g1[i] * sigmoidf_(g1[i]) * u1[i]; }
                u32x4 w; w.x = cvt_pk_bf16(g0[0], g0[1]); w.y = cvt_pk_bf16(g0[2], g0[3]); w.z = cvt_pk_bf16(g1[0], g1[1]); w.w = cvt_pk_bf16(g1[2], g1[3]);
                *(u32x4*)(O + row * 2816 + col0) = w; }
    }
};

template <class Epi, class Sched, bool ALIGN_EPI = false, bool SP2 = false>
__device__ __forceinline__ void gemm_phase(PG8_LAS unsigned char* lds, const Gemm g, const Sched& S, const Epi& E) {
    const int tid = otid(), wid = __builtin_amdgcn_readfirstlane(tid >> 6), lane = tid & 63, wr = wid >> 2, wc = wid & 3, fr = lane & 15, fq = lane >> 4;
    const int K = g.K, lda = g.lda, nt = K / BK;
    unsigned voffA[2], voffB[2];
#pragma unroll
    for (int i = 0; i < 2; ++i) { int R, C; stage_rc(tid * 16 + i * 8192, R, C); const int Rb = Epi::PERM ? ((R & ~31) + perm32(R & 31)) : R;
        voffA[i] = (unsigned)(R * lda + C) * 2u; voffB[i] = (unsigned)(Rb * K + C) * 2u; }
    const size_t kstep = (size_t)(BK * 2);
    const size_t hstepB = (size_t)HALF * K * 2, hstepA = (size_t)HALF * lda * 2;
    const size_t tstepB = 2 * hstepB, tstepA = 2 * hstepA;
    const unsigned ldsw = (unsigned)wid * 1024u;
    const int aoff = lds_byte(wr * 64 + fr, fq * 8), boff = lds_byte(wc * 32 + fr, fq * 8);
#define PG8_SA(b, h) (((b) * 2 + (h)) * HTB)
#define PG8_SB(b, h) ((4 + (b) * 2 + (h)) * HTB)
#define PG8_STAGE(bufoff, gbase, voff) do { _Pragma("unroll") for (int _i = 0; _i < 2; ++_i) \
        __builtin_amdgcn_global_load_lds((const unsigned*)((const char*)(gbase) + (voff)[_i]), (PG8_LAS unsigned*)(lds + (bufoff) + ldsw + _i * 8192), 16, 0, 0); } while (0)
#define PG8_LDA(dst, b, h) do { _Pragma("unroll") for (int m = 0; m < 4; ++m) _Pragma("unroll") for (int k = 0; k < 2; ++k) dst[m][k] = *(const PG8_LAS bf16x8*)(lds + PG8_SA(b, h) + aoff + m * 2048 + k * 1024); } while (0)
#define PG8_LDB(dst, b, h) do { _Pragma("unroll") for (int n = 0; n < 2; ++n) _Pragma("unroll") for (int k = 0; k < 2; ++k) dst[n][k] = *(const PG8_LAS bf16x8*)(lds + PG8_SB(b, h) + boff + n * 2048 + k * 1024); } while (0)
#define PG8_MMA(ai, bj, At, Bt) do { __builtin_amdgcn_s_setprio(1); _Pragma("unroll") for (int m = 0; m < 4; ++m) _Pragma("unroll") for (int n = 0; n < 2; ++n) _Pragma("unroll") for (int k = 0; k < 2; ++k) \
        acc[ai][bj][m][n] = __builtin_amdgcn_mfma_f32_16x16x32_bf16(Bt[n][k], At[m][k], acc[ai][bj][m][n], 0, 0, 0); __builtin_amdgcn_s_setprio(0); } while (0)
#define PG8_WAIT_V(n) asm volatile("s_waitcnt vmcnt(" #n ")" ::: "memory")
#define PG8_WAIT_L(n) asm volatile("s_waitcnt lgkmcnt(" #n ")" ::: "memory")
#define PG8_BAR __builtin_amdgcn_s_barrier()
#define PG8_SCHED __builtin_amdgcn_sched_barrier(0)
    Unit cur, nxt; int ui = 0;
    if (!S.next(0, cur)) return;
    f32x4 acc[2][2][4][2];
#pragma unroll
    for (int a = 0; a < 2; ++a)
#pragma unroll
        for (int b = 0; b < 2; ++b)
#pragma unroll
            for (int m = 0; m < 4; ++m)
#pragma unroll
                for (int n = 0; n < 2; ++n) acc[a][b][m][n] = (f32x4){0.f, 0.f, 0.f, 0.f};
    bf16x8 At[4][2], B0[2][2], B1[2][2];
    const char* cA = (const char*)g.A + (size_t)cur.pm * tstepA + (cur.pn >= g.asplit ? (size_t)g.aoff2 * 2 : 0); const char* cB = (const char*)g.Bt + (size_t)cur.pn * tstepB;
    S.a_ready(cur);
    if constexpr (SP2) {
        PG8_STAGE(PG8_SB(0, 0), cB, voffB); PG8_STAGE(PG8_SB(0, 1), cB + hstepB, voffB); PG8_STAGE(PG8_SA(0, 0), cA, voffA); PG8_STAGE(PG8_SA(0, 1), cA + hstepA, voffA);
        if (wr == 1) PG8_BAR;
        PG8_WAIT_V(2); PG8_BAR;
        PG8_STAGE(PG8_SB(1, 0), cB + kstep, voffB); PG8_STAGE(PG8_SA(1, 0), cA + kstep, voffA); PG8_STAGE(PG8_SB(1, 1), cB + hstepB + kstep, voffB);
        PG8_WAIT_V(6); PG8_BAR;
    } else {
        PG8_STAGE(PG8_SB(0, 0), cB, voffB); PG8_STAGE(PG8_SA(0, 0), cA, voffA); PG8_STAGE(PG8_SB(0, 1), cB + hstepB, voffB); PG8_STAGE(PG8_SA(0, 1), cA + hstepA, voffA);
        if (wr == 1) PG8_BAR;
        PG8_WAIT_V(4); PG8_BAR;
        PG8_STAGE(PG8_SB(1, 0), cB + kstep, voffB); PG8_STAGE(PG8_SA(1, 0), cA + kstep, voffA); PG8_STAGE(PG8_SB(1, 1), cB + hstepB + kstep, voffB);
        PG8_WAIT_V(6); PG8_BAR;
    }
    for (;;) {
        const bool has_next = S.next(ui + 1, nxt);
        const char* nA = has_next ? (const char*)g.A + (size_t)nxt.pm * tstepA + (nxt.pn >= g.asplit ? (size_t)g.aoff2 * 2 : 0) : cA; const char* nB = has_next ? (const char*)g.Bt + (size_t)nxt.pn * tstepB : cB;
        for (int t = 0; t < nt; t += 2) {
            const bool last = (t == nt - 2);
            if constexpr (Epi::MIDHOOK) { if (t == (nt >> 1)) E.mid(acc, cur, wr, wc); }
            const char* a1 = cA + (size_t)(t + 1) * kstep;
            const char* a2 = last ? nA : cA + (size_t)(t + 2) * kstep; const char* b2 = last ? nB : cB + (size_t)(t + 2) * kstep;
            const char* a3 = a2 + kstep; const char* b3 = b2 + kstep;
            if (last && has_next) S.a_ready(nxt);
            if constexpr (SP2) {
            PG8_LDB(B0, 0, 0); PG8_LDB(B1, 0, 1); PG8_SCHED; PG8_LDA(At, 0, 0); PG8_STAGE(PG8_SA(1, 1), a1 + hstepA, voffA);
            PG8_WAIT_V(8); PG8_WAIT_L(0); PG8_BAR; PG8_MMA(0, 0, At, B0); PG8_MMA(0, 1, At, B1); PG8_BAR; PG8_SCHED;
            PG8_LDA(At, 0, 1); PG8_STAGE(PG8_SB(0, 0), b2, voffB); PG8_STAGE(PG8_SB(0, 1), b2 + hstepB, voffB); PG8_STAGE(PG8_SA(0, 0), a2, voffA);
            PG8_WAIT_V(8); PG8_WAIT_L(0); PG8_BAR; PG8_MMA(1, 0, At, B0); PG8_MMA(1, 1, At, B1); PG8_BAR; PG8_SCHED;
            PG8_LDB(B0, 1, 0); PG8_LDB(B1, 1, 1); PG8_SCHED; PG8_LDA(At, 1, 0); PG8_STAGE(PG8_SA(0, 1), a2 + hstepA, voffA);
            PG8_WAIT_V(8); PG8_WAIT_L(0); PG8_BAR; PG8_MMA(0, 0, At, B0); PG8_MMA(0, 1, At, B1); PG8_BAR; PG8_SCHED;
            PG8_LDA(At, 1, 1); PG8_STAGE(PG8_SB(1, 0), b3, voffB); PG8_STAGE(PG8_SB(1, 1), b3 + hstepB, voffB); PG8_STAGE(PG8_SA(1, 0), a3, voffA);
            PG8_WAIT_V(8); PG8_WAIT_L(0); PG8_BAR; PG8_MMA(1, 0, At, B0); PG8_MMA(1, 1, At, B1); PG8_BAR; PG8_SCHED;
            } else {
            PG8_LDB(B0, 0, 0); PG8_SCHED; PG8_LDA(At, 0, 0); PG8_STAGE(PG8_SA(1, 1), a1 + hstepA, voffA);
            PG8_WAIT_L(8); PG8_BAR; PG8_WAIT_L(0); PG8_MMA(0, 0, At, B0); PG8_BAR; PG8_SCHED;
            PG8_LDB(B1, 0, 1); PG8_STAGE(PG8_SB(0, 0), b2, voffB);
            PG8_BAR; PG8_WAIT_L(0); PG8_MMA(0, 1, At, B1); PG8_BAR;
            PG8_LDA(At, 0, 1); PG8_STAGE(PG8_SA(0, 0), a2, voffA);
            PG8_BAR; PG8_WAIT_L(0); PG8_MMA(1, 0, At, B0); PG8_BAR; PG8_SCHED;
            PG8_STAGE(PG8_SB(0, 1), b2 + hstepB, voffB);
            PG8_WAIT_V(6); PG8_BAR; PG8_MMA(1, 1, At, B1); PG8_BAR;
            PG8_LDB(B0, 1, 0); PG8_SCHED; PG8_LDA(At, 1, 0); PG8_STAGE(PG8_SA(0, 1), a2 + hstepA, voffA);
            PG8_WAIT_L(8); PG8_BAR; PG8_WAIT_L(0); PG8_MMA(0, 0, At, B0); PG8_BAR; PG8_SCHED;
            PG8_LDB(B1, 1, 1); PG8_STAGE(PG8_SB(1, 0), b3, voffB);
            PG8_BAR; PG8_WAIT_L(0); PG8_MMA(0, 1, At, B1); PG8_BAR;
            PG8_LDA(At, 1, 1); PG8_STAGE(PG8_SA(1, 0), a3, voffA);
            PG8_BAR; PG8_WAIT_L(0); PG8_MMA(1, 0, At, B0); PG8_BAR; PG8_SCHED;
            PG8_STAGE(PG8_SB(1, 1), b3 + hstepB, voffB);
            PG8_WAIT_V(6); PG8_BAR; PG8_MMA(1, 1, At, B1); PG8_BAR;
            }
        }
        if constexpr (ALIGN_EPI) { if (wr == 0) PG8_BAR; }
        if constexpr (!Epi::AFTER_DRAIN) { E(acc, cur, wr, wc, fr, fq); S.done(cur); }
        if (!has_next) break;
#pragma unroll
        for (int a = 0; a < 2; ++a)
#pragma unroll
            for (int b = 0; b < 2; ++b)
#pragma unroll
                for (int m = 0; m < 4; ++m)
#pragma unroll
                    for (int n = 0; n < 2; ++n) acc[a][b][m][n] = (f32x4){0.f, 0.f, 0.f, 0.f};
        cur = nxt; cA = nA; cB = nB; ++ui;
        if constexpr (ALIGN_EPI) { if (wr == 1) PG8_BAR; }
    }
    PG8_WAIT_V(0);
    if constexpr (!ALIGN_EPI) { if (wr == 0) PG8_BAR; }
    PG8_BAR;
    if constexpr (Epi::AFTER_DRAIN) { E.fused(acc, cur, wr, wc, fr, fq, lds, wid, lane); S.done(cur); }
#undef PG8_SA
#undef PG8_SB
#undef PG8_STAGE
#undef PG8_LDA
#undef PG8_LDB
#undef PG8_MMA
#undef PG8_WAIT_V
#undef PG8_WAIT_L
#undef PG8_BAR
#undef PG8_SCHED
}
}

constexpr int NB = 16, SEQ = 4096, DM = 1024, DEPTH = 4, NTOK = NB * SEQ, NH = 8, FFH = 2816, NIN = 4096, INC = 4000;
constexpr int NWAVES = 8, NTHR = 512;
constexpr int LDS_BYTES = 147456, RING_BYTES = 131072;
constexpr size_t MiB = 1u << 20;
constexpr size_t WS_H = 0;
constexpr size_t WS_PA = 128 * MiB;
constexpr size_t WS_DIL = 192 * MiB;
constexpr size_t WS_GATES = 384 * MiB;
constexpr size_t WS_HID = 128 * MiB;
constexpr size_t WS_KVRAW = 640 * MiB;
constexpr size_t WS_K = 768 * MiB;
constexpr size_t WS_V = 864 * MiB;
constexpr size_t WS_W = 928 * MiB, WS_WSTRIDE = 30 * MiB;
constexpr size_t W_IN = 0, W_Q = W_IN + (size_t)NIN * 1024 * 2, W_KV = W_Q + 768 * 256 * 2, W_A = W_KV + 1024 * 256 * 2, W_B = W_A + 1024 * 512 * 2,
                 W_O = W_B + 1024 * 512 * 2, W_1 = W_O + 1024 * 1024 * 2, W_2 = W_1 + (size_t)5632 * 1024 * 2, W_END = W_2 + (size_t)1024 * 2816 * 2;
constexpr size_t WS_MOD = 988 * MiB;
constexpr size_t WS_ROPE = 990 * MiB;
constexpr size_t WS_SSQ = 998 * MiB;
constexpr size_t WS_LSE = 999 * MiB;
constexpr size_t WS_BT = 1001 * MiB;
constexpr size_t WS_SSQKR = 1001 * MiB + 65536;
constexpr size_t WS_BW1 = 1002 * MiB;
constexpr size_t WS_BW2 = 1003 * MiB;
constexpr size_t WS_CTL = 1005 * MiB, CTL_BYTES = 65536;
constexpr size_t WS_END = 1006 * MiB;
static_assert(W_END <= WS_WSTRIDE && WS_W + 2 * WS_WSTRIDE <= WS_MOD, "weights fit");
static_assert(pg8::EpiRowScale2::O_Q == WS_H && pg8::EpiRowScale2::O_PA == WS_PA && pg8::EpiRowScale2::O_K == WS_K && pg8::EpiRowScale2::O_V == WS_V && pg8::EpiRowScale2::O_ROPE == WS_ROPE && pg8::EpiRowScale2::O_SSQ == WS_SSQ && pg8::EpiRowScale2::O_SSQKR == WS_SSQKR, "EpiRowScale2 offsets");
static_assert(WS_HID + (size_t)NTOK * FFH * 2 <= WS_KVRAW, "hid overlay");

#define LAS __attribute__((address_space(3)))
typedef unsigned short bf16_t;
typedef short bf16x8 __attribute__((ext_vector_type(8)));
typedef short s16x4 __attribute__((ext_vector_type(4)));
typedef float f32x4 __attribute__((ext_vector_type(4)));
typedef float f32x16 __attribute__((ext_vector_type(16)));
typedef unsigned u32x4 __attribute__((ext_vector_type(4)));
typedef unsigned u32x2 __attribute__((ext_vector_type(2)));
using pg8::cvt_pk_bf16; using pg8::bf_lo; using pg8::bf_hi;

struct Params {
    const float *x, *c; const int* pos; const float *rel_bias, *norm1_g, *norm2_g, *ada_w, *ada_b, *w_in, *q_a_norm, *w_q_b, *kv_a_norm, *w_kv_b, *q_norm_a, *k_norm_a, *q_norm_b, *k_norm_b,
        *w_branch_a, *w_branch_b, *w_out, *w_ffn_gate, *w_ffn_up, *w_ffn_down;
    float* out; unsigned char* ws;
    float inv_freq[16];
    int ph_lo, ph_hi;
};

__device__ __forceinline__ float wave_sum(float v) {
#pragma unroll
    for (int o = 1; o < 64; o <<= 1) v += __shfl_xor(v, o);
    return v;
}
#define LDS_WAIT() asm volatile("s_waitcnt lgkmcnt(0)" ::: "memory")

__device__ __forceinline__ void phase0(const Params& P, LAS unsigned char* lds, int G) {
    const int tid = otid(), lane = tid & 63, wid = __builtin_amdgcn_readfirstlane(tid >> 6);
    float* MOD = (float*)(P.ws + WS_MOD); float* ROPE = (float*)(P.ws + WS_ROPE); float* BT = (float*)(P.ws + WS_BT);
    const int gtid = obid() * NTHR + tid, nthr = G * NTHR;
    for (int idx = gtid; idx < NTOK * 16; idx += nthr) { const int t = idx >> 4, i = idx & 15;
        const float ang = (float)P.pos[t] * P.inv_freq[i];
        double rev = (double)ang * 0.15915494309189535; rev -= __builtin_rint(rev); const float f = (float)rev;
        ROPE[t * 32 + i] = __builtin_amdgcn_cosf(f); ROPE[t * 32 + 16 + i] = __builtin_amdgcn_sinf(f); }
    for (int idx = gtid; idx < 3 * 8 * 129; idx += nthr) { const int j = idx % 129, h = (idx / 129) & 7, p = idx / (129 * 8);
        const int dil = p == 0 ? 1 : (p == 1 ? 4 : 16); const int rp = (j - 64) * dil; const int n = rp < 0 ? -rp : rp; int bk = rp > 0 ? 16 : 0;
        if (n < 8) bk += n; else { const float nf = (float)n; int lg = 8 + (int)(__logf(nf * 0.125f) / 4.852030263919617f * 8.0f); bk += lg < 15 ? lg : 15; }
        BT[idx] = P.rel_bias[bk * 8 + h] * pg8::LOG2E; }
    LAS float* sC = (LAS float*)lds;
    LAS float* red = (LAS float*)(lds + 65536);
    for (int i = tid; i < 16 * 1024; i += NTHR) { const float v = P.c[i]; sC[i] = v / (1.0f + __expf(-v)); }
    __syncthreads();
    for (int it = obid(); it < 4 * 96; it += G) { const int l = it / 96, cb = it % 96; const int col = cb * 64 + lane;
        float a[16];
#pragma unroll
        for (int b = 0; b < 16; ++b) a[b] = 0.f;
        const float* wp = P.ada_w + ((size_t)l * 1024 + wid * 128) * 6144 + col;
#pragma unroll 16
        for (int k = 0; k < 128; ++k) { const float w = wp[(size_t)k * 6144];
#pragma unroll
            for (int b = 0; b < 16; ++b) a[b] += sC[b * 1024 + wid * 128 + k] * w; }
#pragma unroll
        for (int b = 0; b < 16; ++b) red[(wid * 16 + b) * 64 + lane] = a[b];
        __syncthreads();
        for (int o = tid; o < 1024; o += NTHR) { const int b = o >> 6, ln = o & 63; float s = 0.f;
#pragma unroll
            for (int w = 0; w < 8; ++w) s += red[(w * 16 + b) * 64 + ln];
            MOD[((size_t)l * 16 + b) * 6144 + cb * 64 + ln] = s + P.ada_b[l * 6144 + cb * 64 + ln]; }
        __syncthreads();
    }
}

__device__ __forceinline__ void tr_item(const float* W, int Nsrc, int k0, int j0, const float* kscale, bf16_t* WT, int Kdst, int R0, LAS float* scr, int lane) {
    if (j0 >= 0) {
#pragma unroll 8
        for (int i = 0; i < 32; ++i) { const int kk = 2 * i + (lane >> 5); float v = W[(size_t)(k0 + kk) * Nsrc + j0 + (lane & 31)]; if (kscale) v *= kscale[k0 + kk]; scr[kk * 33 + (lane & 31)] = v; }
    } else {
#pragma unroll 8
        for (int i = 0; i < 32; ++i) { const int kk = 2 * i + (lane >> 5); scr[kk * 33 + (lane & 31)] = 0.f; }
    }
    LDS_WAIT();
    const int c = lane & 7;
#pragma unroll
    for (int j = 0; j < 4; ++j) { const int n = (lane >> 3) + 8 * j; const LAS float* s = scr + (8 * c) * 33 + n;
        u32x4 o; o.x = cvt_pk_bf16(s[0 * 33], s[1 * 33]); o.y = cvt_pk_bf16(s[2 * 33], s[3 * 33]); o.z = cvt_pk_bf16(s[4 * 33], s[5 * 33]); o.w = cvt_pk_bf16(s[6 * 33], s[7 * 33]);
        *(u32x4*)(WT + (size_t)(R0 + n) * Kdst + k0 + 8 * c) = o; }
    LDS_WAIT();
}
__device__ __forceinline__ int win_src_col(int R0) {
    const int pn = R0 >> 8, rho = R0 & 255;
    if (pn == 0) return rho;
    if (pn == 1) return rho < 160 ? 256 + rho : -1;
    if (pn < 6) { const int wc = (rho >> 5) & 3, dd = 32 * (rho >> 7); const int sec = (pn - 2) >> 1, head = 4 * ((pn - 2) & 1) + wc; return 416 + sec * 512 + head * 64 + dd; }
    if (pn < 8) return 416 + 1024 + (R0 - 1536);
    return 1952 + (R0 - 2048);
}
__device__ __forceinline__ void conv_weights(const Params& P, int l, unsigned char* wb, LAS unsigned char* lds, int G) {
    const int tid = otid(), lane = tid & 63, wid = __builtin_amdgcn_readfirstlane(tid >> 6);
    LAS float* scr = (LAS float*)(lds + wid * 16384);
    constexpr int I_IN = 16 * 128, I_Q = 4 * 24, I_KV = 4 * 32, I_A = 8 * 32, I_B = 8 * 32, I_O = 16 * 32, I_1 = 16 * 176, I_2 = 44 * 32;
    constexpr int NIT = I_IN + I_Q + I_KV + I_A + I_B + I_O + I_1 + I_2;
    for (int it = obid() * NWAVES + wid; it < NIT; it += G * NWAVES) {
        int r = it;
        if (r < I_IN) { const int kb = r / 128, rb = r % 128; tr_item(P.w_in + (size_t)l * 1024 * INC, INC, kb * 64, win_src_col(rb * 32), nullptr, (bf16_t*)(wb + W_IN), 1024, rb * 32, scr, lane); continue; } r -= I_IN;
        if (r < I_Q) { const int kb = r / 24, rb = r % 24; tr_item(P.w_q_b + (size_t)l * 256 * 768, 768, kb * 64, rb * 32, P.q_a_norm + l * 256, (bf16_t*)(wb + W_Q), 256, rb * 32, scr, lane); continue; } r -= I_Q;
        if (r < I_KV) { const int kb = r / 32, rb = r % 32; const int R0 = rb * 32, pnl = R0 >> 8, rho = R0 & 255, wcq = (rho >> 5) & 3;
            const int jsrc = (pnl * 2 + (wcq & 1)) * 128 + (wcq >= 2 ? 64 : 0) + 32 * (rho >> 7);
            tr_item(P.w_kv_b + (size_t)l * 128 * 1024, 1024, kb * 64, kb < 2 ? jsrc : -1, P.kv_a_norm + l * 128, (bf16_t*)(wb + W_KV), 256, R0, scr, lane); continue; } r -= I_KV;
        if (r < I_A) { const int kb = r / 32, rb = r % 32; tr_item(P.w_branch_a + (size_t)l * 512 * 1024, 1024, kb * 64, rb * 32, nullptr, (bf16_t*)(wb + W_A), 1024, rb * 32, scr, lane); continue; } r -= I_A;
        if (r < I_B) { const int kb = r / 32, rb = r % 32; tr_item(P.w_branch_b + (size_t)l * 512 * 1024, 1024, kb * 64, rb * 32, nullptr, (bf16_t*)(wb + W_A) + 512, 1024, rb * 32, scr, lane); continue; } r -= I_B;
        if (r < I_O) { const int kb = r / 32, rb = r % 32; tr_item(P.w_out + (size_t)l * 1024 * 1024, 1024, kb * 64, rb * 32, nullptr, (bf16_t*)(wb + W_O), 1024, rb * 32, scr, lane); continue; } r -= I_O;
        if (r < I_1) { const int kb = r / 176, rb = r % 176; const int R0 = rb * 32, pn = R0 >> 8, rho = R0 & 255;
            const float* src = (rho < 128 ? P.w_ffn_gate : P.w_ffn_up) + (size_t)l * 1024 * FFH;
            tr_item(src, FFH, kb * 64, pn * 128 + (rho & 127), nullptr, (bf16_t*)(wb + W_1), 1024, R0, scr, lane); continue; } r -= I_1;
        { const int kb = r / 32, rb = r % 32; tr_item(P.w_ffn_down + (size_t)l * FFH * 1024, 1024, kb * 64, rb * 32, nullptr, (bf16_t*)(wb + W_2), FFH, rb * 32, scr, lane); }
    }
}

__device__ __forceinline__ void norm_phase(const float* xin, const float* g, const float* mod  , int sh_off, int sc_off, bf16_t* H, int G) {
    const int tid = otid(), lane = tid & 63, wid = __builtin_amdgcn_readfirstlane(tid >> 6);
    for (int m = obid() * NWAVES + wid; m < NTOK; m += G * NWAVES) {
        const f32x4* xr = (const f32x4*)(xin + (size_t)m * DM) + lane; f32x4 v[4]; float s = 0.f;
#pragma unroll
        for (int j = 0; j < 4; ++j) { v[j] = xr[64 * j]; s += (v[j][0] * v[j][0] + v[j][1] * v[j][1]) + (v[j][2] * v[j][2] + v[j][3] * v[j][3]); }
        const float r = __builtin_amdgcn_rsqf(wave_sum(s) * (1.0f / DM) + pg8::RMS_EPS);
        const float* mb = mod + (size_t)(m >> 12) * 6144;
#pragma unroll
        for (int j = 0; j < 4; ++j) { const int col = 4 * lane + 256 * j;
            const f32x4 gv = *(const f32x4*)(g + col), sc = *(const f32x4*)(mb + sc_off + col), sh = *(const f32x4*)(mb + sh_off + col);
            const f32x4 o = (v[j] * r) * gv * (1.0f + sc) + sh;
            u32x2 w; w.x = cvt_pk_bf16(o[0], o[1]); w.y = cvt_pk_bf16(o[2], o[3]);
            *(u32x2*)(H + (size_t)m * DM + col) = w; }
    }
}

__device__ __forceinline__ void prepass_phase(const float* xin, const float* g, const float* mod  , int sc_off, bf16_t* XG, float* ssq, int G) {
    const int tid = otid(), lane = tid & 63, wid = __builtin_amdgcn_readfirstlane(tid >> 6);
    for (int m = obid() * NWAVES + wid; m < NTOK; m += G * NWAVES) {
        const f32x4* xr = (const f32x4*)(xin + (size_t)m * DM) + lane; float s = 0.f;
        const float* mb = mod + (size_t)(m >> 12) * 6144;
#pragma unroll
        for (int j = 0; j < 4; ++j) { const f32x4 v = xr[64 * j]; s += (v[0] * v[0] + v[1] * v[1]) + (v[2] * v[2] + v[3] * v[3]); const int col = 4 * lane + 256 * j;
            const f32x4 o = v * *(const f32x4*)(g + col) * (1.0f + *(const f32x4*)(mb + sc_off + col));
            u32x2 w; w.x = cvt_pk_bf16(o[0], o[1]); w.y = cvt_pk_bf16(o[2], o[3]);
            *(u32x2*)(XG + (size_t)m * DM + col) = w; }
        s = wave_sum(s);
        if (lane == 0) ssq[m] = s;
    }
}
__device__ __forceinline__ void bias_phase(const Params& P, LAS unsigned char* lds, int G) {
    const int tid = otid(), lane = tid & 63, wid = __builtin_amdgcn_readfirstlane(tid >> 6);
    const float* MOD = (const float*)(P.ws + WS_MOD); float* BW1 = (float*)(P.ws + WS_BW1); float* BW2 = (float*)(P.ws + WS_BW2);
    LAS float* sC = (LAS float*)lds;
    LAS float* red = (LAS float*)(lds + 65536);
    for (int it = obid(); it < 4 * 152; it += G) { const int l = it / 152, blk = it % 152; const bool ffn = blk >= 64; const int R0 = (ffn ? blk - 64 : blk) * 64;
        __syncthreads();
        for (int i = tid; i < 16 * 1024; i += NTHR) sC[i] = MOD[((size_t)l * 16 + (i >> 10)) * 6144 + (ffn ? 3072 : 0) + (i & 1023)];
        __syncthreads();
        const int R = R0 + lane; const float* wsrc; int j; size_t ncol;
        if (!ffn) { const int jb = win_src_col(R & ~31); j = jb < 0 ? -1 : jb + (R & 31); wsrc = P.w_in + (size_t)l * 1024 * INC; ncol = INC; }
        else { const int pn = R >> 8, rho = R & 255; j = pn * 128 + (rho & 127); wsrc = (rho < 128 ? P.w_ffn_gate : P.w_ffn_up) + (size_t)l * 1024 * FFH; ncol = FFH; }
        float a[16];
#pragma unroll
        for (int b = 0; b < 16; ++b) a[b] = 0.f;
        if (j >= 0) { const float* wp = wsrc + (size_t)(wid * 128) * ncol + j;
#pragma unroll 16
            for (int k = 0; k < 128; ++k) { const float w = wp[(size_t)k * ncol];
#pragma unroll
                for (int b = 0; b < 16; ++b) a[b] += sC[b * 1024 + wid * 128 + k] * w; } }
#pragma unroll
        for (int b = 0; b < 16; ++b) red[(wid * 16 + b) * 64 + lane] = a[b];
        __syncthreads();
        for (int o = tid; o < 1024; o += NTHR) { const int b = o >> 6, ln = o & 63; float s = 0.f;
#pragma unroll
            for (int w = 0; w < 8; ++w) s += red[(w * 16 + b) * 64 + ln];
            if (!ffn) BW1[((size_t)l * 16 + b) * 4096 + R0 + ln] = s; else BW2[((size_t)l * 16 + b) * 5632 + R0 + ln] = s; }
    }
    __syncthreads();
}

__device__ __forceinline__ void unpack8(const u32x4 w, float* f) { f[0] = bf_lo(w.x); f[1] = bf_hi(w.x); f[2] = bf_lo(w.y); f[3] = bf_hi(w.y); f[4] = bf_lo(w.z); f[5] = bf_hi(w.z); f[6] = bf_lo(w.w); f[7] = bf_hi(w.w); }
__device__ __forceinline__ u32x4 pack8(const float* f) { u32x4 w; w.x = cvt_pk_bf16(f[0], f[1]); w.y = cvt_pk_bf16(f[2], f[3]); w.z = cvt_pk_bf16(f[4], f[5]); w.w = cvt_pk_bf16(f[6], f[7]); return w; }
__device__ __forceinline__ float ssq8(const u32x4 w) { float f[8]; unpack8(w, f); return ((f[0] * f[0] + f[1] * f[1]) + (f[2] * f[2] + f[3] * f[3])) + ((f[4] * f[4] + f[5] * f[5]) + (f[6] * f[6] + f[7] * f[7])); }
__device__ __forceinline__ void head_norm_rope(const bf16_t* src_nope, const bf16_t* src_rope, bf16_t* dst, const float* gain, const float* rope, float oscale) {
    float s = 0.f;
#pragma unroll
    for (int c = 0; c < 8; ++c) s += ssq8(*(const u32x4*)(src_nope + 8 * c));
#pragma unroll
    for (int c = 0; c < 4; ++c) s += ssq8(*(const u32x4*)(src_rope + 8 * c));
    const float r = __builtin_amdgcn_rsqf(s * (1.0f / 96.0f) + pg8::RMS_EPS);
    asm volatile("" ::: "memory");
#pragma unroll
    for (int c = 0; c < 8; ++c) { float f[8]; unpack8(*(const u32x4*)(src_nope + 8 * c), f);
#pragma unroll
        for (int i = 0; i < 8; ++i) f[i] = f[i] * r * gain[8 * c + i] * oscale;
        *(u32x4*)(dst + 8 * c) = pack8(f); asm volatile("" ::: "memory"); }
    float x[32];
#pragma unroll
    for (int c = 0; c < 4; ++c) unpack8(*(const u32x4*)(src_rope + 8 * c), x + 8 * c);
#pragma unroll
    for (int i = 0; i < 32; ++i) x[i] = x[i] * r * gain[64 + i];
#pragma unroll
    for (int i = 0; i < 16; ++i) { const float cs = rope[i], sn = rope[16 + i]; const float x1 = x[i], x2 = x[16 + i]; x[i] = (x1 * cs - x2 * sn) * oscale; x[16 + i] = (x2 * cs + x1 * sn) * oscale; }
#pragma unroll
    for (int c = 0; c < 4; ++c) *(u32x4*)(dst + 64 + 8 * c) = pack8(x + 8 * c);
    asm volatile("" ::: "memory");
}
__device__ __forceinline__ void prep_phase(const Params& P, int l, int G) {
    const bf16_t* KVRAW = (const bf16_t*)(P.ws + WS_KVRAW); const bf16_t* PA = (const bf16_t*)(P.ws + WS_PA);
    bf16_t* K = (bf16_t*)(P.ws + WS_K); const float* ROPE = (const float*)(P.ws + WS_ROPE);
    const float* kg = P.k_norm_a + l * 96;
    for (int idx = obid() * NTHR + otid(); idx < NTOK * NH; idx += G * NTHR) { const int t = idx >> 3, h = idx & 7;
        const float* rp = ROPE + (size_t)t * 32;
        const bf16_t* kp = KVRAW + (size_t)t * 1024 + h * 128;
        const size_t hrow = ((size_t)((t >> 12) * 8 + h) << 12) + (t & 4095);
        head_norm_rope(kp, PA + (size_t)t * 512 + 384, K + hrow * 96, kg, rp, 1.0f);
    }
}
typedef short v4i16_t __attribute__((ext_vector_type(4)));
__device__ __forceinline__ s16x4 vtr(const LAS unsigned char* p) { return __builtin_bit_cast(s16x4, __builtin_amdgcn_ds_read_tr16_b64_v4i16((LAS v4i16_t*)p)); }
__device__ __forceinline__ bf16x8 cat8(s16x4 a, s16x4 b) { return (bf16x8){a[0], a[1], a[2], a[3], b[0], b[1], b[2], b[3]}; }
__device__ __forceinline__ bf16x8 packp(const f32x16& p, int o) {
    u32x4 w; w.x = cvt_pk_bf16(p[o + 0], p[o + 1]); w.y = cvt_pk_bf16(p[o + 2], p[o + 3]); w.z = cvt_pk_bf16(p[o + 4], p[o + 5]); w.w = cvt_pk_bf16(p[o + 6], p[o + 7]);
    return __builtin_bit_cast(bf16x8, w);
}
__device__ __forceinline__ float max16(const f32x16& p) {
    float a = fmaxf(fmaxf(p[0], p[1]), fmaxf(p[2], p[3])), b = fmaxf(fmaxf(p[4], p[5]), fmaxf(p[6], p[7]));
    float c = fmaxf(fmaxf(p[8], p[9]), fmaxf(p[10], p[11])), d = fmaxf(fmaxf(p[12], p[13]), fmaxf(p[14], p[15]));
    return fmaxf(fmaxf(a, b), fmaxf(c, d));
}
#define MFMA32(a, b, c) __builtin_amdgcn_mfma_f32_32x32x16_bf16((a), (b), (c), 0, 0, 0)
constexpr int KP = 208, VP = 192;
constexpr int KT_B = 64 * KP, VT_B = 64 * VP;
constexpr int MLA_K0 = 0, MLA_V0 = 2 * KT_B;

constexpr float MLA_THR = 8.0f;
__device__ __forceinline__ float max3f(float a, float b, float c) { float r; asm("v_max3_f32 %0, %1, %2, %3" : "=v"(r) : "v"(a), "v"(b), "v"(c)); return r; }
__device__ __forceinline__ float rowmax32(const f32x16& a, const f32x16& b) {
    float x = max3f(a[0], a[1], a[2]), y = max3f(b[0], b[1], b[2]);
    x = max3f(x, a[3], a[4]); y = max3f(y, b[3], b[4]); x = max3f(x, a[5], a[6]); y = max3f(y, b[5], b[6]); x = max3f(x, a[7], a[8]); y = max3f(y, b[7], b[8]);
    x = max3f(x, a[9], a[10]); y = max3f(y, b[9], b[10]); x = max3f(x, a[11], a[12]); y = max3f(y, b[11], b[12]); x = max3f(x, a[13], a[14]); y = max3f(y, b[13], b[14]);
    x = max3f(x, a[15], b[15]); x = max3f(x, y, y);
    return max3f(x, __shfl_xor(x, 32), x);
}
#define SBAR0() __builtin_amdgcn_sched_barrier(0)
__device__ __forceinline__ void mla_unit(LAS unsigned char* lds, const bf16_t* Q, const bf16_t* K, const bf16_t* V, bf16_t* Y, const float* qgain, const float* ROPE, int b, int h, int qb) {
    const int tid = otid(), lane = tid & 63, wid = __builtin_amdgcn_readfirstlane(tid >> 6), r32 = lane & 31, hi = lane >> 5;
    const size_t tok0 = (size_t)b * SEQ; const size_t qrow = tok0 + qb * 256 + wid * 32 + r32;
    const int kr0 = tid / 12, kc0 = tid % 12, kr1 = (512 + tid) / 12, kc1 = (512 + tid) % 12, vr = tid >> 3, vc = tid & 7;
    const size_t hrow0 = (size_t)(b * 8 + h) * SEQ;
    const bf16_t* kg0 = K + (hrow0 + kr0) * 96 + kc0 * 8; const bf16_t* kg1 = K + (hrow0 + kr1) * 96 + kc1 * 8;
    const bf16_t* vg = V + (hrow0 + vr) * 64 + vc * 8;
    const int kl0 = kr0 * KP + kc0 * 16, kl1 = kr1 * KP + kc1 * 16, vl = vr * VP + vc * 16;
    const bool has1 = tid < 256;
    u32x4 ka0, kb0, ka1, kb1, vv0, vv1;
    ka0 = *(const u32x4*)kg0; if (has1) kb0 = *(const u32x4*)kg1; vv0 = *(const u32x4*)vg;
    ka1 = *(const u32x4*)(kg0 + (size_t)64 * 96); if (has1) kb1 = *(const u32x4*)(kg1 + (size_t)64 * 96);
    bf16x8 qf[6];
    {
        const bf16_t* qp = Q + qrow * 768 + h * 96 + hi * 8; float f[6][8]; float s = 0.f;
#pragma unroll
        for (int d0 = 0; d0 < 6; ++d0) { unpack8(*(const u32x4*)(qp + d0 * 16), f[d0]);
#pragma unroll
            for (int i = 0; i < 8; ++i) s += f[d0][i] * f[d0][i]; }
        s += __shfl_xor(s, 32);
        const float r = __builtin_amdgcn_rsqf(s * (1.0f / 96.0f) + pg8::RMS_EPS);
#pragma unroll
        for (int d0 = 0; d0 < 6; ++d0)
#pragma unroll
            for (int i = 0; i < 8; ++i) f[d0][i] = f[d0][i] * r * qgain[d0 * 16 + hi * 8 + i];
        const float* rp = ROPE + qrow * 32 + hi * 8;
#pragma unroll
        for (int i = 0; i < 8; ++i) { const float cs = rp[i], sn = rp[16 + i]; const float x1 = f[4][i], x2 = f[5][i]; f[4][i] = x1 * cs - x2 * sn; f[5][i] = x2 * cs + x1 * sn; }
#pragma unroll
        for (int d0 = 0; d0 < 6; ++d0) {
#pragma unroll
            for (int i = 0; i < 8; ++i) f[d0][i] *= pg8::QSCALE_A;
            qf[d0] = __builtin_bit_cast(bf16x8, pack8(f[d0])); }
    }
    *(LAS u32x4*)(lds + MLA_K0 + kl0) = ka0; if (has1) *(LAS u32x4*)(lds + MLA_K0 + kl1) = kb0; *(LAS u32x4*)(lds + MLA_V0 + vl) = vv0;
    *(LAS u32x4*)(lds + MLA_K0 + KT_B + kl0) = ka1; if (has1) *(LAS u32x4*)(lds + MLA_K0 + KT_B + kl1) = kb1;
    ka0 = *(const u32x4*)(kg0 + (size_t)128 * 96); if (has1) kb0 = *(const u32x4*)(kg1 + (size_t)128 * 96); vv1 = *(const u32x4*)(vg + (size_t)64 * 64);
    __syncthreads();
    f32x16 o0, o1, negm;
#pragma unroll
    for (int i = 0; i < 16; ++i) { o0[i] = 0.f; o1[i] = 0.f; negm[i] = 0.f; }
    const int koff = r32 * KP + hi * 16;
    const int voff = (4 * hi + ((lane & 15) >> 2)) * VP + (16 * ((lane >> 4) & 1) + 4 * (lane & 3)) * 2;
    f32x16 p0, p1, n0, n1;
    { const LAS unsigned char* kb_ = lds + MLA_K0 + koff; p0 = negm; p1 = negm;
#pragma unroll
      for (int d0 = 0; d0 < 6; ++d0) { const bf16x8 a0 = *(const LAS bf16x8*)(kb_ + d0 * 32), a1 = *(const LAS bf16x8*)(kb_ + 32 * KP + d0 * 32); p0 = MFMA32(a0, qf[d0], p0); p1 = MFMA32(a1, qf[d0], p1); } }
    float m_ref, l_run = 0.f;
    { const float mx = rowmax32(p0, p1); m_ref = mx;
#pragma unroll
      for (int i = 0; i < 16; ++i) { p0[i] -= mx; p1[i] -= mx; negm[i] = -mx; } }
#define MLA_STEP(C0, C1, X0, X1, T, KAI, KBI, VVI, KAW, KBW, VVW) do { const int t_ = (T); const int cur = t_ & 1; \
        if (t_ + 3 < 64) { const size_t go = (size_t)(t_ + 3) * 64; KAI = *(const u32x4*)(kg0 + go * 96); if (has1) KBI = *(const u32x4*)(kg1 + go * 96); } \
        if (t_ + 2 < 64) { const size_t go = (size_t)(t_ + 2) * 64; VVI = *(const u32x4*)(vg + go * 64); } \
        bf16x8 kfr[12]; { const LAS unsigned char* kn = lds + MLA_K0 + (cur ^ 1) * KT_B + koff; \
            _Pragma("unroll") for (int d0 = 0; d0 < 6; ++d0) { kfr[2 * d0] = *(const LAS bf16x8*)(kn + d0 * 32); kfr[2 * d0 + 1] = *(const LAS bf16x8*)(kn + 32 * KP + d0 * 32); } } \
        SBAR0(); \
        const float mx = rowmax32(C0, C1); \
        if (__builtin_amdgcn_ballot_w64(mx > MLA_THR) != 0ull) { const float d = fmaxf(mx, 0.f); const float sc = __builtin_amdgcn_exp2f(-d); m_ref += d; l_run *= sc; \
            _Pragma("unroll") for (int i = 0; i < 16; ++i) { C0[i] -= d; C1[i] -= d; o0[i] *= sc; o1[i] *= sc; negm[i] = -m_ref; } } \
        SBAR0(); \
        X0 = negm; X1 = negm; \
        _Pragma("unroll") for (int d0 = 0; d0 < 6; ++d0) { X0 = MFMA32(kfr[2 * d0], qf[d0], X0); X1 = MFMA32(kfr[2 * d0 + 1], qf[d0], X1); } \
        SBAR0(); \
        float ls = 0.f; \
        _Pragma("unroll") for (int i = 0; i < 16; ++i) { C0[i] = __builtin_amdgcn_exp2f(C0[i]); C1[i] = __builtin_amdgcn_exp2f(C1[i]); ls += C0[i] + C1[i]; } \
        l_run += ls; \
        bf16x8 pb[4]; pb[0] = packp(C0, 0); pb[1] = packp(C0, 8); pb[2] = packp(C1, 0); pb[3] = packp(C1, 8); \
        const LAS unsigned char* vb_ = lds + MLA_V0 + cur * VT_B + voff; \
        _Pragma("unroll") for (int j = 0; j < 4; ++j) { const LAS unsigned char* vj = vb_ + 16 * j * VP; \
            const bf16x8 a0 = cat8(vtr(vj), vtr(vj + 8 * VP)); const bf16x8 a1 = cat8(vtr(vj + 64), vtr(vj + 8 * VP + 64)); \
            o0 = MFMA32(a0, pb[j], o0); o1 = MFMA32(a1, pb[j], o1); } \
        if (t_ + 2 < 64) { *(LAS u32x4*)(lds + MLA_K0 + cur * KT_B + kl0) = KAW; if (has1) *(LAS u32x4*)(lds + MLA_K0 + cur * KT_B + kl1) = KBW; } \
        if (t_ + 1 < 64) *(LAS u32x4*)(lds + MLA_V0 + (cur ^ 1) * VT_B + vl) = VVW; \
        __syncthreads(); } while (0)
    if (wid >= 4) __builtin_amdgcn_s_setprio(1);
    for (int t = 0; t < 64; t += 2) { MLA_STEP(p0, p1, n0, n1, t, ka1, kb1, vv0, ka0, kb0, vv1); MLA_STEP(n0, n1, p0, p1, t + 1, ka0, kb0, vv1, ka1, kb1, vv0); }
    __builtin_amdgcn_s_setprio(0);
#undef MLA_STEP
    const float lt = l_run + __shfl_xor(l_run, 32); const float inv = 1.0f / lt;
    bf16_t* yp = Y + qrow * 1024 + h * 64 + 4 * hi;
#pragma unroll
    for (int g = 0; g < 4; ++g) {
        u32x2 w0; w0.x = cvt_pk_bf16(o0[4 * g] * inv, o0[4 * g + 1] * inv); w0.y = cvt_pk_bf16(o0[4 * g + 2] * inv, o0[4 * g + 3] * inv); *(u32x2*)(yp + 8 * g) = w0;
        u32x2 w1; w1.x = cvt_pk_bf16(o1[4 * g] * inv, o1[4 * g + 1] * inv); w1.y = cvt_pk_bf16(o1[4 * g + 2] * inv, o1[4 * g + 3] * inv); *(u32x2*)(yp + 32 + 8 * g) = w1; }
}

constexpr int DW_BYTES = 13440;
template <int DELTA>
__device__ __forceinline__ void dil_block(LAS unsigned char* wl, const bf16_t* kbase  , const bf16_t* vbase, size_t rstride  ,
                                          const bf16x8 (&qf)[2][4], f32x16 (&o)[2][2], float (&m_run)[2], float (&l_run)[2], int bvar, int voff, int lane, int r32, int hi, int btb) {
    u32x4 vv[8]; bf16x8 kf[2][4];
#pragma unroll
    for (int i = 0; i < 8; ++i) { const int idx = lane + 64 * i, row = idx >> 3, ch = idx & 7; vv[i] = *(const u32x4*)(vbase + (size_t)row * rstride + ch * 8); }
#pragma unroll
    for (int kvh = 0; kvh < 2; ++kvh)
#pragma unroll
        for (int d0 = 0; d0 < 4; ++d0) kf[kvh][d0] = *(const bf16x8*)(kbase + (size_t)(32 * kvh + r32) * rstride + d0 * 16);
    SBAR0();
#pragma unroll
    for (int i = 0; i < 8; ++i) { const int idx = lane + 64 * i, row = idx >> 3, ch = idx & 7; *(LAS u32x4*)(wl + row * VP + ch * 16) = vv[i]; }
    bf16x8 pb[2][4];
#pragma unroll
    for (int qh = 0; qh < 2; ++qh) {
        f32x16 s[2]; float mx = -1e30f;
#pragma unroll
        for (int kvh = 0; kvh < 2; ++kvh) {
            constexpr int dummy = 0; (void)dummy;
            const int toff = 64 * DELTA + 32 * (kvh - qh);
            if (toff > 64 || toff < -64) continue;
#pragma unroll
            for (int i = 0; i < 16; ++i) s[kvh][i] = 0.f;
#pragma unroll
            for (int d0 = 0; d0 < 4; ++d0) s[kvh] = MFMA32(kf[kvh][d0], qf[qh][d0], s[kvh]);
#pragma unroll
            for (int rr = 0; rr < 16; ++rr) { const int c4 = 4 * ((rr & 3) + 8 * (rr >> 2)); const float bias = *(const LAS float*)(wl + bvar + (VT_B + c4 + toff * 4));
                float v = s[kvh][rr] + bias;
                if (toff == 64) v = (bvar <= btb - c4) ? v : -1e30f;
                if (toff == -64) v = (bvar >= btb - c4) ? v : -1e30f;
                s[kvh][rr] = v; mx = fmaxf(mx, v); }
        }
        mx = fmaxf(mx, __shfl_xor(mx, 32));
        const float m_new = fmaxf(m_run[qh], mx); const float alpha = __builtin_amdgcn_exp2f(m_run[qh] - m_new); m_run[qh] = m_new;
        float ls = 0.f;
#pragma unroll
        for (int kvh = 0; kvh < 2; ++kvh) { const int toff = 64 * DELTA + 32 * (kvh - qh);
            if (toff > 64 || toff < -64) continue;
#pragma unroll
            for (int rr = 0; rr < 16; ++rr) { const float e = __builtin_amdgcn_exp2f(s[kvh][rr] - m_new); s[kvh][rr] = e; ls += e; }
            pb[qh][2 * kvh] = packp(s[kvh], 0); pb[qh][2 * kvh + 1] = packp(s[kvh], 8); }
        l_run[qh] = l_run[qh] * alpha + ls;
#pragma unroll
        for (int i = 0; i < 16; ++i) { o[qh][0][i] *= alpha; o[qh][1][i] *= alpha; }
    }
    LDS_WAIT();
#pragma unroll
    for (int j = 0; j < 4; ++j) { const LAS unsigned char* vj = wl + voff + 16 * j * VP;
        const bf16x8 a0 = cat8(vtr(vj), vtr(vj + 8 * VP)); const bf16x8 a1 = cat8(vtr(vj + 64), vtr(vj + 8 * VP + 64));
#pragma unroll
        for (int qh = 0; qh < 2; ++qh) { const int toff = 64 * DELTA + 32 * ((j >> 1) - qh);
            if (toff > 64 || toff < -64) continue;
            o[qh][0] = MFMA32(a0, pb[qh][j], o[qh][0]); o[qh][1] = MFMA32(a1, pb[qh][j], o[qh][1]); } }
    LDS_WAIT();
}
template <int P_>
__device__ __forceinline__ void dil_wave_unit(LAS unsigned char* wl, const bf16_t* DIL, bf16_t* Y, bf16_t* ST, float* LSE, const float* BT, int b, int h, int r, int nb) {
    constexpr int dil = P_ == 0 ? 1 : (P_ == 1 ? 4 : 16), nblk = 64 / dil; constexpr bool first = P_ == 0, last = P_ == 2;
    const int lane = otid() & 63, r32 = lane & 31, hi = lane >> 5;
    const size_t tok0 = (size_t)b * SEQ; const size_t rstride = (size_t)dil * 64;
    LAS float* bt = (LAS float*)(wl + VT_B);
    for (int i = lane; i < 257; i += 64) { int j = i - 64; j = j < 0 ? 0 : (j > 128 ? 128 : j); bt[i] = BT[(P_ * 8 + h) * 129 + j]; }
    const int btb = 128 * 4;
    const int bvar = btb + 4 * (4 * hi - r32);
    bf16x8 qf[2][4];
    const bf16_t* rowb = DIL + ((size_t)(b * 8 + h) * SEQ + (size_t)(64 * nb) * dil + r) * 64;
    constexpr size_t KOFF = pg8::DPLANE, VOFF = 2 * pg8::DPLANE;
#pragma unroll
    for (int qh = 0; qh < 2; ++qh)
#pragma unroll
        for (int d0 = 0; d0 < 4; ++d0) qf[qh][d0] = *(const bf16x8*)(rowb + (size_t)(32 * qh + r32) * rstride + hi * 8 + d0 * 16);
    f32x16 o[2][2];
#pragma unroll
    for (int a = 0; a < 2; ++a)
#pragma unroll
        for (int c = 0; c < 2; ++c)
#pragma unroll
            for (int i = 0; i < 16; ++i) o[a][c][i] = 0.f;
    float m_run[2] = {-1e30f, -1e30f}, l_run[2] = {0.f, 0.f};
    const int voff = (4 * hi + ((lane & 15) >> 2)) * VP + (16 * ((lane >> 4) & 1) + 4 * (lane & 3)) * 2;
    LDS_WAIT();
    dil_block<0>(wl, rowb + KOFF + hi * 8, rowb + VOFF, rstride, qf, o, m_run, l_run, bvar, voff, lane, r32, hi, btb);
    if (nb > 0) dil_block<-1>(wl, rowb - 64 * rstride + KOFF + hi * 8, rowb - 64 * rstride + VOFF, rstride, qf, o, m_run, l_run, bvar, voff, lane, r32, hi, btb);
    if (nb + 1 < nblk) dil_block<1>(wl, rowb + 64 * rstride + KOFF + hi * 8, rowb + 64 * rstride + VOFF, rstride, qf, o, m_run, l_run, bvar, voff, lane, r32, hi, btb);
    float lp[2]; u32x2 pv[2][8];
    if (!first) {
#pragma unroll
        for (int qh = 0; qh < 2; ++qh) { const size_t srow = (size_t)(b * 8 + h) * SEQ + (size_t)(64 * nb + 32 * qh + r32) * dil + r; lp[qh] = LSE[srow];
            const bf16_t* sp = ST + srow * 64 + 4 * hi;
#pragma unroll
            for (int e = 0; e < 8; ++e) pv[qh][e] = *(const u32x2*)(sp + 32 * (e >> 2) + 8 * (e & 3)); }
    }
#pragma unroll
    for (int qh = 0; qh < 2; ++qh) {
        const size_t spos = (size_t)(64 * nb + 32 * qh + r32) * dil + r; const size_t srow = (size_t)(b * 8 + h) * SEQ + spos;
        const float lt = l_run[qh] + __shfl_xor(l_run[qh], 32); const float inv = 1.0f / lt; const float lse2 = m_run[qh] + __builtin_amdgcn_logf(lt);
        float a_prev = 0.f, a_cur = inv, lse_new = lse2;
        if (!first) { const float M = fmaxf(lp[qh], lse2); const float wp = __builtin_amdgcn_exp2f(lp[qh] - M), wc = __builtin_amdgcn_exp2f(lse2 - M); const float den = wp + wc;
            a_prev = wp / den; a_cur = wc / den * inv; lse_new = M + __builtin_amdgcn_logf(den); }
        bf16_t* yp = last ? Y + (tok0 + spos) * 1024 + 512 + h * 64 + 4 * hi : ST + srow * 64 + 4 * hi;
#pragma unroll
        for (int e = 0; e < 8; ++e) { const int blk = e >> 2, g = e & 3;
            float v0 = o[qh][blk][4 * g] * a_cur, v1 = o[qh][blk][4 * g + 1] * a_cur, v2 = o[qh][blk][4 * g + 2] * a_cur, v3 = o[qh][blk][4 * g + 3] * a_cur;
            if (!first) { v0 += a_prev * bf_lo(pv[qh][e].x); v1 += a_prev * bf_hi(pv[qh][e].x); v2 += a_prev * bf_lo(pv[qh][e].y); v3 += a_prev * bf_hi(pv[qh][e].y); }
            u32x2 w; w.x = cvt_pk_bf16(v0, v1); w.y = cvt_pk_bf16(v2, v3); *(u32x2*)(yp + 32 * blk + 8 * g) = w; }
        if (!last && hi == 0) LSE[srow] = lse_new;
    }
}
__device__ __forceinline__ void dil_unit(LAS unsigned char* lds, const bf16_t* DIL, bf16_t* Y, bf16_t* ST, float* LSE, const float* BT, int b, int h, int c) {
    const int wid = __builtin_amdgcn_readfirstlane(otid() >> 6);
    LAS unsigned char* wl = lds + wid * DW_BYTES;
    for (int j = 0; j < 2; ++j) { const int wu = 2 * wid + j; dil_wave_unit<0>(wl, DIL, Y, ST, LSE, BT, b, h, 0, c * 16 + wu); }
    __syncthreads();
    for (int j = 0; j < 2; ++j) { const int wu = 2 * wid + j; dil_wave_unit<1>(wl, DIL, Y, ST, LSE, BT, b, h, wu >> 2, c * 4 + (wu & 3)); }
    __syncthreads();
    for (int j = 0; j < 2; ++j) { const int wu = 2 * wid + j; dil_wave_unit<2>(wl, DIL, Y, ST, LSE, BT, b, h, wu, c); }
    __syncthreads();
}

typedef __attribute__((address_space(1))) unsigned gu32;
#define XB_TMO      128
#define XB_XCNT(j)  (256  + 64 * (j))
#define XB_XSUB(j)  (1280 + 64 * (j))
#define XB_XGEN(j)  (2304 + 64 * (j))
#define XB_TOP      3328
#define XB_TOPGEN   3392
#define XCD_BAR_WORDS 3456
#define XB_SPIN_CAP (1u << 18)

__device__ __forceinline__ unsigned xb_ld(unsigned* p)              { return __hip_atomic_load(p, __ATOMIC_RELAXED, __HIP_MEMORY_SCOPE_AGENT); }
__device__ __forceinline__ unsigned xb_add(unsigned* p, unsigned v) { return __hip_atomic_fetch_add(p, v, __ATOMIC_RELAXED, __HIP_MEMORY_SCOPE_AGENT); }
__device__ __forceinline__ unsigned xb_xcc_id() { return (unsigned)__builtin_amdgcn_s_getreg((3 << 11) | 20) & 0xFu; }
#define XB_SPIN(cond, bar) do { unsigned _sp = 0; while (cond) { __builtin_amdgcn_s_sleep(1); \
    if ((++_sp & 255u) == 0u) { if (xb_ld(&(bar)[XB_TMO])) break; if (_sp > XB_SPIN_CAP) { atomicAdd(&(bar)[XB_TMO], 1u); break; } } } } while (0)

struct XcdBarrier {
    unsigned* bar; unsigned x;
    volatile LAS unsigned* st;
};

__device__ __forceinline__ XcdBarrier xcd_barrier_post(unsigned* bar, volatile LAS unsigned* st) {
    XcdBarrier b; b.bar = bar; b.x = xb_xcc_id(); b.st = st;
    if (threadIdx.x == 0) (void)xb_add(&bar[XB_XCNT(b.x)], 1u);
    return b;
}
__device__ __forceinline__ void xcd_barrier_complete(unsigned* bar, unsigned x, unsigned& nloc, unsigned& nx) {
    const unsigned G = gridDim.x * gridDim.y * gridDim.z;
    unsigned sum, cnt, mine, sp = 0u;
    for (;;) {
        sum = 0u; cnt = 0u; mine = 0u;
#pragma unroll
        for (unsigned j = 0; j < 16; ++j) { const unsigned c = xb_ld(&bar[XB_XCNT(j)]); sum += c; cnt += (c > 0u) ? 1u : 0u; mine = (j == x) ? c : mine; }
        if (sum == G) break;
        __builtin_amdgcn_s_sleep(1);
        if ((++sp & 255u) == 0u) { if (xb_ld(&bar[XB_TMO])) break; if (sp > XB_SPIN_CAP) { atomicAdd(&bar[XB_TMO], 1u); break; } }
    }
    nloc = mine > 0u ? mine : 1u; nx = cnt > 0u ? cnt : 1u;
}

__device__ __forceinline__ void xcd_barrier(const XcdBarrier& b) {
    asm volatile("s_waitcnt vmcnt(0)" ::: "memory");
    __syncthreads();
    if (threadIdx.x == 0) {
        unsigned* bar = b.bar;
        __builtin_amdgcn_s_waitcnt(0);
        unsigned nloc = b.st[0], nx = b.st[1];
        if (nloc == 0u) { xcd_barrier_complete(bar, b.x, nloc, nx); b.st[0] = nloc; b.st[1] = nx; }
        const unsigned old = xb_add(&bar[XB_XSUB(b.x)], 1u);
        const unsigned gen = old / nloc;
        if (old + 1u == (gen + 1u) * nloc) {
            __builtin_amdgcn_fence(__ATOMIC_RELEASE, "agent");
            asm volatile("s_waitcnt vmcnt(0)" ::: "memory");
            const unsigned og = xb_add(&bar[XB_TOP], 1u);
            const unsigned tg = og / nx;
            if (og + 1u == (tg + 1u) * nx) xb_add(&bar[XB_TOPGEN], 1u);
            else XB_SPIN(xb_ld(&bar[XB_TOPGEN]) == tg, bar);
            __builtin_amdgcn_fence(__ATOMIC_ACQUIRE, "agent");
            xb_add(&bar[XB_XGEN(b.x)], 1u);
            asm volatile("s_waitcnt vmcnt(0)" ::: "memory");
        } else {
            XB_SPIN(xb_ld(&bar[XB_XGEN(b.x)]) == gen, bar);
            __builtin_amdgcn_fence(__ATOMIC_ACQUIRE, "agent");
            asm volatile("s_waitcnt vmcnt(0)" ::: "memory");
        }
    }
    __syncthreads();
}

constexpr int NPHASE = 2 + DEPTH * 7;
__device__ __forceinline__ unsigned char* opaque_ptr(unsigned char* p) { asm volatile("" : "+s"(p)); return p; }
#define GEMM(EpiT, Ev, Ap, Bp, Nn, Kk, Ld) do { pg8::Gemm g_{(Ap), (Bp), NTOK, (Nn), (Kk), (Ld), 1 << 30, 0}; pg8::StaticOrder S_; S_.init(NTOK, (Nn), G, obid()); \
        pg8::gemm_phase<EpiT, pg8::StaticOrder, true, true>(lds, g_, S_, (Ev)); } while (0)
#define BF(off) ((bf16_t*)(unsigned char*)(ws + (off)))
#define FP(off) ((float*)(unsigned char*)(ws + (off)))
#define WB(l_, off) ((bf16_t*)(unsigned char*)(ws + WS_W + (size_t)((l_) & 1) * WS_WSTRIDE + (off)))
__global__ void __launch_bounds__(NTHR, 2) mega_fwd(Params P0) {
    extern __shared__ __attribute__((aligned(16))) unsigned char lds_raw[];
    LAS unsigned char* lds = (LAS unsigned char*)lds_raw;
    cg::grid_group grid = cg::this_grid();
    { volatile LAS unsigned* misc = (volatile LAS unsigned*)(lds + RING_BYTES + 320); if (otid() < 32) misc[otid()] = 0u; }
    __syncthreads();
    XcdBarrier xbar = xcd_barrier_post((unsigned*)(P0.ws + WS_CTL) + 1024, (volatile LAS unsigned*)(lds + RING_BYTES + 320) + 8);
    { volatile LAS unsigned* misc = (volatile LAS unsigned*)(lds + RING_BYTES + 320);
      if (otid() == 0) { const unsigned x = xb_xcc_id(); misc[16] = xb_add((unsigned*)(P0.ws + WS_CTL) + 8192 + 64 * x, 1u); misc[17] = x; } }
    __syncthreads();
    const int ph_lo = P0.ph_lo, ph_hi = P0.ph_hi;
    for (int ph = ph_lo; ph < ph_hi; ++ph) {
        int G_ = (int)gridDim.x; asm volatile("" : "+s"(G_)); const int G = G_;
        typedef const __attribute__((address_space(4))) Params* kparams_t;
        kparams_t kp_ = (kparams_t)__builtin_amdgcn_kernarg_segment_ptr(); asm volatile("" : "+s"(kp_));
        const Params& P = *(const Params*)kp_;
        __attribute__((address_space(1))) unsigned char* ws = (__attribute__((address_space(1))) unsigned char*)opaque_ptr(P.ws);
        const int l = ph > 1 ? (ph - 2) / 7 : 0, kk_ = ph > 1 ? (ph - 2) % 7 + 2 : ph; const int k = kk_ >= 4 ? kk_ + 1 : kk_;
        const size_t modl = (size_t)l * 16 * 6144;
        switch (k) {
        case 0: {
            phase0(P, lds, G);
            float* SSQ = FP(WS_SSQ);
            float* SKR = FP(WS_SSQKR);
            for (int i = obid() * NTHR + otid(); i < 2 * NTOK; i += G * NTHR) { SSQ[i] = 0.f; if (i < NTOK) SKR[i] = 0.f; }
            __syncthreads();
            conv_weights(P, 0, (unsigned char*)(ws + WS_W), lds, G);
        } break;
        case 1: {
            bias_phase(P, lds, G);
            prepass_phase(P.x, P.norm1_g, FP(WS_MOD), 1024, BF(WS_H), FP(WS_SSQ) + 2 * NTOK, G);
        } break;
        case 2: {
            pg8::EpiIn E{BF(WS_PA), BF(WS_DIL), BF(WS_GATES), FP(WS_SSQ), FP(WS_SSQ) + NTOK, FP(WS_SSQKR), P.q_norm_b + l * 64, P.k_norm_b + l * 64, FP(WS_SSQ) + 2 * NTOK, FP(WS_BW1) + (size_t)l * 16 * 4096};
            GEMM(pg8::EpiIn, E, BF(WS_H), WB(l, W_IN), NIN, 1024, 1024);
        } break;
        case 3: {
            pg8::EpiRowScale2 E{(unsigned char*)ws, P.k_norm_a + l * 96};
            { pg8::Gemm g_{BF(WS_PA), WB(l, W_Q), NTOK, 1792, 256, 512, 3, 256}; pg8::StaticOrder S_; S_.init(NTOK, 1792, G, obid()); pg8::gemm_phase<pg8::EpiRowScale2, pg8::StaticOrder, true, true>(lds, g_, S_, E); }
        } break;
        case 5: {
            { float* SSQ = FP(WS_SSQ); float* SKR = FP(WS_SSQKR); for (int i = obid() * NTHR + otid(); i < 4 * NTOK; i += G * NTHR) { SSQ[i] = 0.f; if (i < NTOK) SKR[i] = 0.f; } }
            if (l + 1 < DEPTH) { conv_weights(P, l + 1, (unsigned char*)(ws + WS_W + (size_t)((l + 1) & 1) * WS_WSTRIDE), lds, G); __syncthreads(); }
            bf16_t* Y = BF(WS_KVRAW);
            if (G == 256) { int xcd = obid() & 7, slot = obid() >> 3;
                { const unsigned* tk = (const unsigned*)(ws + WS_CTL) + 8192; bool even = true;
#pragma unroll
                  for (int x = 0; x < 8; ++x) even = even && (__hip_atomic_load(tk + 64 * x, __ATOMIC_RELAXED, __HIP_MEMORY_SCOPE_AGENT) == 32u);
                  if (even) { volatile LAS unsigned* misc = (volatile LAS unsigned*)(lds + RING_BYTES + 320); slot = (int)misc[16]; xcd = (int)misc[17]; } }
                slot = __builtin_amdgcn_readfirstlane(slot); xcd = __builtin_amdgcn_readfirstlane(xcd);
                for (int i = 0; i < 8; ++i) { const int bh = ((i * 2 + (slot >> 4)) << 3) + xcd; mla_unit(lds, BF(WS_H), BF(WS_K), BF(WS_V), Y, P.q_norm_a + l * 96, FP(WS_ROPE), bh >> 3, bh & 7, slot & 15); }
            } else { for (int u = obid(); u < NB * NH * 16; u += G) mla_unit(lds, BF(WS_H), BF(WS_K), BF(WS_V), Y, P.q_norm_a + l * 96, FP(WS_ROPE), u >> 7, (u >> 4) & 7, u & 15); }
            __syncthreads();
            for (int u = obid(); u < NB * NH * 4; u += G) dil_unit(lds, BF(WS_DIL), Y, BF(WS_PA), FP(WS_LSE), FP(WS_BT), u >> 5, (u >> 2) & 7, u & 3);
        } break;
        case 6: {
            pg8::EpiGate2 E{BF(WS_H), BF(WS_GATES)}; GEMM(pg8::EpiGate2, E, BF(WS_KVRAW), WB(l, W_A), 1024, 1024, 1024);
        } break;
        case 7: {
            pg8::EpiResid E{(const __attribute__((address_space(1))) float*)(l == 0 ? P.x : P.out), (__attribute__((address_space(1))) float*)P.out, FP(WS_MOD) + modl + 2048, BF(WS_KVRAW), P.norm2_g + l * DM, FP(WS_MOD) + modl + 4096, FP(WS_SSQ) + 3 * NTOK};
            GEMM(pg8::EpiResid, E, BF(WS_H), WB(l, W_O), 1024, 1024, 1024);
        } break;
        case 8: {
            pg8::EpiSwiGLU E{BF(WS_HID), FP(WS_SSQ) + 3 * NTOK, FP(WS_BW2) + (size_t)l * 16 * 5632}; GEMM(pg8::EpiSwiGLU, E, BF(WS_KVRAW), WB(l, W_1), 5632, 1024, 1024);
        } break;
        default: {
            const bool nxt = l + 1 < DEPTH; const size_t modn = (size_t)(l + 1) * 16 * 6144;
            pg8::EpiResid E{(const __attribute__((address_space(1))) float*)P.out, (__attribute__((address_space(1))) float*)P.out, FP(WS_MOD) + modl + 5120, nxt ? BF(WS_H) : (bf16_t*)nullptr, P.norm1_g + (nxt ? (l + 1) * DM : 0), FP(WS_MOD) + (nxt ? modn + 1024 : 0), FP(WS_SSQ) + 2 * NTOK};
            GEMM(pg8::EpiResid, E, BF(WS_HID), WB(l, W_2), 1024, FFH, FFH);
        } break;
        }
        if (ph + 1 < ph_hi) { if (ph == ph_lo) grid.sync(); else xcd_barrier(xbar); }
    }
}

extern "C" void kernel_launch(void* const* d_in, const int* in_sizes, int n_in, void* d_out, int out_size, void* d_ws, size_t ws_size, hipStream_t stream) {
    static int grid = 0;
    if (grid == 0) {
        if (n_in != 23 || ws_size < WS_END) { fprintf(stderr, "kernel_launch: unexpected n_in %d / ws_size %zu\n", n_in, ws_size); grid = -1; return; }
        int dev = 0, cus = 0, per_cu = 0;
        (void)hipGetDevice(&dev); (void)hipDeviceGetAttribute(&cus, hipDeviceAttributeMultiprocessorCount, dev);
        if (hipFuncSetAttribute((const void*)mega_fwd, hipFuncAttributeMaxDynamicSharedMemorySize, LDS_BYTES) != hipSuccess) { fprintf(stderr, "kernel_launch: hipFuncSetAttribute failed\n"); grid = -1; return; }
        if (hipOccupancyMaxActiveBlocksPerMultiprocessor(&per_cu, (const void*)mega_fwd, NTHR, LDS_BYTES) != hipSuccess || per_cu < 1) { fprintf(stderr, "kernel_launch: occupancy query gave %d\n", per_cu); per_cu = 1; }
        (void)hipGetLastError();
        grid = cus * per_cu;
    }
    if (grid < 0) return;
    Params p{};
    const float** fp = (const float**)&p.x;
    p.x = (const float*)d_in[0]; p.c = (const float*)d_in[1]; p.pos = (const int*)d_in[2]; p.rel_bias = (const float*)d_in[3]; p.norm1_g = (const float*)d_in[4]; p.norm2_g = (const float*)d_in[5];
    p.ada_w = (const float*)d_in[6]; p.ada_b = (const float*)d_in[7]; p.w_in = (const float*)d_in[8]; p.q_a_norm = (const float*)d_in[9]; p.w_q_b = (const float*)d_in[10]; p.kv_a_norm = (const float*)d_in[11];
    p.w_kv_b = (const float*)d_in[12]; p.q_norm_a = (const float*)d_in[13]; p.k_norm_a = (const float*)d_in[14]; p.q_norm_b = (const float*)d_in[15]; p.k_norm_b = (const float*)d_in[16];
    p.w_branch_a = (const float*)d_in[17]; p.w_branch_b = (const float*)d_in[18]; p.w_out = (const float*)d_in[19]; p.w_ffn_gate = (const float*)d_in[20]; p.w_ffn_up = (const float*)d_in[21]; p.w_ffn_down = (const float*)d_in[22];
    (void)fp;
    p.out = (float*)d_out; p.ws = (unsigned char*)d_ws;
    for (int i = 0; i < 16; ++i) p.inv_freq[i] = (float)pow(10000.0, -(double)i / 16.0);
    p.ph_lo = 0; p.ph_hi = NPHASE;
    if (hipMemsetAsync((char*)d_ws + WS_CTL, 0, CTL_BYTES, stream) != hipSuccess) { fprintf(stderr, "kernel_launch: memset failed\n"); return; }
    void* args[] = {&p};
    hipError_t e = hipLaunchCooperativeKernel((const void*)mega_fwd, dim3(grid), dim3(NTHR), args, LDS_BYTES, stream);
    if (e != hipSuccess) fprintf(stderr, "kernel_launch: cooperative launch failed: %s (grid %d)\n", hipGetErrorString(e), grid);
}
```

```cpp
#include <hip/hip_runtime.h>
#include <hip/hip_cooperative_groups.h>
#include <cstdio>
#include <cstdint>
namespace cg = cooperative_groups;
__device__ __forceinline__ int otid() { int t = (int)threadIdx.x; asm volatile("" : "+v"(t)); return t; }
__device__ __forceinline__ int obid() { int b = (int)blockIdx.x; asm volatile("" : "+s"(b)); return b; }

#include <cmath>
namespace pg8 {
#define PG8_LAS __attribute__((address_space(3)))
typedef unsigned short bf16_t;
typedef short bf16x8 __attribute__((ext_vector_type(8)));
typedef float f32x4 __attribute__((ext_vector_type(4)));
typedef unsigned u32x4 __attribute__((ext_vector_type(4)));
constexpr int BM = 256, BK = 64, HALF = 128, HTB = HALF * BK * 2  , STAGE_BYTES = 8 * HTB, NXCD = 8, WGM = 8;

__host__ __device__ __forceinline__ int lds_byte(int r, int c) { const int st = (r >> 4) * 2 + (c >> 5), rr = r & 15, cc = c & 31, ob = rr * 64 + cc * 2; return st * 1024 + (ob ^ (((ob >> 9) & 1) << 5)); }
__host__ __device__ __forceinline__ void stage_rc(int b, int& R, int& C) { const int st = b / 1024, sb = b % 1024, swz = sb ^ (((sb >> 9) & 1) << 5); R = (st >> 1) * 16 + swz / 64; C = (st & 1) * 32 + (swz % 64) / 2; }
__host__ __device__ __forceinline__ int perm32(int rho) { const int n = rho >> 4, i = rho & 15; return 8 * (i >> 2) + 4 * n + (i & 3); }

struct Unit { int pm, pn; };
struct Gemm { const bf16_t* A; const bf16_t* Bt; int M, N, K, lda, asplit, aoff2; };

struct StaticOrder {
    int nM, nN, nwg, G, c;
    __host__ __device__ void init(int M, int N, int G_, int c_) { nM = M / BM; nN = N / BM; nwg = nM * nN; G = G_; c = c_; }
    __host__ __device__ bool next(int i, Unit& u) const {
        const long L = (long)i * G + c; if (L >= nwg) return false;
        int wgid = (int)L; { const int q = nwg / NXCD, r = nwg % NXCD, xcd = wgid % NXCD, off = wgid / NXCD; wgid = (xcd < r ? xcd * (q + 1) : r * (q + 1) + (xcd - r) * q) + off; }
        const int nig = WGM * nN, gid = wgid / nig, fm = gid * WGM, gsz = (nM - fm) < WGM ? (nM - fm) : WGM;
        u.pm = fm + ((wgid % nig) % gsz); u.pn = (wgid % nig) / gsz; return true;
    }
    __device__ __forceinline__ void a_ready(const Unit&) const {}
    __device__ __forceinline__ void done(const Unit&) const {}
};


__device__ __forceinline__ unsigned cvt_pk_bf16(float lo, float hi) { unsigned r; asm volatile("v_cvt_pk_bf16_f32 %0, %1, %2" : "=v"(r) : "v"(lo), "v"(hi)); return r; }
typedef unsigned u32x2 __attribute__((ext_vector_type(2)));
__device__ __forceinline__ float bf_lo(unsigned w) { return __builtin_bit_cast(float, w << 16); }
__device__ __forceinline__ float bf_hi(unsigned w) { return __builtin_bit_cast(float, w & 0xffff0000u); }
__device__ __forceinline__ float sigmoidf_(float x) { return 1.0f / (1.0f + __builtin_amdgcn_exp2f(-1.4426950408889634f * x)); }

constexpr float RMS_EPS = 1e-6f;
constexpr size_t DPLANE = (size_t)65536 * 512;
constexpr float LOG2E = 1.4426950408889634f;
constexpr float QSCALE_B = 0.125f * 1.4426950408889634f;
constexpr float QSCALE_A = 0.10206207261596575f * 1.4426950408889634f;

struct EpiIn {
    static constexpr bool PERM = true, AFTER_DRAIN = false, MIDHOOK = false;
    bf16_t* PA; bf16_t* DIL; bf16_t* GATES; float* ssq_q; float* ssq_kv; float* ssq_kr; const float* qn; const float* kn; const float* ssq1; const float* bw;
    __device__ __forceinline__ void operator()(const f32x4 (&acc_)[2][2][4][2], const Unit& u, int wr, int wc, int fr, int fq) const {
        { const int ln_ = otid() & 63; fr = ln_ & 15; fq = ln_ >> 4; }
        const int pn = u.pn; const size_t rowb = (size_t)u.pm * BM + wr * 64 + fr;
        f32x4 bv[2][2]; float r8[2][4];
        { const float* bwp = bw + (size_t)(u.pm >> 4) * 4096 + pn * BM + wc * 32 + fq * 8;
#pragma unroll
          for (int bj = 0; bj < 2; ++bj)
#pragma unroll
              for (int n = 0; n < 2; ++n) bv[bj][n] = *(const f32x4*)(bwp + bj * HALF + n * 4);
#pragma unroll
          for (int ai = 0; ai < 2; ++ai)
#pragma unroll
              for (int m = 0; m < 4; ++m) r8[ai][m] = __builtin_amdgcn_rsqf(ssq1[rowb + ai * HALF + m * 16] * (1.0f / 1024.0f) + RMS_EPS); }
#define EPIIN_VAL(ai, bj, m, n) (acc_[ai][bj][m][n] * r8[ai][m] + bv[bj][n])
#define EPIIN_PACK(w, a, b) do { (w).x = cvt_pk_bf16((a)[0], (a)[1]); (w).y = cvt_pk_bf16((a)[2], (a)[3]); (w).z = cvt_pk_bf16((b)[0], (b)[1]); (w).w = cvt_pk_bf16((b)[2], (b)[3]); } while (0)
        if (pn < 2) {
            float* sq = pn == 0 ? ssq_q : ssq_kv;
#pragma unroll
            for (int ai = 0; ai < 2; ++ai)
#pragma unroll
                for (int m = 0; m < 4; ++m) { const size_t row = rowb + ai * HALF + m * 16; float s = 0.f, s2 = 0.f;
#pragma unroll
                    for (int bj = 0; bj < 2; ++bj) { const f32x4 a = EPIIN_VAL(ai, bj, m, 0), b = EPIIN_VAL(ai, bj, m, 1);
                        u32x4 w; EPIIN_PACK(w, a, b);
                        *(u32x4*)(PA + row * 512 + pn * 256 + bj * HALF + wc * 32 + fq * 8) = w;
                        const float q = ((a[0] * a[0] + a[1] * a[1]) + (a[2] * a[2] + a[3] * a[3])) + ((b[0] * b[0] + b[1] * b[1]) + (b[2] * b[2] + b[3] * b[3]));
                        if (pn == 0 || bj == 0) s += q; else s2 += q; }
                    s += __shfl_xor(s, 16); s += __shfl_xor(s, 32);
                    if (fq == 0) atomicAdd(sq + row, s);
                    if (pn == 1 && wc == 0) { s2 += __shfl_xor(s2, 16); s2 += __shfl_xor(s2, 32); if (fq == 0) atomicAdd(ssq_kr + row, s2); } }
        } else if (pn < 6) {
            const int sec = (pn - 2) >> 1, head = 4 * ((pn - 2) & 1) + wc; const float* gp = sec == 0 ? qn : kn; const float gs = sec == 0 ? QSCALE_B : 1.0f;
            f32x4 gv[2][2];
#pragma unroll
            for (int bj = 0; bj < 2; ++bj)
#pragma unroll
                for (int n = 0; n < 2; ++n) gv[bj][n] = *(const f32x4*)(gp + 32 * bj + 8 * fq + 4 * n) * gs;
#pragma unroll
            for (int ai = 0; ai < 2; ++ai)
#pragma unroll
                for (int m = 0; m < 4; ++m) { const size_t row = rowb + ai * HALF + m * 16; float s = 0.f;
#pragma unroll
                    for (int bj = 0; bj < 2; ++bj)
#pragma unroll
                        for (int n = 0; n < 2; ++n) { const f32x4 v = EPIIN_VAL(ai, bj, m, n); s += (v[0] * v[0] + v[1] * v[1]) + (v[2] * v[2] + v[3] * v[3]); }
                    s += __shfl_xor(s, 16); s += __shfl_xor(s, 32);
                    const float r = __builtin_amdgcn_rsqf(s * (1.0f / 64.0f) + RMS_EPS);
#pragma unroll
                    for (int bj = 0; bj < 2; ++bj) { const f32x4 a = EPIIN_VAL(ai, bj, m, 0) * r * gv[bj][0], b = EPIIN_VAL(ai, bj, m, 1) * r * gv[bj][1];
                        u32x4 w; EPIIN_PACK(w, a, b);
                        *(u32x4*)(DIL + (size_t)sec * DPLANE + ((((row >> 12) * 8 + head) << 12) + (row & 4095)) * 64 + 32 * bj + 8 * fq) = w; } }
        } else if (pn < 8) {
#pragma unroll
            for (int ai = 0; ai < 2; ++ai)
#pragma unroll
                for (int m = 0; m < 4; ++m) { const size_t row = rowb + ai * HALF + m * 16;
#pragma unroll
                    for (int bj = 0; bj < 2; ++bj) { const f32x4 a = EPIIN_VAL(ai, bj, m, 0), b = EPIIN_VAL(ai, bj, m, 1);
                        u32x4 w; EPIIN_PACK(w, a, b);
                        *(u32x4*)(DIL + 2 * DPLANE + ((((row >> 12) * 8 + (pn - 6) * 4 + 2 * bj + (wc >> 1)) << 12) + (row & 4095)) * 64 + 32 * (wc & 1) + fq * 8) = w; } }
        } else {
#pragma unroll
            for (int ai = 0; ai < 2; ++ai)
#pragma unroll
                for (int m = 0; m < 4; ++m) { const size_t row = rowb + ai * HALF + m * 16;
#pragma unroll
                    for (int bj = 0; bj < 2; ++bj) { f32x4 a = EPIIN_VAL(ai, bj, m, 0), b = EPIIN_VAL(ai, bj, m, 1);
#pragma unroll
                        for (int i = 0; i < 4; ++i) { a[i] = sigmoidf_(a[i]); b[i] = sigmoidf_(b[i]); }
                        u32x4 w; EPIIN_PACK(w, a, b);
                        *(u32x4*)(GATES + row * 2048 + (pn - 8) * 256 + bj * HALF + wc * 32 + fq * 8) = w; } }
        }
    }
};
#undef EPIIN_PACK
#undef EPIIN_VAL
struct EpiRowScale2 {
    static constexpr bool PERM = true, AFTER_DRAIN = false, MIDHOOK = false;
    unsigned char* ws; const float* kg;
    static constexpr size_t O_Q = 0, O_PA = 128u << 20, O_K = 768u << 20, O_V = 864u << 20, O_ROPE = 990u << 20, O_SSQ = 998u << 20, O_SSQKR = (1001u << 20) + 65536;
    __device__ __forceinline__ void operator()(const f32x4 (&acc)[2][2][4][2], const Unit& u, int wr, int wc, int fr, int fq) const {
        { const int ln_ = otid() & 63; fr = ln_ & 15; fq = ln_ >> 4; }
        bf16_t* Oq = (bf16_t*)(ws + O_Q); bf16_t* Kp = (bf16_t*)(ws + O_K); bf16_t* Vp = (bf16_t*)(ws + O_V); const bf16_t* PA = (const bf16_t*)(ws + O_PA); const float* ROPE = (const float*)(ws + O_ROPE);
        const float* ssq_q = (const float*)(ws + O_SSQ); const float* ssq_kv = ssq_q + 65536; const float* ssq_kr = (const float*)(ws + O_SSQKR);
        const size_t rowb = (size_t)u.pm * BM + wr * 64 + fr;
        if (u.pn < 3) {
            const int col0 = u.pn * BM + wc * 32 + 8 * fq;
#pragma unroll
            for (int ai = 0; ai < 2; ++ai)
#pragma unroll
                for (int m = 0; m < 4; ++m) { const size_t row = rowb + ai * HALF + m * 16; const float r = __builtin_amdgcn_rsqf(ssq_q[row] * (1.0f / 256.0f) + RMS_EPS);
#pragma unroll
                    for (int bj = 0; bj < 2; ++bj) { const f32x4 v0 = acc[ai][bj][m][0] * r, v1 = acc[ai][bj][m][1] * r;
                        u32x4 w; w.x = cvt_pk_bf16(v0[0], v0[1]); w.y = cvt_pk_bf16(v0[2], v0[3]); w.z = cvt_pk_bf16(v1[0], v1[1]); w.w = cvt_pk_bf16(v1[2], v1[3]);
                        *(u32x4*)(Oq + row * 768 + col0 + bj * HALF) = w; } }
        } else {
            const int head = (u.pn - 3) * 2 + (wc & 1); float rh8[2][4];
#pragma unroll
            for (int ai = 0; ai < 2; ++ai)
#pragma unroll
                for (int m = 0; m < 4; ++m) { const size_t row = rowb + ai * HALF + m * 16; const float r = __builtin_amdgcn_rsqf(ssq_kv[row] * (1.0f / 128.0f) + RMS_EPS);
                    const size_t hrow = ((((row >> 12) * 8 + head) << 12) + (row & 4095));
                    if (wc >= 2) {
#pragma unroll
                        for (int bj = 0; bj < 2; ++bj) { const f32x4 a = acc[ai][bj][m][0] * r, b = acc[ai][bj][m][1] * r;
                            u32x4 w; w.x = cvt_pk_bf16(a[0], a[1]); w.y = cvt_pk_bf16(a[2], a[3]); w.z = cvt_pk_bf16(b[0], b[1]); w.w = cvt_pk_bf16(b[2], b[3]);
                            *(u32x4*)(Vp + hrow * 64 + 32 * bj + 8 * fq) = w; }
                    } else {
                        float s = 0.f;
#pragma unroll
                        for (int bj = 0; bj < 2; ++bj) { const f32x4 a = acc[ai][bj][m][0], b = acc[ai][bj][m][1]; s += ((a[0] * a[0] + a[1] * a[1]) + (a[2] * a[2] + a[3] * a[3])) + ((b[0] * b[0] + b[1] * b[1]) + (b[2] * b[2] + b[3] * b[3])); }
                        s += __shfl_xor(s, 16); s += __shfl_xor(s, 32);
                        const float rh = __builtin_amdgcn_rsqf((s * r * r + ssq_kr[row]) * (1.0f / 96.0f) + RMS_EPS); const float rr = r * rh;
#pragma unroll
                        for (int bj = 0; bj < 2; ++bj) { const f32x4 a = acc[ai][bj][m][0] * rr * *(const f32x4*)(kg + 32 * bj + 8 * fq), b = acc[ai][bj][m][1] * rr * *(const f32x4*)(kg + 32 * bj + 8 * fq + 4);
                            u32x4 w; w.x = cvt_pk_bf16(a[0], a[1]); w.y = cvt_pk_bf16(a[2], a[3]); w.z = cvt_pk_bf16(b[0], b[1]); w.w = cvt_pk_bf16(b[2], b[3]);
                            *(u32x4*)(Kp + hrow * 96 + 32 * bj + 8 * fq) = w; }
                        rh8[ai][m] = rh;
                    }
                    asm volatile("" ::: "memory"); }
            if (wc < 2) {
#pragma unroll
                for (int ai = 0; ai < 2; ++ai)
#pragma unroll
                    for (int m = 0; m < 4; ++m) { const size_t row = rowb + ai * HALF + m * 16; const size_t hrow = ((((row >> 12) * 8 + head) << 12) + (row & 4095)); const float rh = rh8[ai][m];
                        const bf16_t* krp = PA + row * 512 + 384; const float* rp = ROPE + row * 32;
#pragma unroll
                        for (int e = 0; e < 2; ++e) { const int i0 = 4 * fq + 2 * e;
                            const unsigned xa = *(const unsigned*)(krp + i0), xb = *(const unsigned*)(krp + 16 + i0);
                            const float c0 = rp[i0], c1 = rp[i0 + 1], s0 = rp[16 + i0], s1 = rp[16 + i0 + 1];
                            const float a0 = bf_lo(xa) * rh * kg[64 + i0], a1 = bf_hi(xa) * rh * kg[64 + i0 + 1], b0 = bf_lo(xb) * rh * kg[80 + i0], b1 = bf_hi(xb) * rh * kg[80 + i0 + 1];
                            *(unsigned*)(Kp + hrow * 96 + 64 + i0) = cvt_pk_bf16(a0 * c0 - b0 * s0, a1 * c1 - b1 * s1);
                            *(unsigned*)(Kp + hrow * 96 + 80 + i0) = cvt_pk_bf16(b0 * c0 + a0 * s0, b1 * c1 + a1 * s1); }
                        asm volatile("" ::: "memory"); }
            }
        }
    }
};
struct EpiRowScale {
    static constexpr bool PERM = true, AFTER_DRAIN = false, MIDHOOK = false;
    bf16_t* O; int ldc; const float* ssq; float invk;
    __device__ __forceinline__ void operator()(const f32x4 (&acc)[2][2][4][2], const Unit& u, int wr, int wc, int fr, int fq) const {
        { const int ln_ = otid() & 63; fr = ln_ & 15; fq = ln_ >> 4; }
        const size_t rowb = (size_t)u.pm * BM + wr * 64 + fr; const int col0 = u.pn * BM + wc * 32 + 8 * fq;
#pragma unroll
        for (int ai = 0; ai < 2; ++ai)
#pragma unroll
            for (int m = 0; m < 4; ++m) { const size_t row = rowb + ai * HALF + m * 16; const float r = __builtin_amdgcn_rsqf(ssq[row] * invk + RMS_EPS);
#pragma unroll
                for (int bj = 0; bj < 2; ++bj) { const f32x4 v0 = acc[ai][bj][m][0] * r, v1 = acc[ai][bj][m][1] * r;
                    u32x4 w; w.x = cvt_pk_bf16(v0[0], v0[1]); w.y = cvt_pk_bf16(v0[2], v0[3]); w.z = cvt_pk_bf16(v1[0], v1[1]); w.w = cvt_pk_bf16(v1[2], v1[3]);
                    *(u32x4*)(O + row * ldc + col0 + bj * HALF) = w; } }
    }
};
struct EpiGate2 {
    static constexpr bool PERM = true, AFTER_DRAIN = false, MIDHOOK = true;
    bf16_t* O; const bf16_t* SIG;
    __device__ __forceinline__ void mid(f32x4 (&acc)[2][2][4][2], const Unit& u, int wr, int wc) const {
        const int ln_ = otid() & 63, fr = ln_ & 15, fq = ln_ >> 4;
        const size_t rowb = (size_t)u.pm * BM + wr * 64 + fr; const int col0 = u.pn * BM + wc * 32 + 8 * fq;
#pragma unroll
        for (int ai = 0; ai < 2; ++ai)
#pragma unroll
            for (int m = 0; m < 4; ++m) { const bf16_t* sp = SIG + (rowb + ai * HALF + m * 16) * 2048 + col0;
#pragma unroll
                for (int bj = 0; bj < 2; ++bj) { const u32x4 sa = *(const u32x4*)(sp + bj * HALF), sb = *(const u32x4*)(sp + 1024 + bj * HALF);
                    f32x4& v0 = acc[ai][bj][m][0]; f32x4& v1 = acc[ai][bj][m][1];
                    v0[0] *= bf_lo(sa.x) * __builtin_amdgcn_rcpf(1e-30f + bf_lo(sb.x)); v0[1] *= bf_hi(sa.x) * __builtin_amdgcn_rcpf(1e-30f + bf_hi(sb.x));
                    v0[2] *= bf_lo(sa.y) * __builtin_amdgcn_rcpf(1e-30f + bf_lo(sb.y)); v0[3] *= bf_hi(sa.y) * __builtin_amdgcn_rcpf(1e-30f + bf_hi(sb.y));
                    v1[0] *= bf_lo(sa.z) * __builtin_amdgcn_rcpf(1e-30f + bf_lo(sb.z)); v1[1] *= bf_hi(sa.z) * __builtin_amdgcn_rcpf(1e-30f + bf_hi(sb.z));
                    v1[2] *= bf_lo(sa.w) * __builtin_amdgcn_rcpf(1e-30f + bf_lo(sb.w)); v1[3] *= bf_hi(sa.w) * __builtin_amdgcn_rcpf(1e-30f + bf_hi(sb.w)); }
                asm volatile("" ::: "memory"); }
    }
    __device__ __forceinline__ void operator()(const f32x4 (&acc)[2][2][4][2], const Unit& u, int wr, int wc, int fr, int fq) const {
        { const int ln_ = otid() & 63; fr = ln_ & 15; fq = ln_ >> 4; }
        const size_t rowb = (size_t)u.pm * BM + wr * 64 + fr; const int col0 = u.pn * BM + wc * 32 + 8 * fq;
#pragma unroll
        for (int ai = 0; ai < 2; ++ai)
#pragma unroll
            for (int m = 0; m < 4; ++m) { const size_t row = rowb + ai * HALF + m * 16;
#pragma unroll
                for (int bj = 0; bj < 2; ++bj) { const u32x4 sg = *(const u32x4*)(SIG + row * 2048 + 1024 + col0 + bj * HALF);
                    f32x4 v0 = acc[ai][bj][m][0], v1 = acc[ai][bj][m][1];
                    v0[0] *= bf_lo(sg.x); v0[1] *= bf_hi(sg.x); v0[2] *= bf_lo(sg.y); v0[3] *= bf_hi(sg.y);
                    v1[0] *= bf_lo(sg.z); v1[1] *= bf_hi(sg.z); v1[2] *= bf_lo(sg.w); v1[3] *= bf_hi(sg.w);
                    u32x4 w; w.x = cvt_pk_bf16(v0[0], v0[1]); w.y = cvt_pk_bf16(v0[2], v0[3]); w.z = cvt_pk_bf16(v1[0], v1[1]); w.w = cvt_pk_bf16(v1[2], v1[3]);
                    *(u32x4*)(O + row * 1024 + col0 + bj * HALF) = w; } }
    }
};
struct EpiResid {
    static constexpr bool PERM = false, AFTER_DRAIN = false, MIDHOOK = false;
    const __attribute__((address_space(1))) float* xin; __attribute__((address_space(1))) float* out; const float* gmod;
    bf16_t* XG; const float* gnorm; const float* scmod; float* ssq;
    __device__ __forceinline__ void operator()(const f32x4 (&acc)[2][2][4][2], const Unit& u, int wr, int wc, int fr, int fq) const {
        { const int ln_ = otid() & 63; fr = ln_ & 15; fq = ln_ >> 4; }
        const size_t rowb = (size_t)u.pm * BM + wr * 64 + fr; const int col0 = u.pn * BM + wc * 32 + 4 * fq; const float* gb = gmod + (size_t)(u.pm >> 4) * 6144;
        f32x4 gv[2][2], Gv[2][2];
#pragma unroll
        for (int bj = 0; bj < 2; ++bj)
#pragma unroll
            for (int n = 0; n < 2; ++n) { gv[bj][n] = *(const f32x4*)(gb + col0 + bj * HALF + n * 16);
                if (XG) Gv[bj][n] = *(const f32x4*)(gnorm + col0 + bj * HALF + n * 16) * (1.0f + *(const f32x4*)(scmod + (size_t)(u.pm >> 4) * 6144 + col0 + bj * HALF + n * 16)); }
#pragma unroll
        for (int ai = 0; ai < 2; ++ai)
#pragma unroll
            for (int m = 0; m < 4; ++m) { const size_t row = rowb + ai * HALF + m * 16; const size_t off = row * 1024 + col0; float s = 0.f;
#pragma unroll
                for (int bj = 0; bj < 2; ++bj) { u32x2 w[2];
#pragma unroll
                    for (int n = 0; n < 2; ++n) { const f32x4 xv = *(const __attribute__((address_space(1))) f32x4*)(xin + off + bj * HALF + n * 16);
                        const f32x4 xn = xv + gv[bj][n] * acc[ai][bj][m][n];
                        *(__attribute__((address_space(1))) f32x4*)(out + off + bj * HALF + n * 16) = xn;
                        if (XG) { s += (xn[0] * xn[0] + xn[1] * xn[1]) + (xn[2] * xn[2] + xn[3] * xn[3]); const f32x4 t = xn * Gv[bj][n];
                            w[n].x = cvt_pk_bf16(t[0], t[1]); w[n].y = cvt_pk_bf16(t[2], t[3]); } }
                    if (XG) {
                        const bool odd = (fq & 1) != 0; const u32x2 snd = odd ? w[0] : w[1]; u32x2 rcv; rcv.x = __shfl_xor(snd.x, 16); rcv.y = __shfl_xor(snd.y, 16);
                        u32x4 o4; if (odd) { o4.x = rcv.x; o4.y = rcv.y; o4.z = w[1].x; o4.w = w[1].y; } else { o4.x = w[0].x; o4.y = w[0].y; o4.z = rcv.x; o4.w = rcv.y; }
                        *(u32x4*)(XG + off + bj * HALF + (odd ? 12 : 0)) = o4; } }
                if (XG) { s += __shfl_xor(s, 16); s += __shfl_xor(s, 32); if (fq == 0) atomicAdd(ssq + row, s); } }
    }
};
struct EpiSwiGLU {
    static constexpr bool PERM = true, AFTER_DRAIN = false, MIDHOOK = false;
    bf16_t* O; const float* ssq2; const float* bw;
    __device__ __forceinline__ void operator()(const f32x4 (&acc)[2][2][4][2], const Unit& u, int wr, int wc, int fr, int fq) const {
        { const int ln_ = otid() & 63; fr = ln_ & 15; fq = ln_ >> 4; }
        const size_t rowb = (size_t)u.pm * BM + wr * 64 + fr; const int col0 = u.pn * HALF + wc * 32 + 8 * fq;
        const float* bwp = bw + (size_t)(u.pm >> 4) * 5632 + u.pn * BM + wc * 32 + 8 * fq;
        const f32x4 bg0 = *(const f32x4*)bwp, bg1 = *(const f32x4*)(bwp + 4), bu0 = *(const f32x4*)(bwp + HALF), bu1 = *(const f32x4*)(bwp + HALF + 4);
#pragma unroll
        for (int ai = 0; ai < 2; ++ai)
#pragma unroll
            for (int m = 0; m < 4; ++m) { const size_t row = rowb + ai * HALF + m * 16; const float r = __builtin_amdgcn_rsqf(ssq2[row] * (1.0f / 1024.0f) + RMS_EPS);
                f32x4 g0 = acc[ai][0][m][0] * r + bg0, g1 = acc[ai][0][m][1] * r + bg1; const f32x4 u0 = acc[ai][1][m][0] * r + bu0, u1 = acc[ai][1][m][1] * r + bu1;
#pragma unroll
                for (int i = 0; i < 4; ++i) { g0[i] = g0[i] * sigmoidf_(g0[i]) * u0[i]; g1[i] = g1[i] * sigmoidf_(g1[i]) * u1[i]; }
                u32x4 w; w.x = cvt_pk_bf16(g0[0], g0[1]); w.y = cvt_pk_bf16(g0[2], g0[3]); w.z = cvt_pk_bf16(g1[0], g1[1]); w.w = cvt_pk_bf16(g1[2], g1[3]);
                *(u32x4*)(O + row * 2816 + col0) = w; }
    }
};

template <class Epi, class Sched, bool ALIGN_EPI = false, bool SP2 = false>
__device__ __forceinline__ void gemm_phase(PG8_LAS unsigned char* lds, const Gemm g, const Sched& S, const Epi& E) {
    const int tid = otid(), wid = __builtin_amdgcn_readfirstlane(tid >> 6), lane = tid & 63, wr = wid >> 2, wc = wid & 3, fr = lane & 15, fq = lane >> 4;
    const int K = g.K, lda = g.lda, nt = K / BK;
    unsigned voffA[2], voffB[2];
#pragma unroll
    for (int i = 0; i < 2; ++i) { int R, C; stage_rc(tid * 16 + i * 8192, R, C); const int Rb = Epi::PERM ? ((R & ~31) + perm32(R & 31)) : R;
        voffA[i] = (unsigned)(R * lda + C) * 2u; voffB[i] = (unsigned)(Rb * K + C) * 2u; }
    const size_t kstep = (size_t)(BK * 2);
    const size_t hstepB = (size_t)HALF * K * 2, hstepA = (size_t)HALF * lda * 2;
    const size_t tstepB = 2 * hstepB, tstepA = 2 * hstepA;
    const unsigned ldsw = (unsigned)wid * 1024u;
    const int aoff = lds_byte(wr * 64 + fr, fq * 8), boff = lds_byte(wc * 32 + fr, fq * 8);
#define PG8_SA(b, h) (((b) * 2 + (h)) * HTB)
#define PG8_SB(b, h) ((4 + (b) * 2 + (h)) * HTB)
#define PG8_STAGE(bufoff, gbase, voff) do { _Pragma("unroll") for (int _i = 0; _i < 2; ++_i) \
        __builtin_amdgcn_global_load_lds((const unsigned*)((const char*)(gbase) + (voff)[_i]), (PG8_LAS unsigned*)(lds + (bufoff) + ldsw + _i * 8192), 16, 0, 0); } while (0)
#define PG8_LDA(dst, b, h) do { _Pragma("unroll") for (int m = 0; m < 4; ++m) _Pragma("unroll") for (int k = 0; k < 2; ++k) dst[m][k] = *(const PG8_LAS bf16x8*)(lds + PG8_SA(b, h) + aoff + m * 2048 + k * 1024); } while (0)
#define PG8_LDB(dst, b, h) do { _Pragma("unroll") for (int n = 0; n < 2; ++n) _Pragma("unroll") for (int k = 0; k < 2; ++k) dst[n][k] = *(const PG8_LAS bf16x8*)(lds + PG8_SB(b, h) + boff + n * 2048 + k * 1024); } while (0)
#define PG8_MMA(ai, bj, At, Bt) do { __builtin_amdgcn_s_setprio(1); _Pragma("unroll") for (int m = 0; m < 4; ++m) _Pragma("unroll") for (int n = 0; n < 2; ++n) _Pragma("unroll") for (int k = 0; k < 2; ++k) \
        acc[ai][bj][m][n] = __builtin_amdgcn_mfma_f32_16x16x32_bf16(Bt[n][k], At[m][k], acc[ai][bj][m][n], 0, 0, 0); __builtin_amdgcn_s_setprio(0); } while (0)
#define PG8_WAIT_V(n) asm volatile("s_waitcnt vmcnt(" #n ")" ::: "memory")
#define PG8_WAIT_L(n) asm volatile("s_waitcnt lgkmcnt(" #n ")" ::: "memory")
#define PG8_BAR __builtin_amdgcn_s_barrier()
#define PG8_SCHED __builtin_amdgcn_sched_barrier(0)
    Unit cur, nxt; int ui = 0;
    if (!S.next(0, cur)) return;
    f32x4 acc[2][2][4][2];
#pragma unroll
    for (int a = 0; a < 2; ++a)
#pragma unroll
        for (int b = 0; b < 2; ++b)
#pragma unroll
            for (int m = 0; m < 4; ++m)
#pragma unroll
                for (int n = 0; n < 2; ++n) acc[a][b][m][n] = (f32x4){0.f, 0.f, 0.f, 0.f};
    bf16x8 At[4][2], B0[2][2], B1[2][2];
    const char* cA = (const char*)g.A + (size_t)cur.pm * tstepA + (cur.pn >= g.asplit ? (size_t)g.aoff2 * 2 : 0); const char* cB = (const char*)g.Bt + (size_t)cur.pn * tstepB;
    S.a_ready(cur);
    if constexpr (SP2) {
        PG8_STAGE(PG8_SB(0, 0), cB, voffB); PG8_STAGE(PG8_SB(0, 1), cB + hstepB, voffB); PG8_STAGE(PG8_SA(0, 0), cA, voffA); PG8_STAGE(PG8_SA(0, 1), cA + hstepA, voffA);
        if (wr == 1) PG8_BAR;
        PG8_WAIT_V(2); PG8_BAR;
        PG8_STAGE(PG8_SB(1, 0), cB + kstep, voffB); PG8_STAGE(PG8_SA(1, 0), cA + kstep, voffA); PG8_STAGE(PG8_SB(1, 1), cB + hstepB + kstep, voffB);
        PG8_WAIT_V(6); PG8_BAR;
    } else {
        PG8_STAGE(PG8_SB(0, 0), cB, voffB); PG8_STAGE(PG8_SA(0, 0), cA, voffA); PG8_STAGE(PG8_SB(0, 1), cB + hstepB, voffB); PG8_STAGE(PG8_SA(0, 1), cA + hstepA, voffA);
        if (wr == 1) PG8_BAR;
        PG8_WAIT_V(4); PG8_BAR;
        PG8_STAGE(PG8_SB(1, 0), cB + kstep, voffB); PG8_STAGE(PG8_SA(1, 0), cA + kstep, voffA); PG8_STAGE(PG8_SB(1, 1), cB + hstepB + kstep, voffB);
        PG8_WAIT_V(6); PG8_BAR;
    }
    for (;;) {
        const bool has_next = S.next(ui + 1, nxt);
        const char* nA = has_next ? (const char*)g.A + (size_t)nxt.pm * tstepA + (nxt.pn >= g.asplit ? (size_t)g.aoff2 * 2 : 0) : cA; const char* nB = has_next ? (const char*)g.Bt + (size_t)nxt.pn * tstepB : cB;
        for (int t = 0; t < nt; t += 2) {
            const bool last = (t == nt - 2);
            if constexpr (Epi::MIDHOOK) { if (t == (nt >> 1)) E.mid(acc, cur, wr, wc); }
            const char* a1 = cA + (size_t)(t + 1) * kstep;
            const char* a2 = last ? nA : cA + (size_t)(t + 2) * kstep; const char* b2 = last ? nB : cB + (size_t)(t + 2) * kstep;
            const char* a3 = a2 + kstep; const char* b3 = b2 + kstep;
            if (last && has_next) S.a_ready(nxt);
            if constexpr (SP2) {
            PG8_LDB(B0, 0, 0); PG8_LDB(B1, 0, 1); PG8_SCHED; PG8_LDA(At, 0, 0); PG8_STAGE(PG8_SA(1, 1), a1 + hstepA, voffA);
            PG8_WAIT_V(8); PG8_WAIT_L(0); PG8_BAR; PG8_MMA(0, 0, At, B0); PG8_MMA(0, 1, At, B1); PG8_BAR; PG8_SCHED;
            PG8_LDA(At, 0, 1); PG8_STAGE(PG8_SB(0, 0), b2, voffB); PG8_STAGE(PG8_SB(0, 1), b2 + hstepB, voffB); PG8_STAGE(PG8_SA(0, 0), a2, voffA);
            PG8_WAIT_V(8); PG8_WAIT_L(0); PG8_BAR; PG8_MMA(1, 0, At, B0); PG8_MMA(1, 1, At, B1); PG8_BAR; PG8_SCHED;
            PG8_LDB(B0, 1, 0); PG8_LDB(B1, 1, 1); PG8_SCHED; PG8_LDA(At, 1, 0); PG8_STAGE(PG8_SA(0, 1), a2 + hstepA, voffA);
            PG8_WAIT_V(8); PG8_WAIT_L(0); PG8_BAR; PG8_MMA(0, 0, At, B0); PG8_MMA(0, 1, At, B1); PG8_BAR; PG8_SCHED;
            PG8_LDA(At, 1, 1); PG8_STAGE(PG8_SB(1, 0), b3, voffB); PG8_STAGE(PG8_SB(1, 1), b3 + hstepB, voffB); PG8_STAGE(PG8_SA(1, 0), a3, voffA);
            PG8_WAIT_V(8); PG8_WAIT_L(0); PG8_BAR; PG8_MMA(1, 0, At, B0); PG8_MMA(1, 1, At, B1); PG8_BAR; PG8_SCHED;
            } else {
            PG8_LDB(B0, 0, 0); PG8_SCHED; PG8_LDA(At, 0, 0); PG8_STAGE(PG8_SA(1, 1), a1 + hstepA, voffA);
            PG8_WAIT_L(8); PG8_BAR; PG8_WAIT_L(0); PG8_MMA(0, 0, At, B0); PG8_BAR; PG8_SCHED;
            PG8_LDB(B1, 0, 1); PG8_STAGE(PG8_SB(0, 0), b2, voffB);
            PG8_BAR; PG8_WAIT_L(0); PG8_MMA(0, 1, At, B1); PG8_BAR;
            PG8_LDA(At, 0, 1); PG8_STAGE(PG8_SA(0, 0), a2, voffA);
            PG8_BAR; PG8_WAIT_L(0); PG8_MMA(1, 0, At, B0); PG8_BAR; PG8_SCHED;
            PG8_STAGE(PG8_SB(0, 1), b2 + hstepB, voffB);
            PG8_WAIT_V(6); PG8_BAR; PG8_MMA(1, 1, At, B1); PG8_BAR;
            PG8_LDB(B0, 1, 0); PG8_SCHED; PG8_LDA(At, 1, 0); PG8_STAGE(PG8_SA(0, 1), a2 + hstepA, voffA);
            PG8_WAIT_L(8); PG8_BAR; PG8_WAIT_L(0); PG8_MMA(0, 0, At, B0); PG8_BAR; PG8_SCHED;
            PG8_LDB(B1, 1, 1); PG8_STAGE(PG8_SB(1, 0), b3, voffB);
            PG8_BAR; PG8_WAIT_L(0); PG8_MMA(0, 1, At, B1); PG8_BAR;
            PG8_LDA(At, 1, 1); PG8_STAGE(PG8_SA(1, 0), a3, voffA);
            PG8_BAR; PG8_WAIT_L(0); PG8_MMA(1, 0, At, B0); PG8_BAR; PG8_SCHED;
            PG8_STAGE(PG8_SB(1, 1), b3 + hstepB, voffB);
            PG8_WAIT_V(6); PG8_BAR; PG8_MMA(1, 1, At, B1); PG8_BAR;
            }
        }
        if constexpr (ALIGN_EPI) { if (wr == 0) PG8_BAR; }
        if constexpr (!Epi::AFTER_DRAIN) { E(acc, cur, wr, wc, fr, fq); S.done(cur); }
        if (!has_next) break;
#pragma unroll
        for (int a = 0; a < 2; ++a)
#pragma unroll
            for (int b = 0; b < 2; ++b)
#pragma unroll
                for (int m = 0; m < 4; ++m)
#pragma unroll
                    for (int n = 0; n < 2; ++n) acc[a][b][m][n] = (f32x4){0.f, 0.f, 0.f, 0.f};
        cur = nxt; cA = nA; cB = nB; ++ui;
        if constexpr (ALIGN_EPI) { if (wr == 1) PG8_BAR; }
    }
    PG8_WAIT_V(0);
    if constexpr (!ALIGN_EPI) { if (wr == 0) PG8_BAR; }
    PG8_BAR;
    if constexpr (Epi::AFTER_DRAIN) { E.fused(acc, cur, wr, wc, fr, fq, lds, wid, lane); S.done(cur); }
#undef PG8_SA
#undef PG8_SB
#undef PG8_STAGE
#undef PG8_LDA
#undef PG8_LDB
#undef PG8_MMA
#undef PG8_WAIT_V
#undef PG8_WAIT_L
#undef PG8_BAR
#undef PG8_SCHED
}
}

constexpr int NB = 16, SEQ = 4096, DM = 1024, DEPTH = 4, NTOK = NB * SEQ, NH = 8, FFH = 2816, NIN = 4096, INC = 4000;
constexpr int NWAVES = 8, NTHR = 512;
constexpr int LDS_BYTES = 147456, RING_BYTES = 131072;
constexpr size_t MiB = 1u << 20;
constexpr size_t WS_H = 0;
constexpr size_t WS_PA = 128 * MiB;
constexpr size_t WS_DIL = 192 * MiB;
constexpr size_t WS_GATES = 384 * MiB;
constexpr size_t WS_HID = 128 * MiB;
constexpr size_t WS_KVRAW = 640 * MiB;
constexpr size_t WS_K = 768 * MiB;
constexpr size_t WS_V = 864 * MiB;
constexpr size_t WS_W = 928 * MiB, WS_WSTRIDE = 30 * MiB;
constexpr size_t W_IN = 0, W_Q = W_IN + (size_t)NIN * 1024 * 2, W_KV = W_Q + 768 * 256 * 2, W_A = W_KV + 1024 * 256 * 2, W_B = W_A + 1024 * 512 * 2,
                 W_O = W_B + 1024 * 512 * 2, W_1 = W_O + 1024 * 1024 * 2, W_2 = W_1 + (size_t)5632 * 1024 * 2, W_END = W_2 + (size_t)1024 * 2816 * 2;
constexpr size_t WS_MOD = 988 * MiB;
constexpr size_t WS_ROPE = 990 * MiB;
constexpr size_t WS_SSQ = 998 * MiB;
constexpr size_t WS_LSE = 999 * MiB;
constexpr size_t WS_BT = 1001 * MiB;
constexpr size_t WS_SSQKR = 1001 * MiB + 65536;
constexpr size_t WS_BW1 = 1002 * MiB;
constexpr size_t WS_BW2 = 1003 * MiB;
constexpr size_t WS_CTL = 1005 * MiB, CTL_BYTES = 65536;
constexpr size_t WS_END = 1006 * MiB;
static_assert(W_END <= WS_WSTRIDE && WS_W + 2 * WS_WSTRIDE <= WS_MOD, "weights fit");
static_assert(pg8::EpiRowScale2::O_Q == WS_H && pg8::EpiRowScale2::O_PA == WS_PA && pg8::EpiRowScale2::O_K == WS_K && pg8::EpiRowScale2::O_V == WS_V && pg8::EpiRowScale2::O_ROPE == WS_ROPE && pg8::EpiRowScale2::O_SSQ == WS_SSQ && pg8::EpiRowScale2::O_SSQKR == WS_SSQKR, "EpiRowScale2 offsets");
static_assert(WS_HID + (size_t)NTOK * FFH * 2 <= WS_KVRAW, "hid overlay");

#define LAS __attribute__((address_space(3)))
typedef unsigned short bf16_t;
typedef short bf16x8 __attribute__((ext_vector_type(8)));
typedef short s16x4 __attribute__((ext_vector_type(4)));
typedef float f32x4 __attribute__((ext_vector_type(4)));
typedef float f32x16 __attribute__((ext_vector_type(16)));
typedef unsigned u32x4 __attribute__((ext_vector_type(4)));
typedef unsigned u32x2 __attribute__((ext_vector_type(2)));
using pg8::cvt_pk_bf16; using pg8::bf_lo; using pg8::bf_hi;

struct Params {
    const float *x, *c; const int* pos; const float *rel_bias, *norm1_g, *norm2_g, *ada_w, *ada_b, *w_in, *q_a_norm, *w_q_b, *kv_a_norm, *w_kv_b, *q_norm_a, *k_norm_a, *q_norm_b, *k_norm_b,
        *w_branch_a, *w_branch_b, *w_out, *w_ffn_gate, *w_ffn_up, *w_ffn_down;
    float* out; unsigned char* ws;
    float inv_freq[16];
    int ph_lo, ph_hi;
};

__device__ __forceinline__ float wave_sum(float v) {
#pragma unroll
    for (int o = 1; o < 64; o <<= 1) v += __shfl_xor(v, o);
    return v;
}
#define LDS_WAIT() asm volatile("s_waitcnt lgkmcnt(0)" ::: "memory")

__device__ __forceinline__ void phase0(const Params& P, LAS unsigned char* lds, int G) {
    const int tid = otid(), lane = tid & 63, wid = __builtin_amdgcn_readfirstlane(tid >> 6);
    float* MOD = (float*)(P.ws + WS_MOD); float* ROPE = (float*)(P.ws + WS_ROPE); float* BT = (float*)(P.ws + WS_BT);
    const int gtid = obid() * NTHR + tid, nthr = G * NTHR;
    for (int idx = gtid; idx < NTOK * 16; idx += nthr) { const int t = idx >> 4, i = idx & 15;
        const float ang = (float)P.pos[t] * P.inv_freq[i];
        double rev = (double)ang * 0.15915494309189535; rev -= __builtin_rint(rev); const float f = (float)rev;
        ROPE[t * 32 + i] = __builtin_amdgcn_cosf(f); ROPE[t * 32 + 16 + i] = __builtin_amdgcn_sinf(f); }
    for (int idx = gtid; idx < 3 * 8 * 129; idx += nthr) { const int j = idx % 129, h = (idx / 129) & 7, p = idx / (129 * 8);
        const int dil = p == 0 ? 1 : (p == 1 ? 4 : 16); const int rp = (j - 64) * dil; const int n = rp < 0 ? -rp : rp; int bk = rp > 0 ? 16 : 0;
        if (n < 8) bk += n; else { const float nf = (float)n; int lg = 8 + (int)(__logf(nf * 0.125f) / 4.852030263919617f * 8.0f); bk += lg < 15 ? lg : 15; }
        BT[idx] = P.rel_bias[bk * 8 + h] * pg8::LOG2E; }
    LAS float* sC = (LAS float*)lds;
    LAS float* red = (LAS float*)(lds + 65536);
    for (int i = tid; i < 16 * 1024; i += NTHR) { const float v = P.c[i]; sC[i] = v / (1.0f + __expf(-v)); }
    __syncthreads();
    for (int it = obid(); it < 4 * 96; it += G) { const int l = it / 96, cb = it % 96; const int col = cb * 64 + lane;
        float a[16];
#pragma unroll
        for (int b = 0; b < 16; ++b) a[b] = 0.f;
        const float* wp = P.ada_w + ((size_t)l * 1024 + wid * 128) * 6144 + col;
#pragma unroll 16
        for (int k = 0; k < 128; ++k) { const float w = wp[(size_t)k * 6144];
#pragma unroll
            for (int b = 0; b < 16; ++b) a[b] += sC[b * 1024 + wid * 128 + k] * w; }
#pragma unroll
        for (int b = 0; b < 16; ++b) red[(wid * 16 + b) * 64 + lane] = a[b];
        __syncthreads();
        for (int o = tid; o < 1024; o += NTHR) { const int b = o >> 6, ln = o & 63; float s = 0.f;
#pragma unroll
            for (int w = 0; w < 8; ++w) s += red[(w * 16 + b) * 64 + ln];
            MOD[((size_t)l * 16 + b) * 6144 + cb * 64 + ln] = s + P.ada_b[l * 6144 + cb * 64 + ln]; }
        __syncthreads();
    }
}

__device__ __forceinline__ void tr_item(const float* W, int Nsrc, int k0, int j0, const float* kscale, bf16_t* WT, int Kdst, int R0, LAS float* scr, int lane) {
    if (j0 >= 0) {
#pragma unroll 8
        for (int i = 0; i < 32; ++i) { const int kk = 2 * i + (lane >> 5); float v = W[(size_t)(k0 + kk) * Nsrc + j0 + (lane & 31)]; if (kscale) v *= kscale[k0 + kk]; scr[kk * 33 + (lane & 31)] = v; }
    } else {
#pragma unroll 8
        for (int i = 0; i < 32; ++i) { const int kk = 2 * i + (lane >> 5); scr[kk * 33 + (lane & 31)] = 0.f; }
    }
    LDS_WAIT();
    const int c = lane & 7;
#pragma unroll
    for (int j = 0; j < 4; ++j) { const int n = (lane >> 3) + 8 * j; const LAS float* s = scr + (8 * c) * 33 + n;
        u32x4 o; o.x = cvt_pk_bf16(s[0 * 33], s[1 * 33]); o.y = cvt_pk_bf16(s[2 * 33], s[3 * 33]); o.z = cvt_pk_bf16(s[4 * 33], s[5 * 33]); o.w = cvt_pk_bf16(s[6 * 33], s[7 * 33]);
        *(u32x4*)(WT + (size_t)(R0 + n) * Kdst + k0 + 8 * c) = o; }
    LDS_WAIT();
}
__device__ __forceinline__ int win_src_col(int R0) {
    const int pn = R0 >> 8, rho = R0 & 255;
    if (pn == 0) return rho;
    if (pn == 1) return rho < 160 ? 256 + rho : -1;
    if (pn < 6) { const int wc = (rho >> 5) & 3, dd = 32 * (rho >> 7); const int sec = (pn - 2) >> 1, head = 4 * ((pn - 2) & 1) + wc; return 416 + sec * 512 + head * 64 + dd; }
    if (pn < 8) return 416 + 1024 + (R0 - 1536);
    return 1952 + (R0 - 2048);
}
__device__ __forceinline__ void conv_weights(const Params& P, int l, unsigned char* wb, LAS unsigned char* lds, int G) {
    const int tid = otid(), lane = tid & 63, wid = __builtin_amdgcn_readfirstlane(tid >> 6);
    LAS float* scr = (LAS float*)(lds + wid * 16384);
    constexpr int I_IN = 16 * 128, I_Q = 4 * 24, I_KV = 4 * 32, I_A = 8 * 32, I_B = 8 * 32, I_O = 16 * 32, I_1 = 16 * 176, I_2 = 44 * 32;
    constexpr int NIT = I_IN + I_Q + I_KV + I_A + I_B + I_O + I_1 + I_2;
    for (int it = obid() * NWAVES + wid; it < NIT; it += G * NWAVES) {
        int r = it;
        if (r < I_IN) { const int kb = r / 128, rb = r % 128; tr_item(P.w_in + (size_t)l * 1024 * INC, INC, kb * 64, win_src_col(rb * 32), nullptr, (bf16_t*)(wb + W_IN), 1024, rb * 32, scr, lane); continue; } r -= I_IN;
        if (r < I_Q) { const int kb = r / 24, rb = r % 24; tr_item(P.w_q_b + (size_t)l * 256 * 768, 768, kb * 64, rb * 32, P.q_a_norm + l * 256, (bf16_t*)(wb + W_Q), 256, rb * 32, scr, lane); continue; } r -= I_Q;
        if (r < I_KV) { const int kb = r / 32, rb = r % 32; const int R0 = rb * 32, pnl = R0 >> 8, rho = R0 & 255, wcq = (rho >> 5) & 3;
            const int jsrc = (pnl * 2 + (wcq & 1)) * 128 + (wcq >= 2 ? 64 : 0) + 32 * (rho >> 7);
            tr_item(P.w_kv_b + (size_t)l * 128 * 1024, 1024, kb * 64, kb < 2 ? jsrc : -1, P.kv_a_norm + l * 128, (bf16_t*)(wb + W_KV), 256, R0, scr, lane); continue; } r -= I_KV;
        if (r < I_A) { const int kb = r / 32, rb = r % 32; tr_item(P.w_branch_a + (size_t)l * 512 * 1024, 1024, kb * 64, rb * 32, nullptr, (bf16_t*)(wb + W_A), 1024, rb * 32, scr, lane); continue; } r -= I_A;
        if (r < I_B) { const int kb = r / 32, rb = r % 32; tr_item(P.w_branch_b + (size_t)l * 512 * 1024, 1024, kb * 64, rb * 32, nullptr, (bf16_t*)(wb + W_A) + 512, 1024, rb * 32, scr, lane); continue; } r -= I_B;
        if (r < I_O) { const int kb = r / 32, rb = r % 32; tr_item(P.w_out + (size_t)l * 1024 * 1024, 1024, kb * 64, rb * 32, nullptr, (bf16_t*)(wb + W_O), 1024, rb * 32, scr, lane); continue; } r -= I_O;
        if (r < I_1) { const int kb = r / 176, rb = r % 176; const int R0 = rb * 32, pn = R0 >> 8, rho = R0 & 255;
            const float* src = (rho < 128 ? P.w_ffn_gate : P.w_ffn_up) + (size_t)l * 1024 * FFH;
            tr_item(src, FFH, kb * 64, pn * 128 + (rho & 127), nullptr, (bf16_t*)(wb + W_1), 1024, R0, scr, lane); continue; } r -= I_1;
        { const int kb = r / 32, rb = r % 32; tr_item(P.w_ffn_down + (size_t)l * FFH * 1024, 1024, kb * 64, rb * 32, nullptr, (bf16_t*)(wb + W_2), FFH, rb * 32, scr, lane); }
    }
}

__device__ __forceinline__ void norm_phase(const float* xin, const float* g, const float* mod  , int sh_off, int sc_off, bf16_t* H, int G) {
    const int tid = otid(), lane = tid & 63, wid = __builtin_amdgcn_readfirstlane(tid >> 6);
    for (int m = obid() * NWAVES + wid; m < NTOK; m += G * NWAVES) {
        const f32x4* xr = (const f32x4*)(xin + (size_t)m * DM) + lane; f32x4 v[4]; float s = 0.f;
#pragma unroll
        for (int j = 0; j < 4; ++j) { v[j] = xr[64 * j]; s += (v[j][0] * v[j][0] + v[j][1] * v[j][1]) + (v[j][2] * v[j][2] + v[j][3] * v[j][3]); }
        const float r = __builtin_amdgcn_rsqf(wave_sum(s) * (1.0f / DM) + pg8::RMS_EPS);
        const float* mb = mod + (size_t)(m >> 12) * 6144;
#pragma unroll
        for (int j = 0; j < 4; ++j) { const int col = 4 * lane + 256 * j;
            const f32x4 gv = *(const f32x4*)(g + col), sc = *(const f32x4*)(mb + sc_off + col), sh = *(const f32x4*)(mb + sh_off + col);
            const f32x4 o = (v[j] * r) * gv * (1.0f + sc) + sh;
            u32x2 w; w.x = cvt_pk_bf16(o[0], o[1]); w.y = cvt_pk_bf16(o[2], o[3]);
            *(u32x2*)(H + (size_t)m * DM + col) = w; }
    }
}

__device__ __forceinline__ void prepass_phase(const float* xin, const float* g, const float* mod  , int sc_off, bf16_t* XG, float* ssq, int G) {
    const int tid = otid(), lane = tid & 63, wid = __builtin_amdgcn_readfirstlane(tid >> 6);
    for (int m = obid() * NWAVES + wid; m < NTOK; m += G * NWAVES) {
        const f32x4* xr = (const f32x4*)(xin + (size_t)m * DM) + lane; float s = 0.f;
        const float* mb = mod + (size_t)(m >> 12) * 6144;
#pragma unroll
        for (int j = 0; j < 4; ++j) { const f32x4 v = xr[64 * j]; s += (v[0] * v[0] + v[1] * v[1]) + (v[2] * v[2] + v[3] * v[3]); const int col = 4 * lane + 256 * j;
            const f32x4 o = v * *(const f32x4*)(g + col) * (1.0f + *(const f32x4*)(mb + sc_off + col));
            u32x2 w; w.x = cvt_pk_bf16(o[0], o[1]); w.y = cvt_pk_bf16(o[2], o[3]);
            *(u32x2*)(XG + (size_t)m * DM + col) = w; }
        s = wave_sum(s);
        if (lane == 0) ssq[m] = s;
    }
}
__device__ __forceinline__ void bias_phase(const Params& P, LAS unsigned char* lds, int G) {
    const int tid = otid(), lane = tid & 63, wid = __builtin_amdgcn_readfirstlane(tid >> 6);
    const float* MOD = (const float*)(P.ws + WS_MOD); float* BW1 = (float*)(P.ws + WS_BW1); float* BW2 = (float*)(P.ws + WS_BW2);
    LAS float* sC = (LAS float*)lds;
    LAS float* red = (LAS float*)(lds + 65536);
    for (int it = obid(); it < 4 * 152; it += G) { const int l = it / 152, blk = it % 152; const bool ffn = blk >= 64; const int R0 = (ffn ? blk - 64 : blk) * 64;
        __syncthreads();
        for (int i = tid; i < 16 * 1024; i += NTHR) sC[i] = MOD[((size_t)l * 16 + (i >> 10)) * 6144 + (ffn ? 3072 : 0) + (i & 1023)];
        __syncthreads();
        const int R = R0 + lane; const float* wsrc; int j; size_t ncol;
        if (!ffn) { const int jb = win_src_col(R & ~31); j = jb < 0 ? -1 : jb + (R & 31); wsrc = P.w_in + (size_t)l * 1024 * INC; ncol = INC; }
        else { const int pn = R >> 8, rho = R & 255; j = pn * 128 + (rho & 127); wsrc = (rho < 128 ? P.w_ffn_gate : P.w_ffn_up) + (size_t)l * 1024 * FFH; ncol = FFH; }
        float a[16];
#pragma unroll
        for (int b = 0; b < 16; ++b) a[b] = 0.f;
        if (j >= 0) { const float* wp = wsrc + (size_t)(wid * 128) * ncol + j;
#pragma unroll 16
            for (int k = 0; k < 128; ++k) { const float w = wp[(size_t)k * ncol];
#pragma unroll
                for (int b = 0; b < 16; ++b) a[b] += sC[b * 1024 + wid * 128 + k] * w; } }
#pragma unroll
        for (int b = 0; b < 16; ++b) red[(wid * 16 + b) * 64 + lane] = a[b];
        __syncthreads();
        for (int o = tid; o < 1024; o += NTHR) { const int b = o >> 6, ln = o & 63; float s = 0.f;
#pragma unroll
            for (int w = 0; w < 8; ++w) s += red[(w * 16 + b) * 64 + ln];
            if (!ffn) BW1[((size_t)l * 16 + b) * 4096 + R0 + ln] = s; else BW2[((size_t)l * 16 + b) * 5632 + R0 + ln] = s; }
    }
    __syncthreads();
}

__device__ __forceinline__ void unpack8(const u32x4 w, float* f) { f[0] = bf_lo(w.x); f[1] = bf_hi(w.x); f[2] = bf_lo(w.y); f[3] = bf_hi(w.y); f[4] = bf_lo(w.z); f[5] = bf_hi(w.z); f[6] = bf_lo(w.w); f[7] = bf_hi(w.w); }
__device__ __forceinline__ u32x4 pack8(const float* f) { u32x4 w; w.x = cvt_pk_bf16(f[0], f[1]); w.y = cvt_pk_bf16(f[2], f[3]); w.z = cvt_pk_bf16(f[4], f[5]); w.w = cvt_pk_bf16(f[6], f[7]); return w; }
__device__ __forceinline__ float ssq8(const u32x4 w) { float f[8]; unpack8(w, f); return ((f[0] * f[0] + f[1] * f[1]) + (f[2] * f[2] + f[3] * f[3])) + ((f[4] * f[4] + f[5] * f[5]) + (f[6] * f[6] + f[7] * f[7])); }
__device__ __forceinline__ void head_norm_rope(const bf16_t* src_nope, const bf16_t* src_rope, bf16_t* dst, const float* gain, const float* rope, float oscale) {
    float s = 0.f;
#pragma unroll
    for (int c = 0; c < 8; ++c) s += ssq8(*(const u32x4*)(src_nope + 8 * c));
#pragma unroll
    for (int c = 0; c < 4; ++c) s += ssq8(*(const u32x4*)(src_rope + 8 * c));
    const float r = __builtin_amdgcn_rsqf(s * (1.0f / 96.0f) + pg8::RMS_EPS);
    asm volatile("" ::: "memory");
#pragma unroll
    for (int c = 0; c < 8; ++c) { float f[8]; unpack8(*(const u32x4*)(src_nope + 8 * c), f);
#pragma unroll
        for (int i = 0; i < 8; ++i) f[i] = f[i] * r * gain[8 * c + i] * oscale;
        *(u32x4*)(dst + 8 * c) = pack8(f); asm volatile("" ::: "memory"); }
    float x[32];
#pragma unroll
    for (int c = 0; c < 4; ++c) unpack8(*(const u32x4*)(src_rope + 8 * c), x + 8 * c);
#pragma unroll
    for (int i = 0; i < 32; ++i) x[i] = x[i] * r * gain[64 + i];
#pragma unroll
    for (int i = 0; i < 16; ++i) { const float cs = rope[i], sn = rope[16 + i]; const float x1 = x[i], x2 = x[16 + i]; x[i] = (x1 * cs - x2 * sn) * oscale; x[16 + i] = (x2 * cs + x1 * sn) * oscale; }
#pragma unroll
    for (int c = 0; c < 4; ++c) *(u32x4*)(dst + 64 + 8 * c) = pack8(x + 8 * c);
    asm volatile("" ::: "memory");
}
__device__ __forceinline__ void prep_phase(const Params& P, int l, int G) {
    const bf16_t* KVRAW = (const bf16_t*)(P.ws + WS_KVRAW); const bf16_t* PA = (const bf16_t*)(P.ws + WS_PA);
    bf16_t* K = (bf16_t*)(P.ws + WS_K); const float* ROPE = (const float*)(P.ws + WS_ROPE);
    const float* kg = P.k_norm_a + l * 96;
    for (int idx = obid() * NTHR + otid(); idx < NTOK * NH; idx += G * NTHR) { const int t = idx >> 3, h = idx & 7;
        const float* rp = ROPE + (size_t)t * 32;
        const bf16_t* kp = KVRAW + (size_t)t * 1024 + h * 128;
        const size_t hrow = ((size_t)((t >> 12) * 8 + h) << 12) + (t & 4095);
        head_norm_rope(kp, PA + (size_t)t * 512 + 384, K + hrow * 96, kg, rp, 1.0f);
    }
}
typedef short v4i16_t __attribute__((ext_vector_type(4)));
__device__ __forceinline__ s16x4 vtr(const LAS unsigned char* p) { return __builtin_bit_cast(s16x4, __builtin_amdgcn_ds_read_tr16_b64_v4i16((LAS v4i16_t*)p)); }
__device__ __forceinline__ bf16x8 cat8(s16x4 a, s16x4 b) { return (bf16x8){a[0], a[1], a[2], a[3], b[0], b[1], b[2], b[3]}; }
__device__ __forceinline__ bf16x8 packp(const f32x16& p, int o) {
    u32x4 w; w.x = cvt_pk_bf16(p[o + 0], p[o + 1]); w.y = cvt_pk_bf16(p[o + 2], p[o + 3]); w.z = cvt_pk_bf16(p[o + 4], p[o + 5]); w.w = cvt_pk_bf16(p[o + 6], p[o + 7]);
    return __builtin_bit_cast(bf16x8, w);
}
__device__ __forceinline__ float max16(const f32x16& p) {
    float a = fmaxf(fmaxf(p[0], p[1]), fmaxf(p[2], p[3])), b = fmaxf(fmaxf(p[4], p[5]), fmaxf(p[6], p[7]));
    float c = fmaxf(fmaxf(p[8], p[9]), fmaxf(p[10], p[11])), d = fmaxf(fmaxf(p[12], p[13]), fmaxf(p[14], p[15]));
    return fmaxf(fmaxf(a, b), fmaxf(c, d));
}
#define MFMA32(a, b, c) __builtin_amdgcn_mfma_f32_32x32x16_bf16((a), (b), (c), 0, 0, 0)
constexpr int KP = 208, VP = 192;
constexpr int KT_B = 64 * KP, VT_B = 64 * VP;
constexpr int MLA_K0 = 0, MLA_V0 = 2 * KT_B;

constexpr float MLA_THR = 8.0f;
__device__ __forceinline__ float max3f(float a, float b, float c) { float r; asm("v_max3_f32 %0, %1, %2, %3" : "=v"(r) : "v"(a), "v"(b), "v"(c)); return r; }
__device__ __forceinline__ float rowmax32(const f32x16& a, const f32x16& b) {
    float x = max3f(a[0], a[1], a[2]), y = max3f(b[0], b[1], b[2]);
    x = max3f(x, a[3], a[4]); y = max3f(y, b[3], b[4]); x = max3f(x, a[5], a[6]); y = max3f(y, b[5], b[6]); x = max3f(x, a[7], a[8]); y = max3f(y, b[7], b[8]);
    x = max3f(x, a[9], a[10]); y = max3f(y, b[9], b[10]); x = max3f(x, a[11], a[12]); y = max3f(y, b[11], b[12]); x = max3f(x, a[13], a[14]); y = max3f(y, b[13], b[14]);
    x = max3f(x, a[15], b[15]); x = max3f(x, y, y);
    return max3f(x, __shfl_xor(x, 32), x);
}
#define SBAR0() __builtin_amdgcn_sched_barrier(0)
__device__ __forceinline__ void mla_unit(LAS unsigned char* lds, const bf16_t* Q, const bf16_t* K, const bf16_t* V, bf16_t* Y, const float* qgain, const float* ROPE, int b, int h, int qb) {
    const int tid = otid(), lane = tid & 63, wid = __builtin_amdgcn_readfirstlane(tid >> 6), r32 = lane & 31, hi = lane >> 5;
    const size_t tok0 = (size_t)b * SEQ; const size_t qrow = tok0 + qb * 256 + wid * 32 + r32;
    const int kr0 = tid / 12, kc0 = tid % 12, kr1 = (512 + tid) / 12, kc1 = (512 + tid) % 12, vr = tid >> 3, vc = tid & 7;
    const size_t hrow0 = (size_t)(b * 8 + h) * SEQ;
    const bf16_t* kg0 = K + (hrow0 + kr0) * 96 + kc0 * 8; const bf16_t* kg1 = K + (hrow0 + kr1) * 96 + kc1 * 8;
    const bf16_t* vg = V + (hrow0 + vr) * 64 + vc * 8;
    const int kl0 = kr0 * KP + kc0 * 16, kl1 = kr1 * KP + kc1 * 16, vl = vr * VP + vc * 16;
    const bool has1 = tid < 256;
    u32x4 ka0, kb0, ka1, kb1, vv0, vv1;
    ka0 = *(const u32x4*)kg0; if (has1) kb0 = *(const u32x4*)kg1; vv0 = *(const u32x4*)vg;
    ka1 = *(const u32x4*)(kg0 + (size_t)64 * 96); if (has1) kb1 = *(const u32x4*)(kg1 + (size_t)64 * 96);
    bf16x8 qf[6];
    {
        const bf16_t* qp = Q + qrow * 768 + h * 96 + hi * 8; float f[6][8]; float s = 0.f;
#pragma unroll
        for (int d0 = 0; d0 < 6; ++d0) { unpack8(*(const u32x4*)(qp + d0 * 16), f[d0]);
#pragma unroll
            for (int i = 0; i < 8; ++i) s += f[d0][i] * f[d0][i]; }
        s += __shfl_xor(s, 32);
        const float r = __builtin_amdgcn_rsqf(s * (1.0f / 96.0f) + pg8::RMS_EPS);
#pragma unroll
        for (int d0 = 0; d0 < 6; ++d0)
#pragma unroll
            for (int i = 0; i < 8; ++i) f[d0][i] = f[d0][i] * r * qgain[d0 * 16 + hi * 8 + i];
        const float* rp = ROPE + qrow * 32 + hi * 8;
#pragma unroll
        for (int i = 0; i < 8; ++i) { const float cs = rp[i], sn = rp[16 + i]; const float x1 = f[4][i], x2 = f[5][i]; f[4][i] = x1 * cs - x2 * sn; f[5][i] = x2 * cs + x1 * sn; }
#pragma unroll
        for (int d0 = 0; d0 < 6; ++d0) {
#pragma unroll
            for (int i = 0; i < 8; ++i) f[d0][i] *= pg8::QSCALE_A;
            qf[d0] = __builtin_bit_cast(bf16x8, pack8(f[d0])); }
    }
    *(LAS u32x4*)(lds + MLA_K0 + kl0) = ka0; if (has1) *(LAS u32x4*)(lds + MLA_K0 + kl1) = kb0; *(LAS u32x4*)(lds + MLA_V0 + vl) = vv0;
    *(LAS u32x4*)(lds + MLA_K0 + KT_B + kl0) = ka1; if (has1) *(LAS u32x4*)(lds + MLA_K0 + KT_B + kl1) = kb1;
    ka0 = *(const u32x4*)(kg0 + (size_t)128 * 96); if (has1) kb0 = *(const u32x4*)(kg1 + (size_t)128 * 96); vv1 = *(const u32x4*)(vg + (size_t)64 * 64);
    __syncthreads();
    f32x16 o0, o1, negm;
#pragma unroll
    for (int i = 0; i < 16; ++i) { o0[i] = 0.f; o1[i] = 0.f; negm[i] = 0.f; }
    const int koff = r32 * KP + hi * 16;
    const int voff = (4 * hi + ((lane & 15) >> 2)) * VP + (16 * ((lane >> 4) & 1) + 4 * (lane & 3)) * 2;
    f32x16 p0, p1, n0, n1;
    { const LAS unsigned char* kb_ = lds + MLA_K0 + koff; p0 = negm; p1 = negm;
#pragma unroll
      for (int d0 = 0; d0 < 6; ++d0) { const bf16x8 a0 = *(const LAS bf16x8*)(kb_ + d0 * 32), a1 = *(const LAS bf16x8*)(kb_ + 32 * KP + d0 * 32); p0 = MFMA32(a0, qf[d0], p0); p1 = MFMA32(a1, qf[d0], p1); } }
    float m_ref, l_run = 0.f;
    { const float mx = rowmax32(p0, p1); m_ref = mx;
#pragma unroll
      for (int i = 0; i < 16; ++i) { p0[i] -= mx; p1[i] -= mx; negm[i] = -mx; } }
#define MLA_STEP(C0, C1, X0, X1, T, KAI, KBI, VVI, KAW, KBW, VVW) do { const int t_ = (T); const int cur = t_ & 1; \
        if (t_ + 3 < 64) { const size_t go = (size_t)(t_ + 3) * 64; KAI = *(const u32x4*)(kg0 + go * 96); if (has1) KBI = *(const u32x4*)(kg1 + go * 96); } \
        if (t_ + 2 < 64) { const size_t go = (size_t)(t_ + 2) * 64; VVI = *(const u32x4*)(vg + go * 64); } \
        bf16x8 kfr[12]; { const LAS unsigned char* kn = lds + MLA_K0 + (cur ^ 1) * KT_B + koff; \
            _Pragma("unroll") for (int d0 = 0; d0 < 6; ++d0) { kfr[2 * d0] = *(const LAS bf16x8*)(kn + d0 * 32); kfr[2 * d0 + 1] = *(const LAS bf16x8*)(kn + 32 * KP + d0 * 32); } } \
        SBAR0(); \
        const float mx = rowmax32(C0, C1); \
        if (__builtin_amdgcn_ballot_w64(mx > MLA_THR) != 0ull) { const float d = fmaxf(mx, 0.f); const float sc = __builtin_amdgcn_exp2f(-d); m_ref += d; l_run *= sc; \
            _Pragma("unroll") for (int i = 0; i < 16; ++i) { C0[i] -= d; C1[i] -= d; o0[i] *= sc; o1[i] *= sc; negm[i] = -m_ref; } } \
        SBAR0(); \
        X0 = negm; X1 = negm; \
        _Pragma("unroll") for (int d0 = 0; d0 < 6; ++d0) { X0 = MFMA32(kfr[2 * d0], qf[d0], X0); X1 = MFMA32(kfr[2 * d0 + 1], qf[d0], X1); } \
        SBAR0(); \
        float ls = 0.f; \
        _Pragma("unroll") for (int i = 0; i < 16; ++i) { C0[i] = __builtin_amdgcn_exp2f(C0[i]); C1[i] = __builtin_amdgcn_exp2f(C1[i]); ls += C0[i] + C1[i]; } \
        l_run += ls; \
        bf16x8 pb[4]; pb[0] = packp(C0, 0); pb[1] = packp(C0, 8); pb[2] = packp(C1, 0); pb[3] = packp(C1, 8); \
        const LAS unsigned char* vb_ = lds + MLA_V0 + cur * VT_B + voff; \
        _Pragma("unroll") for (int j = 0; j < 4; ++j) { const LAS unsigned char* vj = vb_ + 16 * j * VP; \
            const bf16x8 a0 = cat8(vtr(vj), vtr(vj + 8 * VP)); const bf16x8 a1 = cat8(vtr(vj + 64), vtr(vj + 8 * VP + 64)); \
            o0 = MFMA32(a0, pb[j], o0); o1 = MFMA32(a1, pb[j], o1); } \
        if (t_ + 2 < 64) { *(LAS u32x4*)(lds + MLA_K0 + cur * KT_B + kl0) = KAW; if (has1) *(LAS u32x4*)(lds + MLA_K0 + cur * KT_B + kl1) = KBW; } \
        if (t_ + 1 < 64) *(LAS u32x4*)(lds + MLA_V0 + (cur ^ 1) * VT_B + vl) = VVW; \
        __syncthreads(); } while (0)
    if (wid >= 4) __builtin_amdgcn_s_setprio(1);
    for (int t = 0; t < 64; t += 2) { MLA_STEP(p0, p1, n0, n1, t, ka1, kb1, vv0, ka0, kb0, vv1); MLA_STEP(n0, n1, p0, p1, t + 1, ka0, kb0, vv1, ka1, kb1, vv0); }
    __builtin_amdgcn_s_setprio(0);
#undef MLA_STEP
    const float lt = l_run + __shfl_xor(l_run, 32); const float inv = 1.0f / lt;
    bf16_t* ypb = Y + qrow * 1024 + h * 64;
    u32x2 wv[8];
#pragma unroll
    for (int g = 0; g < 4; ++g) {
        wv[g].x = cvt_pk_bf16(o0[4 * g] * inv, o0[4 * g + 1] * inv); wv[g].y = cvt_pk_bf16(o0[4 * g + 2] * inv, o0[4 * g + 3] * inv);
        wv[4 + g].x = cvt_pk_bf16(o1[4 * g] * inv, o1[4 * g + 1] * inv); wv[4 + g].y = cvt_pk_bf16(o1[4 * g + 2] * inv, o1[4 * g + 3] * inv); }
#pragma unroll
    for (int e = 0; e < 8; e += 2) { const u32x2 snd = hi ? wv[e] : wv[e + 1]; u32x2 rcv; rcv.x = __shfl_xor(snd.x, 32); rcv.y = __shfl_xor(snd.y, 32);
        u32x4 o4; if (hi) { o4.x = rcv.x; o4.y = rcv.y; o4.z = wv[e + 1].x; o4.w = wv[e + 1].y; } else { o4.x = wv[e].x; o4.y = wv[e].y; o4.z = rcv.x; o4.w = rcv.y; }
        *(u32x4*)(ypb + 32 * (e >> 2) + 8 * ((e & 3) + hi)) = o4; }
}

constexpr int DW_BYTES = 13440;
template <int DELTA>
__device__ __forceinline__ void dil_block(LAS unsigned char* wl, const bf16_t* kbase  , const bf16_t* vbase, size_t rstride  ,
                                          const bf16x8 (&qf)[2][4], f32x16 (&o)[2][2], float (&m_run)[2], float (&l_run)[2], int bvar, int voff, int lane, int r32, int hi, int btb) {
    u32x4 vv[8]; bf16x8 kf[2][4];
#pragma unroll
    for (int i = 0; i < 8; ++i) { const int idx = lane + 64 * i, row = idx >> 3, ch = idx & 7; vv[i] = *(const u32x4*)(vbase + (size_t)row * rstride + ch * 8); }
#pragma unroll
    for (int kvh = 0; kvh < 2; ++kvh)
#pragma unroll
        for (int d0 = 0; d0 < 4; ++d0) kf[kvh][d0] = *(const bf16x8*)(kbase + (size_t)(32 * kvh + r32) * rstride + d0 * 16);
    SBAR0();
#pragma unroll
    for (int i = 0; i < 8; ++i) { const int idx = lane + 64 * i, row = idx >> 3, ch = idx & 7; *(LAS u32x4*)(wl + row * VP + ch * 16) = vv[i]; }
    bf16x8 pb[2][4];
#pragma unroll
    for (int qh = 0; qh < 2; ++qh) {
        f32x16 s[2]; float mx = -1e30f;
#pragma unroll
        for (int kvh = 0; kvh < 2; ++kvh) {
            constexpr int dummy = 0; (void)dummy;
            const int toff = 64 * DELTA + 32 * (kvh - qh);
            if (toff > 64 || toff < -64) continue;
#pragma unroll
            for (int i = 0; i < 16; ++i) s[kvh][i] = 0.f;
#pragma unroll
            for (int d0 = 0; d0 < 4; ++d0) s[kvh] = MFMA32(kf[kvh][d0], qf[qh][d0], s[kvh]);
#pragma unroll
            for (int rr = 0; rr < 16; ++rr) { const int c4 = 4 * ((rr & 3) + 8 * (rr >> 2)); const float bias = *(const LAS float*)(wl + bvar + (VT_B + c4 + toff * 4));
                float v = s[kvh][rr] + bias;
                if (toff == 64) v = (bvar <= btb - c4) ? v : -1e30f;
                if (toff == -64) v = (bvar >= btb - c4) ? v : -1e30f;
                s[kvh][rr] = v; mx = fmaxf(mx, v); }
        }
        mx = fmaxf(mx, __shfl_xor(mx, 32));
        const float m_new = fmaxf(m_run[qh], mx); const float alpha = __builtin_amdgcn_exp2f(m_run[qh] - m_new); m_run[qh] = m_new;
        float ls = 0.f;
#pragma unroll
        for (int kvh = 0; kvh < 2; ++kvh) { const int toff = 64 * DELTA + 32 * (kvh - qh);
            if (toff > 64 || toff < -64) continue;
#pragma unroll
            for (int rr = 0; rr < 16; ++rr) { const float e = __builtin_amdgcn_exp2f(s[kvh][rr] - m_new); s[kvh][rr] = e; ls += e; }
            pb[qh][2 * kvh] = packp(s[kvh], 0); pb[qh][2 * kvh + 1] = packp(s[kvh], 8); }
        l_run[qh] = l_run[qh] * alpha + ls;
#pragma unroll
        for (int i = 0; i < 16; ++i) { o[qh][0][i] *= alpha; o[qh][1][i] *= alpha; }
    }
    LDS_WAIT();
#pragma unroll
    for (int j = 0; j < 4; ++j) { const LAS unsigned char* vj = wl + voff + 16 * j * VP;
        const bf16x8 a0 = cat8(vtr(vj), vtr(vj + 8 * VP)); const bf16x8 a1 = cat8(vtr(vj + 64), vtr(vj + 8 * VP + 64));
#pragma unroll
        for (int qh = 0; qh < 2; ++qh) { const int toff = 64 * DELTA + 32 * ((j >> 1) - qh);
            if (toff > 64 || toff < -64) continue;
            o[qh][0] = MFMA32(a0, pb[qh][j], o[qh][0]); o[qh][1] = MFMA32(a1, pb[qh][j], o[qh][1]); } }
    LDS_WAIT();
}
template <int P_>
__device__ __forceinline__ void dil_wave_unit(LAS unsigned char* wl, const bf16_t* DIL, bf16_t* Y, bf16_t* ST, float* LSE, const float* BT, int b, int h, int r, int nb) {
    constexpr int dil = P_ == 0 ? 1 : (P_ == 1 ? 4 : 16), nblk = 64 / dil; constexpr bool first = P_ == 0, last = P_ == 2;
    const int lane = otid() & 63, r32 = lane & 31, hi = lane >> 5;
    const size_t tok0 = (size_t)b * SEQ; const size_t rstride = (size_t)dil * 64;
    LAS float* bt = (LAS float*)(wl + VT_B);
    for (int i = lane; i < 257; i += 64) { int j = i - 64; j = j < 0 ? 0 : (j > 128 ? 128 : j); bt[i] = BT[(P_ * 8 + h) * 129 + j]; }
    const int btb = 128 * 4;
    const int bvar = btb + 4 * (4 * hi - r32);
    bf16x8 qf[2][4];
    const bf16_t* rowb = DIL + ((size_t)(b * 8 + h) * SEQ + (size_t)(64 * nb) * dil + r) * 64;
    constexpr size_t KOFF = pg8::DPLANE, VOFF = 2 * pg8::DPLANE;
#pragma unroll
    for (int qh = 0; qh < 2; ++qh)
#pragma unroll
        for (int d0 = 0; d0 < 4; ++d0) qf[qh][d0] = *(const bf16x8*)(rowb + (size_t)(32 * qh + r32) * rstride + hi * 8 + d0 * 16);
    f32x16 o[2][2];
#pragma unroll
    for (int a = 0; a < 2; ++a)
#pragma unroll
        for (int c = 0; c < 2; ++c)
#pragma unroll
            for (int i = 0; i < 16; ++i) o[a][c][i] = 0.f;
    float m_run[2] = {-1e30f, -1e30f}, l_run[2] = {0.f, 0.f};
    const int voff = (4 * hi + ((lane & 15) >> 2)) * VP + (16 * ((lane >> 4) & 1) + 4 * (lane & 3)) * 2;
    LDS_WAIT();
    dil_block<0>(wl, rowb + KOFF + hi * 8, rowb + VOFF, rstride, qf, o, m_run, l_run, bvar, voff, lane, r32, hi, btb);
    if (nb > 0) dil_block<-1>(wl, rowb - 64 * rstride + KOFF + hi * 8, rowb - 64 * rstride + VOFF, rstride, qf, o, m_run, l_run, bvar, voff, lane, r32, hi, btb);
    if (nb + 1 < nblk) dil_block<1>(wl, rowb + 64 * rstride + KOFF + hi * 8, rowb + 64 * rstride + VOFF, rstride, qf, o, m_run, l_run, bvar, voff, lane, r32, hi, btb);
    float lp[2]; u32x2 pv[2][8];
    if (!first) {
#pragma unroll
        for (int qh = 0; qh < 2; ++qh) { const size_t srow = (size_t)(b * 8 + h) * SEQ + (size_t)(64 * nb + 32 * qh + r32) * dil + r; lp[qh] = LSE[srow];
            const bf16_t* sp = ST + srow * 64 + 4 * hi;
#pragma unroll
            for (int e = 0; e < 8; ++e) pv[qh][e] = *(const u32x2*)(sp + 32 * (e >> 2) + 8 * (e & 3)); }
    }
#pragma unroll
    for (int qh = 0; qh < 2; ++qh) {
        const size_t spos = (size_t)(64 * nb + 32 * qh + r32) * dil + r; const size_t srow = (size_t)(b * 8 + h) * SEQ + spos;
        const float lt = l_run[qh] + __shfl_xor(l_run[qh], 32); const float inv = 1.0f / lt; const float lse2 = m_run[qh] + __builtin_amdgcn_logf(lt);
        float a_prev = 0.f, a_cur = inv, lse_new = lse2;
        if (!first) { const float M = fmaxf(lp[qh], lse2); const float wp = __builtin_amdgcn_exp2f(lp[qh] - M), wc = __builtin_amdgcn_exp2f(lse2 - M); const float den = wp + wc;
            a_prev = wp / den; a_cur = wc / den * inv; lse_new = M + __builtin_amdgcn_logf(den); }
        bf16_t* ypb = last ? Y + (tok0 + spos) * 1024 + 512 + h * 64 : ST + srow * 64;
        u32x2 wv[8];
#pragma unroll
        for (int e = 0; e < 8; ++e) { const int blk = e >> 2, g = e & 3;
            float v0 = o[qh][blk][4 * g] * a_cur, v1 = o[qh][blk][4 * g + 1] * a_cur, v2 = o[qh][blk][4 * g + 2] * a_cur, v3 = o[qh][blk][4 * g + 3] * a_cur;
            if (!first) { v0 += a_prev * bf_lo(pv[qh][e].x); v1 += a_prev * bf_hi(pv[qh][e].x); v2 += a_prev * bf_lo(pv[qh][e].y); v3 += a_prev * bf_hi(pv[qh][e].y); }
            wv[e].x = cvt_pk_bf16(v0, v1); wv[e].y = cvt_pk_bf16(v2, v3); }
#pragma unroll
        for (int e = 0; e < 8; e += 2) { const u32x2 snd = hi ? wv[e] : wv[e + 1]; u32x2 rcv; rcv.x = __shfl_xor(snd.x, 32); rcv.y = __shfl_xor(snd.y, 32);
            u32x4 o4; if (hi) { o4.x = rcv.x; o4.y = rcv.y; o4.z = wv[e + 1].x; o4.w = wv[e + 1].y; } else { o4.x = wv[e].x; o4.y = wv[e].y; o4.z = rcv.x; o4.w = rcv.y; }
            *(u32x4*)(ypb + 32 * (e >> 2) + 8 * ((e & 3) + hi)) = o4; }
        if (!last && hi == 0) LSE[srow] = lse_new;
    }
}
__device__ __forceinline__ void dil_unit(LAS unsigned char* lds, const bf16_t* DIL, bf16_t* Y, bf16_t* ST, float* LSE, const float* BT, int b, int h, int c) {
    const int wid = __builtin_amdgcn_readfirstlane(otid() >> 6);
    LAS unsigned char* wl = lds + wid * DW_BYTES;
    for (int j = 0; j < 2; ++j) { const int wu = 2 * wid + j; dil_wave_unit<0>(wl, DIL, Y, ST, LSE, BT, b, h, 0, c * 16 + wu); }
    __syncthreads();
    for (int j = 0; j < 2; ++j) { const int wu = 2 * wid + j; dil_wave_unit<1>(wl, DIL, Y, ST, LSE, BT, b, h, wu >> 2, c * 4 + (wu & 3)); }
    __syncthreads();
    for (int j = 0; j < 2; ++j) { const int wu = 2 * wid + j; dil_wave_unit<2>(wl, DIL, Y, ST, LSE, BT, b, h, wu, c); }
    __syncthreads();
}

typedef __attribute__((address_space(1))) unsigned gu32;
#define XB_TMO      128
#define XB_XCNT(j)  (256  + 64 * (j))
#define XB_XSUB(j)  (1280 + 64 * (j))
#define XB_XGEN(j)  (2304 + 64 * (j))
#define XB_TOP      3328
#define XB_TOPGEN   3392
#define XCD_BAR_WORDS 3456
#define XB_SPIN_CAP (1u << 18)

__device__ __forceinline__ unsigned xb_ld(unsigned* p)              { return __hip_atomic_load(p, __ATOMIC_RELAXED, __HIP_MEMORY_SCOPE_AGENT); }
__device__ __forceinline__ unsigned xb_add(unsigned* p, unsigned v) { return __hip_atomic_fetch_add(p, v, __ATOMIC_RELAXED, __HIP_MEMORY_SCOPE_AGENT); }
__device__ __forceinline__ unsigned xb_xcc_id() { return (unsigned)__builtin_amdgcn_s_getreg((3 << 11) | 20) & 0xFu; }
#define XB_SPIN(cond, bar) do { unsigned _sp = 0; while (cond) { __builtin_amdgcn_s_sleep(1); \
    if ((++_sp & 255u) == 0u) { if (xb_ld(&(bar)[XB_TMO])) break; if (_sp > XB_SPIN_CAP) { atomicAdd(&(bar)[XB_TMO], 1u); break; } } } } while (0)

struct XcdBarrier {
    unsigned* bar; unsigned x;
    volatile LAS unsigned* st;
};

__device__ __forceinline__ XcdBarrier xcd_barrier_post(unsigned* bar, volatile LAS unsigned* st) {
    XcdBarrier b; b.bar = bar; b.x = xb_xcc_id(); b.st = st;
    if (threadIdx.x == 0) (void)xb_add(&bar[XB_XCNT(b.x)], 1u);
    return b;
}
__device__ __forceinline__ void xcd_barrier_complete(unsigned* bar, unsigned x, unsigned& nloc, unsigned& nx) {
    const unsigned G = gridDim.x * gridDim.y * gridDim.z;
    unsigned sum, cnt, mine, sp = 0u;
    for (;;) {
        sum = 0u; cnt = 0u; mine = 0u;
#pragma unroll
        for (unsigned j = 0; j < 16; ++j) { const unsigned c = xb_ld(&bar[XB_XCNT(j)]); sum += c; cnt += (c > 0u) ? 1u : 0u; mine = (j == x) ? c : mine; }
        if (sum == G) break;
        __builtin_amdgcn_s_sleep(1);
        if ((++sp & 255u) == 0u) { if (xb_ld(&bar[XB_TMO])) break; if (sp > XB_SPIN_CAP) { atomicAdd(&bar[XB_TMO], 1u); break; } }
    }
    nloc = mine > 0u ? mine : 1u; nx = cnt > 0u ? cnt : 1u;
}

__device__ __forceinline__ void xcd_barrier(const XcdBarrier& b) {
    asm volatile("s_waitcnt vmcnt(0)" ::: "memory");
    __syncthreads();
    if (threadIdx.x == 0) {
        unsigned* bar = b.bar;
        __builtin_amdgcn_s_waitcnt(0);
        unsigned nloc = b.st[0], nx = b.st[1];
        if (nloc == 0u) { xcd_barrier_complete(bar, b.x, nloc, nx); b.st[0] = nloc; b.st[1] = nx; }
        const unsigned old = xb_add(&bar[XB_XSUB(b.x)], 1u);
        const unsigned gen = old / nloc;
        if (old + 1u == (gen + 1u) * nloc) {
            __builtin_amdgcn_fence(__ATOMIC_RELEASE, "agent");
            asm volatile("s_waitcnt vmcnt(0)" ::: "memory");
            const unsigned og = xb_add(&bar[XB_TOP], 1u);
            const unsigned tg = og / nx;
            if (og + 1u == (tg + 1u) * nx) xb_add(&bar[XB_TOPGEN], 1u);
            else XB_SPIN(xb_ld(&bar[XB_TOPGEN]) == tg, bar);
            __builtin_amdgcn_fence(__ATOMIC_ACQUIRE, "agent");
            xb_add(&bar[XB_XGEN(b.x)], 1u);
            asm volatile("s_waitcnt vmcnt(0)" ::: "memory");
        } else {
            XB_SPIN(xb_ld(&bar[XB_XGEN(b.x)]) == gen, bar);
            __builtin_amdgcn_fence(__ATOMIC_ACQUIRE, "agent");
            asm volatile("s_waitcnt vmcnt(0)" ::: "memory");
        }
    }
    __syncthreads();
}

constexpr int NPHASE = 2 + DEPTH * 7;
__device__ __forceinline__ unsigned char* opaque_ptr(unsigned char* p) { asm volatile("" : "+s"(p)); return p; }
#define GEMM(EpiT, Ev, Ap, Bp, Nn, Kk, Ld) do { pg8::Gemm g_{(Ap), (Bp), NTOK, (Nn), (Kk), (Ld), 1 << 30, 0}; pg8::StaticOrder S_; S_.init(NTOK, (Nn), G, obid()); \
        pg8::gemm_phase<EpiT, pg8::StaticOrder, true, true>(lds, g_, S_, (Ev)); } while (0)
#define BF(off) ((bf16_t*)(unsigned char*)(ws + (off)))
#define FP(off) ((float*)(unsigned char*)(ws + (off)))
#define WB(l_, off) ((bf16_t*)(unsigned char*)(ws + WS_W + (size_t)((l_) & 1) * WS_WSTRIDE + (off)))
__global__ void __launch_bounds__(NTHR, 2) mega_fwd(Params P0) {
    extern __shared__ __attribute__((aligned(16))) unsigned char lds_raw[];
    LAS unsigned char* lds = (LAS unsigned char*)lds_raw;
    cg::grid_group grid = cg::this_grid();
    { volatile LAS unsigned* misc = (volatile LAS unsigned*)(lds + RING_BYTES + 320); if (otid() < 32) misc[otid()] = 0u; }
    __syncthreads();
    XcdBarrier xbar = xcd_barrier_post((unsigned*)(P0.ws + WS_CTL) + 1024, (volatile LAS unsigned*)(lds + RING_BYTES + 320) + 8);
    { volatile LAS unsigned* misc = (volatile LAS unsigned*)(lds + RING_BYTES + 320);
      if (otid() == 0) { const unsigned x = xb_xcc_id(); misc[16] = xb_add((unsigned*)(P0.ws + WS_CTL) + 8192 + 64 * x, 1u); misc[17] = x; } }
    __syncthreads();
    const int ph_lo = P0.ph_lo, ph_hi = P0.ph_hi;
    for (int ph = ph_lo; ph < ph_hi; ++ph) {
        int G_ = (int)gridDim.x; asm volatile("" : "+s"(G_)); const int G = G_;
        typedef const __attribute__((address_space(4))) Params* kparams_t;
        kparams_t kp_ = (kparams_t)__builtin_amdgcn_kernarg_segment_ptr(); asm volatile("" : "+s"(kp_));
        const Params& P = *(const Params*)kp_;
        __attribute__((address_space(1))) unsigned char* ws = (__attribute__((address_space(1))) unsigned char*)opaque_ptr(P.ws);
        const int l = ph > 1 ? (ph - 2) / 7 : 0, kk_ = ph > 1 ? (ph - 2) % 7 + 2 : ph; const int k = kk_ >= 4 ? kk_ + 1 : kk_;
        const size_t modl = (size_t)l * 16 * 6144;
        switch (k) {
        case 0: {
            phase0(P, lds, G);
            float* SSQ = FP(WS_SSQ);
            float* SKR = FP(WS_SSQKR);
            for (int i = obid() * NTHR + otid(); i < 2 * NTOK; i += G * NTHR) { SSQ[i] = 0.f; if (i < NTOK) SKR[i] = 0.f; }
            __syncthreads();
            conv_weights(P, 0, (unsigned char*)(ws + WS_W), lds, G);
        } break;
        case 1: {
            bias_phase(P, lds, G);
            prepass_phase(P.x, P.norm1_g, FP(WS_MOD), 1024, BF(WS_H), FP(WS_SSQ) + 2 * NTOK, G);
        } break;
        case 2: {
            pg8::EpiIn E{BF(WS_PA), BF(WS_DIL), BF(WS_GATES), FP(WS_SSQ), FP(WS_SSQ) + NTOK, FP(WS_SSQKR), P.q_norm_b + l * 64, P.k_norm_b + l * 64, FP(WS_SSQ) + 2 * NTOK, FP(WS_BW1) + (size_t)l * 16 * 4096};
            GEMM(pg8::EpiIn, E, BF(WS_H), WB(l, W_IN), NIN, 1024, 1024);
        } break;
        case 3: {
            pg8::EpiRowScale2 E{(unsigned char*)ws, P.k_norm_a + l * 96};
            { pg8::Gemm g_{BF(WS_PA), WB(l, W_Q), NTOK, 1792, 256, 512, 3, 256}; pg8::StaticOrder S_; S_.init(NTOK, 1792, G, obid()); pg8::gemm_phase<pg8::EpiRowScale2, pg8::StaticOrder, true, true>(lds, g_, S_, E); }
        } break;
        case 5: {
            { float* SSQ = FP(WS_SSQ); float* SKR = FP(WS_SSQKR); for (int i = obid() * NTHR + otid(); i < 4 * NTOK; i += G * NTHR) { SSQ[i] = 0.f; if (i < NTOK) SKR[i] = 0.f; } }
            if (l + 1 < DEPTH) { conv_weights(P, l + 1, (unsigned char*)(ws + WS_W + (size_t)((l + 1) & 1) * WS_WSTRIDE), lds, G); __syncthreads(); }
            bf16_t* Y = BF(WS_KVRAW);
            if (G == 256) { int xcd = obid() & 7, slot = obid() >> 3;
                { const unsigned* tk = (const unsigned*)(ws + WS_CTL) + 8192; bool even = true;
#pragma unroll
                  for (int x = 0; x < 8; ++x) even = even && (__hip_atomic_load(tk + 64 * x, __ATOMIC_RELAXED, __HIP_MEMORY_SCOPE_AGENT) == 32u);
                  if (even) { volatile LAS unsigned* misc = (volatile LAS unsigned*)(lds + RING_BYTES + 320); slot = (int)misc[16]; xcd = (int)misc[17]; } }
                slot = __builtin_amdgcn_readfirstlane(slot); xcd = __builtin_amdgcn_readfirstlane(xcd);
                for (int i = 0; i < 8; ++i) { const int bh = ((i * 2 + (slot >> 4)) << 3) + xcd; mla_unit(lds, BF(WS_H), BF(WS_K), BF(WS_V), Y, P.q_norm_a + l * 96, FP(WS_ROPE), bh >> 3, bh & 7, slot & 15); }
            } else { for (int u = obid(); u < NB * NH * 16; u += G) mla_unit(lds, BF(WS_H), BF(WS_K), BF(WS_V), Y, P.q_norm_a + l * 96, FP(WS_ROPE), u >> 7, (u >> 4) & 7, u & 15); }
            __syncthreads();
            for (int u = obid(); u < NB * NH * 4; u += G) dil_unit(lds, BF(WS_DIL), Y, BF(WS_PA), FP(WS_LSE), FP(WS_BT), u >> 5, (u >> 2) & 7, u & 3);
        } break;
        case 6: {
            pg8::EpiGate2 E{BF(WS_H), BF(WS_GATES)}; GEMM(pg8::EpiGate2, E, BF(WS_KVRAW), WB(l, W_A), 1024, 1024, 1024);
        } break;
        case 7: {
            pg8::EpiResid E{(const __attribute__((address_space(1))) float*)(l == 0 ? P.x : P.out), (__attribute__((address_space(1))) float*)P.out, FP(WS_MOD) + modl + 2048, BF(WS_KVRAW), P.norm2_g + l * DM, FP(WS_MOD) + modl + 4096, FP(WS_SSQ) + 3 * NTOK};
            GEMM(pg8::EpiResid, E, BF(WS_H), WB(l, W_O), 1024, 1024, 1024);
        } break;
        case 8: {
            pg8::EpiSwiGLU E{BF(WS_HID), FP(WS_SSQ) + 3 * NTOK, FP(WS_BW2) + (size_t)l * 16 * 5632}; GEMM(pg8::EpiSwiGLU, E, BF(WS_KVRAW), WB(l, W_1), 5632, 1024, 1024);
        } break;
        default: {
            const bool nxt = l + 1 < DEPTH; const size_t modn = (size_t)(l + 1) * 16 * 6144;
            pg8::EpiResid E{(const __attribute__((address_space(1))) float*)P.out, (__attribute__((address_space(1))) float*)P.out, FP(WS_MOD) + modl + 5120, nxt ? BF(WS_H) : (bf16_t*)nullptr, P.norm1_g + (nxt ? (l + 1) * DM : 0), FP(WS_MOD) + (nxt ? modn + 1024 : 0), FP(WS_SSQ) + 2 * NTOK};
            GEMM(pg8::EpiResid, E, BF(WS_HID), WB(l, W_2), 1024, FFH, FFH);
        } break;
        }
        if (ph + 1 < ph_hi) { if (ph == ph_lo) grid.sync(); else xcd_barrier(xbar); }
    }
}

extern "C" void kernel_launch(void* const* d_in, const int* in_sizes, int n_in, void* d_out, int out_size, void* d_ws, size_t ws_size, hipStream_t stream) {
    static int grid = 0;
    if (grid == 0) {
        if (n_in != 23 || ws_size < WS_END) { fprintf(stderr, "kernel_launch: unexpected n_in %d / ws_size %zu\n", n_in, ws_size); grid = -1; return; }
        int dev = 0, cus = 0, per_cu = 0;
        (void)hipGetDevice(&dev); (void)hipDeviceGetAttribute(&cus, hipDeviceAttributeMultiprocessorCount, dev);
        if (hipFuncSetAttribute((const void*)mega_fwd, hipFuncAttributeMaxDynamicSharedMemorySize, LDS_BYTES) != hipSuccess) { fprintf(stderr, "kernel_launch: hipFuncSetAttribute failed\n"); grid = -1; return; }
        if (hipOccupancyMaxActiveBlocksPerMultiprocessor(&per_cu, (const void*)mega_fwd, NTHR, LDS_BYTES) != hipSuccess || per_cu < 1) { fprintf(stderr, "kernel_launch: occupancy query gave %d\n", per_cu); per_cu = 1; }
        (void)hipGetLastError();
        grid = cus * per_cu;
    }
    if (grid < 0) return;
    Params p{};
    const float** fp = (const float**)&p.x;
    p.x = (const float*)d_in[0]; p.c = (const float*)d_in[1]; p.pos = (const int*)d_in[2]; p.rel_bias = (const float*)d_in[3]; p.norm1_g = (const float*)d_in[4]; p.norm2_g = (const float*)d_in[5];
    p.ada_w = (const float*)d_in[6]; p.ada_b = (const float*)d_in[7]; p.w_in = (const float*)d_in[8]; p.q_a_norm = (const float*)d_in[9]; p.w_q_b = (const float*)d_in[10]; p.kv_a_norm = (const float*)d_in[11];
    p.w_kv_b = (const float*)d_in[12]; p.q_norm_a = (const float*)d_in[13]; p.k_norm_a = (const float*)d_in[14]; p.q_norm_b = (const float*)d_in[15]; p.k_norm_b = (const float*)d_in[16];
    p.w_branch_a = (const float*)d_in[17]; p.w_branch_b = (const float*)d_in[18]; p.w_out = (const float*)d_in[19]; p.w_ffn_gate = (const float*)d_in[20]; p.w_ffn_up = (const float*)d_in[21]; p.w_ffn_down = (const float*)d_in[22];
    (void)fp;
    p.out = (float*)d_out; p.ws = (unsigned char*)d_ws;
    for (int i = 0; i < 16; ++i) p.inv_freq[i] = (float)pow(10000.0, -(double)i / 16.0);
    p.ph_lo = 0; p.ph_hi = NPHASE;
    if (hipMemsetAsync((char*)d_ws + WS_CTL, 0, CTL_BYTES, stream) != hipSuccess) { fprintf(stderr, "kernel_launch: memset failed\n"); return; }
    void* args[] = {&p};
    hipError_t e = hipLaunchCooperativeKernel((const void*)mega_fwd, dim3(grid), dim3(NTHR), args, LDS_BYTES, stream);
    if (e != hipSuccess) fprintf(stderr, "kernel_launch: cooperative launch failed: %s (grid %d)\n", hipGetErrorString(e), grid);
}
```

```cpp
#include <hip/hip_runtime.h>
#include <hip/hip_cooperative_groups.h>
#include <cstdio>
#include <cstdint>
namespace cg = cooperative_groups;
__device__ __forceinline__ int otid() { int t = (int)threadIdx.x; asm volatile("" : "+v"(t)); return t; }
__device__ __forceinline__ int obid() { int b = (int)blockIdx.x; asm volatile("" : "+s"(b)); return b; }

#include <cmath>
namespace pg8 {
#define PG8_LAS __attribute__((address_space(3)))
typedef unsigned short bf16_t;
typedef short bf16x8 __attribute__((ext_vector_type(8)));
typedef float f32x4 __attribute__((ext_vector_type(4)));
typedef unsigned u32x4 __attribute__((ext_vector_type(4)));
constexpr int BM = 256, BK = 64, HALF = 128, HTB = HALF * BK * 2  , STAGE_BYTES = 8 * HTB, NXCD = 8, WGM = 8;

__host__ __device__ __forceinline__ int lds_byte(int r, int c) { const int st = (r >> 4) * 2 + (c >> 5), rr = r & 15, cc = c & 31, ob = rr * 64 + cc * 2; return st * 1024 + (ob ^ (((ob >> 9) & 1) << 5)); }
__host__ __device__ __forceinline__ void stage_rc(int b, int& R, int& C) { const int st = b / 1024, sb = b % 1024, swz = sb ^ (((sb >> 9) & 1) << 5); R = (st >> 1) * 16 + swz / 64; C = (st & 1) * 32 + (swz % 64) / 2; }
__host__ __device__ __forceinline__ int perm32(int rho) { const int n = rho >> 4, i = rho & 15; return 8 * (i >> 2) + 4 * n + (i & 3); }

struct Unit { int pm, pn; };
struct Gemm { const bf16_t* A; const bf16_t* Bt; int M, N, K, lda, asplit, aoff2; };

struct StaticOrder {
    int nM, nN, nwg, G, c;
    __host__ __device__ void init(int M, int N, int G_, int c_) { nM = M / BM; nN = N / BM; nwg = nM * nN; G = G_; c = c_; }
    __host__ __device__ bool next(int i, Unit& u) const {
        const long L = (long)i * G + c; if (L >= nwg) return false;
        int wgid = (int)L; { const int q = nwg / NXCD, r = nwg % NXCD, xcd = wgid % NXCD, off = wgid / NXCD; wgid = (xcd < r ? xcd * (q + 1) : r * (q + 1) + (xcd - r) * q) + off; }
        const int nig = WGM * nN, gid = wgid / nig, fm = gid * WGM, gsz = (nM - fm) < WGM ? (nM - fm) : WGM;
        u.pm = fm + ((wgid % nig) % gsz); u.pn = (wgid % nig) / gsz; return true;
    }
    __device__ __forceinline__ void a_ready(const Unit&) const {}
    __device__ __forceinline__ void done(const Unit&) const {}
};


__device__ __forceinline__ unsigned cvt_pk_bf16(float lo, float hi) { unsigned r; asm volatile("v_cvt_pk_bf16_f32 %0, %1, %2" : "=v"(r) : "v"(lo), "v"(hi)); return r; }
typedef unsigned u32x2 __attribute__((ext_vector_type(2)));
__device__ __forceinline__ float bf_lo(unsigned w) { return __builtin_bit_cast(float, w << 16); }
__device__ __forceinline__ float bf_hi(unsigned w) { return __builtin_bit_cast(float, w & 0xffff0000u); }
__device__ __forceinline__ float sigmoidf_(float x) { return 1.0f / (1.0f + __builtin_amdgcn_exp2f(-1.4426950408889634f * x)); }

constexpr float RMS_EPS = 1e-6f;
constexpr size_t DPLANE = (size_t)65536 * 512;
constexpr float LOG2E = 1.4426950408889634f;
constexpr float QSCALE_B = 0.125f * 1.4426950408889634f;
constexpr float QSCALE_A = 0.10206207261596575f * 1.4426950408889634f;

struct EpiIn {
    static constexpr bool PERM = true, AFTER_DRAIN = false, MIDHOOK = false;
    bf16_t* PA; bf16_t* DIL; bf16_t* GATES; float* ssq_q; float* ssq_kv; float* ssq_kr; const float* qn; const float* kn; const float* ssq1; const float* bw;
    __device__ __forceinline__ void operator()(const f32x4 (&acc_)[2][2][4][2], const Unit& u, int wr, int wc, int fr, int fq) const {
        { const int ln_ = otid() & 63; fr = ln_ & 15; fq = ln_ >> 4; }
        const int pn = u.pn; const size_t rowb = (size_t)u.pm * BM + wr * 64 + fr;
        f32x4 bv[2][2]; float r8[2][4];
        { const float* bwp = bw + (size_t)(u.pm >> 4) * 4096 + pn * BM + wc * 32 + fq * 8;
#pragma unroll
          for (int bj = 0; bj < 2; ++bj)
#pragma unroll
              for (int n = 0; n < 2; ++n) bv[bj][n] = *(const f32x4*)(bwp + bj * HALF + n * 4);
#pragma unroll
          for (int ai = 0; ai < 2; ++ai)
#pragma unroll
              for (int m = 0; m < 4; ++m) r8[ai][m] = __builtin_amdgcn_rsqf(ssq1[rowb + ai * HALF + m * 16] * (1.0f / 1024.0f) + RMS_EPS); }
#define EPIIN_VAL(ai, bj, m, n) (acc_[ai][bj][m][n] * r8[ai][m] + bv[bj][n])
#define EPIIN_PACK(w, a, b) do { (w).x = cvt_pk_bf16((a)[0], (a)[1]); (w).y = cvt_pk_bf16((a)[2], (a)[3]); (w).z = cvt_pk_bf16((b)[0], (b)[1]); (w).w = cvt_pk_bf16((b)[2], (b)[3]); } while (0)
        if (pn < 2) {
            float* sq = pn == 0 ? ssq_q : ssq_kv;
#pragma unroll
            for (int ai = 0; ai < 2; ++ai)
#pragma unroll
                for (int m = 0; m < 4; ++m) { const size_t row = rowb + ai * HALF + m * 16; float s = 0.f, s2 = 0.f;
#pragma unroll
                    for (int bj = 0; bj < 2; ++bj) { const f32x4 a = EPIIN_VAL(ai, bj, m, 0), b = EPIIN_VAL(ai, bj, m, 1);
                        u32x4 w; EPIIN_PACK(w, a, b);
                        *(u32x4*)(PA + row * 512 + pn * 256 + bj * HALF + wc * 32 + fq * 8) = w;
                        const float q = ((a[0] * a[0] + a[1] * a[1]) + (a[2] * a[2] + a[3] * a[3])) + ((b[0] * b[0] + b[1] * b[1]) + (b[2] * b[2] + b[3] * b[3]));
                        if (pn == 0 || bj == 0) s += q; else s2 += q; }
                    s += __shfl_xor(s, 16); s += __shfl_xor(s, 32);
                    if (fq == 0) atomicAdd(sq + row, s);
                    if (pn == 1 && wc == 0) { s2 += __shfl_xor(s2, 16); s2 += __shfl_xor(s2, 32); if (fq == 0) atomicAdd(ssq_kr + row, s2); } }
        } else if (pn < 6) {
            const int sec = (pn - 2) >> 1, head = 4 * ((pn - 2) & 1) + wc; const float* gp = sec == 0 ? qn : kn; const float gs = sec == 0 ? QSCALE_B : 1.0f;
            f32x4 gv[2][2];
#pragma unroll
            for (int bj = 0; bj < 2; ++bj)
#pragma unroll
                for (int n = 0; n < 2; ++n) gv[bj][n] = *(const f32x4*)(gp + 32 * bj + 8 * fq + 4 * n) * gs;
#pragma unroll
            for (int ai = 0; ai < 2; ++ai)
#pragma unroll
                for (int m = 0; m < 4; ++m) { const size_t row = rowb + ai * HALF + m * 16; float s = 0.f;
#pragma unroll
                    for (int bj = 0; bj < 2; ++bj)
#pragma unroll
                        for (int n = 0; n < 2; ++n) { const f32x4 v = EPIIN_VAL(ai, bj, m, n); s += (v[0] * v[0] + v[1] * v[1]) + (v[2] * v[2] + v[3] * v[3]); }
                    s += __shfl_xor(s, 16); s += __shfl_xor(s, 32);
                    const float r = __builtin_amdgcn_rsqf(s * (1.0f / 64.0f) + RMS_EPS);
#pragma unroll
                    for (int bj = 0; bj < 2; ++bj) { const f32x4 a = EPIIN_VAL(ai, bj, m, 0) * r * gv[bj][0], b = EPIIN_VAL(ai, bj, m, 1) * r * gv[bj][1];
                        u32x4 w; EPIIN_PACK(w, a, b);
                        *(u32x4*)(DIL + (size_t)sec * DPLANE + ((((row >> 12) * 8 + head) << 12) + (row & 4095)) * 64 + 32 * bj + 8 * fq) = w; } }
        } else if (pn < 8) {
#pragma unroll
            for (int ai = 0; ai < 2; ++ai)
#pragma unroll
                for (int m = 0; m < 4; ++m) { const size_t row = rowb + ai * HALF + m * 16;
#pragma unroll
                    for (int bj = 0; bj < 2; ++bj) { const f32x4 a = EPIIN_VAL(ai, bj, m, 0), b = EPIIN_VAL(ai, bj, m, 1);
                        u32x4 w; EPIIN_PACK(w, a, b);
                        *(u32x4*)(DIL + 2 * DPLANE + ((((row >> 12) * 8 + (pn - 6) * 4 + 2 * bj + (wc >> 1)) << 12) + (row & 4095)) * 64 + 32 * (wc & 1) + fq * 8) = w; } }
        } else {
#pragma unroll
            for (int ai = 0; ai < 2; ++ai)
#pragma unroll
                for (int m = 0; m < 4; ++m) { const size_t row = rowb + ai * HALF + m * 16;
#pragma unroll
                    for (int bj = 0; bj < 2; ++bj) { f32x4 a = EPIIN_VAL(ai, bj, m, 0), b = EPIIN_VAL(ai, bj, m, 1);
#pragma unroll
                        for (int i = 0; i < 4; ++i) { a[i] = sigmoidf_(a[i]); b[i] = sigmoidf_(b[i]); }
                        u32x4 w; EPIIN_PACK(w, a, b);
                        *(u32x4*)(GATES + row * 2048 + (pn - 8) * 256 + bj * HALF + wc * 32 + fq * 8) = w; } }
        }
    }
};
#undef EPIIN_PACK
#undef EPIIN_VAL
struct EpiRowScale2 {
    static constexpr bool PERM = true, AFTER_DRAIN = false, MIDHOOK = false;
    unsigned char* ws; const float* kg;
    static constexpr size_t O_Q = 0, O_PA = 128u << 20, O_K = 768u << 20, O_V = 864u << 20, O_ROPE = 990u << 20, O_SSQ = 998u << 20, O_SSQKR = (1001u << 20) + 65536;
    __device__ __forceinline__ void operator()(const f32x4 (&acc)[2][2][4][2], const Unit& u, int wr, int wc, int fr, int fq) const {
        { const int ln_ = otid() & 63; fr = ln_ & 15; fq = ln_ >> 4; }
        bf16_t* Oq = (bf16_t*)(ws + O_Q); bf16_t* Kp = (bf16_t*)(ws + O_K); bf16_t* Vp = (bf16_t*)(ws + O_V); const bf16_t* PA = (const bf16_t*)(ws + O_PA); const float* ROPE = (const float*)(ws + O_ROPE);
        const float* ssq_q = (const float*)(ws + O_SSQ); const float* ssq_kv = ssq_q + 65536; const float* ssq_kr = (const float*)(ws + O_SSQKR);
        const size_t rowb = (size_t)u.pm * BM + wr * 64 + fr;
        if (u.pn < 3) {
            const int col0 = u.pn * BM + wc * 32 + 8 * fq;
#pragma unroll
            for (int ai = 0; ai < 2; ++ai)
#pragma unroll
                for (int m = 0; m < 4; ++m) { const size_t row = rowb + ai * HALF + m * 16; const float r = __builtin_amdgcn_rsqf(ssq_q[row] * (1.0f / 256.0f) + RMS_EPS);
#pragma unroll
                    for (int bj = 0; bj < 2; ++bj) { const f32x4 v0 = acc[ai][bj][m][0] * r, v1 = acc[ai][bj][m][1] * r;
                        u32x4 w; w.x = cvt_pk_bf16(v0[0], v0[1]); w.y = cvt_pk_bf16(v0[2], v0[3]); w.z = cvt_pk_bf16(v1[0], v1[1]); w.w = cvt_pk_bf16(v1[2], v1[3]);
                        *(u32x4*)(Oq + row * 768 + col0 + bj * HALF) = w; } }
        } else {
            const int head = (u.pn - 3) * 2 + (wc & 1); float rh8[2][4];
#pragma unroll
            for (int ai = 0; ai < 2; ++ai)
#pragma unroll
                for (int m = 0; m < 4; ++m) { const size_t row = rowb + ai * HALF + m * 16; const float r = __builtin_amdgcn_rsqf(ssq_kv[row] * (1.0f / 128.0f) + RMS_EPS);
                    const size_t hrow = ((((row >> 12) * 8 + head) << 12) + (row & 4095));
                    if (wc >= 2) {
#pragma unroll
                        for (int bj = 0; bj < 2; ++bj) { const f32x4 a = acc[ai][bj][m][0] * r, b = acc[ai][bj][m][1] * r;
                            u32x4 w; w.x = cvt_pk_bf16(a[0], a[1]); w.y = cvt_pk_bf16(a[2], a[3]); w.z = cvt_pk_bf16(b[0], b[1]); w.w = cvt_pk_bf16(b[2], b[3]);
                            *(u32x4*)(Vp + hrow * 64 + 32 * bj + 8 * fq) = w; }
                    } else {
                        float s = 0.f;
#pragma unroll
                        for (int bj = 0; bj < 2; ++bj) { const f32x4 a = acc[ai][bj][m][0], b = acc[ai][bj][m][1]; s += ((a[0] * a[0] + a[1] * a[1]) + (a[2] * a[2] + a[3] * a[3])) + ((b[0] * b[0] + b[1] * b[1]) + (b[2] * b[2] + b[3] * b[3])); }
                        s += __shfl_xor(s, 16); s += __shfl_xor(s, 32);
                        const float rh = __builtin_amdgcn_rsqf((s * r * r + ssq_kr[row]) * (1.0f / 96.0f) + RMS_EPS); const float rr = r * rh;
#pragma unroll
                        for (int bj = 0; bj < 2; ++bj) { const f32x4 a = acc[ai][bj][m][0] * rr * *(const f32x4*)(kg + 32 * bj + 8 * fq), b = acc[ai][bj][m][1] * rr * *(const f32x4*)(kg + 32 * bj + 8 * fq + 4);
                            u32x4 w; w.x = cvt_pk_bf16(a[0], a[1]); w.y = cvt_pk_bf16(a[2], a[3]); w.z = cvt_pk_bf16(b[0], b[1]); w.w = cvt_pk_bf16(b[2], b[3]);
                            *(u32x4*)(Kp + hrow * 96 + 32 * bj + 8 * fq) = w; }
                        rh8[ai][m] = rh;
                    }
                    asm volatile("" ::: "memory"); }
            if (wc < 2) {
#pragma unroll
                for (int ai = 0; ai < 2; ++ai)
#pragma unroll
                    for (int m = 0; m < 4; ++m) { const size_t row = rowb + ai * HALF + m * 16; const size_t hrow = ((((row >> 12) * 8 + head) << 12) + (row & 4095)); const float rh = rh8[ai][m];
                        const bf16_t* krp = PA + row * 512 + 384; const float* rp = ROPE + row * 32;
                        { const int i0 = 4 * fq; const u32x2 xa = *(const u32x2*)(krp + i0), xb = *(const u32x2*)(krp + 16 + i0);
                            const f32x4 cs = *(const f32x4*)(rp + i0), sn = *(const f32x4*)(rp + 16 + i0), ga = *(const f32x4*)(kg + 64 + i0), gb = *(const f32x4*)(kg + 80 + i0);
                            const f32x4 a = (f32x4){bf_lo(xa.x), bf_hi(xa.x), bf_lo(xa.y), bf_hi(xa.y)} * rh * ga, bb = (f32x4){bf_lo(xb.x), bf_hi(xb.x), bf_lo(xb.y), bf_hi(xb.y)} * rh * gb;
                            const f32x4 o1_ = a * cs - bb * sn, o2_ = bb * cs + a * sn;
                            u32x2 w1_; w1_.x = cvt_pk_bf16(o1_[0], o1_[1]); w1_.y = cvt_pk_bf16(o1_[2], o1_[3]); u32x2 w2_; w2_.x = cvt_pk_bf16(o2_[0], o2_[1]); w2_.y = cvt_pk_bf16(o2_[2], o2_[3]);
                            *(u32x2*)(Kp + hrow * 96 + 64 + i0) = w1_; *(u32x2*)(Kp + hrow * 96 + 80 + i0) = w2_; }
                        asm volatile("" ::: "memory"); }
            }
        }
    }
};
struct EpiRowScale {
    static constexpr bool PERM = true, AFTER_DRAIN = false, MIDHOOK = false;
    bf16_t* O; int ldc; const float* ssq; float invk;
    __device__ __forceinline__ void operator()(const f32x4 (&acc)[2][2][4][2], const Unit& u, int wr, int wc, int fr, int fq) const {
        { const int ln_ = otid() & 63; fr = ln_ & 15; fq = ln_ >> 4; }
        const size_t rowb = (size_t)u.pm * BM + wr * 64 + fr; const int col0 = u.pn * BM + wc * 32 + 8 * fq;
#pragma unroll
        for (int ai = 0; ai < 2; ++ai)
#pragma unroll
            for (int m = 0; m < 4; ++m) { const size_t row = rowb + ai * HALF + m * 16; const float r = __builtin_amdgcn_rsqf(ssq[row] * invk + RMS_EPS);
#pragma unroll
                for (int bj = 0; bj < 2; ++bj) { const f32x4 v0 = acc[ai][bj][m][0] * r, v1 = acc[ai][bj][m][1] * r;
                    u32x4 w; w.x = cvt_pk_bf16(v0[0], v0[1]); w.y = cvt_pk_bf16(v0[2], v0[3]); w.z = cvt_pk_bf16(v1[0], v1[1]); w.w = cvt_pk_bf16(v1[2], v1[3]);
                    *(u32x4*)(O + row * ldc + col0 + bj * HALF) = w; } }
    }
};
struct EpiGate2 {
    static constexpr bool PERM = true, AFTER_DRAIN = false, MIDHOOK = true;
    bf16_t* O; const bf16_t* SIG;
    __device__ __forceinline__ void mid(f32x4 (&acc)[2][2][4][2], const Unit& u, int wr, int wc) const {
        const int ln_ = otid() & 63, fr = ln_ & 15, fq = ln_ >> 4;
        const size_t rowb = (size_t)u.pm * BM + wr * 64 + fr; const int col0 = u.pn * BM + wc * 32 + 8 * fq;
#pragma unroll
        for (int ai = 0; ai < 2; ++ai)
#pragma unroll
            for (int m = 0; m < 4; ++m) { const bf16_t* sp = SIG + (rowb + ai * HALF + m * 16) * 2048 + col0;
#pragma unroll
                for (int bj = 0; bj < 2; ++bj) { const u32x4 sa = *(const u32x4*)(sp + bj * HALF), sb = *(const u32x4*)(sp + 1024 + bj * HALF);
                    f32x4& v0 = acc[ai][bj][m][0]; f32x4& v1 = acc[ai][bj][m][1];
                    v0[0] *= bf_lo(sa.x) * __builtin_amdgcn_rcpf(1e-30f + bf_lo(sb.x)); v0[1] *= bf_hi(sa.x) * __builtin_amdgcn_rcpf(1e-30f + bf_hi(sb.x));
                    v0[2] *= bf_lo(sa.y) * __builtin_amdgcn_rcpf(1e-30f + bf_lo(sb.y)); v0[3] *= bf_hi(sa.y) * __builtin_amdgcn_rcpf(1e-30f + bf_hi(sb.y));
                    v1[0] *= bf_lo(sa.z) * __builtin_amdgcn_rcpf(1e-30f + bf_lo(sb.z)); v1[1] *= bf_hi(sa.z) * __builtin_amdgcn_rcpf(1e-30f + bf_hi(sb.z));
                    v1[2] *= bf_lo(sa.w) * __builtin_amdgcn_rcpf(1e-30f + bf_lo(sb.w)); v1[3] *= bf_hi(sa.w) * __builtin_amdgcn_rcpf(1e-30f + bf_hi(sb.w)); }
                asm volatile("" ::: "memory"); }
    }
    __device__ __forceinline__ void operator()(const f32x4 (&acc)[2][2][4][2], const Unit& u, int wr, int wc, int fr, int fq) const {
        { const int ln_ = otid() & 63; fr = ln_ & 15; fq = ln_ >> 4; }
        const size_t rowb = (size_t)u.pm * BM + wr * 64 + fr; const int col0 = u.pn * BM + wc * 32 + 8 * fq;
#pragma unroll
        for (int ai = 0; ai < 2; ++ai)
#pragma unroll
            for (int m = 0; m < 4; ++m) { const size_t row = rowb + ai * HALF + m * 16;
#pragma unroll
                for (int bj = 0; bj < 2; ++bj) { const u32x4 sg = *(const u32x4*)(SIG + row * 2048 + 1024 + col0 + bj * HALF);
                    f32x4 v0 = acc[ai][bj][m][0], v1 = acc[ai][bj][m][1];
                    v0[0] *= bf_lo(sg.x); v0[1] *= bf_hi(sg.x); v0[2] *= bf_lo(sg.y); v0[3] *= bf_hi(sg.y);
                    v1[0] *= bf_lo(sg.z); v1[1] *= bf_hi(sg.z); v1[2] *= bf_lo(sg.w); v1[3] *= bf_hi(sg.w);
                    u32x4 w; w.x = cvt_pk_bf16(v0[0], v0[1]); w.y = cvt_pk_bf16(v0[2], v0[3]); w.z = cvt_pk_bf16(v1[0], v1[1]); w.w = cvt_pk_bf16(v1[2], v1[3]);
                    *(u32x4*)(O + row * 1024 + col0 + bj * HALF) = w; } }
    }
};
struct EpiResid {
    static constexpr bool PERM = false, AFTER_DRAIN = false, MIDHOOK = false;
    const __attribute__((address_space(1))) float* xin; __attribute__((address_space(1))) float* out; const float* gmod;
    bf16_t* XG; const float* gnorm; const float* scmod; float* ssq;
    __device__ __forceinline__ void operator()(const f32x4 (&acc)[2][2][4][2], const Unit& u, int wr, int wc, int fr, int fq) const {
        { const int ln_ = otid() & 63; fr = ln_ & 15; fq = ln_ >> 4; }
        const size_t rowb = (size_t)u.pm * BM + wr * 64 + fr; const int col0 = u.pn * BM + wc * 32 + 4 * fq; const float* gb = gmod + (size_t)(u.pm >> 4) * 6144;
        f32x4 gv[2][2], Gv[2][2];
#pragma unroll
        for (int bj = 0; bj < 2; ++bj)
#pragma unroll
            for (int n = 0; n < 2; ++n) { gv[bj][n] = *(const f32x4*)(gb + col0 + bj * HALF + n * 16);
                if (XG) Gv[bj][n] = *(const f32x4*)(gnorm + col0 + bj * HALF + n * 16) * (1.0f + *(const f32x4*)(scmod + (size_t)(u.pm >> 4) * 6144 + col0 + bj * HALF + n * 16)); }
#pragma unroll
        for (int ai = 0; ai < 2; ++ai)
#pragma unroll
            for (int m = 0; m < 4; ++m) { const size_t row = rowb + ai * HALF + m * 16; const size_t off = row * 1024 + col0; float s = 0.f;
#pragma unroll
                for (int bj = 0; bj < 2; ++bj) { u32x2 w[2];
#pragma unroll
                    for (int n = 0; n < 2; ++n) { const f32x4 xv = *(const __attribute__((address_space(1))) f32x4*)(xin + off + bj * HALF + n * 16);
                        const f32x4 xn = xv + gv[bj][n] * acc[ai][bj][m][n];
                        *(__attribute__((address_space(1))) f32x4*)(out + off + bj * HALF + n * 16) = xn;
                        if (XG) { s += (xn[0] * xn[0] + xn[1] * xn[1]) + (xn[2] * xn[2] + xn[3] * xn[3]); const f32x4 t = xn * Gv[bj][n];
                            w[n].x = cvt_pk_bf16(t[0], t[1]); w[n].y = cvt_pk_bf16(t[2], t[3]); } }
                    if (XG) {
                        const bool odd = (fq & 1) != 0; const u32x2 snd = odd ? w[0] : w[1]; u32x2 rcv; rcv.x = __shfl_xor(snd.x, 16); rcv.y = __shfl_xor(snd.y, 16);
                        u32x4 o4; if (odd) { o4.x = rcv.x; o4.y = rcv.y; o4.z = w[1].x; o4.w = w[1].y; } else { o4.x = w[0].x; o4.y = w[0].y; o4.z = rcv.x; o4.w = rcv.y; }
                        *(u32x4*)(XG + off + bj * HALF + (odd ? 12 : 0)) = o4; } }
                if (XG) { s += __shfl_xor(s, 16); s += __shfl_xor(s, 32); if (fq == 0) atomicAdd(ssq + row, s); } }
    }
};
struct EpiSwiGLU {
    static constexpr bool PERM = true, AFTER_DRAIN = false, MIDHOOK = false;
    bf16_t* O; const float* ssq2; const float* bw;
    __device__ __forceinline__ void operator()(const f32x4 (&acc)[2][2][4][2], const Unit& u, int wr, int wc, int fr, int fq) const {
        { const int ln_ = otid() & 63; fr = ln_ & 15; fq = ln_ >> 4; }
        const size_t rowb = (size_t)u.pm * BM + wr * 64 + fr; const int col0 = u.pn * HALF + wc * 32 + 8 * fq;
        const float* bwp = bw + (size_t)(u.pm >> 4) * 5632 + u.pn * BM + wc * 32 + 8 * fq;
        const f32x4 bg0 = *(const f32x4*)bwp, bg1 = *(const f32x4*)(bwp + 4), bu0 = *(const f32x4*)(bwp + HALF), bu1 = *(const f32x4*)(bwp + HALF + 4);
#pragma unroll
        for (int ai = 0; ai < 2; ++ai)
#pragma unroll
            for (int m = 0; m < 4; ++m) { const size_t row = rowb + ai * HALF + m * 16; const float r = __builtin_amdgcn_rsqf(ssq2[row] * (1.0f / 1024.0f) + RMS_EPS);
                f32x4 g0 = acc[ai][0][m][0] * r + bg0, g1 = acc[ai][0][m][1] * r + bg1; const f32x4 u0 = acc[ai][1][m][0] * r + bu0, u1 = acc[ai][1][m][1] * r + bu1;
#pragma unroll
                for (int i = 0; i < 4; ++i) { g0[i] = g0[i] * sigmoidf_(g0[i]) * u0[i]; g1[i] = g1[i] * sigmoidf_(g1[i]) * u1[i]; }
                u32x4 w; w.x = cvt_pk_bf16(g0[0], g0[1]); w.y = cvt_pk_bf16(g0[2], g0[3]); w.z = cvt_pk_bf16(g1[0], g1[1]); w.w = cvt_pk_bf16(g1[2], g1[3]);
                *(u32x4*)(O + row * 2816 + col0) = w; }
    }
};

template <class Epi, class Sched, bool ALIGN_EPI = false, bool SP2 = false>
__device__ __forceinline__ void gemm_phase(PG8_LAS unsigned char* lds, const Gemm g, const Sched& S, const Epi& E) {
    const int tid = otid(), wid = __builtin_amdgcn_readfirstlane(tid >> 6), lane = tid & 63, wr = wid >> 2, wc = wid & 3, fr = lane & 15, fq = lane >> 4;
    const int K = g.K, lda = g.lda, nt = K / BK;
    unsigned voffA[2], voffB[2];
#pragma unroll
    for (int i = 0; i < 2; ++i) { int R, C; stage_rc(tid * 16 + i * 8192, R, C); const int Rb = Epi::PERM ? ((R & ~31) + perm32(R & 31)) : R;
        voffA[i] = (unsigned)(R * lda + C) * 2u; voffB[i] = (unsigned)(Rb * K + C) * 2u; }
    const size_t kstep = (size_t)(BK * 2);
    const size_t hstepB = (size_t)HALF * K * 2, hstepA = (size_t)HALF * lda * 2;
    const size_t tstepB = 2 * hstepB, tstepA = 2 * hstepA;
    const unsigned ldsw = (unsigned)wid * 1024u;
    const int aoff = lds_byte(wr * 64 + fr, fq * 8), boff = lds_byte(wc * 32 + fr, fq * 8);
#define PG8_SA(b, h) (((b) * 2 + (h)) * HTB)
#define PG8_SB(b, h) ((4 + (b) * 2 + (h)) * HTB)
#define PG8_STAGE(bufoff, gbase, voff) do { _Pragma("unroll") for (int _i = 0; _i < 2; ++_i) \
        __builtin_amdgcn_global_load_lds((const unsigned*)((const char*)(gbase) + (voff)[_i]), (PG8_LAS unsigned*)(lds + (bufoff) + ldsw + _i * 8192), 16, 0, 0); } while (0)
#define PG8_LDA(dst, b, h) do { _Pragma("unroll") for (int m = 0; m < 4; ++m) _Pragma("unroll") for (int k = 0; k < 2; ++k) dst[m][k] = *(const PG8_LAS bf16x8*)(lds + PG8_SA(b, h) + aoff + m * 2048 + k * 1024); } while (0)
#define PG8_LDB(dst, b, h) do { _Pragma("unroll") for (int n = 0; n < 2; ++n) _Pragma("unroll") for (int k = 0; k < 2; ++k) dst[n][k] = *(const PG8_LAS bf16x8*)(lds + PG8_SB(b, h) + boff + n * 2048 + k * 1024); } while (0)
#define PG8_MMA(ai, bj, At, Bt) do { __builtin_amdgcn_s_setprio(1); _Pragma("unroll") for (int m = 0; m < 4; ++m) _Pragma("unroll") for (int n = 0; n < 2; ++n) _Pragma("unroll") for (int k = 0; k < 2; ++k) \
        acc[ai][bj][m][n] = __builtin_amdgcn_mfma_f32_16x16x32_bf16(Bt[n][k], At[m][k], acc[ai][bj][m][n], 0, 0, 0); __builtin_amdgcn_s_setprio(0); } while (0)
#define PG8_WAIT_V(n) asm volatile("s_waitcnt vmcnt(" #n ")" ::: "memory")
#define PG8_WAIT_L(n) asm volatile("s_waitcnt lgkmcnt(" #n ")" ::: "memory")
#define PG8_BAR __builtin_amdgcn_s_barrier()
#define PG8_SCHED __builtin_amdgcn_sched_barrier(0)
    Unit cur, nxt; int ui = 0;
    if (!S.next(0, cur)) return;
    f32x4 acc[2][2][4][2];
#pragma unroll
    for (int a = 0; a < 2; ++a)
#pragma unroll
        for (int b = 0; b < 2; ++b)
#pragma unroll
            for (int m = 0; m < 4; ++m)
#pragma unroll
                for (int n = 0; n < 2; ++n) acc[a][b][m][n] = (f32x4){0.f, 0.f, 0.f, 0.f};
    bf16x8 At[4][2], B0[2][2], B1[2][2];
    const char* cA = (const char*)g.A + (size_t)cur.pm * tstepA + (cur.pn >= g.asplit ? (size_t)g.aoff2 * 2 : 0); const char* cB = (const char*)g.Bt + (size_t)cur.pn * tstepB;
    S.a_ready(cur);
    if constexpr (SP2) {
        PG8_STAGE(PG8_SB(0, 0), cB, voffB); PG8_STAGE(PG8_SB(0, 1), cB + hstepB, voffB); PG8_STAGE(PG8_SA(0, 0), cA, voffA); PG8_STAGE(PG8_SA(0, 1), cA + hstepA, voffA);
        if (wr == 1) PG8_BAR;
        PG8_WAIT_V(2); PG8_BAR;
        PG8_STAGE(PG8_SB(1, 0), cB + kstep, voffB); PG8_STAGE(PG8_SA(1, 0), cA + kstep, voffA); PG8_STAGE(PG8_SB(1, 1), cB + hstepB + kstep, voffB);
        PG8_WAIT_V(6); PG8_BAR;
    } else {
        PG8_STAGE(PG8_SB(0, 0), cB, voffB); PG8_STAGE(PG8_SA(0, 0), cA, voffA); PG8_STAGE(PG8_SB(0, 1), cB + hstepB, voffB); PG8_STAGE(PG8_SA(0, 1), cA + hstepA, voffA);
        if (wr == 1) PG8_BAR;
        PG8_WAIT_V(4); PG8_BAR;
        PG8_STAGE(PG8_SB(1, 0), cB + kstep, voffB); PG8_STAGE(PG8_SA(1, 0), cA + kstep, voffA); PG8_STAGE(PG8_SB(1, 1), cB + hstepB + kstep, voffB);
        PG8_WAIT_V(6); PG8_BAR;
    }
    for (;;) {
        const bool has_next = S.next(ui + 1, nxt);
        const char* nA = has_next ? (const char*)g.A + (size_t)nxt.pm * tstepA + (nxt.pn >= g.asplit ? (size_t)g.aoff2 * 2 : 0) : cA; const char* nB = has_next ? (const char*)g.Bt + (size_t)nxt.pn * tstepB : cB;
        for (int t = 0; t < nt; t += 2) {
            const bool last = (t == nt - 2);
            if constexpr (Epi::MIDHOOK) { if (t == (nt >> 1)) E.mid(acc, cur, wr, wc); }
            const char* a1 = cA + (size_t)(t + 1) * kstep;
            const char* a2 = last ? nA : cA + (size_t)(t + 2) * kstep; const char* b2 = last ? nB : cB + (size_t)(t + 2) * kstep;
            const char* a3 = a2 + kstep; const char* b3 = b2 + kstep;
            if (last && has_next) S.a_ready(nxt);
            if constexpr (SP2) {
            PG8_LDB(B0, 0, 0); PG8_LDB(B1, 0, 1); PG8_SCHED; PG8_LDA(At, 0, 0); PG8_STAGE(PG8_SA(1, 1), a1 + hstepA, voffA);
            PG8_WAIT_V(8); PG8_WAIT_L(0); PG8_BAR; PG8_MMA(0, 0, At, B0); PG8_MMA(0, 1, At, B1); PG8_BAR; PG8_SCHED;
            PG8_LDA(At, 0, 1); PG8_STAGE(PG8_SB(0, 0), b2, voffB); PG8_STAGE(PG8_SB(0, 1), b2 + hstepB, voffB); PG8_STAGE(PG8_SA(0, 0), a2, voffA);
            PG8_WAIT_V(8); PG8_WAIT_L(0); PG8_BAR; PG8_MMA(1, 0, At, B0); PG8_MMA(1, 1, At, B1); PG8_BAR; PG8_SCHED;
            PG8_LDB(B0, 1, 0); PG8_LDB(B1, 1, 1); PG8_SCHED; PG8_LDA(At, 1, 0); PG8_STAGE(PG8_SA(0, 1), a2 + hstepA, voffA);
            PG8_WAIT_V(8); PG8_WAIT_L(0); PG8_BAR; PG8_MMA(0, 0, At, B0); PG8_MMA(0, 1, At, B1); PG8_BAR; PG8_SCHED;
            PG8_LDA(At, 1, 1); PG8_STAGE(PG8_SB(1, 0), b3, voffB); PG8_STAGE(PG8_SB(1, 1), b3 + hstepB, voffB); PG8_STAGE(PG8_SA(1, 0), a3, voffA);
            PG8_WAIT_V(8); PG8_WAIT_L(0); PG8_BAR; PG8_MMA(1, 0, At, B0); PG8_MMA(1, 1, At, B1); PG8_BAR; PG8_SCHED;
            } else {
            PG8_LDB(B0, 0, 0); PG8_SCHED; PG8_LDA(At, 0, 0); PG8_STAGE(PG8_SA(1, 1), a1 + hstepA, voffA);
            PG8_WAIT_L(8); PG8_BAR; PG8_WAIT_L(0); PG8_MMA(0, 0, At, B0); PG8_BAR; PG8_SCHED;
            PG8_LDB(B1, 0, 1); PG8_STAGE(PG8_SB(0, 0), b2, voffB);
            PG8_BAR; PG8_WAIT_L(0); PG8_MMA(0, 1, At, B1); PG8_BAR;
            PG8_LDA(At, 0, 1); PG8_STAGE(PG8_SA(0, 0), a2, voffA);
            PG8_BAR; PG8_WAIT_L(0); PG8_MMA(1, 0, At, B0); PG8_BAR; PG8_SCHED;
            PG8_STAGE(PG8_SB(0, 1), b2 + hstepB, voffB);
            PG8_WAIT_V(6); PG8_BAR; PG8_MMA(1, 1, At, B1); PG8_BAR;
            PG8_LDB(B0, 1, 0); PG8_SCHED; PG8_LDA(At, 1, 0); PG8_STAGE(PG8_SA(0, 1), a2 + hstepA, voffA);
            PG8_WAIT_L(8); PG8_BAR; PG8_WAIT_L(0); PG8_MMA(0, 0, At, B0); PG8_BAR; PG8_SCHED;
            PG8_LDB(B1, 1, 1); PG8_STAGE(PG8_SB(1, 0), b3, voffB);
            PG8_BAR; PG8_WAIT_L(0); PG8_MMA(0, 1, At, B1); PG8_BAR;
            PG8_LDA(At, 1, 1); PG8_STAGE(PG8_SA(1, 0), a3, voffA);
            PG8_BAR; PG8_WAIT_L(0); PG8_MMA(1, 0, At, B0); PG8_BAR; PG8_SCHED;
            PG8_STAGE(PG8_SB(1, 1), b3 + hstepB, voffB);
            PG8_WAIT_V(6); PG8_BAR; PG8_MMA(1, 1, At, B1); PG8_BAR;
            }
        }
        if constexpr (ALIGN_EPI) { if (wr == 0) PG8_BAR; }
        if constexpr (!Epi::AFTER_DRAIN) { E(acc, cur, wr, wc, fr, fq); S.done(cur); }
        if (!has_next) break;
#pragma unroll
        for (int a = 0; a < 2; ++a)
#pragma unroll
            for (int b = 0; b < 2; ++b)
#pragma unroll
                for (int m = 0; m < 4; ++m)
#pragma unroll
                    for (int n = 0; n < 2; ++n) acc[a][b][m][n] = (f32x4){0.f, 0.f, 0.f, 0.f};
        cur = nxt; cA = nA; cB = nB; ++ui;
        if constexpr (ALIGN_EPI) { if (wr == 1) PG8_BAR; }
    }
    PG8_WAIT_V(0);
    if constexpr (!ALIGN_EPI) { if (wr == 0) PG8_BAR; }
    PG8_BAR;
    if constexpr (Epi::AFTER_DRAIN) { E.fused(acc, cur, wr, wc, fr, fq, lds, wid, lane); S.done(cur); }
#undef PG8_SA
#undef PG8_SB
#undef PG8_STAGE
#undef PG8_LDA
#undef PG8_LDB
#undef PG8_MMA
#undef PG8_WAIT_V
#undef PG8_WAIT_L
#undef PG8_BAR
#undef PG8_SCHED
}
}

constexpr int NB = 16, SEQ = 4096, DM = 1024, DEPTH = 4, NTOK = NB * SEQ, NH = 8, FFH = 2816, NIN = 4096, INC = 4000;
constexpr int NWAVES = 8, NTHR = 512;
constexpr int LDS_BYTES = 147456, RING_BYTES = 131072;
constexpr size_t MiB = 1u << 20;
constexpr size_t WS_H = 0;
constexpr size_t WS_PA = 128 * MiB;
constexpr size_t WS_DIL = 192 * MiB;
constexpr size_t WS_GATES = 384 * MiB;
constexpr size_t WS_HID = 128 * MiB;
constexpr size_t WS_KVRAW = 640 * MiB;
constexpr size_t WS_K = 768 * MiB;
constexpr size_t WS_V = 864 * MiB;
constexpr size_t WS_W = 928 * MiB, WS_WSTRIDE = 30 * MiB;
constexpr size_t W_IN = 0, W_Q = W_IN + (size_t)NIN * 1024 * 2, W_KV = W_Q + 768 * 256 * 2, W_A = W_KV + 1024 * 256 * 2, W_B = W_A + 1024 * 512 * 2,
                 W_O = W_B + 1024 * 512 * 2, W_1 = W_O + 1024 * 1024 * 2, W_2 = W_1 + (size_t)5632 * 1024 * 2, W_END = W_2 + (size_t)1024 * 2816 * 2;
constexpr size_t WS_MOD = 988 * MiB;
constexpr size_t WS_ROPE = 990 * MiB;
constexpr size_t WS_SSQ = 998 * MiB;
constexpr size_t WS_LSE = 999 * MiB;
constexpr size_t WS_BT = 1001 * MiB;
constexpr size_t WS_SSQKR = 1001 * MiB + 65536;
constexpr size_t WS_BW1 = 1002 * MiB;
constexpr size_t WS_BW2 = 1003 * MiB;
constexpr size_t WS_CTL = 1005 * MiB, CTL_BYTES = 65536;
constexpr size_t WS_END = 1006 * MiB;
static_assert(W_END <= WS_WSTRIDE && WS_W + 2 * WS_WSTRIDE <= WS_MOD, "weights fit");
static_assert(pg8::EpiRowScale2::O_Q == WS_H && pg8::EpiRowScale2::O_PA == WS_PA && pg8::EpiRowScale2::O_K == WS_K && pg8::EpiRowScale2::O_V == WS_V && pg8::EpiRowScale2::O_ROPE == WS_ROPE && pg8::EpiRowScale2::O_SSQ == WS_SSQ && pg8::EpiRowScale2::O_SSQKR == WS_SSQKR, "EpiRowScale2 offsets");
static_assert(WS_HID + (size_t)NTOK * FFH * 2 <= WS_KVRAW, "hid overlay");

#define LAS __attribute__((address_space(3)))
typedef unsigned short bf16_t;
typedef short bf16x8 __attribute__((ext_vector_type(8)));
typedef short s16x4 __attribute__((ext_vector_type(4)));
typedef float f32x4 __attribute__((ext_vector_type(4)));
typedef float f32x16 __attribute__((ext_vector_type(16)));
typedef unsigned u32x4 __attribute__((ext_vector_type(4)));
typedef unsigned u32x2 __attribute__((ext_vector_type(2)));
using pg8::cvt_pk_bf16; using pg8::bf_lo; using pg8::bf_hi;

struct Params {
    const float *x, *c; const int* pos; const float *rel_bias, *norm1_g, *norm2_g, *ada_w, *ada_b, *w_in, *q_a_norm, *w_q_b, *kv_a_norm, *w_kv_b, *q_norm_a, *k_norm_a, *q_norm_b, *k_norm_b,
        *w_branch_a, *w_branch_b, *w_out, *w_ffn_gate, *w_ffn_up, *w_ffn_down;
    float* out; unsigned char* ws;
    float inv_freq[16];
    int ph_lo, ph_hi;
};

__device__ __forceinline__ float wave_sum(float v) {
#pragma unroll
    for (int o = 1; o < 64; o <<= 1) v += __shfl_xor(v, o);
    return v;
}
#define LDS_WAIT() asm volatile("s_waitcnt lgkmcnt(0)" ::: "memory")

__device__ __forceinline__ void phase0(const Params& P, LAS unsigned char* lds, int G) {
    const int tid = otid(), lane = tid & 63, wid = __builtin_amdgcn_readfirstlane(tid >> 6);
    float* MOD = (float*)(P.ws + WS_MOD); float* ROPE = (float*)(P.ws + WS_ROPE); float* BT = (float*)(P.ws + WS_BT);
    const int gtid = obid() * NTHR + tid, nthr = G * NTHR;
    for (int idx = gtid; idx < NTOK * 16; idx += nthr) { const int t = idx >> 4, i = idx & 15;
        const float ang = (float)P.pos[t] * P.inv_freq[i];
        double rev = (double)ang * 0.15915494309189535; rev -= __builtin_rint(rev); const float f = (float)rev;
        ROPE[t * 32 + i] = __builtin_amdgcn_cosf(f); ROPE[t * 32 + 16 + i] = __builtin_amdgcn_sinf(f); }
    for (int idx = gtid; idx < 3 * 8 * 129; idx += nthr) { const int j = idx % 129, h = (idx / 129) & 7, p = idx / (129 * 8);
        const int dil = p == 0 ? 1 : (p == 1 ? 4 : 16); const int rp = (j - 64) * dil; const int n = rp < 0 ? -rp : rp; int bk = rp > 0 ? 16 : 0;
        if (n < 8) bk += n; else { const float nf = (float)n; int lg = 8 + (int)(__logf(nf * 0.125f) / 4.852030263919617f * 8.0f); bk += lg < 15 ? lg : 15; }
        BT[idx] = P.rel_bias[bk * 8 + h] * pg8::LOG2E; }
    LAS float* sC = (LAS float*)lds;
    LAS float* red = (LAS float*)(lds + 65536);
    for (int i = tid; i < 16 * 1024; i += NTHR) { const float v = P.c[i]; sC[i] = v / (1.0f + __expf(-v)); }
    __syncthreads();
    for (int it = obid(); it < 4 * 96; it += G) { const int l = it / 96, cb = it % 96; const int col = cb * 64 + lane;
        float a[16];
#pragma unroll
        for (int b = 0; b < 16; ++b) a[b] = 0.f;
        const float* wp = P.ada_w + ((size_t)l * 1024 + wid * 128) * 6144 + col;
#pragma unroll 16
        for (int k = 0; k < 128; ++k) { const float w = wp[(size_t)k * 6144];
#pragma unroll
            for (int b = 0; b < 16; ++b) a[b] += sC[b * 1024 + wid * 128 + k] * w; }
#pragma unroll
        for (int b = 0; b < 16; ++b) red[(wid * 16 + b) * 64 + lane] = a[b];
        __syncthreads();
        for (int o = tid; o < 1024; o += NTHR) { const int b = o >> 6, ln = o & 63; float s = 0.f;
#pragma unroll
            for (int w = 0; w < 8; ++w) s += red[(w * 16 + b) * 64 + ln];
            MOD[((size_t)l * 16 + b) * 6144 + cb * 64 + ln] = s + P.ada_b[l * 6144 + cb * 64 + ln]; }
        __syncthreads();
    }
}

__device__ __forceinline__ void tr_item(const float* W, int Nsrc, int k0, int j0, const float* kscale, bf16_t* WT, int Kdst, int R0, LAS float* scr, int lane) {
    if (j0 >= 0) {
#pragma unroll 8
        for (int i = 0; i < 32; ++i) { const int kk = 2 * i + (lane >> 5); float v = W[(size_t)(k0 + kk) * Nsrc + j0 + (lane & 31)]; if (kscale) v *= kscale[k0 + kk]; scr[kk * 33 + (lane & 31)] = v; }
    } else {
#pragma unroll 8
        for (int i = 0; i < 32; ++i) { const int kk = 2 * i + (lane >> 5); scr[kk * 33 + (lane & 31)] = 0.f; }
    }
    LDS_WAIT();
    const int c = lane & 7;
#pragma unroll
    for (int j = 0; j < 4; ++j) { const int n = (lane >> 3) + 8 * j; const LAS float* s = scr + (8 * c) * 33 + n;
        u32x4 o; o.x = cvt_pk_bf16(s[0 * 33], s[1 * 33]); o.y = cvt_pk_bf16(s[2 * 33], s[3 * 33]); o.z = cvt_pk_bf16(s[4 * 33], s[5 * 33]); o.w = cvt_pk_bf16(s[6 * 33], s[7 * 33]);
        *(u32x4*)(WT + (size_t)(R0 + n) * Kdst + k0 + 8 * c) = o; }
    LDS_WAIT();
}
__device__ __forceinline__ int win_src_col(int R0) {
    const int pn = R0 >> 8, rho = R0 & 255;
    if (pn == 0) return rho;
    if (pn == 1) return rho < 160 ? 256 + rho : -1;
    if (pn < 6) { const int wc = (rho >> 5) & 3, dd = 32 * (rho >> 7); const int sec = (pn - 2) >> 1, head = 4 * ((pn - 2) & 1) + wc; return 416 + sec * 512 + head * 64 + dd; }
    if (pn < 8) return 416 + 1024 + (R0 - 1536);
    return 1952 + (R0 - 2048);
}
__device__ __forceinline__ void conv_weights(const Params& P, int l, unsigned char* wb, LAS unsigned char* lds, int G) {
    const int tid = otid(), lane = tid & 63, wid = __builtin_amdgcn_readfirstlane(tid >> 6);
    LAS float* scr = (LAS float*)(lds + wid * 16384);
    constexpr int I_IN = 16 * 128, I_Q = 4 * 24, I_KV = 4 * 32, I_A = 8 * 32, I_B = 8 * 32, I_O = 16 * 32, I_1 = 16 * 176, I_2 = 44 * 32;
    constexpr int NIT = I_IN + I_Q + I_KV + I_A + I_B + I_O + I_1 + I_2;
    for (int it = obid() * NWAVES + wid; it < NIT; it += G * NWAVES) {
        int r = it;
        if (r < I_IN) { const int kb = r / 128, rb = r % 128; tr_item(P.w_in + (size_t)l * 1024 * INC, INC, kb * 64, win_src_col(rb * 32), nullptr, (bf16_t*)(wb + W_IN), 1024, rb * 32, scr, lane); continue; } r -= I_IN;
        if (r < I_Q) { const int kb = r / 24, rb = r % 24; tr_item(P.w_q_b + (size_t)l * 256 * 768, 768, kb * 64, rb * 32, P.q_a_norm + l * 256, (bf16_t*)(wb + W_Q), 256, rb * 32, scr, lane); continue; } r -= I_Q;
        if (r < I_KV) { const int kb = r / 32, rb = r % 32; const int R0 = rb * 32, pnl = R0 >> 8, rho = R0 & 255, wcq = (rho >> 5) & 3;
            const int jsrc = (pnl * 2 + (wcq & 1)) * 128 + (wcq >= 2 ? 64 : 0) + 32 * (rho >> 7);
            tr_item(P.w_kv_b + (size_t)l * 128 * 1024, 1024, kb * 64, kb < 2 ? jsrc : -1, P.kv_a_norm + l * 128, (bf16_t*)(wb + W_KV), 256, R0, scr, lane); continue; } r -= I_KV;
        if (r < I_A) { const int kb = r / 32, rb = r % 32; tr_item(P.w_branch_a + (size_t)l * 512 * 1024, 1024, kb * 64, rb * 32, nullptr, (bf16_t*)(wb + W_A), 1024, rb * 32, scr, lane); continue; } r -= I_A;
        if (r < I_B) { const int kb = r / 32, rb = r % 32; tr_item(P.w_branch_b + (size_t)l * 512 * 1024, 1024, kb * 64, rb * 32, nullptr, (bf16_t*)(wb + W_A) + 512, 1024, rb * 32, scr, lane); continue; } r -= I_B;
        if (r < I_O) { const int kb = r / 32, rb = r % 32; tr_item(P.w_out + (size_t)l * 1024 * 1024, 1024, kb * 64, rb * 32, nullptr, (bf16_t*)(wb + W_O), 1024, rb * 32, scr, lane); continue; } r -= I_O;
        if (r < I_1) { const int kb = r / 176, rb = r % 176; const int R0 = rb * 32, pn = R0 >> 8, rho = R0 & 255;
            const float* src = (rho < 128 ? P.w_ffn_gate : P.w_ffn_up) + (size_t)l * 1024 * FFH;
            tr_item(src, FFH, kb * 64, pn * 128 + (rho & 127), nullptr, (bf16_t*)(wb + W_1), 1024, R0, scr, lane); continue; } r -= I_1;
        { const int kb = r / 32, rb = r % 32; tr_item(P.w_ffn_down + (size_t)l * FFH * 1024, 1024, kb * 64, rb * 32, nullptr, (bf16_t*)(wb + W_2), FFH, rb * 32, scr, lane); }
    }
}

__device__ __forceinline__ void norm_phase(const float* xin, const float* g, const float* mod  , int sh_off, int sc_off, bf16_t* H, int G) {
    const int tid = otid(), lane = tid & 63, wid = __builtin_amdgcn_readfirstlane(tid >> 6);
    for (int m = obid() * NWAVES + wid; m < NTOK; m += G * NWAVES) {
        const f32x4* xr = (const f32x4*)(xin + (size_t)m * DM) + lane; f32x4 v[4]; float s = 0.f;
#pragma unroll
        for (int j = 0; j < 4; ++j) { v[j] = xr[64 * j]; s += (v[j][0] * v[j][0] + v[j][1] * v[j][1]) + (v[j][2] * v[j][2] + v[j][3] * v[j][3]); }
        const float r = __builtin_amdgcn_rsqf(wave_sum(s) * (1.0f / DM) + pg8::RMS_EPS);
        const float* mb = mod + (size_t)(m >> 12) * 6144;
#pragma unroll
        for (int j = 0; j < 4; ++j) { const int col = 4 * lane + 256 * j;
            const f32x4 gv = *(const f32x4*)(g + col), sc = *(const f32x4*)(mb + sc_off + col), sh = *(const f32x4*)(mb + sh_off + col);
            const f32x4 o = (v[j] * r) * gv * (1.0f + sc) + sh;
            u32x2 w; w.x = cvt_pk_bf16(o[0], o[1]); w.y = cvt_pk_bf16(o[2], o[3]);
            *(u32x2*)(H + (size_t)m * DM + col) = w; }
    }
}

__device__ __forceinline__ void prepass_phase(const float* xin, const float* g, const float* mod  , int sc_off, bf16_t* XG, float* ssq, int G) {
    const int tid = otid(), lane = tid & 63, wid = __builtin_amdgcn_readfirstlane(tid >> 6);
    for (int m = obid() * NWAVES + wid; m < NTOK; m += G * NWAVES) {
        const f32x4* xr = (const f32x4*)(xin + (size_t)m * DM) + lane; float s = 0.f;
        const float* mb = mod + (size_t)(m >> 12) * 6144;
#pragma unroll
        for (int j = 0; j < 4; ++j) { const f32x4 v = xr[64 * j]; s += (v[0] * v[0] + v[1] * v[1]) + (v[2] * v[2] + v[3] * v[3]); const int col = 4 * lane + 256 * j;
            const f32x4 o = v * *(const f32x4*)(g + col) * (1.0f + *(const f32x4*)(mb + sc_off + col));
            u32x2 w; w.x = cvt_pk_bf16(o[0], o[1]); w.y = cvt_pk_bf16(o[2], o[3]);
            *(u32x2*)(XG + (size_t)m * DM + col) = w; }
        s = wave_sum(s);
        if (lane == 0) ssq[m] = s;
    }
}
__device__ __forceinline__ void bias_phase(const Params& P, LAS unsigned char* lds, int G) {
    const int tid = otid(), lane = tid & 63, wid = __builtin_amdgcn_readfirstlane(tid >> 6);
    const float* MOD = (const float*)(P.ws + WS_MOD); float* BW1 = (float*)(P.ws + WS_BW1); float* BW2 = (float*)(P.ws + WS_BW2);
    LAS float* sC = (LAS float*)lds;
    LAS float* red = (LAS float*)(lds + 65536);
    for (int it = obid(); it < 4 * 152; it += G) { const int l = it / 152, blk = it % 152; const bool ffn = blk >= 64; const int R0 = (ffn ? blk - 64 : blk) * 64;
        __syncthreads();
        for (int i = tid; i < 16 * 1024; i += NTHR) sC[i] = MOD[((size_t)l * 16 + (i >> 10)) * 6144 + (ffn ? 3072 : 0) + (i & 1023)];
        __syncthreads();
        const int R = R0 + lane; const float* wsrc; int j; size_t ncol;
        if (!ffn) { const int jb = win_src_col(R & ~31); j = jb < 0 ? -1 : jb + (R & 31); wsrc = P.w_in + (size_t)l * 1024 * INC; ncol = INC; }
        else { const int pn = R >> 8, rho = R & 255; j = pn * 128 + (rho & 127); wsrc = (rho < 128 ? P.w_ffn_gate : P.w_ffn_up) + (size_t)l * 1024 * FFH; ncol = FFH; }
        float a[16];
#pragma unroll
        for (int b = 0; b < 16; ++b) a[b] = 0.f;
        if (j >= 0) { const float* wp = wsrc + (size_t)(wid * 128) * ncol + j;
#pragma unroll 16
            for (int k = 0; k < 128; ++k) { const float w = wp[(size_t)k * ncol];
#pragma unroll
                for (int b = 0; b < 16; ++b) a[b] += sC[b * 1024 + wid * 128 + k] * w; } }
#pragma unroll
        for (int b = 0; b < 16; ++b) red[(wid * 16 + b) * 64 + lane] = a[b];
        __syncthreads();
        for (int o = tid; o < 1024; o += NTHR) { const int b = o >> 6, ln = o & 63; float s = 0.f;
#pragma unroll
            for (int w = 0; w < 8; ++w) s += red[(w * 16 + b) * 64 + ln];
            if (!ffn) BW1[((size_t)l * 16 + b) * 4096 + R0 + ln] = s; else BW2[((size_t)l * 16 + b) * 5632 + R0 + ln] = s; }
    }
    __syncthreads();
}

__device__ __forceinline__ void unpack8(const u32x4 w, float* f) { f[0] = bf_lo(w.x); f[1] = bf_hi(w.x); f[2] = bf_lo(w.y); f[3] = bf_hi(w.y); f[4] = bf_lo(w.z); f[5] = bf_hi(w.z); f[6] = bf_lo(w.w); f[7] = bf_hi(w.w); }
__device__ __forceinline__ u32x4 pack8(const float* f) { u32x4 w; w.x = cvt_pk_bf16(f[0], f[1]); w.y = cvt_pk_bf16(f[2], f[3]); w.z = cvt_pk_bf16(f[4], f[5]); w.w = cvt_pk_bf16(f[6], f[7]); return w; }
__device__ __forceinline__ float ssq8(const u32x4 w) { float f[8]; unpack8(w, f); return ((f[0] * f[0] + f[1] * f[1]) + (f[2] * f[2] + f[3] * f[3])) + ((f[4] * f[4] + f[5] * f[5]) + (f[6] * f[6] + f[7] * f[7])); }
__device__ __forceinline__ void head_norm_rope(const bf16_t* src_nope, const bf16_t* src_rope, bf16_t* dst, const float* gain, const float* rope, float oscale) {
    float s = 0.f;
#pragma unroll
    for (int c = 0; c < 8; ++c) s += ssq8(*(const u32x4*)(src_nope + 8 * c));
#pragma unroll
    for (int c = 0; c < 4; ++c) s += ssq8(*(const u32x4*)(src_rope + 8 * c));
    const float r = __builtin_amdgcn_rsqf(s * (1.0f / 96.0f) + pg8::RMS_EPS);
    asm volatile("" ::: "memory");
#pragma unroll
    for (int c = 0; c < 8; ++c) { float f[8]; unpack8(*(const u32x4*)(src_nope + 8 * c), f);
#pragma unroll
        for (int i = 0; i < 8; ++i) f[i] = f[i] * r * gain[8 * c + i] * oscale;
        *(u32x4*)(dst + 8 * c) = pack8(f); asm volatile("" ::: "memory"); }
    float x[32];
#pragma unroll
    for (int c = 0; c < 4; ++c) unpack8(*(const u32x4*)(src_rope + 8 * c), x + 8 * c);
#pragma unroll
    for (int i = 0; i < 32; ++i) x[i] = x[i] * r * gain[64 + i];
#pragma unroll
    for (int i = 0; i < 16; ++i) { const float cs = rope[i], sn = rope[16 + i]; const float x1 = x[i], x2 = x[16 + i]; x[i] = (x1 * cs - x2 * sn) * oscale; x[16 + i] = (x2 * cs + x1 * sn) * oscale; }
#pragma unroll
    for (int c = 0; c < 4; ++c) *(u32x4*)(dst + 64 + 8 * c) = pack8(x + 8 * c);
    asm volatile("" ::: "memory");
}
__device__ __forceinline__ void prep_phase(const Params& P, int l, int G) {
    const bf16_t* KVRAW = (const bf16_t*)(P.ws + WS_KVRAW); const bf16_t* PA = (const bf16_t*)(P.ws + WS_PA);
    bf16_t* K = (bf16_t*)(P.ws + WS_K); const float* ROPE = (const float*)(P.ws + WS_ROPE);
    const float* kg = P.k_norm_a + l * 96;
    for (int idx = obid() * NTHR + otid(); idx < NTOK * NH; idx += G * NTHR) { const int t = idx >> 3, h = idx & 7;
        const float* rp = ROPE + (size_t)t * 32;
        const bf16_t* kp = KVRAW + (size_t)t * 1024 + h * 128;
        const size_t hrow = ((size_t)((t >> 12) * 8 + h) << 12) + (t & 4095);
        head_norm_rope(kp, PA + (size_t)t * 512 + 384, K + hrow * 96, kg, rp, 1.0f);
    }
}
typedef short v4i16_t __attribute__((ext_vector_type(4)));
__device__ __forceinline__ s16x4 vtr(const LAS unsigned char* p) { return __builtin_bit_cast(s16x4, __builtin_amdgcn_ds_read_tr16_b64_v4i16((LAS v4i16_t*)p)); }
__device__ __forceinline__ bf16x8 cat8(s16x4 a, s16x4 b) { return (bf16x8){a[0], a[1], a[2], a[3], b[0], b[1], b[2], b[3]}; }
__device__ __forceinline__ bf16x8 packp(const f32x16& p, int o) {
    u32x4 w; w.x = cvt_pk_bf16(p[o + 0], p[o + 1]); w.y = cvt_pk_bf16(p[o + 2], p[o + 3]); w.z = cvt_pk_bf16(p[o + 4], p[o + 5]); w.w = cvt_pk_bf16(p[o + 6], p[o + 7]);
    return __builtin_bit_cast(bf16x8, w);
}
__device__ __forceinline__ float max16(const f32x16& p) {
    float a = fmaxf(fmaxf(p[0], p[1]), fmaxf(p[2], p[3])), b = fmaxf(fmaxf(p[4], p[5]), fmaxf(p[6], p[7]));
    float c = fmaxf(fmaxf(p[8], p[9]), fmaxf(p[10], p[11])), d = fmaxf(fmaxf(p[12], p[13]), fmaxf(p[14], p[15]));
    return fmaxf(fmaxf(a, b), fmaxf(c, d));
}
#define MFMA32(a, b, c) __builtin_amdgcn_mfma_f32_32x32x16_bf16((a), (b), (c), 0, 0, 0)
constexpr int KP = 208, VP = 192;
constexpr int KT_B = 64 * KP, VT_B = 64 * VP;
constexpr int MLA_K0 = 0, MLA_V0 = 2 * KT_B;

constexpr float MLA_THR = 8.0f;
__device__ __forceinline__ float max3f(float a, float b, float c) { float r; asm("v_max3_f32 %0, %1, %2, %3" : "=v"(r) : "v"(a), "v"(b), "v"(c)); return r; }
__device__ __forceinline__ float rowmax32(const f32x16& a, const f32x16& b) {
    float x = max3f(a[0], a[1], a[2]), y = max3f(b[0], b[1], b[2]);
    x = max3f(x, a[3], a[4]); y = max3f(y, b[3], b[4]); x = max3f(x, a[5], a[6]); y = max3f(y, b[5], b[6]); x = max3f(x, a[7], a[8]); y = max3f(y, b[7], b[8]);
    x = max3f(x, a[9], a[10]); y = max3f(y, b[9], b[10]); x = max3f(x, a[11], a[12]); y = max3f(y, b[11], b[12]); x = max3f(x, a[13], a[14]); y = max3f(y, b[13], b[14]);
    x = max3f(x, a[15], b[15]); x = max3f(x, y, y);
    return max3f(x, __shfl_xor(x, 32), x);
}
#define SBAR0() __builtin_amdgcn_sched_barrier(0)
__device__ __forceinline__ void mla_unit(LAS unsigned char* lds, const bf16_t* Q, const bf16_t* K, const bf16_t* V, bf16_t* Y, const float* qgain, const float* ROPE, int b, int h, int qb) {
    const int tid = otid(), lane = tid & 63, wid = __builtin_amdgcn_readfirstlane(tid >> 6), r32 = lane & 31, hi = lane >> 5;
    const size_t tok0 = (size_t)b * SEQ; const size_t qrow = tok0 + qb * 256 + wid * 32 + r32;
    const int kr0 = tid / 12, kc0 = tid % 12, kr1 = (512 + tid) / 12, kc1 = (512 + tid) % 12, vr = tid >> 3, vc = tid & 7;
    const size_t hrow0 = (size_t)(b * 8 + h) * SEQ;
    const bf16_t* kg0 = K + (hrow0 + kr0) * 96 + kc0 * 8; const bf16_t* kg1 = K + (hrow0 + kr1) * 96 + kc1 * 8;
    const bf16_t* vg = V + (hrow0 + vr) * 64 + vc * 8;
    const int kl0 = kr0 * KP + kc0 * 16, kl1 = kr1 * KP + kc1 * 16, vl = vr * VP + vc * 16;
    const bool has1 = tid < 256;
    u32x4 ka0, kb0, ka1, kb1, vv0, vv1;
    ka0 = *(const u32x4*)kg0; if (has1) kb0 = *(const u32x4*)kg1; vv0 = *(const u32x4*)vg;
    ka1 = *(const u32x4*)(kg0 + (size_t)64 * 96); if (has1) kb1 = *(const u32x4*)(kg1 + (size_t)64 * 96);
    bf16x8 qf[6];
    {
        const bf16_t* qp = Q + qrow * 768 + h * 96 + hi * 8; float f[6][8]; float s = 0.f;
#pragma unroll
        for (int d0 = 0; d0 < 6; ++d0) { unpack8(*(const u32x4*)(qp + d0 * 16), f[d0]);
#pragma unroll
            for (int i = 0; i < 8; ++i) s += f[d0][i] * f[d0][i]; }
        s += __shfl_xor(s, 32);
        const float r = __builtin_amdgcn_rsqf(s * (1.0f / 96.0f) + pg8::RMS_EPS);
#pragma unroll
        for (int d0 = 0; d0 < 6; ++d0)
#pragma unroll
            for (int i = 0; i < 8; ++i) f[d0][i] = f[d0][i] * r * qgain[d0 * 16 + hi * 8 + i];
        const float* rp = ROPE + qrow * 32 + hi * 8;
#pragma unroll
        for (int i = 0; i < 8; ++i) { const float cs = rp[i], sn = rp[16 + i]; const float x1 = f[4][i], x2 = f[5][i]; f[4][i] = x1 * cs - x2 * sn; f[5][i] = x2 * cs + x1 * sn; }
#pragma unroll
        for (int d0 = 0; d0 < 6; ++d0) {
#pragma unroll
            for (int i = 0; i < 8; ++i) f[d0][i] *= pg8::QSCALE_A;
            qf[d0] = __builtin_bit_cast(bf16x8, pack8(f[d0])); }
    }
    *(LAS u32x4*)(lds + MLA_K0 + kl0) = ka0; if (has1) *(LAS u32x4*)(lds + MLA_K0 + kl1) = kb0; *(LAS u32x4*)(lds + MLA_V0 + vl) = vv0;
    *(LAS u32x4*)(lds + MLA_K0 + KT_B + kl0) = ka1; if (has1) *(LAS u32x4*)(lds + MLA_K0 + KT_B + kl1) = kb1;
    ka0 = *(const u32x4*)(kg0 + (size_t)128 * 96); if (has1) kb0 = *(const u32x4*)(kg1 + (size_t)128 * 96); vv1 = *(const u32x4*)(vg + (size_t)64 * 64);
    __syncthreads();
    f32x16 o0, o1, negm;
#pragma unroll
    for (int i = 0; i < 16; ++i) { o0[i] = 0.f; o1[i] = 0.f; negm[i] = 0.f; }
    const int koff = r32 * KP + hi * 16;
    const int voff = (4 * hi + ((lane & 15) >> 2)) * VP + (16 * ((lane >> 4) & 1) + 4 * (lane & 3)) * 2;
    f32x16 p0, p1, n0, n1;
    { const LAS unsigned char* kb_ = lds + MLA_K0 + koff; p0 = negm; p1 = negm;
#pragma unroll
      for (int d0 = 0; d0 < 6; ++d0) { const bf16x8 a0 = *(const LAS bf16x8*)(kb_ + d0 * 32), a1 = *(const LAS bf16x8*)(kb_ + 32 * KP + d0 * 32); p0 = MFMA32(a0, qf[d0], p0); p1 = MFMA32(a1, qf[d0], p1); } }
    float m_ref, l_run = 0.f;
    { const float mx = rowmax32(p0, p1); m_ref = mx;
#pragma unroll
      for (int i = 0; i < 16; ++i) { p0[i] -= mx; p1[i] -= mx; negm[i] = -mx; } }
#define MLA_STEP(C0, C1, X0, X1, T, KAI, KBI, VVI, KAW, KBW, VVW) do { const int t_ = (T); const int cur = t_ & 1; \
        if (t_ + 3 < 64) { const size_t go = (size_t)(t_ + 3) * 64; KAI = *(const u32x4*)(kg0 + go * 96); if (has1) KBI = *(const u32x4*)(kg1 + go * 96); } \
        if (t_ + 2 < 64) { const size_t go = (size_t)(t_ + 2) * 64; VVI = *(const u32x4*)(vg + go * 64); } \
        bf16x8 kfr[12]; { const LAS unsigned char* kn = lds + MLA_K0 + (cur ^ 1) * KT_B + koff; \
            _Pragma("unroll") for (int d0 = 0; d0 < 6; ++d0) { kfr[2 * d0] = *(const LAS bf16x8*)(kn + d0 * 32); kfr[2 * d0 + 1] = *(const LAS bf16x8*)(kn + 32 * KP + d0 * 32); } } \
        SBAR0(); \
        const float mx = rowmax32(C0, C1); \
        if (__builtin_amdgcn_ballot_w64(mx > MLA_THR) != 0ull) { const float d = fmaxf(mx, 0.f); const float sc = __builtin_amdgcn_exp2f(-d); m_ref += d; l_run *= sc; \
            _Pragma("unroll") for (int i = 0; i < 16; ++i) { C0[i] -= d; C1[i] -= d; o0[i] *= sc; o1[i] *= sc; negm[i] = -m_ref; } } \
        SBAR0(); \
        X0 = negm; X1 = negm; \
        _Pragma("unroll") for (int d0 = 0; d0 < 6; ++d0) { X0 = MFMA32(kfr[2 * d0], qf[d0], X0); X1 = MFMA32(kfr[2 * d0 + 1], qf[d0], X1); } \
        SBAR0(); \
        float ls = 0.f; \
        _Pragma("unroll") for (int i = 0; i < 16; ++i) { C0[i] = __builtin_amdgcn_exp2f(C0[i]); C1[i] = __builtin_amdgcn_exp2f(C1[i]); ls += C0[i] + C1[i]; } \
        l_run += ls; \
        bf16x8 pb[4]; pb[0] = packp(C0, 0); pb[1] = packp(C0, 8); pb[2] = packp(C1, 0); pb[3] = packp(C1, 8); \
        const LAS unsigned char* vb_ = lds + MLA_V0 + cur * VT_B + voff; \
        _Pragma("unroll") for (int j = 0; j < 4; ++j) { const LAS unsigned char* vj = vb_ + 16 * j * VP; \
            const bf16x8 a0 = cat8(vtr(vj), vtr(vj + 8 * VP)); const bf16x8 a1 = cat8(vtr(vj + 64), vtr(vj + 8 * VP + 64)); \
            o0 = MFMA32(a0, pb[j], o0); o1 = MFMA32(a1, pb[j], o1); } \
        if (t_ + 2 < 64) { *(LAS u32x4*)(lds + MLA_K0 + cur * KT_B + kl0) = KAW; if (has1) *(LAS u32x4*)(lds + MLA_K0 + cur * KT_B + kl1) = KBW; } \
        if (t_ + 1 < 64) *(LAS u32x4*)(lds + MLA_V0 + (cur ^ 1) * VT_B + vl) = VVW; \
        __syncthreads(); } while (0)
    if (wid >= 4) __builtin_amdgcn_s_setprio(1);
    for (int t = 0; t < 64; t += 2) { MLA_STEP(p0, p1, n0, n1, t, ka1, kb1, vv0, ka0, kb0, vv1); MLA_STEP(n0, n1, p0, p1, t + 1, ka0, kb0, vv1, ka1, kb1, vv0); }
    __builtin_amdgcn_s_setprio(0);
#undef MLA_STEP
    const float lt = l_run + __shfl_xor(l_run, 32); const float inv = 1.0f / lt;
    bf16_t* ypb = Y + qrow * 1024 + h * 64;
    u32x2 wv[8];
#pragma unroll
    for (int g = 0; g < 4; ++g) {
        wv[g].x = cvt_pk_bf16(o0[4 * g] * inv, o0[4 * g + 1] * inv); wv[g].y = cvt_pk_bf16(o0[4 * g + 2] * inv, o0[4 * g + 3] * inv);
        wv[4 + g].x = cvt_pk_bf16(o1[4 * g] * inv, o1[4 * g + 1] * inv); wv[4 + g].y = cvt_pk_bf16(o1[4 * g + 2] * inv, o1[4 * g + 3] * inv); }
#pragma unroll
    for (int e = 0; e < 8; e += 2) { const u32x2 snd = hi ? wv[e] : wv[e + 1]; u32x2 rcv; rcv.x = __shfl_xor(snd.x, 32); rcv.y = __shfl_xor(snd.y, 32);
        u32x4 o4; if (hi) { o4.x = rcv.x; o4.y = rcv.y; o4.z = wv[e + 1].x; o4.w = wv[e + 1].y; } else { o4.x = wv[e].x; o4.y = wv[e].y; o4.z = rcv.x; o4.w = rcv.y; }
        *(u32x4*)(ypb + 32 * (e >> 2) + 8 * ((e & 3) + hi)) = o4; }
}

constexpr int DW_BYTES = 13440;
template <int DELTA>
__device__ __forceinline__ void dil_block(LAS unsigned char* wl, const bf16_t* kbase  , const bf16_t* vbase, size_t rstride  ,
                                          const bf16x8 (&qf)[2][4], f32x16 (&o)[2][2], float (&m_run)[2], float (&l_run)[2], int bvar, int voff, int lane, int r32, int hi, int btb) {
    u32x4 vv[8]; bf16x8 kf[2][4];
#pragma unroll
    for (int i = 0; i < 8; ++i) { const int idx = lane + 64 * i, row = idx >> 3, ch = idx & 7; vv[i] = *(const u32x4*)(vbase + (size_t)row * rstride + ch * 8); }
#pragma unroll
    for (int kvh = 0; kvh < 2; ++kvh)
#pragma unroll
        for (int d0 = 0; d0 < 4; ++d0) kf[kvh][d0] = *(const bf16x8*)(kbase + (size_t)(32 * kvh + r32) * rstride + d0 * 16);
    SBAR0();
#pragma unroll
    for (int i = 0; i < 8; ++i) { const int idx = lane + 64 * i, row = idx >> 3, ch = idx & 7; *(LAS u32x4*)(wl + row * VP + ch * 16) = vv[i]; }
    bf16x8 pb[2][4];
#pragma unroll
    for (int qh = 0; qh < 2; ++qh) {
        f32x16 s[2]; float mx = -1e30f;
#pragma unroll
        for (int kvh = 0; kvh < 2; ++kvh) {
            constexpr int dummy = 0; (void)dummy;
            const int toff = 64 * DELTA + 32 * (kvh - qh);
            if (toff > 64 || toff < -64) continue;
#pragma unroll
            for (int i = 0; i < 16; ++i) s[kvh][i] = 0.f;
#pragma unroll
            for (int d0 = 0; d0 < 4; ++d0) s[kvh] = MFMA32(kf[kvh][d0], qf[qh][d0], s[kvh]);
#pragma unroll
            for (int rr = 0; rr < 16; ++rr) { const int c4 = 4 * ((rr & 3) + 8 * (rr >> 2)); const float bias = *(const LAS float*)(wl + bvar + (VT_B + c4 + toff * 4));
                float v = s[kvh][rr] + bias;
                if (toff == 64) v = (bvar <= btb - c4) ? v : -1e30f;
                if (toff == -64) v = (bvar >= btb - c4) ? v : -1e30f;
                s[kvh][rr] = v; mx = fmaxf(mx, v); }
        }
        mx = fmaxf(mx, __shfl_xor(mx, 32));
        const float m_new = fmaxf(m_run[qh], mx); const float alpha = __builtin_amdgcn_exp2f(m_run[qh] - m_new); m_run[qh] = m_new;
        float ls = 0.f;
#pragma unroll
        for (int kvh = 0; kvh < 2; ++kvh) { const int toff = 64 * DELTA + 32 * (kvh - qh);
            if (toff > 64 || toff < -64) continue;
#pragma unroll
            for (int rr = 0; rr < 16; ++rr) { const float e = __builtin_amdgcn_exp2f(s[kvh][rr] - m_new); s[kvh][rr] = e; ls += e; }
            pb[qh][2 * kvh] = packp(s[kvh], 0); pb[qh][2 * kvh + 1] = packp(s[kvh], 8); }
        l_run[qh] = l_run[qh] * alpha + ls;
#pragma unroll
        for (int i = 0; i < 16; ++i) { o[qh][0][i] *= alpha; o[qh][1][i] *= alpha; }
    }
    LDS_WAIT();
#pragma unroll
    for (int j = 0; j < 4; ++j) { const LAS unsigned char* vj = wl + voff + 16 * j * VP;
        const bf16x8 a0 = cat8(vtr(vj), vtr(vj + 8 * VP)); const bf16x8 a1 = cat8(vtr(vj + 64), vtr(vj + 8 * VP + 64));
#pragma unroll
        for (int qh = 0; qh < 2; ++qh) { const int toff = 64 * DELTA + 32 * ((j >> 1) - qh);
            if (toff > 64 || toff < -64) continue;
            o[qh][0] = MFMA32(a0, pb[qh][j], o[qh][0]); o[qh][1] = MFMA32(a1, pb[qh][j], o[qh][1]); } }
    LDS_WAIT();
}
template <int P_>
__device__ __forceinline__ void dil_wave_unit(LAS unsigned char* wl, const bf16_t* DIL, bf16_t* Y, bf16_t* ST, float* LSE, const float* BT, int b, int h, int r, int nb) {
    constexpr int dil = P_ == 0 ? 1 : (P_ == 1 ? 4 : 16), nblk = 64 / dil; constexpr bool first = P_ == 0, last = P_ == 2;
    const int lane = otid() & 63, r32 = lane & 31, hi = lane >> 5;
    const size_t tok0 = (size_t)b * SEQ; const size_t rstride = (size_t)dil * 64;
    LAS float* bt = (LAS float*)(wl + VT_B);
    for (int i = lane; i < 257; i += 64) { int j = i - 64; j = j < 0 ? 0 : (j > 128 ? 128 : j); bt[i] = BT[(P_ * 8 + h) * 129 + j]; }
    const int btb = 128 * 4;
    const int bvar = btb + 4 * (4 * hi - r32);
    bf16x8 qf[2][4];
    const bf16_t* rowb = DIL + ((size_t)(b * 8 + h) * SEQ + (size_t)(64 * nb) * dil + r) * 64;
    constexpr size_t KOFF = pg8::DPLANE, VOFF = 2 * pg8::DPLANE;
#pragma unroll
    for (int qh = 0; qh < 2; ++qh)
#pragma unroll
        for (int d0 = 0; d0 < 4; ++d0) qf[qh][d0] = *(const bf16x8*)(rowb + (size_t)(32 * qh + r32) * rstride + hi * 8 + d0 * 16);
    f32x16 o[2][2];
#pragma unroll
    for (int a = 0; a < 2; ++a)
#pragma unroll
        for (int c = 0; c < 2; ++c)
#pragma unroll
            for (int i = 0; i < 16; ++i) o[a][c][i] = 0.f;
    float m_run[2] = {-1e30f, -1e30f}, l_run[2] = {0.f, 0.f};
    const int voff = (4 * hi + ((lane & 15) >> 2)) * VP + (16 * ((lane >> 4) & 1) + 4 * (lane & 3)) * 2;
    LDS_WAIT();
    dil_block<0>(wl, rowb + KOFF + hi * 8, rowb + VOFF, rstride, qf, o, m_run, l_run, bvar, voff, lane, r32, hi, btb);
    if (nb > 0) dil_block<-1>(wl, rowb - 64 * rstride + KOFF + hi * 8, rowb - 64 * rstride + VOFF, rstride, qf, o, m_run, l_run, bvar, voff, lane, r32, hi, btb);
    if (nb + 1 < nblk) dil_block<1>(wl, rowb + 64 * rstride + KOFF + hi * 8, rowb + 64 * rstride + VOFF, rstride, qf, o, m_run, l_run, bvar, voff, lane, r32, hi, btb);
    float lp[2]; u32x2 pv[2][8];
    if (!first) {
#pragma unroll
        for (int qh = 0; qh < 2; ++qh) { const size_t srow = (size_t)(b * 8 + h) * SEQ + (size_t)(64 * nb + 32 * qh + r32) * dil + r; lp[qh] = LSE[srow];
            const bf16_t* spb = ST + srow * 64;
#pragma unroll
            for (int e = 0; e < 8; e += 2) { const u32x4 L = *(const u32x4*)(spb + 32 * (e >> 2) + 8 * ((e & 3) + hi));
                u32x2 snd; snd.x = hi ? L.x : L.z; snd.y = hi ? L.y : L.w; u32x2 rcv; rcv.x = __shfl_xor(snd.x, 32); rcv.y = __shfl_xor(snd.y, 32);
                if (hi) { pv[qh][e] = rcv; pv[qh][e + 1].x = L.z; pv[qh][e + 1].y = L.w; } else { pv[qh][e].x = L.x; pv[qh][e].y = L.y; pv[qh][e + 1] = rcv; } } }
    }
#pragma unroll
    for (int qh = 0; qh < 2; ++qh) {
        const size_t spos = (size_t)(64 * nb + 32 * qh + r32) * dil + r; const size_t srow = (size_t)(b * 8 + h) * SEQ + spos;
        const float lt = l_run[qh] + __shfl_xor(l_run[qh], 32); const float inv = 1.0f / lt; const float lse2 = m_run[qh] + __builtin_amdgcn_logf(lt);
        float a_prev = 0.f, a_cur = inv, lse_new = lse2;
        if (!first) { const float M = fmaxf(lp[qh], lse2); const float wp = __builtin_amdgcn_exp2f(lp[qh] - M), wc = __builtin_amdgcn_exp2f(lse2 - M); const float den = wp + wc;
            a_prev = wp / den; a_cur = wc / den * inv; lse_new = M + __builtin_amdgcn_logf(den); }
        bf16_t* ypb = last ? Y + (tok0 + spos) * 1024 + 512 + h * 64 : ST + srow * 64;
        u32x2 wv[8];
#pragma unroll
        for (int e = 0; e < 8; ++e) { const int blk = e >> 2, g = e & 3;
            float v0 = o[qh][blk][4 * g] * a_cur, v1 = o[qh][blk][4 * g + 1] * a_cur, v2 = o[qh][blk][4 * g + 2] * a_cur, v3 = o[qh][blk][4 * g + 3] * a_cur;
            if (!first) { v0 += a_prev * bf_lo(pv[qh][e].x); v1 += a_prev * bf_hi(pv[qh][e].x); v2 += a_prev * bf_lo(pv[qh][e].y); v3 += a_prev * bf_hi(pv[qh][e].y); }
            wv[e].x = cvt_pk_bf16(v0, v1); wv[e].y = cvt_pk_bf16(v2, v3); }
#pragma unroll
        for (int e = 0; e < 8; e += 2) { const u32x2 snd = hi ? wv[e] : wv[e + 1]; u32x2 rcv; rcv.x = __shfl_xor(snd.x, 32); rcv.y = __shfl_xor(snd.y, 32);
            u32x4 o4; if (hi) { o4.x = rcv.x; o4.y = rcv.y; o4.z = wv[e + 1].x; o4.w = wv[e + 1].y; } else { o4.x = wv[e].x; o4.y = wv[e].y; o4.z = rcv.x; o4.w = rcv.y; }
            *(u32x4*)(ypb + 32 * (e >> 2) + 8 * ((e & 3) + hi)) = o4; }
        if (!last && hi == 0) LSE[srow] = lse_new;
    }
}
__device__ __forceinline__ void dil_unit(LAS unsigned char* lds, const bf16_t* DIL, bf16_t* Y, bf16_t* ST, float* LSE, const float* BT, int b, int h, int c) {
    const int wid = __builtin_amdgcn_readfirstlane(otid() >> 6);
    LAS unsigned char* wl = lds + wid * DW_BYTES;
    for (int j = 0; j < 2; ++j) { const int wu = 2 * wid + j; dil_wave_unit<0>(wl, DIL, Y, ST, LSE, BT, b, h, 0, c * 16 + wu); }
    __syncthreads();
    for (int j = 0; j < 2; ++j) { const int wu = 2 * wid + j; dil_wave_unit<1>(wl, DIL, Y, ST, LSE, BT, b, h, wu >> 2, c * 4 + (wu & 3)); }
    __syncthreads();
    for (int j = 0; j < 2; ++j) { const int wu = 2 * wid + j; dil_wave_unit<2>(wl, DIL, Y, ST, LSE, BT, b, h, wu, c); }
    __syncthreads();
}

typedef __attribute__((address_space(1))) unsigned gu32;
#define XB_TMO      128
#define XB_XCNT(j)  (256  + 64 * (j))
#define XB_XSUB(j)  (1280 + 64 * (j))
#define XB_XGEN(j)  (2304 + 64 * (j))
#define XB_TOP      3328
#define XB_TOPGEN   3392
#define XCD_BAR_WORDS 3456
#define XB_SPIN_CAP (1u << 18)

__device__ __forceinline__ unsigned xb_ld(unsigned* p)              { return __hip_atomic_load(p, __ATOMIC_RELAXED, __HIP_MEMORY_SCOPE_AGENT); }
__device__ __forceinline__ unsigned xb_add(unsigned* p, unsigned v) { return __hip_atomic_fetch_add(p, v, __ATOMIC_RELAXED, __HIP_MEMORY_SCOPE_AGENT); }
__device__ __forceinline__ unsigned xb_xcc_id() { return (unsigned)__builtin_amdgcn_s_getreg((3 << 11) | 20) & 0xFu; }
#define XB_SPIN(cond, bar) do { unsigned _sp = 0; while (cond) { __builtin_amdgcn_s_sleep(1); \
    if ((++_sp & 255u) == 0u) { if (xb_ld(&(bar)[XB_TMO])) break; if (_sp > XB_SPIN_CAP) { atomicAdd(&(bar)[XB_TMO], 1u); break; } } } } while (0)

struct XcdBarrier {
    unsigned* bar; unsigned x;
    volatile LAS unsigned* st;
};

__device__ __forceinline__ XcdBarrier xcd_barrier_post(unsigned* bar, volatile LAS unsigned* st) {
    XcdBarrier b; b.bar = bar; b.x = xb_xcc_id(); b.st = st;
    if (threadIdx.x == 0) (void)xb_add(&bar[XB_XCNT(b.x)], 1u);
    return b;
}
__device__ __forceinline__ void xcd_barrier_complete(unsigned* bar, unsigned x, unsigned& nloc, unsigned& nx) {
    const unsigned G = gridDim.x * gridDim.y * gridDim.z;
    unsigned sum, cnt, mine, sp = 0u;
    for (;;) {
        sum = 0u; cnt = 0u; mine = 0u;
#pragma unroll
        for (unsigned j = 0; j < 16; ++j) { const unsigned c = xb_ld(&bar[XB_XCNT(j)]); sum += c; cnt += (c > 0u) ? 1u : 0u; mine = (j == x) ? c : mine; }
        if (sum == G) break;
        __builtin_amdgcn_s_sleep(1);
        if ((++sp & 255u) == 0u) { if (xb_ld(&bar[XB_TMO])) break; if (sp > XB_SPIN_CAP) { atomicAdd(&bar[XB_TMO], 1u); break; } }
    }
    nloc = mine > 0u ? mine : 1u; nx = cnt > 0u ? cnt : 1u;
}

__device__ __forceinline__ void xcd_barrier(const XcdBarrier& b) {
    asm volatile("s_waitcnt vmcnt(0)" ::: "memory");
    __syncthreads();
    if (threadIdx.x == 0) {
        unsigned* bar = b.bar;
        __builtin_amdgcn_s_waitcnt(0);
        unsigned nloc = b.st[0], nx = b.st[1];
        if (nloc == 0u) { xcd_barrier_complete(bar, b.x, nloc, nx); b.st[0] = nloc; b.st[1] = nx; }
        const unsigned old = xb_add(&bar[XB_XSUB(b.x)], 1u);
        const unsigned gen = old / nloc;
        if (old + 1u == (gen + 1u) * nloc) {
            __builtin_amdgcn_fence(__ATOMIC_RELEASE, "agent");
            asm volatile("s_waitcnt vmcnt(0)" ::: "memory");
            const unsigned og = xb_add(&bar[XB_TOP], 1u);
            const unsigned tg = og / nx;
            if (og + 1u == (tg + 1u) * nx) xb_add(&bar[XB_TOPGEN], 1u);
            else XB_SPIN(xb_ld(&bar[XB_TOPGEN]) == tg, bar);
            __builtin_amdgcn_fence(__ATOMIC_ACQUIRE, "agent");
            xb_add(&bar[XB_XGEN(b.x)], 1u);
            asm volatile("s_waitcnt vmcnt(0)" ::: "memory");
        } else {
            XB_SPIN(xb_ld(&bar[XB_XGEN(b.x)]) == gen, bar);
            __builtin_amdgcn_fence(__ATOMIC_ACQUIRE, "agent");
            asm volatile("s_waitcnt vmcnt(0)" ::: "memory");
        }
    }
    __syncthreads();
}

constexpr int NPHASE = 2 + DEPTH * 7;
__device__ __forceinline__ unsigned char* opaque_ptr(unsigned char* p) { asm volatile("" : "+s"(p)); return p; }
#define GEMM(EpiT, Ev, Ap, Bp, Nn, Kk, Ld) do { pg8::Gemm g_{(Ap), (Bp), NTOK, (Nn), (Kk), (Ld), 1 << 30, 0}; pg8::StaticOrder S_; S_.init(NTOK, (Nn), G, obid()); \
        pg8::gemm_phase<EpiT, pg8::StaticOrder, true, true>(lds, g_, S_, (Ev)); } while (0)
#define BF(off) ((bf16_t*)(unsigned char*)(ws + (off)))
#define FP(off) ((float*)(unsigned char*)(ws + (off)))
#define WB(l_, off) ((bf16_t*)(unsigned char*)(ws + WS_W + (size_t)((l_) & 1) * WS_WSTRIDE + (off)))
__global__ void __launch_bounds__(NTHR, 2) mega_fwd(Params P0) {
    extern __shared__ __attribute__((aligned(16))) unsigned char lds_raw[];
    LAS unsigned char* lds = (LAS unsigned char*)lds_raw;
    cg::grid_group grid = cg::this_grid();
    { volatile LAS unsigned* misc = (volatile LAS unsigned*)(lds + RING_BYTES + 320); if (otid() < 32) misc[otid()] = 0u; }
    __syncthreads();
    XcdBarrier xbar = xcd_barrier_post((unsigned*)(P0.ws + WS_CTL) + 1024, (volatile LAS unsigned*)(lds + RING_BYTES + 320) + 8);
    { volatile LAS unsigned* misc = (volatile LAS unsigned*)(lds + RING_BYTES + 320);
      if (otid() == 0) { const unsigned x = xb_xcc_id(); misc[16] = xb_add((unsigned*)(P0.ws + WS_CTL) + 8192 + 64 * x, 1u); misc[17] = x; } }
    __syncthreads();
    const int ph_lo = P0.ph_lo, ph_hi = P0.ph_hi;
    for (int ph = ph_lo; ph < ph_hi; ++ph) {
        int G_ = (int)gridDim.x; asm volatile("" : "+s"(G_)); const int G = G_;
        typedef const __attribute__((address_space(4))) Params* kparams_t;
        kparams_t kp_ = (kparams_t)__builtin_amdgcn_kernarg_segment_ptr(); asm volatile("" : "+s"(kp_));
        const Params& P = *(const Params*)kp_;
        __attribute__((address_space(1))) unsigned char* ws = (__attribute__((address_space(1))) unsigned char*)opaque_ptr(P.ws);
        const int l = ph > 1 ? (ph - 2) / 7 : 0, kk_ = ph > 1 ? (ph - 2) % 7 + 2 : ph; const int k = kk_ >= 4 ? kk_ + 1 : kk_;
        const size_t modl = (size_t)l * 16 * 6144;
        switch (k) {
        case 0: {
            phase0(P, lds, G);
            float* SSQ = FP(WS_SSQ);
            float* SKR = FP(WS_SSQKR);
            for (int i = obid() * NTHR + otid(); i < 2 * NTOK; i += G * NTHR) { SSQ[i] = 0.f; if (i < NTOK) SKR[i] = 0.f; }
            __syncthreads();
            conv_weights(P, 0, (unsigned char*)(ws + WS_W), lds, G);
        } break;
        case 1: {
            bias_phase(P, lds, G);
            prepass_phase(P.x, P.norm1_g, FP(WS_MOD), 1024, BF(WS_H), FP(WS_SSQ) + 2 * NTOK, G);
        } break;
        case 2: {
            pg8::EpiIn E{BF(WS_PA), BF(WS_DIL), BF(WS_GATES), FP(WS_SSQ), FP(WS_SSQ) + NTOK, FP(WS_SSQKR), P.q_norm_b + l * 64, P.k_norm_b + l * 64, FP(WS_SSQ) + 2 * NTOK, FP(WS_BW1) + (size_t)l * 16 * 4096};
            GEMM(pg8::EpiIn, E, BF(WS_H), WB(l, W_IN), NIN, 1024, 1024);
        } break;
        case 3: {
            pg8::EpiRowScale2 E{(unsigned char*)ws, P.k_norm_a + l * 96};
            { pg8::Gemm g_{BF(WS_PA), WB(l, W_Q), NTOK, 1792, 256, 512, 3, 256}; pg8::StaticOrder S_; S_.init(NTOK, 1792, G, obid()); pg8::gemm_phase<pg8::EpiRowScale2, pg8::StaticOrder, true, true>(lds, g_, S_, E); }
        } break;
        case 5: {
            { float* SSQ = FP(WS_SSQ); float* SKR = FP(WS_SSQKR); for (int i = obid() * NTHR + otid(); i < 4 * NTOK; i += G * NTHR) { SSQ[i] = 0.f; if (i < NTOK) SKR[i] = 0.f; } }
            if (l + 1 < DEPTH) { conv_weights(P, l + 1, (unsigned char*)(ws + WS_W + (size_t)((l + 1) & 1) * WS_WSTRIDE), lds, G); __syncthreads(); }
            bf16_t* Y = BF(WS_KVRAW);
            if (G == 256) { int xcd = obid() & 7, slot = obid() >> 3;
                { const unsigned* tk = (const unsigned*)(ws + WS_CTL) + 8192; bool even = true;
#pragma unroll
                  for (int x = 0; x < 8; ++x) even = even && (__hip_atomic_load(tk + 64 * x, __ATOMIC_RELAXED, __HIP_MEMORY_SCOPE_AGENT) == 32u);
                  if (even) { volatile LAS unsigned* misc = (volatile LAS unsigned*)(lds + RING_BYTES + 320); slot = (int)misc[16]; xcd = (int)misc[17]; } }
                slot = __builtin_amdgcn_readfirstlane(slot); xcd = __builtin_amdgcn_readfirstlane(xcd);
                for (int i = 0; i < 8; ++i) { const int bh = ((i * 2 + (slot >> 4)) << 3) + xcd; mla_unit(lds, BF(WS_H), BF(WS_K), BF(WS_V), Y, P.q_norm_a + l * 96, FP(WS_ROPE), bh >> 3, bh & 7, slot & 15); }
            } else { for (int u = obid(); u < NB * NH * 16; u += G) mla_unit(lds, BF(WS_H), BF(WS_K), BF(WS_V), Y, P.q_norm_a + l * 96, FP(WS_ROPE), u >> 7, (u >> 4) & 7, u & 15); }
            __syncthreads();
            for (int u = obid(); u < NB * NH * 4; u += G) dil_unit(lds, BF(WS_DIL), Y, BF(WS_PA), FP(WS_LSE), FP(WS_BT), u >> 5, (u >> 2) & 7, u & 3);
        } break;
        case 6: {
            pg8::EpiGate2 E{BF(WS_H), BF(WS_GATES)}; GEMM(pg8::EpiGate2, E, BF(WS_KVRAW), WB(l, W_A), 1024, 1024, 1024);
        } break;
        case 7: {
            pg8::EpiResid E{(const __attribute__((address_space(1))) float*)(l == 0 ? P.x : P.out), (__attribute__((address_space(1))) float*)P.out, FP(WS_MOD) + modl + 2048, BF(WS_KVRAW), P.norm2_g + l * DM, FP(WS_MOD) + modl + 4096, FP(WS_SSQ) + 3 * NTOK};
            GEMM(pg8::EpiResid, E, BF(WS_H), WB(l, W_O), 1024, 1024, 1024);
        } break;
        case 8: {
            pg8::EpiSwiGLU E{BF(WS_HID), FP(WS_SSQ) + 3 * NTOK, FP(WS_BW2) + (size_t)l * 16 * 5632}; GEMM(pg8::EpiSwiGLU, E, BF(WS_KVRAW), WB(l, W_1), 5632, 1024, 1024);
        } break;
        default: {
            const bool nxt = l + 1 < DEPTH; const size_t modn = (size_t)(l + 1) * 16 * 6144;
            pg8::EpiResid E{(const __attribute__((address_space(1))) float*)P.out, (__attribute__((address_space(1))) float*)P.out, FP(WS_MOD) + modl + 5120, nxt ? BF(WS_H) : (bf16_t*)nullptr, P.norm1_g + (nxt ? (l + 1) * DM : 0), FP(WS_MOD) + (nxt ? modn + 1024 : 0), FP(WS_SSQ) + 2 * NTOK};
            GEMM(pg8::EpiResid, E, BF(WS_HID), WB(l, W_2), 1024, FFH, FFH);
        } break;
        }
        if (ph + 1 < ph_hi) { if (ph == ph_lo) grid.sync(); else xcd_barrier(xbar); }
    }
}

extern "C" void kernel_launch(void* const* d_in, const int* in_sizes, int n_in, void* d_out, int out_size, void* d_ws, size_t ws_size, hipStream_t stream) {
    static int grid = 0;
    if (grid == 0) {
        if (n_in != 23 || ws_size < WS_END) { fprintf(stderr, "kernel_launch: unexpected n_in %d / ws_size %zu\n", n_in, ws_size); grid = -1; return; }
        int dev = 0, cus = 0, per_cu = 0;
        (void)hipGetDevice(&dev); (void)hipDeviceGetAttribute(&cus, hipDeviceAttributeMultiprocessorCount, dev);
        if (hipFuncSetAttribute((const void*)mega_fwd, hipFuncAttributeMaxDynamicSharedMemorySize, LDS_BYTES) != hipSuccess) { fprintf(stderr, "kernel_launch: hipFuncSetAttribute failed\n"); grid = -1; return; }
        if (hipOccupancyMaxActiveBlocksPerMultiprocessor(&per_cu, (const void*)mega_fwd, NTHR, LDS_BYTES) != hipSuccess || per_cu < 1) { fprintf(stderr, "kernel_launch: occupancy query gave %d\n", per_cu); per_cu = 1; }
        (void)hipGetLastError();
        grid = cus * per_cu;
    }
    if (grid < 0) return;
    Params p{};
    const float** fp = (const float**)&p.x;
    p.x = (const float*)d_in[0]; p.c = (const float*)d_in[1]; p.pos = (const int*)d_in[2]; p.rel_bias = (const float*)d_in[3]; p.norm1_g = (const float*)d_in[4]; p.norm2_g = (const float*)d_in[5];
    p.ada_w = (const float*)d_in[6]; p.ada_b = (const float*)d_in[7]; p.w_in = (const float*)d_in[8]; p.q_a_norm = (const float*)d_in[9]; p.w_q_b = (const float*)d_in[10]; p.kv_a_norm = (const float*)d_in[11];
    p.w_kv_b = (const float*)d_in[12]; p.q_norm_a = (const float*)d_in[13]; p.k_norm_a = (const float*)d_in[14]; p.q_norm_b = (const float*)d_in[15]; p.k_norm_b = (const float*)d_in[16];
    p.w_branch_a = (const float*)d_in[17]; p.w_branch_b = (const float*)d_in[18]; p.w_out = (const float*)d_in[19]; p.w_ffn_gate = (const float*)d_in[20]; p.w_ffn_up = (const float*)d_in[21]; p.w_ffn_down = (const float*)d_in[22];
    (void)fp;
    p.out = (float*)d_out; p.ws = (unsigned char*)d_ws;
    for (int i = 0; i < 16; ++i) p.inv_freq[i] = (float)pow(10000.0, -(double)i / 16.0);
    p.ph_lo = 0; p.ph_hi = NPHASE;
    if (hipMemsetAsync((char*)d_ws + WS_CTL, 0, CTL_BYTES, stream) != hipSuccess) { fprintf(stderr, "kernel_launch: memset failed\n"); return; }
    void* args[] = {&p};
    hipError_t e = hipLaunchCooperativeKernel((const void*)mega_fwd, dim3(grid), dim3(NTHR), args, LDS_BYTES, stream);
    if (e != hipSuccess) fprintf(stderr, "kernel_launch: cooperative launch failed: %s (grid %d)\n", hipGetErrorString(e), grid);
}
```
